# Optimizing an MI355X kernel written in HIP

```python
import math
import jax, jax.numpy as jnp
from jax import lax
import numpy as np

D_MODEL = 2048
BATCH = 1
SEQ = 8192
DEPTH = 2

GRID_W = 64
CTX_LEN = 256
GLA_HEADS = D_MODEL // 512
GLA_DK = 128
GLA_DV = 128
GLA_GATE_RANK = 16
GLA_GATE_NORM = 16.0
GLA_CHUNK = 64
DIFF_HEADS = D_MODEL // 512
DIFF_DQK = 64
DIFF_DV = 128
Q_BLOCK = 128
DELTA_HEADS = D_MODEL // 256
DELTA_DK = 128
DELTA_DV = 128
DELTA_CONV = 5
DELTA_CHUNK = 64
ROPE_BASE = 10000.0
RMS_EPS = 1e-6
L2_EPS = 1e-6
D_FF = ((8 * D_MODEL + 3 * 256 - 1) // (3 * 256)) * 256
GLA_W = GLA_HEADS * GLA_DV
DIFF_W = DIFF_HEADS * DIFF_DV
DELTA_W = DELTA_HEADS * DELTA_DV
IN_SIZES = (
    GLA_HEADS * GLA_DK, GLA_HEADS * GLA_DK, GLA_W, 2 * GLA_GATE_RANK, GLA_W,
    DIFF_HEADS * 2 * DIFF_DQK, DIFF_HEADS * 2 * DIFF_DQK, DIFF_W,
    DELTA_HEADS * DELTA_DK, DELTA_HEADS * DELTA_DK, DELTA_W,
    2 * DELTA_HEADS, 2 * DELTA_HEADS, DELTA_W,
    3 * D_MODEL,
)
N_IN = sum(IN_SIZES)

kernel_name = 'hybrid_gla_diffattn_gdn_block'


def rmsnorm(x, w):
    xf = x.astype(jnp.float32)
    y = xf * lax.rsqrt(jnp.mean(xf * xf, axis=-1, keepdims=True) + RMS_EPS)
    return (y * w.astype(jnp.float32)).astype(x.dtype)


def l2norm(x):
    xf = x.astype(jnp.float32)
    return (xf * lax.rsqrt(jnp.sum(xf * xf, axis=-1, keepdims=True) + L2_EPS)).astype(x.dtype)


def modulate(h, shift, scale):
    return h * (1.0 + scale) + shift


def to_heads(t, n_heads):
    b, l, _ = t.shape
    return t.reshape(b, l, n_heads, -1).transpose(0, 2, 1, 3)


def from_heads(t):
    b, h, l, d = t.shape
    return t.transpose(0, 2, 1, 3).reshape(b, l, h * d)


def split_in(z):
    return jnp.split(z, np.cumsum(IN_SIZES)[:-1].tolist(), axis=-1)


def flip_seq(t):
    return jnp.flip(t, axis=2)


def axial_rope_tables(n_tokens):
    rows = n_tokens // GRID_W
    row_ids = jnp.repeat(jnp.arange(rows, dtype=jnp.float32), GRID_W)
    col_ids = jnp.tile(jnp.arange(GRID_W, dtype=jnp.float32), rows)
    half = DIFF_DQK // 2
    inv = 1.0 / (ROPE_BASE ** (jnp.arange(0, half, 2, dtype=jnp.float32) / half))
    ang_r = row_ids[:, None] * inv
    ang_c = col_ids[:, None] * inv
    return (jnp.cos(ang_r), jnp.sin(ang_r), jnp.cos(ang_c), jnp.sin(ang_c))


def rotate(x, cos, sin):
    x1, x2 = jnp.split(x, 2, axis=-1)
    return jnp.concatenate([x1 * cos - x2 * sin, x2 * cos + x1 * sin], axis=-1)


def apply_axial_rope(x, rope):
    cr, sr, cc, sc = rope
    xr, xc = jnp.split(x, 2, axis=-1)
    return jnp.concatenate([rotate(xr, cr, sr), rotate(xc, cc, sc)], axis=-1).astype(x.dtype)


def centred_depthwise_conv(x, w):
    k_size = w.shape[0]
    pad = k_size // 2
    n = x.shape[1]
    xp = jnp.pad(x, ((0, 0), (pad, pad), (0, 0)))
    out = xp[:, 0:n] * w[0]
    for i in range(1, k_size):
        out = out + xp[:, i:i + n] * w[i]
    return out


def bidirectional_scan(scan_fn, shared_ctx, gates_ctx, shared_lat, gates_lat, s0):
    o_cf, s_f = scan_fn(*shared_ctx, *gates_ctx[0], s0)
    o_cb, s_b = scan_fn(*[flip_seq(t) for t in shared_ctx], *[flip_seq(t) for t in gates_ctx[1]], s0)
    o_lf, _ = scan_fn(*shared_lat, *gates_lat[0], s_f)
    o_lb, _ = scan_fn(*[flip_seq(t) for t in shared_lat], *[flip_seq(t) for t in gates_lat[1]], s_b)
    return o_lf + flip_seq(o_lb), o_cf + flip_seq(o_cb)


def gla_chunk_scan(q, k, v, g, s0):
    b, h, l, _ = q.shape
    dv = v.shape[-1]
    n = l // GLA_CHUNK

    def chunks(t):
        return jnp.moveaxis(t.astype(jnp.float32).reshape(b, h, n, GLA_CHUNK, t.shape[-1]), 2, 0)

    qc, kc, vc = chunks(q), chunks(k), chunks(v)
    bc = lax.cumsum(chunks(g), axis=3)
    causal = jnp.tril(jnp.ones((GLA_CHUNK, GLA_CHUNK), dtype=bool))[:, :, None]

    def step(state, xs):
        qi, ki, vi, bi = xs
        decay = jnp.exp(jnp.where(causal, bi[:, :, :, None, :] - bi[:, :, None, :, :], -jnp.inf))
        att = jnp.einsum('bhid,bhjd,bhijd->bhij', qi, ki, decay)
        o = jnp.einsum('bhij,bhjv->bhiv', att, vi) + jnp.einsum('bhid,bhdv->bhiv', qi * jnp.exp(bi), state)
        b_last = bi[:, :, -1:, :]
        state = state * jnp.exp(b_last)[:, :, 0, :, None] + jnp.einsum('bhjd,bhjv->bhdv', ki * jnp.exp(b_last - bi), vi)
        return state, o

    s_final, o = lax.scan(step, s0, (qc, kc, vc, bc))
    o = jnp.moveaxis(o, 0, 2).reshape(b, h, l, dv)
    return o.astype(v.dtype), s_final


def gated_delta_chunk_scan(q, k, v, g, beta, s0):
    f32 = jnp.float32
    b, h, l, dk = q.shape
    dv = v.shape[-1]
    cs = DELTA_CHUNK
    n = l // cs
    qc = q.astype(f32).reshape(b, h, n, cs, dk)
    kc = k.astype(f32).reshape(b, h, n, cs, dk)
    vc = v.astype(f32).reshape(b, h, n, cs, dv)
    gc = lax.cumsum(g.astype(f32).reshape(b, h, n, cs), axis=3)
    bc = beta.astype(f32).reshape(b, h, n, cs)[..., None]
    incl = jnp.tril(jnp.ones((cs, cs), dtype=bool))
    strict = jnp.tril(jnp.ones((cs, cs), dtype=bool), -1)
    decay = jnp.exp(jnp.where(incl, gc[..., :, None] - gc[..., None, :], -jnp.inf))
    kb = kc * bc
    a_strict = jnp.where(strict, jnp.einsum('bhnid,bhnjd->bhnij', kb, kc) * decay, 0.0)
    rhs = jnp.concatenate([vc * bc, kb * jnp.exp(gc)[..., None]], axis=-1)
    sol = lax.linalg.triangular_solve(jnp.eye(cs, dtype=f32) + a_strict, rhs, left_side=True, lower=True)
    u, w = sol[..., :dv], sol[..., dv:]
    att = jnp.einsum('bhnid,bhnjd->bhnij', qc, kc) * decay
    q_dec = qc * jnp.exp(gc)[..., None]
    k_dec = kc * jnp.exp(gc[..., -1:] - gc)[..., None]
    g_last = jnp.exp(gc[..., -1])[..., None, None]
    xs = tuple(jnp.moveaxis(t, 2, 0) for t in (u, w, att, q_dec, k_dec, g_last))

    def step(state, xs_i):
        u_i, w_i, a_i, qd_i, kd_i, gl_i = xs_i
        v_new = u_i - jnp.einsum('bhcd,bhdv->bhcv', w_i, state)
        o = jnp.einsum('bhcd,bhdv->bhcv', qd_i, state) + jnp.einsum('bhij,bhjv->bhiv', a_i, v_new)
        state = state * gl_i + jnp.einsum('bhjd,bhjv->bhdv', kd_i, v_new)
        return state, o

    s_final, o = lax.scan(step, s0, xs)
    o = jnp.moveaxis(o, 0, 2).reshape(b, h, l, dv)
    return o.astype(v.dtype), s_final


def gla_prep(q, k, v, glr, w2, bias):
    qh = to_heads(q, GLA_HEADS) * (GLA_DK ** -0.5)
    kh = to_heads(k, GLA_HEADS)
    vh = to_heads(v, GLA_HEADS)
    gates = []
    for i, lr in enumerate(jnp.split(glr, 2, axis=-1)):
        gk = jax.nn.log_sigmoid((lr @ w2[i] + bias[i]).astype(jnp.float32)) / GLA_GATE_NORM
        gates.append((to_heads(gk, GLA_HEADS),))
    return (qh, kh, vh), (gates[0], gates[1])


def delta_prep(q, k, v, a, bt, conv_w, a_log, dt_bias):
    qkv = jax.nn.silu(centred_depthwise_conv(jnp.concatenate([q, k, v], axis=-1), conv_w))
    q, k, v = jnp.split(qkv, 3, axis=-1)
    qh = l2norm(to_heads(q, DELTA_HEADS)) * (DELTA_DK ** -0.5)
    kh = l2norm(to_heads(k, DELTA_HEADS))
    vh = to_heads(v, DELTA_HEADS)
    a_dirs = jnp.split(a.astype(jnp.float32), 2, axis=-1)
    b_dirs = jnp.split(bt.astype(jnp.float32), 2, axis=-1)
    gates = []
    for i in range(2):
        g = -jnp.exp(a_log[i].astype(jnp.float32)) * jax.nn.softplus(a_dirs[i] + dt_bias[i].astype(jnp.float32))
        beta = jax.nn.sigmoid(b_dirs[i])
        gates.append((jnp.swapaxes(g, 1, 2), jnp.swapaxes(beta, 1, 2)))
    return (qh, kh, vh), (gates[0], gates[1])


def diff_heads(t):
    b, l, _ = t.shape
    return t.reshape(b, l, DIFF_HEADS, 2, DIFF_DQK).transpose(0, 2, 3, 1, 4)


def diff_attend(q, k, v, lam):
    s = jnp.einsum('bhmqd,bhmkd->bhmqk', q, k).astype(jnp.float32) * (DIFF_DQK ** -0.5)
    p = jax.nn.softmax(s, axis=-1)
    a = p[:, :, 0] - lam * p[:, :, 1]
    return jnp.einsum('bhqk,bhkd->bhqd', a.astype(v.dtype), v)


def hybrid_mixer(h_lat, h_ctx, rope, lam_init, with_ctx_out, w_in, gla_gate_w2, gla_gate_b, gla_norm_w,
                 diff_lambda, diff_norm_w, delta_conv_w, delta_a_log, delta_dt_bias, delta_norm_w,
                 w_up_gla, w_up_diff, w_up_delta, w_o):
    lat = split_in(h_lat @ w_in)
    ctx = split_in(h_ctx @ w_in)
    bsz = h_lat.shape[0]

    ga_lat, gg_lat = gla_prep(lat[0], lat[1], lat[2], lat[3], gla_gate_w2, gla_gate_b)
    ga_ctx, gg_ctx = gla_prep(ctx[0], ctx[1], ctx[2], ctx[3], gla_gate_w2, gla_gate_b)
    s0a = jnp.zeros((bsz, GLA_HEADS, GLA_DK, GLA_DV), jnp.float32)
    oa_lat, oa_ctx = bidirectional_scan(gla_chunk_scan, ga_ctx, gg_ctx, ga_lat, gg_lat, s0a)

    lam_p = diff_lambda.astype(jnp.float32)
    lam = jnp.exp(jnp.sum(lam_p[0] * lam_p[1])) - jnp.exp(jnp.sum(lam_p[2] * lam_p[3])) + lam_init
    q_lat = apply_axial_rope(diff_heads(lat[5]), rope)
    k_lat = apply_axial_rope(diff_heads(lat[6]), rope)
    v_lat = to_heads(lat[7], DIFF_HEADS)
    k_ctx = diff_heads(ctx[6])
    v_ctx = to_heads(ctx[7], DIFF_HEADS)
    k_all = jnp.concatenate([k_ctx, k_lat], axis=3)
    v_all = jnp.concatenate([v_ctx, v_lat], axis=2)
    _, nh, _, l, dq = q_lat.shape
    n_blk = l // Q_BLOCK
    q_blocks = jnp.moveaxis(q_lat.reshape(bsz, nh, 2, n_blk, Q_BLOCK, dq), 3, 0)
    ob = lax.map(lambda qb: diff_attend(qb, k_all, v_all, lam), q_blocks)
    od_lat = jnp.moveaxis(ob, 0, 2).reshape(bsz, nh, l, DIFF_DV)

    ea_lat, eg_lat = delta_prep(lat[8], lat[9], lat[10], lat[11], lat[12], delta_conv_w, delta_a_log, delta_dt_bias)
    ea_ctx, eg_ctx = delta_prep(ctx[8], ctx[9], ctx[10], ctx[11], ctx[12], delta_conv_w, delta_a_log, delta_dt_bias)
    s0e = jnp.zeros((bsz, DELTA_HEADS, DELTA_DK, DELTA_DV), jnp.float32)
    oe_lat, oe_ctx = bidirectional_scan(gated_delta_chunk_scan, ea_ctx, eg_ctx, ea_lat, eg_lat, s0e)

    def finish(oa, od, oe, p):
        a = from_heads(rmsnorm(oa, gla_norm_w)) * jax.nn.silu(p[4])
        d = from_heads(rmsnorm(od, diff_norm_w) * (1.0 - lam_init))
        e = from_heads(rmsnorm(oe, delta_norm_w)) * jax.nn.silu(p[13])
        g_a, g_d, g_e = jnp.split(jax.nn.sigmoid(p[14]), 3, axis=-1)
        y = g_a * (a @ w_up_gla) + g_d * (d @ w_up_diff) + g_e * (e @ w_up_delta)
        return y @ w_o

    y_lat = finish(oa_lat, od_lat, oe_lat, lat)
    if not with_ctx_out:
        return y_lat, None
    od_ctx = diff_attend(diff_heads(ctx[5]), k_ctx, v_ctx, lam)
    y_ctx = finish(oa_ctx, od_ctx, oe_ctx, ctx)
    return y_lat, y_ctx


def swiglu(h, w1, w3, w2):
    return (jax.nn.silu(h @ w1) * (h @ w3)) @ w2


def setup_inputs(seed: int = 0) -> dict:
    key = jax.random.key(seed)
    ks = jax.random.split(key, 32)
    f32 = jnp.float32

    def nrm(k, shape, scale):
        return jax.random.normal(k, shape, f32) * scale

    def gain(k, shape):
        return 1.0 + 0.02 * jax.random.normal(k, shape, f32)

    dt = jnp.exp(jax.random.uniform(ks[17], (DEPTH, 2, DELTA_HEADS), f32, math.log(0.001), math.log(0.1)))
    return {
        'x': nrm(ks[0], (BATCH, SEQ, D_MODEL), 1.0),
        'c': nrm(ks[1], (BATCH, D_MODEL), 1.0),
        'ctx': nrm(ks[2], (BATCH, CTX_LEN, D_MODEL), 1.0),
        'c_ctx': nrm(ks[3], (D_MODEL,), 1.0),
        'ada_w': nrm(ks[4], (DEPTH, D_MODEL, 6 * D_MODEL), 0.5 * D_MODEL ** -0.5),
        'ada_b': nrm(ks[5], (DEPTH, 6 * D_MODEL), 0.02),
        'mix_pre_w': gain(ks[6], (DEPTH, D_MODEL)),
        'mix_post_w': gain(ks[7], (DEPTH, D_MODEL)),
        'ffn_pre_w': gain(ks[8], (DEPTH, D_MODEL)),
        'ffn_post_w': gain(ks[9], (DEPTH, D_MODEL)),
        'w_in': nrm(ks[10], (DEPTH, D_MODEL, N_IN), D_MODEL ** -0.5),
        'gla_gate_w2': nrm(ks[11], (DEPTH, 2, GLA_GATE_RANK, GLA_HEADS * GLA_DK), GLA_GATE_RANK ** -0.5),
        'gla_gate_b': nrm(ks[12], (DEPTH, 2, GLA_HEADS * GLA_DK), 0.02),
        'gla_norm_w': gain(ks[13], (DEPTH, GLA_DV)),
        'diff_lambda': nrm(ks[14], (DEPTH, 4, DIFF_DQK), 0.1),
        'diff_norm_w': gain(ks[15], (DEPTH, DIFF_DV)),
        'delta_conv_w': nrm(ks[16], (DEPTH, DELTA_CONV, 3 * DELTA_W), DELTA_CONV ** -0.5),
        'delta_a_log': jnp.log(jax.random.uniform(ks[18], (DEPTH, 2, DELTA_HEADS), f32, 1.0, 16.0)),
        'delta_dt_bias': dt + jnp.log(-jnp.expm1(-dt)),
        'delta_norm_w': gain(ks[19], (DEPTH, DELTA_DV)),
        'w_up_gla': nrm(ks[20], (DEPTH, GLA_W, D_MODEL), GLA_W ** -0.5),
        'w_up_diff': nrm(ks[21], (DEPTH, DIFF_W, D_MODEL), DIFF_W ** -0.5),
        'w_up_delta': nrm(ks[22], (DEPTH, DELTA_W, D_MODEL), DELTA_W ** -0.5),
        'w_o': nrm(ks[23], (DEPTH, D_MODEL, D_MODEL), D_MODEL ** -0.5),
        'ffn_w1': nrm(ks[24], (DEPTH, D_MODEL, D_FF), D_MODEL ** -0.5),
        'ffn_w3': nrm(ks[25], (DEPTH, D_MODEL, D_FF), D_MODEL ** -0.5),
        'ffn_w2': nrm(ks[26], (DEPTH, D_FF, D_MODEL), D_FF ** -0.5),
    }


def reference(x, c, ctx, c_ctx, ada_w, ada_b, mix_pre_w, mix_post_w, ffn_pre_w, ffn_post_w, w_in,
              gla_gate_w2, gla_gate_b, gla_norm_w, diff_lambda, diff_norm_w, delta_conv_w, delta_a_log,
              delta_dt_bias, delta_norm_w, w_up_gla, w_up_diff, w_up_delta, w_o, ffn_w1, ffn_w3, ffn_w2):
    rope = axial_rope_tables(x.shape[1])
    for layer in range(DEPTH):
        with_ctx_out = layer < DEPTH - 1
        lam_init = 0.8 - 0.6 * math.exp(-0.3 * layer)
        mod_lat = jnp.split((jax.nn.silu(c) @ ada_w[layer] + ada_b[layer])[:, None, :], 6, axis=-1)
        mod_ctx = jnp.split(jax.nn.silu(c_ctx) @ ada_w[layer] + ada_b[layer], 6, axis=-1)
        h_lat = modulate(rmsnorm(x, mix_pre_w[layer]), mod_lat[0], mod_lat[1])
        h_ctx = modulate(rmsnorm(ctx, mix_pre_w[layer]), mod_ctx[0], mod_ctx[1])
        y_lat, y_ctx = hybrid_mixer(h_lat, h_ctx, rope, lam_init, with_ctx_out, w_in[layer],
                                    gla_gate_w2[layer], gla_gate_b[layer], gla_norm_w[layer],
                                    diff_lambda[layer], diff_norm_w[layer], delta_conv_w[layer],
                                    delta_a_log[layer], delta_dt_bias[layer], delta_norm_w[layer],
                                    w_up_gla[layer], w_up_diff[layer], w_up_delta[layer], w_o[layer])
        x = x + mod_lat[2] * rmsnorm(y_lat, mix_post_w[layer])
        h_lat = modulate(rmsnorm(x, ffn_pre_w[layer]), mod_lat[3], mod_lat[4])
        x = x + mod_lat[5] * rmsnorm(swiglu(h_lat, ffn_w1[layer], ffn_w3[layer], ffn_w2[layer]), ffn_post_w[layer])
        if with_ctx_out:
            ctx = ctx + mod_ctx[2] * rmsnorm(y_ctx, mix_post_w[layer])
            h_ctx = modulate(rmsnorm(ctx, ffn_pre_w[layer]), mod_ctx[3], mod_ctx[4])
            ctx = ctx + mod_ctx[5] * rmsnorm(swiglu(h_ctx, ffn_w1[layer], ffn_w3[layer], ffn_w2[layer]), ffn_post_w[layer])
    return x
```

```cpp
#include <hip/hip_runtime.h>
#include <hip/hip_cooperative_groups.h>
#include <hip/hip_bf16.h>
#include <cstdio>
#include <cstdint>
#include <cmath>
namespace cg = cooperative_groups;
#ifndef SKIP_G1
#define SKIP_G1 0
#endif
#ifndef SKIP_G2
#define SKIP_G2 0
#endif
#ifndef SKIP_G3
#define SKIP_G3 0
#endif
#ifndef SKIP_G4
#define SKIP_G4 0
#endif
#ifndef SKIP_G5
#define SKIP_G5 0
#endif
#ifndef REP_G1
#define REP_G1 1
#endif
#ifndef REP_G3
#define REP_G3 1
#endif
#ifndef REP_G4
#define REP_G4 1
#endif
#ifndef REP_G5
#define REP_G5 1
#endif
#ifndef REP_C1
#define REP_C1 1
#endif
#ifndef REP_C2
#define REP_C2 1
#endif
#ifndef REP_C3
#define REP_C3 1
#endif
#ifndef REP_C4
#define REP_C4 1
#endif
#ifndef REP_GEMM
#define REP_GEMM 1
#endif
#ifndef REP_CHUNK
#define REP_CHUNK 1
#endif
#ifndef REP_ATTN
#define REP_ATTN 1
#endif
#ifndef REP_ROWS
#define REP_ROWS 1
#endif
#ifndef REP_P0
#define REP_P0 1
#endif
#ifndef REP_SYNC
#define REP_SYNC 1
#endif
namespace pg8 {
#define PG8_LAS __attribute__((address_space(3)))
typedef unsigned short bf16_t;
typedef short bf16x8 __attribute__((ext_vector_type(8)));
typedef float f32x4 __attribute__((ext_vector_type(4)));
typedef unsigned u32x4 __attribute__((ext_vector_type(4)));
constexpr int BM = 256, BK = 64, HALF = 128, HTB = HALF * BK * 2  , STAGE_BYTES = 8 * HTB, NXCD = 8, WGM = 8;

__host__ __device__ __forceinline__ int lds_byte(int r, int c) { const int st = (r >> 4) * 2 + (c >> 5), rr = r & 15, cc = c & 31, ob = rr * 64 + cc * 2; return st * 1024 + (ob ^ (((ob >> 9) & 1) << 5)); }
__host__ __device__ __forceinline__ void stage_rc(int b, int& R, int& C) { const int st = b / 1024, sb = b % 1024, swz = sb ^ (((sb >> 9) & 1) << 5); R = (st >> 1) * 16 + swz / 64; C = (st & 1) * 32 + (swz % 64) / 2; }
__host__ __device__ __forceinline__ int perm32(int rho) { const int n = rho >> 4, i = rho & 15; return 8 * (i >> 2) + 4 * n + (i & 3); }

struct Unit { int pm, pn; };
struct Gemm { const bf16_t* A; const bf16_t* Bt; int M, N, K; };

struct StaticOrder {
    int nM, nN, nwg, G, c, rep = 1, pmoff = 0;
    __host__ __device__ void init(int M, int N, int G_, int c_) { nM = M / BM; nN = N / BM; nwg = nM * nN; G = G_; c = c_; }
    __host__ __device__ bool next(int i, Unit& u) const {
        const long L = (long)(i / rep) * G + c; if (L >= nwg) return false;
        int wgid = (int)L; { const int q = nwg / NXCD, r = nwg % NXCD, xcd = wgid % NXCD, off = wgid / NXCD; wgid = (xcd < r ? xcd * (q + 1) : r * (q + 1) + (xcd - r) * q) + off; }
        const int nig = WGM * nN, gid = wgid / nig, fm = gid * WGM, gsz = (nM - fm) < WGM ? (nM - fm) : WGM;
        u.pm = pmoff + fm + ((wgid % nig) % gsz); u.pn = (wgid % nig) / gsz; return true;
    }
    __device__ __forceinline__ void a_ready(const Unit&) const {}
    __device__ __forceinline__ void done(const Unit&) const {}
};

__device__ __forceinline__ unsigned cvt_pk_bf16(float lo, float hi) { unsigned r; asm volatile("v_cvt_pk_bf16_f32 %0, %1, %2" : "=v"(r) : "v"(lo), "v"(hi)); return r; }
typedef float f32x2 __attribute__((ext_vector_type(2)));
typedef unsigned u32x2 __attribute__((ext_vector_type(2)));
__device__ __forceinline__ float ep_sigmoid(float x) { return __builtin_amdgcn_rcpf(1.0f + __expf(-x)); }
struct EpiZ {
    static constexpr bool PERM = true, AFTER_DRAIN = false;
    bf16_t* Z; int ldz; float* ZG;
    __device__ __forceinline__ void operator()(const f32x4 (&acc)[2][2][4][2], const Unit& u, int wr, int wc, int fr, int fq) const {
        const int row0 = u.pm * BM + wr * 64 + fr, col0 = u.pn * BM + wc * 32 + 8 * fq;
#pragma unroll
        for (int ai = 0; ai < 2; ++ai)
#pragma unroll
            for (int m = 0; m < 4; ++m) { const int row = row0 + ai * HALF + m * 16;
#pragma unroll
                for (int bj = 0; bj < 2; ++bj) { const int c = col0 + bj * HALF; const f32x4 v0 = acc[ai][bj][m][0], v1 = acc[ai][bj][m][1];
                    u32x4 w; w.x = cvt_pk_bf16(v0[0], v0[1]); w.y = cvt_pk_bf16(v0[2], v0[3]); w.z = cvt_pk_bf16(v1[0], v1[1]); w.w = cvt_pk_bf16(v1[2], v1[3]);
                    *(u32x4*)(Z + (size_t)row * ldz + c) = w;
                    int gc = -1; if (c >= 1536 && c < 1568) gc = c - 1536; else if (c >= 6688 && c < 6720) gc = 32 + c - 6688;
                    if (gc >= 0) { float* g = ZG + (size_t)row * 64 + gc; *(f32x4*)g = v0; *(f32x4*)(g + 4) = v1; } } }
    }
};
template <int MODE> struct EpiGate {
    static constexpr bool PERM = true, AFTER_DRAIN = false;
    const bf16_t* Zg; int ldz; float* YF; bf16_t* YB; int ldc;
    __device__ __forceinline__ void operator()(const f32x4 (&acc)[2][2][4][2], const Unit& u, int wr, int wc, int fr, int fq) const {
        const int row0 = u.pm * BM + wr * 64 + fr, col0 = u.pn * BM + wc * 32 + 8 * fq;
#pragma unroll
        for (int ai = 0; ai < 2; ++ai)
#pragma unroll
            for (int m = 0; m < 4; ++m) { const int row = row0 + ai * HALF + m * 16;
#pragma unroll
                for (int bj = 0; bj < 2; ++bj) { const int c = col0 + bj * HALF;
                    const u32x4 gz = *(const u32x4*)(Zg + (size_t)row * ldz + c);
                    f32x4 g0, g1;
                    g0[0] = ep_sigmoid(__builtin_bit_cast(float, gz.x << 16)); g0[1] = ep_sigmoid(__builtin_bit_cast(float, gz.x & 0xffff0000u));
                    g0[2] = ep_sigmoid(__builtin_bit_cast(float, gz.y << 16)); g0[3] = ep_sigmoid(__builtin_bit_cast(float, gz.y & 0xffff0000u));
                    g1[0] = ep_sigmoid(__builtin_bit_cast(float, gz.z << 16)); g1[1] = ep_sigmoid(__builtin_bit_cast(float, gz.z & 0xffff0000u));
                    g1[2] = ep_sigmoid(__builtin_bit_cast(float, gz.w << 16)); g1[3] = ep_sigmoid(__builtin_bit_cast(float, gz.w & 0xffff0000u));
                    f32x4 v0 = acc[ai][bj][m][0] * g0, v1 = acc[ai][bj][m][1] * g1;
                    float* y = YF + (size_t)row * ldc + c;
                    if (MODE >= 1) { v0 += *(const f32x4*)y; v1 += *(const f32x4*)(y + 4); }
                    if (MODE <= 1) { *(f32x4*)y = v0; *(f32x4*)(y + 4) = v1; }
                    else { u32x4 w; w.x = cvt_pk_bf16(v0[0], v0[1]); w.y = cvt_pk_bf16(v0[2], v0[3]); w.z = cvt_pk_bf16(v1[0], v1[1]); w.w = cvt_pk_bf16(v1[2], v1[3]);
                        *(u32x4*)(YB + (size_t)row * ldc + c) = w; } } }
    }
};
struct EpiF32 {
    static constexpr bool PERM = true, AFTER_DRAIN = false;
    float* Y; int ldc;
    __device__ __forceinline__ void operator()(const f32x4 (&acc)[2][2][4][2], const Unit& u, int wr, int wc, int fr, int fq) const {
        const int row0 = u.pm * BM + wr * 64 + fr, col0 = u.pn * BM + wc * 32 + 8 * fq;
#pragma unroll
        for (int ai = 0; ai < 2; ++ai)
#pragma unroll
            for (int m = 0; m < 4; ++m) { const int row = row0 + ai * HALF + m * 16;
#pragma unroll
                for (int bj = 0; bj < 2; ++bj) { float* y = Y + (size_t)row * ldc + col0 + bj * HALF; *(f32x4*)y = acc[ai][bj][m][0]; *(f32x4*)(y + 4) = acc[ai][bj][m][1]; } }
    }
};
struct EpiSwiglu {
    static constexpr bool PERM = true, AFTER_DRAIN = false;
    bf16_t* Hf; int ldc;
    __device__ __forceinline__ void operator()(const f32x4 (&acc)[2][2][4][2], const Unit& u, int wr, int wc, int fr, int fq) const {
        const int row0 = u.pm * BM + wr * 64 + fr, col0 = u.pn * HALF + wc * 32 + 8 * fq;
#pragma unroll
        for (int ai = 0; ai < 2; ++ai)
#pragma unroll
            for (int m = 0; m < 4; ++m) { const int row = row0 + ai * HALF + m * 16; float o[8];
#pragma unroll
                for (int n = 0; n < 2; ++n)
#pragma unroll
                    for (int j = 0; j < 4; ++j) { const float a = acc[ai][0][m][n][j], b = acc[ai][1][m][n][j]; o[n * 4 + j] = a * __builtin_amdgcn_rcpf(1.0f + __expf(-a)) * b; }
                u32x4 w; w.x = cvt_pk_bf16(o[0], o[1]); w.y = cvt_pk_bf16(o[2], o[3]); w.z = cvt_pk_bf16(o[4], o[5]); w.w = cvt_pk_bf16(o[6], o[7]);
                *(u32x4*)(Hf + (size_t)row * ldc + col0) = w; }
    }
};
template <class Epi, class Sched, bool ALIGN_EPI = false, bool SP2 = false>
__device__ __forceinline__ void gemm_phase(PG8_LAS unsigned char* lds, const Gemm g, const Sched& S, const Epi& E) {
    const int tid = threadIdx.x, wid = __builtin_amdgcn_readfirstlane(tid >> 6), lane = tid & 63, wr = wid >> 2, wc = wid & 3, fr = lane & 15, fq = lane >> 4;
    const int K = g.K, nt = K / BK;
    unsigned voffA[2], voffB[2];
#pragma unroll
    for (int i = 0; i < 2; ++i) { int R, C; stage_rc(tid * 16 + i * 8192, R, C); const int Rb = Epi::PERM ? ((R & ~31) + perm32(R & 31)) : R;
        voffA[i] = (unsigned)(R * K + C) * 2u; voffB[i] = (unsigned)(Rb * K + C) * 2u; }
    const size_t kstep = (size_t)(BK * 2);
    const size_t hstep = (size_t)HALF * K * 2;
    const size_t tstep = 2 * hstep;
    const unsigned ldsw = (unsigned)wid * 1024u;
    const int aoff = lds_byte(wr * 64 + fr, fq * 8), boff = lds_byte(wc * 32 + fr, fq * 8);
#define PG8_SA(b, h) (((b) * 2 + (h)) * HTB)
#define PG8_SB(b, h) ((4 + (b) * 2 + (h)) * HTB)
#define PG8_STAGE(bufoff, gbase, voff) do { _Pragma("unroll") for (int _i = 0; _i < 2; ++_i) \
        __builtin_amdgcn_global_load_lds((const unsigned*)((const char*)(gbase) + (voff)[_i]), (PG8_LAS unsigned*)(lds + (bufoff) + ldsw + _i * 8192), 16, 0, 0); } while (0)
#define PG8_LDA(dst, b, h) do { _Pragma("unroll") for (int m = 0; m < 4; ++m) _Pragma("unroll") for (int k = 0; k < 2; ++k) dst[m][k] = *(const PG8_LAS bf16x8*)(lds + PG8_SA(b, h) + aoff + m * 2048 + k * 1024); } while (0)
#define PG8_LDB(dst, b, h) do { _Pragma("unroll") for (int n = 0; n < 2; ++n) _Pragma("unroll") for (int k = 0; k < 2; ++k) dst[n][k] = *(const PG8_LAS bf16x8*)(lds + PG8_SB(b, h) + boff + n * 2048 + k * 1024); } while (0)
#define PG8_MMA(ai, bj, At, Bt) do { __builtin_amdgcn_s_setprio(1); _Pragma("unroll") for (int m = 0; m < 4; ++m) _Pragma("unroll") for (int n = 0; n < 2; ++n) _Pragma("unroll") for (int k = 0; k < 2; ++k) \
        acc[ai][bj][m][n] = __builtin_amdgcn_mfma_f32_16x16x32_bf16(Bt[n][k], At[m][k], acc[ai][bj][m][n], 0, 0, 0); __builtin_amdgcn_s_setprio(0); } while (0)
#define PG8_WAIT_V(n) asm volatile("s_waitcnt vmcnt(" #n ")" ::: "memory")
#define PG8_WAIT_L(n) asm volatile("s_waitcnt lgkmcnt(" #n ")" ::: "memory")
#define PG8_BAR __builtin_amdgcn_s_barrier()
#define PG8_SCHED __builtin_amdgcn_sched_barrier(0)
    Unit cur, nxt; int ui = 0;
    if (!S.next(0, cur)) return;
    f32x4 acc[2][2][4][2];
#pragma unroll
    for (int a = 0; a < 2; ++a)
#pragma unroll
        for (int b = 0; b < 2; ++b)
#pragma unroll
            for (int m = 0; m < 4; ++m)
#pragma unroll
                for (int n = 0; n < 2; ++n) acc[a][b][m][n] = (f32x4){0.f, 0.f, 0.f, 0.f};
    bf16x8 At[4][2], B0[2][2], B1[2][2];
    const char* cA = (const char*)g.A + (size_t)cur.pm * tstep; const char* cB = (const char*)g.Bt + (size_t)cur.pn * tstep;
    S.a_ready(cur);
    if constexpr (SP2) {
        PG8_STAGE(PG8_SB(0, 0), cB, voffB); PG8_STAGE(PG8_SB(0, 1), cB + hstep, voffB); PG8_STAGE(PG8_SA(0, 0), cA, voffA); PG8_STAGE(PG8_SA(0, 1), cA + hstep, voffA);
        if (wr == 1) PG8_BAR;
        PG8_WAIT_V(2); PG8_BAR;
        PG8_STAGE(PG8_SB(1, 0), cB + kstep, voffB); PG8_STAGE(PG8_SA(1, 0), cA + kstep, voffA); PG8_STAGE(PG8_SB(1, 1), cB + hstep + kstep, voffB);
        PG8_WAIT_V(6); PG8_BAR;
    } else {
        PG8_STAGE(PG8_SB(0, 0), cB, voffB); PG8_STAGE(PG8_SA(0, 0), cA, voffA); PG8_STAGE(PG8_SB(0, 1), cB + hstep, voffB); PG8_STAGE(PG8_SA(0, 1), cA + hstep, voffA);
        if (wr == 1) PG8_BAR;
        PG8_WAIT_V(4); PG8_BAR;
        PG8_STAGE(PG8_SB(1, 0), cB + kstep, voffB); PG8_STAGE(PG8_SA(1, 0), cA + kstep, voffA); PG8_STAGE(PG8_SB(1, 1), cB + hstep + kstep, voffB);
        PG8_WAIT_V(6); PG8_BAR;
    }
    for (;;) {
        const bool has_next = S.next(ui + 1, nxt);
        const char* nA = has_next ? (const char*)g.A + (size_t)nxt.pm * tstep : cA; const char* nB = has_next ? (const char*)g.Bt + (size_t)nxt.pn * tstep : cB;
        for (int t = 0; t < nt; t += 2) {
            const bool last = (t == nt - 2);
            const char* a1 = cA + (size_t)(t + 1) * kstep;
            const char* a2 = last ? nA : cA + (size_t)(t + 2) * kstep; const char* b2 = last ? nB : cB + (size_t)(t + 2) * kstep;
            const char* a3 = a2 + kstep; const char* b3 = b2 + kstep;
            if (last && has_next) S.a_ready(nxt);
            if constexpr (SP2) {
            PG8_LDB(B0, 0, 0); PG8_LDB(B1, 0, 1); PG8_SCHED; PG8_LDA(At, 0, 0); PG8_STAGE(PG8_SA(1, 1), a1 + hstep, voffA);
            PG8_WAIT_V(8); PG8_WAIT_L(0); PG8_BAR; PG8_MMA(0, 0, At, B0); PG8_MMA(0, 1, At, B1); PG8_BAR; PG8_SCHED;
            PG8_LDA(At, 0, 1); PG8_STAGE(PG8_SB(0, 0), b2, voffB); PG8_STAGE(PG8_SB(0, 1), b2 + hstep, voffB); PG8_STAGE(PG8_SA(0, 0), a2, voffA);
            PG8_WAIT_V(8); PG8_WAIT_L(0); PG8_BAR; PG8_MMA(1, 0, At, B0); PG8_MMA(1, 1, At, B1); PG8_BAR; PG8_SCHED;
            PG8_LDB(B0, 1, 0); PG8_LDB(B1, 1, 1); PG8_SCHED; PG8_LDA(At, 1, 0); PG8_STAGE(PG8_SA(0, 1), a2 + hstep, voffA);
            PG8_WAIT_V(8); PG8_WAIT_L(0); PG8_BAR; PG8_MMA(0, 0, At, B0); PG8_MMA(0, 1, At, B1); PG8_BAR; PG8_SCHED;
            PG8_LDA(At, 1, 1); PG8_STAGE(PG8_SB(1, 0), b3, voffB); PG8_STAGE(PG8_SB(1, 1), b3 + hstep, voffB); PG8_STAGE(PG8_SA(1, 0), a3, voffA);
            PG8_WAIT_V(8); PG8_WAIT_L(0); PG8_BAR; PG8_MMA(1, 0, At, B0); PG8_MMA(1, 1, At, B1); PG8_BAR; PG8_SCHED;
            } else {
            PG8_LDB(B0, 0, 0); PG8_SCHED; PG8_LDA(At, 0, 0); PG8_STAGE(PG8_SA(1, 1), a1 + hstep, voffA);
            PG8_WAIT_L(8); PG8_BAR; PG8_WAIT_L(0); PG8_MMA(0, 0, At, B0); PG8_BAR; PG8_SCHED;
            PG8_LDB(B1, 0, 1); PG8_STAGE(PG8_SB(0, 0), b2, voffB);
            PG8_BAR; PG8_WAIT_L(0); PG8_MMA(0, 1, At, B1); PG8_BAR;
            PG8_LDA(At, 0, 1); PG8_STAGE(PG8_SA(0, 0), a2, voffA);
            PG8_BAR; PG8_WAIT_L(0); PG8_MMA(1, 0, At, B0); PG8_BAR; PG8_SCHED;
            PG8_STAGE(PG8_SB(0, 1), b2 + hstep, voffB);
            PG8_WAIT_V(6); PG8_BAR; PG8_MMA(1, 1, At, B1); PG8_BAR;
            PG8_LDB(B0, 1, 0); PG8_SCHED; PG8_LDA(At, 1, 0); PG8_STAGE(PG8_SA(0, 1), a2 + hstep, voffA);
            PG8_WAIT_L(8); PG8_BAR; PG8_WAIT_L(0); PG8_MMA(0, 0, At, B0); PG8_BAR; PG8_SCHED;
            PG8_LDB(B1, 1, 1); PG8_STAGE(PG8_SB(1, 0), b3, voffB);
            PG8_BAR; PG8_WAIT_L(0); PG8_MMA(0, 1, At, B1); PG8_BAR;
            PG8_LDA(At, 1, 1); PG8_STAGE(PG8_SA(1, 0), a3, voffA);
            PG8_BAR; PG8_WAIT_L(0); PG8_MMA(1, 0, At, B0); PG8_BAR; PG8_SCHED;
            PG8_STAGE(PG8_SB(1, 1), b3 + hstep, voffB);
            PG8_WAIT_V(6); PG8_BAR; PG8_MMA(1, 1, At, B1); PG8_BAR;
            }
        }
        if constexpr (ALIGN_EPI) { if (wr == 0) PG8_BAR; }
        if constexpr (!Epi::AFTER_DRAIN) { E(acc, cur, wr, wc, fr, fq); S.done(cur); }
        if (!has_next) break;
#pragma unroll
        for (int a = 0; a < 2; ++a)
#pragma unroll
            for (int b = 0; b < 2; ++b)
#pragma unroll
                for (int m = 0; m < 4; ++m)
#pragma unroll
                    for (int n = 0; n < 2; ++n) acc[a][b][m][n] = (f32x4){0.f, 0.f, 0.f, 0.f};
        cur = nxt; cA = nA; cB = nB; ++ui;
        if constexpr (ALIGN_EPI) { if (wr == 1) PG8_BAR; }
    }
    PG8_WAIT_V(0);
    if constexpr (!ALIGN_EPI) { if (wr == 0) PG8_BAR; }
    PG8_BAR;
    if constexpr (Epi::AFTER_DRAIN) { E.fused(acc, cur, wr, wc, fr, fq, lds, wid, lane); S.done(cur); }
#undef PG8_SA
#undef PG8_SB
#undef PG8_STAGE
#undef PG8_LDA
#undef PG8_LDB
#undef PG8_MMA
#undef PG8_WAIT_V
#undef PG8_WAIT_L
#undef PG8_BAR
#undef PG8_SCHED
}
}
#include <hip/hip_bf16.h>
#include <cmath>
namespace attn_body {
using bf16=__hip_bfloat16;
using bf16x8=__attribute__((ext_vector_type(8)))short;
using s16x4=__attribute__((ext_vector_type(4)))short;
using f32x16=__attribute__((ext_vector_type(16)))float;
using u32x4=__attribute__((ext_vector_type(4)))unsigned;
constexpr int D=64,DM=512,OPITCH=1024;
constexpr int NW=8,QBLK=32,QB=QBLK*NW,KVBLK=64;
constexpr int ATTN_PITCH=DM, ATTN_UNIT_ROWS=QB;
__device__ __forceinline__ int crow(int r,int hi){return (r&3)+8*(r>>2)+4*hi;}
#define SBAR() __builtin_amdgcn_sched_barrier(0)
__device__ __forceinline__ void cmask(f32x16&p0,f32x16&p1,int jb,int qrel,int hi){
  const float NEG=-INFINITY; int kb=64*jb+4*hi;
  #pragma unroll
  for(int r=0;r<16;++r){int kv=kb+(r&3)+8*(r>>2); if(kv>qrel)p0[r]=NEG; if(kv+32>qrel)p1[r]=NEG;}
}

constexpr int NSLOT=3, SLOTB=8192;
constexpr int LDS_K=0, LDS_V=NSLOT*SLOTB, LDS_WS=2*NSLOT*SLOTB, LDS_OST=LDS_WS+NW*64*4, LDS_BYTES=LDS_OST+NW*4096;
constexpr float C2=0.125f*1.4426950408889634f;
__device__ __forceinline__ void glds16(const void*gsrc,unsigned lds_dst){unsigned keep;
  asm volatile("s_mov_b32 %0, m0\n\ts_mov_b32 m0, %2\n\ts_nop 0\n\tglobal_load_lds_dwordx4 %1, off\n\ts_mov_b32 m0, %0":"=&s"(keep):"v"(gsrc),"s"(lds_dst):"memory");}
__device__ __forceinline__ float max3f(float a,float b,float c){float r;asm("v_max3_f32 %0, %1, %2, %3":"=v"(r):"v"(a),"v"(b),"v"(c));return r;}
__device__ __forceinline__ float max2f(float a,float b){float r;asm("v_max_f32_e32 %0, %1, %2":"=v"(r):"v"(a),"v"(b));return r;}
__device__ __forceinline__ float fadd_s(float a,float b){float r;asm("v_add_f32_e32 %0, %1, %2":"=v"(r):"v"(a),"v"(b));return r;}
__device__ __forceinline__ float fsub_s(float a,float b){float r;asm("v_sub_f32_e32 %0, %1, %2":"=v"(r):"v"(a),"v"(b));return r;}
typedef float f32x2_t __attribute__((ext_vector_type(2))); typedef __bf16 bf16x2_t __attribute__((ext_vector_type(2)));
__device__ __forceinline__ unsigned cvtpk_s(float lo,float hi){f32x2_t v={lo,hi};bf16x2_t b=__builtin_convertvector(v,bf16x2_t);return __builtin_bit_cast(unsigned,b);}
#define WAIT_BAR(N) asm volatile("s_waitcnt vmcnt(" #N ") lgkmcnt(0)\n\ts_barrier":::"memory")

__device__ __forceinline__ void qkt(f32x16&p0,f32x16&p1,const char*Kslot,const bf16x8*qr,const f32x16&negm,int r32,int hi){
  const char*kb=Kslot+hi*1024+r32*16;
  #pragma unroll
  for(int d0=0;d0<4;++d0){
    const bf16x8 b0=*reinterpret_cast<const bf16x8*>(kb+d0*2048);
    const bf16x8 b1=*reinterpret_cast<const bf16x8*>(kb+d0*2048+512);
    if(d0==0){p0=__builtin_amdgcn_mfma_f32_32x32x16_bf16(b0,qr[0],negm,0,0,0);p1=__builtin_amdgcn_mfma_f32_32x32x16_bf16(b1,qr[0],negm,0,0,0);}
    else{p0=__builtin_amdgcn_mfma_f32_32x32x16_bf16(b0,qr[d0],p0,0,0,0);p1=__builtin_amdgcn_mfma_f32_32x32x16_bf16(b1,qr[d0],p1,0,0,0);}}
}
typedef __attribute__((address_space(3))) const char* lds_cptr;
typedef short v4i16_t __attribute__((ext_vector_type(4)));
__device__ __forceinline__ void kload8(bf16x8*kf,lds_cptr kp){
  kf[0]=*(const __attribute__((address_space(3))) bf16x8*)(kp);      kf[1]=*(const __attribute__((address_space(3))) bf16x8*)(kp+512);
  kf[2]=*(const __attribute__((address_space(3))) bf16x8*)(kp+2048); kf[3]=*(const __attribute__((address_space(3))) bf16x8*)(kp+2560);
  kf[4]=*(const __attribute__((address_space(3))) bf16x8*)(kp+4096); kf[5]=*(const __attribute__((address_space(3))) bf16x8*)(kp+4608);
  kf[6]=*(const __attribute__((address_space(3))) bf16x8*)(kp+6144); kf[7]=*(const __attribute__((address_space(3))) bf16x8*)(kp+6656);
}
__device__ __forceinline__ void kload2(bf16x8*kf,lds_cptr kp,int j){ kf[2*j]=*(const __attribute__((address_space(3))) bf16x8*)(kp+j*2048); kf[2*j+1]=*(const __attribute__((address_space(3))) bf16x8*)(kp+j*2048+512); }
__device__ __forceinline__ s16x4 vtr(lds_cptr p){ return __builtin_bit_cast(s16x4,__builtin_amdgcn_ds_read_tr16_b64_v4i16((__attribute__((address_space(3))) v4i16_t*)p)); }
__device__ __forceinline__ float rowmax(const f32x16&p0,const f32x16&p1){
  float a=max3f(p0[0],p0[1],p1[0]),b=max3f(p0[2],p0[3],p1[1]);a=max3f(a,p1[2],p1[3]);
  #pragma unroll
  for(int r=4;r<16;r+=4){a=max3f(a,p0[r],p0[r+1]);b=max3f(b,p0[r+2],p0[r+3]);a=max3f(a,p1[r],p1[r+1]);b=max3f(b,p1[r+2],p1[r+3]);}
  const float m=max2f(a,b);
  auto rr=__builtin_amdgcn_permlane32_swap(__float_as_uint(m),__float_as_uint(m),false,false);
  return max2f(__uint_as_float(rr[0]),__uint_as_float(rr[1]));
}
__device__ __forceinline__ void pv(f32x16*o,int vb,bf16x8 pa0,bf16x8 pa1,bf16x8 pa2,bf16x8 pa3){
  #pragma unroll
  for(int d0=0;d0<2;++d0){s16x4 lo[4],hi[4];
    #pragma unroll
    for(int ks=0;ks<4;++ks){
      asm volatile("ds_read_b64_tr_b16 %0,%1 offset:%c2":"=&v"(lo[ks]):"v"(vb),"i"(d0*4096+ks*1024):"memory");
      asm volatile("ds_read_b64_tr_b16 %0,%1 offset:%c2":"=&v"(hi[ks]):"v"(vb),"i"(d0*4096+ks*1024+512):"memory");}
    asm volatile("s_waitcnt lgkmcnt(0)":::"memory");SBAR();
    #define PK(k) (bf16x8){lo[k][0],lo[k][1],lo[k][2],lo[k][3],hi[k][0],hi[k][1],hi[k][2],hi[k][3]}
    o[d0]=__builtin_amdgcn_mfma_f32_32x32x16_bf16(pa0,PK(0),o[d0],0,0,0);
    o[d0]=__builtin_amdgcn_mfma_f32_32x32x16_bf16(pa1,PK(1),o[d0],0,0,0);
    o[d0]=__builtin_amdgcn_mfma_f32_32x32x16_bf16(pa2,PK(2),o[d0],0,0,0);
    o[d0]=__builtin_amdgcn_mfma_f32_32x32x16_bf16(pa3,PK(3),o[d0],0,0,0);
    #undef PK
  }
}

#ifndef ATTN_STORE16
#define ATTN_STORE16(p,v) (*(u32x4*)(p)=(v))
#endif
template<int THRL> __device__ __forceinline__ void attn_unit(const bf16*Qu,const bf16*__restrict__ Kh,const bf16*__restrict__ Vh,bf16*Ou,const int NT,char*shm){
  const int tid=threadIdx.x,lane=tid&63,r32=lane&31,hi=lane>>5; const int wid=__builtin_amdgcn_readfirstlane(tid>>6);
  const bf16*Qw=Qu+(long)(wid*QBLK)*DM;
  const unsigned lds0=(unsigned)(uintptr_t)shm;
  float*wsf=(float*)(shm+LDS_WS)+wid*64;
  const bf16*ksrc=Kh+(long)lane*DM+wid*8;
  const bf16*vsrc=Vh+(long)(16*(wid&3)+(lane>>2))*DM+(wid>>2)*32+(lane&3)*8;
  const unsigned kdst=lds0+LDS_K+wid*1024, vdst=lds0+LDS_V+wid*1024;
  #define DMA_K(t,slot) glds16(ksrc+(long)(t)*KVBLK*DM,(unsigned)__builtin_amdgcn_readfirstlane(kdst+(slot)))
  #define DMA_V(t,slot) glds16(vsrc+(long)(t)*KVBLK*DM,(unsigned)__builtin_amdgcn_readfirstlane(vdst+(slot)))
  const int vb0=(int)(lds0+LDS_V)+((lane>>4)&1)*32+(lane&3)*8+(4*hi+((lane&15)>>2))*64;
  const char*Kbase=shm+LDS_K; bf16x8 kf[8];
  const lds_cptr shm3=(lds_cptr)shm; const lds_cptr kp0=shm3+LDS_K+hi*1024+r32*16; const lds_cptr vp0=shm3+LDS_V+((lane>>4)&1)*32+(lane&3)*8+(4*hi+((lane&15)>>2))*64;
  DMA_K(0,0);DMA_V(0,0);DMA_K(1,SLOTB);
  bf16x8 qr[4];
  #pragma unroll
  for(int d0=0;d0<4;++d0)qr[d0]=*reinterpret_cast<const bf16x8*>(&Qw[(long)r32*DM+d0*16+hi*8]);
  float mhat=0.f,l_reg=0.f;f32x16 o[2];o[0]=f32x16{};o[1]=f32x16{};f32x16 negm=f32x16{};asm volatile("":"+v"(negm));
  #define CMASK(P0,P1,t) do{}while(0)
  bool resc=false;
  #define START(P0,P1) do{ const float rm=rowmax(P0,P1); resc=false; \
    { const float dl=rm; mhat=fadd_s(mhat,dl); \
      _Pragma("unroll") for(int r=0;r<16;++r){P0[r]=fsub_s(P0[r],dl);P1[r]=fsub_s(P1[r],dl);} \
      _Pragma("unroll") for(int r=0;r<16;++r)negm[r]=-mhat; asm volatile("":"+v"(negm)); } \
    _Pragma("unroll") for(int r=0;r<16;++r)P0[r]=__builtin_amdgcn_exp2f(P0[r]); }while(0)
  #define RESC() do{ if(resc){ asm volatile("s_waitcnt lgkmcnt(0)":::"memory"); \
      _Pragma("unroll") for(int d_=0;d_<2;++d_) _Pragma("unroll") for(int r=0;r<16;++r)o[d_][r]*=wsf[crow(r,hi)]; } }while(0)
  f32x16 pA0,pA1,pB0,pB1;
  int sl_prev=0,sl_cur=0,sl_next=SLOTB;
  #define ROT() do{sl_prev=sl_cur;sl_cur=sl_next;sl_next=(sl_next==(NSLOT-1)*SLOTB)?0:sl_next+SLOTB;}while(0)
  DMA_K(2,2*SLOTB);
  WAIT_BAR(3);
  qkt(pA0,pA1,Kbase,qr,negm,r32,hi);asm volatile("s_nop 15\n\ts_nop 7":"+v"(pA0),"+v"(pA1));CMASK(pA0,pA1,0);
  START(pA0,pA1);
  _Pragma("unroll") for(int r=0;r<16;++r)pA1[r]=__builtin_amdgcn_exp2f(pA1[r]);
  WAIT_BAR(0);
  DMA_K(3,0);DMA_V(1,SLOTB);
  ROT();
  kload8(kf,kp0+sl_cur);
  WAIT_BAR(2);
  s16x4 vlo[8],vhi[8]; u32x4 pw0,pw1,pw2,pw3;
  #define PKW(P,B) cvtpk_s(P[B],P[B+1])
  #define PAF(k) __builtin_bit_cast(bf16x8,pw##k)
  #define VFR(i) (bf16x8){vlo[i][0],vlo[i][1],vlo[i][2],vlo[i][3],vhi[i][0],vhi[i][1],vhi[i][2],vhi[i][3]}
  #define PIN(x) asm volatile("":"+v"(x))
  #define MX3(a,b,c) __builtin_fmaxf(__builtin_fmaxf((a),(b)),(c))
  #define GAPA(MF,A0,A1,A2,A3,W0,W1,PW) do{ MF; sacc+=A0; sacc+=A1; sacc+=A2; sacc+=A3; PIN(sacc); W0; W1; PIN(PW); SBAR(); }while(0)
  #define EX(v) __builtin_amdgcn_exp2f(v)
  #define GAPB(MF,X,B) do{ MF; X[B]=EX(X[B]); X[B+1]=EX(X[B+1]); X[B+2]=EX(X[B+2]); X[B+3]=EX(X[B+3]); PIN(X); SBAR(); }while(0)
  #define VRD(i) do{ vlo[i]=vtr(vp_+(((i)>>2)*4096+((i)&3)*1024)); vhi[i]=vtr(vp_+(((i)>>2)*4096+((i)&3)*1024+512)); }while(0)
  #define KRD(G,j) do{ if(G){ kload2(kf,kp0+sl_next,j); SBAR(); } }while(0)
  #define STEP(C0,C1,P0,P1,t,GK,GV,GL) do{ SBAR(); \
    const lds_cptr vp_=vp0+sl_prev; \
    VRD(0); SBAR(); float sacc=(P0[0]+P0[1]); \
    GAPA(C0=__builtin_amdgcn_mfma_f32_32x32x16_bf16(kf[0],qr[0],negm,0,0,0), P0[2],P0[3],P0[4],P0[5],     pw0[0]=PKW(P0,0), pw0[1]=PKW(P0,2), pw0); \
    VRD(4); SBAR(); GAPA(C1=__builtin_amdgcn_mfma_f32_32x32x16_bf16(kf[1],qr[0],negm,0,0,0), P0[6],P0[7],P0[8],P0[9],     pw0[2]=PKW(P0,4), pw0[3]=PKW(P0,6), pw0); \
    VRD(1); SBAR(); GAPA(C0=__builtin_amdgcn_mfma_f32_32x32x16_bf16(kf[2],qr[1],C0,0,0,0),   P0[10],P0[11],P0[12],P0[13], pw1[0]=PKW(P0,8), pw1[1]=PKW(P0,10), pw1); \
    VRD(5); SBAR(); GAPA(C1=__builtin_amdgcn_mfma_f32_32x32x16_bf16(kf[3],qr[1],C1,0,0,0),   P0[14],P0[15],P1[0],P1[1],   pw1[2]=PKW(P0,12),pw1[3]=PKW(P0,14), pw1); \
    VRD(2); SBAR(); GAPA(C0=__builtin_amdgcn_mfma_f32_32x32x16_bf16(kf[4],qr[2],C0,0,0,0),   P1[2],P1[3],P1[4],P1[5],     pw2[0]=PKW(P1,0), pw2[1]=PKW(P1,2), pw2); \
    VRD(6); SBAR(); GAPA(C1=__builtin_amdgcn_mfma_f32_32x32x16_bf16(kf[5],qr[2],C1,0,0,0),   P1[6],P1[7],P1[8],P1[9],     pw2[2]=PKW(P1,4), pw2[3]=PKW(P1,6), pw2); \
    VRD(3); SBAR(); GAPA(C0=__builtin_amdgcn_mfma_f32_32x32x16_bf16(kf[6],qr[3],C0,0,0,0),   P1[10],P1[11],P1[12],P1[13], pw3[0]=PKW(P1,8), pw3[1]=PKW(P1,10), pw3); \
    VRD(7); SBAR(); GAPA(C1=__builtin_amdgcn_mfma_f32_32x32x16_bf16(kf[7],qr[3],C1,0,0,0),   P1[14],P1[15],0.f,0.f,       pw3[2]=PKW(P1,12),pw3[3]=PKW(P1,14), pw3); \
    l_reg+=sacc; \
    if(GK){DMA_K((t)+3,sl_cur);} if(GV){DMA_V((t)+1,sl_next);} \
    CMASK(C0,C1,t); \
    { float a=MX3(C0[0],C0[1],C1[0]),b=MX3(C0[2],C0[3],C1[1]); a=MX3(a,C1[2],C1[3]); \
      _Pragma("unroll") for(int r=4;r<16;r+=4){a=MX3(a,C0[r],C0[r+1]);b=MX3(b,C0[r+2],C0[r+3]);a=MX3(a,C1[r],C1[r+1]);b=MX3(b,C1[r+2],C1[r+3]);} \
      float rm=__builtin_fmaxf(a,b); { auto rr=__builtin_amdgcn_permlane32_swap(__float_as_uint(rm),__float_as_uint(rm),false,false); rm=__builtin_fmaxf(__uint_as_float(rr[0]),__uint_as_float(rr[1])); } \
      resc=false; \
      if(__builtin_expect(__any(rm>(float)THRL),0)){ const float dl=__builtin_fmaxf(rm,0.f); mhat+=dl; \
        _Pragma("unroll") for(int r=0;r<16;++r){C0[r]-=dl;C1[r]-=dl;} \
        _Pragma("unroll") for(int r=0;r<16;++r)negm[r]=-mhat; asm volatile("":"+v"(negm)); \
        const float f=__builtin_amdgcn_exp2f(-dl); l_reg*=f; if(hi==0)wsf[r32]=f; resc=true; } } \
    SBAR(); \
    GAPB(o[0]=__builtin_amdgcn_mfma_f32_32x32x16_bf16(PAF(0),VFR(0),o[0],0,0,0), C0,0); \
    GAPB(o[1]=__builtin_amdgcn_mfma_f32_32x32x16_bf16(PAF(0),VFR(4),o[1],0,0,0), C0,4); \
    KRD(GL,0); GAPB(o[0]=__builtin_amdgcn_mfma_f32_32x32x16_bf16(PAF(1),VFR(1),o[0],0,0,0), C0,8); \
    KRD(GL,1); GAPB(o[1]=__builtin_amdgcn_mfma_f32_32x32x16_bf16(PAF(1),VFR(5),o[1],0,0,0), C0,12); \
    KRD(GL,2); GAPB(o[0]=__builtin_amdgcn_mfma_f32_32x32x16_bf16(PAF(2),VFR(2),o[0],0,0,0), C1,0); \
    KRD(GL,3); GAPB(o[1]=__builtin_amdgcn_mfma_f32_32x32x16_bf16(PAF(2),VFR(6),o[1],0,0,0), C1,4); \
    GAPB(o[0]=__builtin_amdgcn_mfma_f32_32x32x16_bf16(PAF(3),VFR(3),o[0],0,0,0), C1,8); \
    GAPB(o[1]=__builtin_amdgcn_mfma_f32_32x32x16_bf16(PAF(3),VFR(7),o[1],0,0,0), C1,12); \
    }while(0)
  int t=1;
  #undef CMASK
  #define CMASK(P0,P1,t) do{}while(0)
  for(;t+5<NT;t+=2){
    STEP(pB0,pB1,pA0,pA1,t,true,true,true);     WAIT_BAR(2); RESC(); ROT();
    STEP(pA0,pA1,pB0,pB1,t+1,true,true,true);   WAIT_BAR(2); RESC(); ROT();
  }
  #undef CMASK
  #define CMASK(P0,P1,t) do{}while(0)
  #define ENDW(tt) do{ if((tt)+3<NT){WAIT_BAR(2);} else if((tt)+2<NT){WAIT_BAR(1);} else {WAIT_BAR(0);} }while(0)
  for(;t+1<NT;t+=2){
    STEP(pB0,pB1,pA0,pA1,t,(t+3<NT),(t+1<NT),(t+1<NT));       ENDW(t);   RESC(); ROT();
    STEP(pA0,pA1,pB0,pB1,t+1,(t+4<NT),(t+2<NT),(t+2<NT));     ENDW(t+1); RESC(); ROT();
  }
  STEP(pB0,pB1,pA0,pA1,NT-1,false,false,false); RESC();
  { float sacc=pB0[0]+pB0[1]; _Pragma("unroll") for(int r=2;r<16;++r)sacc+=pB0[r]; _Pragma("unroll") for(int r=0;r<16;++r)sacc+=pB1[r]; l_reg+=sacc;
    pw0=(u32x4){PKW(pB0,0),PKW(pB0,2),PKW(pB0,4),PKW(pB0,6)};pw1=(u32x4){PKW(pB0,8),PKW(pB0,10),PKW(pB0,12),PKW(pB0,14)};pw2=(u32x4){PKW(pB1,0),PKW(pB1,2),PKW(pB1,4),PKW(pB1,6)};pw3=(u32x4){PKW(pB1,8),PKW(pB1,10),PKW(pB1,12),PKW(pB1,14)};
    SBAR(); pv(o,vb0+sl_cur,PAF(0),PAF(1),PAF(2),PAF(3)); }
  #undef PKW
  #undef PAF
  #undef VFR
  #undef PIN
  #undef MX3
  #undef GAPA
  #undef GAPB
  #undef EX
  #undef VRD
  #undef KRD
  #undef STEP
  #undef ENDW
  {auto rr=__builtin_amdgcn_permlane32_swap(__float_as_uint(l_reg),__float_as_uint(l_reg),false,false);l_reg=__uint_as_float(rr[0])+__uint_as_float(rr[1]);}
  if(hi==0)wsf[32+r32]=l_reg;asm volatile("s_waitcnt lgkmcnt(0)":::"memory");
  float rli[16];
  #pragma unroll
  for(int r=0;r<16;++r)rli[r]=__builtin_amdgcn_rcpf(wsf[32+crow(r,hi)]);
  bf16*Ow=Ou+(long)(wid*QBLK)*OPITCH;
  { bf16*stg=(bf16*)(shm+LDS_OST)+wid*2048;
    #pragma unroll
    for(int r=0;r<16;++r){const int orow=crow(r,hi);
      #pragma unroll
      for(int d0=0;d0<2;++d0)stg[orow*64+d0*32+r32]=__float2bfloat16(o[d0][r]*rli[r]);}
    asm volatile("s_waitcnt lgkmcnt(0)":::"memory");
    #pragma unroll
    for(int i=0;i<4;++i){const int row=i*8+(lane>>3),ch=lane&7; const u32x4 v=*(const u32x4*)(stg+row*64+ch*8); ATTN_STORE16(Ow+(long)row*OPITCH+ch*8,v);} }
  asm volatile("s_waitcnt lgkmcnt(0)\n\ts_barrier":::"memory");
  #undef DMA_K
  #undef DMA_V
  #undef CMASK
  #undef START
  #undef RESC
  #undef ROT
}
constexpr int ATTN_LDS_BYTES=LDS_BYTES;
#undef SBAR
#undef WAIT_BAR
}
#define GAS __attribute__((address_space(1)))
#define LAS __attribute__((address_space(3)))
typedef unsigned short bf16;
typedef unsigned v4u __attribute__((ext_vector_type(4)));
typedef unsigned v2u __attribute__((ext_vector_type(2)));
typedef float f32x4 __attribute__((ext_vector_type(4)));
#define LDS_WAIT() asm volatile("s_waitcnt lgkmcnt(0)" ::: "memory")

constexpr int DM_ = 2048, SEQ_ = 8192, CTXL = 256, MROWS = SEQ_ + CTXL;
constexpr int NIN = 13888, NINP = 14080, DFF = 5632;
constexpr int ZP = NINP;
constexpr int C_GQ = 0, C_GK = 512, C_GV = 1024, C_GLR = 1536, C_GG = 1568, C_DQ = 2080, C_DK = 2592, C_DV = 3104,
              C_EQ = 3616, C_EA = 6688, C_EB = 6704, C_EG = 6720, C_MG = 7744;
constexpr size_t MiB = 1u << 20;
constexpr size_t WS_MOD = 0;
constexpr size_t WS_BAR = 512 * 1024, BAR_BYTES = 16384;
constexpr int MISC_OFF = 147456 - 256;
constexpr size_t WS_CNT = WS_BAR + 14336;
constexpr size_t WS_W0 = 1 * MiB, W_LAYER = 137 * MiB;
constexpr size_t WO_IN = 0, WO_UA = 55 * MiB, WO_UD = 57 * MiB, WO_UE = 59 * MiB, WO_O = 63 * MiB, WO_13 = 71 * MiB, WO_2 = 115 * MiB;
constexpr size_t WS_X = WS_W0 + 2 * W_LAYER;
constexpr size_t WS_H = WS_X + 66 * MiB;
constexpr size_t WS_Z = WS_H + 33 * MiB;
constexpr size_t WS_ZG = WS_Z + 227 * MiB;
constexpr size_t WS_AQ = WS_ZG + 3 * MiB, WS_AK = WS_AQ + 9 * MiB, WS_AV = WS_AK + 9 * MiB, WS_AO = WS_AV + 9 * MiB;
constexpr size_t WS_DQ = WS_AO + 17 * MiB, WS_DK = WS_DQ + 17 * MiB, WS_DV = WS_DK + 17 * MiB, WS_DGB = WS_DV + 17 * MiB;
constexpr size_t WS_A = WS_DGB + 2 * MiB, WS_D = WS_A + 9 * MiB, WS_E = WS_D + 9 * MiB;
constexpr size_t WS_R2 = WS_E + 17 * MiB;
constexpr size_t WS_YB = WS_R2 + 66 * MiB;
constexpr size_t WS_END = WS_YB + 33 * MiB;
constexpr size_t WS_HFF = WS_Z;

constexpr int LDS_BYTES = 147456;
constexpr int NPH = 24;

typedef float pk_f32x2 __attribute__((ext_vector_type(2))); typedef __bf16 pk_bf16x2 __attribute__((ext_vector_type(2)));
__device__ __forceinline__ unsigned pk2(float lo, float hi) { const pk_f32x2 v = {lo, hi}; const pk_bf16x2 b = __builtin_convertvector(v, pk_bf16x2); return __builtin_bit_cast(unsigned, b); }
__device__ __forceinline__ unsigned f2bf(float f) { return pk2(f, 0.f) & 0xffffu; }
__device__ __forceinline__ float bf2f(unsigned short b) { return __builtin_bit_cast(float, (unsigned)b << 16); }
__device__ __forceinline__ float bflo(unsigned w) { return __builtin_bit_cast(float, w << 16); }
__device__ __forceinline__ float bfhi(unsigned w) { return __builtin_bit_cast(float, w & 0xffff0000u); }
__device__ __forceinline__ float wave_sum(float v) {
#pragma unroll
    for (int o = 1; o < 64; o <<= 1) v += __shfl_xor(v, o);
    return v;
}
__device__ __forceinline__ float sigmoidf_(float x) { return __builtin_amdgcn_rcpf(1.0f + __expf(-x)); }
__device__ __forceinline__ float siluf_(float x) { return x * __builtin_amdgcn_rcpf(1.0f + __expf(-x)); }

struct Args { const float* in[27]; float* out; unsigned char* ws; int ph_lo, ph_hi; };

struct Frame {
    LAS unsigned char* lds;
    int tid, lane, wave, G, bid;
    unsigned char* ws; float* out;
};

#define XB_TMO      128
#define XB_XCNT(j)  (256  + 64 * (j))
#define XB_XSUB(j)  (1280 + 64 * (j))
#define XB_XGEN(j)  (2304 + 64 * (j))
#define XB_TOP      3328
#define XB_TOPGEN   3392
#define XCD_BAR_WORDS 3456
#define XB_SPIN_CAP (1u << 18)

__device__ __forceinline__ unsigned xb_ld(unsigned* p)              { return __hip_atomic_load(p, __ATOMIC_RELAXED, __HIP_MEMORY_SCOPE_AGENT); }
__device__ __forceinline__ unsigned xb_add(unsigned* p, unsigned v) { return __hip_atomic_fetch_add(p, v, __ATOMIC_RELAXED, __HIP_MEMORY_SCOPE_AGENT); }
__device__ __forceinline__ unsigned xb_xcc_id() { return (unsigned)__builtin_amdgcn_s_getreg((3 << 11) | 20) & 0xFu; }
#define XB_SPIN(cond, bar) do { unsigned _sp = 0; while (cond) { __builtin_amdgcn_s_sleep(1); \
    if ((++_sp & 255u) == 0u) { if (xb_ld(&(bar)[XB_TMO])) break; if (_sp > XB_SPIN_CAP) { atomicAdd(&(bar)[XB_TMO], 1u); break; } } } } while (0)

struct XcdBarrier {
    unsigned* bar; unsigned x;
    volatile LAS unsigned* st;
};

__device__ __forceinline__ XcdBarrier xcd_barrier_post(unsigned* bar, volatile LAS unsigned* st) {
    XcdBarrier b; b.bar = bar; b.x = xb_xcc_id(); b.st = st;
    if (threadIdx.x == 0) (void)xb_add(&bar[XB_XCNT(b.x)], 1u);
    return b;
}
__device__ __forceinline__ void xcd_barrier_complete(unsigned* bar, unsigned x, unsigned& nloc, unsigned& nx) {
    const unsigned G = gridDim.x * gridDim.y * gridDim.z;
    unsigned sum, cnt, mine, sp = 0u;
    for (;;) {
        sum = 0u; cnt = 0u; mine = 0u;
#pragma unroll
        for (unsigned j = 0; j < 16; ++j) { const unsigned c = xb_ld(&bar[XB_XCNT(j)]); sum += c; cnt += (c > 0u) ? 1u : 0u; mine = (j == x) ? c : mine; }
        if (sum == G) break;
        __builtin_amdgcn_s_sleep(1);
        if ((++sp & 255u) == 0u) { if (xb_ld(&bar[XB_TMO])) break; if (sp > XB_SPIN_CAP) { atomicAdd(&bar[XB_TMO], 1u); break; } }
    }
    nloc = mine > 0u ? mine : 1u; nx = cnt > 0u ? cnt : 1u;
}

__device__ __forceinline__ void xcd_barrier(const XcdBarrier& b) {
    asm volatile("s_waitcnt vmcnt(0)" ::: "memory");
    __syncthreads();
    if (threadIdx.x == 0) {
        unsigned* bar = b.bar;
        __builtin_amdgcn_s_waitcnt(0);
        unsigned nloc = b.st[0], nx = b.st[1];
        if (nloc == 0u) { xcd_barrier_complete(bar, b.x, nloc, nx); b.st[0] = nloc; b.st[1] = nx; }
        const unsigned old = xb_add(&bar[XB_XSUB(b.x)], 1u);
        const unsigned gen = old / nloc;
        if (old + 1u == (gen + 1u) * nloc) {
            __builtin_amdgcn_fence(__ATOMIC_RELEASE, "agent");
            asm volatile("s_waitcnt vmcnt(0)" ::: "memory");
            const unsigned og = xb_add(&bar[XB_TOP], 1u);
            const unsigned tg = og / nx;
            if (og + 1u == (tg + 1u) * nx) xb_add(&bar[XB_TOPGEN], 1u);
            else XB_SPIN(xb_ld(&bar[XB_TOPGEN]) == tg, bar);
            __builtin_amdgcn_fence(__ATOMIC_ACQUIRE, "agent");
            xb_add(&bar[XB_XGEN(b.x)], 1u);
            asm volatile("s_waitcnt vmcnt(0)" ::: "memory");
        } else {
            XB_SPIN(xb_ld(&bar[XB_XGEN(b.x)]) == gen, bar);
            __builtin_amdgcn_fence(__ATOMIC_ACQUIRE, "agent");
            asm volatile("s_waitcnt vmcnt(0)" ::: "memory");
        }
    }
    __syncthreads();
}

__device__ __forceinline__ void p0_transpose_item(const float* W, int K, int N, bf16* WT, int k0, int n0, int drow, LAS float* scr, int lane) {
#pragma unroll 8
    for (int i = 0; i < 32; ++i) { const int kk = 2 * i + (lane >> 5); scr[kk * 33 + (lane & 31)] = W[(size_t)(k0 + kk) * N + n0 + (lane & 31)]; }
    LDS_WAIT(); asm volatile("" ::: "memory");
    const int c = lane & 7;
#pragma unroll
    for (int j = 0; j < 4; ++j) { const int n = (lane >> 3) + 8 * j; const LAS float* s = scr + (8 * c) * 33 + n;
        v4u o; o.x = pk2(s[0 * 33], s[1 * 33]); o.y = pk2(s[2 * 33], s[3 * 33]); o.z = pk2(s[4 * 33], s[5 * 33]); o.w = pk2(s[6 * 33], s[7 * 33]);
        *(v4u*)(WT + (size_t)(drow + n) * K + k0 + 8 * c) = o; }
    LDS_WAIT(); asm volatile("" ::: "memory");
}
__device__ __forceinline__ void tr_plain(const float* W, int K, int N, bf16* WT, int item, LAS float* scr, int lane) {
    const int nblk = N / 32, kb = item / nblk, nb = item % nblk;
    p0_transpose_item(W, K, N, WT, 64 * kb, 32 * nb, 32 * nb, scr, lane);
}
__device__ __forceinline__ void tr_ffn13(const float* W, bf16* WT, int item, int which, LAS float* scr, int lane) {
    const int nblk = DFF / 32, kb = item / nblk, nb = item % nblk, n0 = 32 * nb;
    p0_transpose_item(W, DM_, DFF, WT, 64 * kb, n0, 256 * (n0 >> 7) + (n0 & 127) + 128 * which, scr, lane);
}
constexpr int I_IN = 32 * (NIN / 32), I_UA = 8 * 64, I_UE = 16 * 64, I_O = 32 * 64, I_F = 32 * (DFF / 32), I_2 = (DFF / 64) * 64;
constexpr int PER_L = I_IN + 2 * I_UA + I_UE + I_O + 2 * I_F + I_2;
__device__ __forceinline__ void p0_item(Frame& F, const Args& A, const int l, int r, LAS float* scr) {
    unsigned char* wb = F.ws + WS_W0;
    if (r < I_IN) { tr_plain(A.in[10] + (size_t)l * DM_ * NIN, DM_, NIN, (bf16*)(wb + WO_IN), r, scr, F.lane); return; } r -= I_IN;
    if (r < I_UA) { tr_plain(A.in[20] + (size_t)l * 512 * DM_, 512, DM_, (bf16*)(wb + WO_UA), r, scr, F.lane); return; } r -= I_UA;
    if (r < I_UA) { tr_plain(A.in[21] + (size_t)l * 512 * DM_, 512, DM_, (bf16*)(wb + WO_UD), r, scr, F.lane); return; } r -= I_UA;
    if (r < I_UE) { tr_plain(A.in[22] + (size_t)l * 1024 * DM_, 1024, DM_, (bf16*)(wb + WO_UE), r, scr, F.lane); return; } r -= I_UE;
    if (r < I_O) { tr_plain(A.in[23] + (size_t)l * DM_ * DM_, DM_, DM_, (bf16*)(wb + WO_O), r, scr, F.lane); return; } r -= I_O;
    if (r < I_F) { tr_ffn13(A.in[24] + (size_t)l * DM_ * DFF, (bf16*)(wb + WO_13), r, 0, scr, F.lane); return; } r -= I_F;
    if (r < I_F) { tr_ffn13(A.in[25] + (size_t)l * DM_ * DFF, (bf16*)(wb + WO_13), r, 1, scr, F.lane); return; } r -= I_F;
    tr_plain(A.in[26] + (size_t)l * DFF * DM_, DFF, DM_, (bf16*)(wb + WO_2), r, scr, F.lane);
}
__device__ __forceinline__ void p0_dynamic(Frame& F, const Args& A, const int l, unsigned* cnt, const int lo_, const int hi) {
    LAS float* scr = (LAS float*)(F.lds + F.wave * 16384);
    volatile LAS unsigned* slot = (volatile LAS unsigned*)(F.lds + MISC_OFF) + 16;
    for (;;) {
        if (F.tid == 0) slot[0] = __hip_atomic_fetch_add(cnt, 64u, __ATOMIC_RELAXED, __HIP_MEMORY_SCOPE_AGENT);
        __syncthreads();
        const int base = lo_ + (int)slot[0];
        __syncthreads();
        if (base >= hi) break;
        for (int k = 0; k < 8; ++k) { const int it = base + F.wave * 8 + k; if (it < hi) p0_item(F, A, l, it, scr); }
    }
}
__device__ __forceinline__ void p0_phase(Frame& F, const Args& A, const int l, const bool gemv, const int ilo, const int ihi) {
    LAS float* scr = (LAS float*)(F.lds + F.wave * 16384);
    const int gw = F.bid * 8 + F.wave, NGW = F.G * 8;
    for (int it = ilo + gw; it < ilo + (ihi - ilo) * REP_P0; it += NGW) p0_item(F, A, l, ilo + (it - ilo) % (ihi - ilo), scr);
    __syncthreads();
    if (!gemv) return;
    LAS float* red = (LAS float*)F.lds;
    const float* cl = A.in[1]; const float* cc = A.in[3];
    for (int it = F.bid; it < 2 * 192; it += F.G) {
        const int lg = it / 192, jb = it % 192, kg = F.tid >> 4, jl = F.tid & 15;
        const float* wp = A.in[4] + ((size_t)lg * DM_ + kg * 64) * 12288 + jb * 64 + jl * 4;
        f32x4 al = {0.f, 0.f, 0.f, 0.f}, ac = {0.f, 0.f, 0.f, 0.f};
#pragma unroll 8
        for (int kk = 0; kk < 64; ++kk) {
            const f32x4 w = *(const f32x4*)(wp + (size_t)kk * 12288);
            const float sl = siluf_(cl[kg * 64 + kk]), sc = siluf_(cc[kg * 64 + kk]);
            al += w * sl; ac += w * sc;
        }
        LAS float* rp = red + (kg * 16 + jl) * 8;
        rp[0] = al.x; rp[1] = al.y; rp[2] = al.z; rp[3] = al.w; rp[4] = ac.x; rp[5] = ac.y; rp[6] = ac.z; rp[7] = ac.w;
        __syncthreads();
        if (F.tid < 128) {
            const int j2 = F.tid & 15, comp = F.tid >> 4; float s = 0.f;
            for (int g = 0; g < 32; ++g) s += red[(g * 16 + j2) * 8 + comp];
            const int sidx = comp >> 2, col = jb * 64 + j2 * 4 + (comp & 3);
            ((float*)(F.ws + WS_MOD))[(size_t)(lg * 2 + sidx) * 12288 + col] = s + A.in[5][(size_t)lg * 12288 + col];
        }
        __syncthreads();
    }
}

template <int MODE> __device__ __forceinline__ void row_phase(Frame& F, const Args& A, int l) {
    const int gw = F.bid * 8 + F.wave, NGW = F.G * 8;
    float* X = (float*)(F.ws + WS_X); const float* Y2 = (const float*)(F.ws + WS_R2); bf16* H = (bf16*)(F.ws + WS_H);
    const float* MOD = (const float*)(F.ws + WS_MOD);
    for (int r = gw + ((MODE >= 1 && l == 1) ? CTXL : 0); r < MROWS; r += NGW) {
        const int s = r < CTXL ? 1 : 0;
        const float* mod = MOD + (size_t)(l * 2 + s) * 12288;
        f32x4 v[8];
        if (MODE == 0) {
            const float* src = s ? A.in[2] + (size_t)r * DM_ : A.in[0] + (size_t)(r - CTXL) * DM_;
#pragma unroll
            for (int j = 0; j < 8; ++j) v[j] = *(const f32x4*)(src + (F.lane + 64 * j) * 4);
        } else {
            const float* y = Y2 + (size_t)r * DM_; float ss = 0.f;
            const float* w = (MODE == 1 ? A.in[7] : A.in[9]) + (size_t)l * DM_;
            const float* gate = mod + (MODE == 1 ? 2 : 5) * DM_;
            f32x4 xv[8], wv[8], gv[8];
#pragma unroll
            for (int j = 0; j < 8; ++j) { const int c = (F.lane + 64 * j) * 4; v[j] = *(const f32x4*)(y + c); xv[j] = *(const f32x4*)(X + (size_t)r * DM_ + c); wv[j] = *(const f32x4*)(w + c); gv[j] = *(const f32x4*)(gate + c); }
#pragma unroll
            for (int j = 0; j < 8; ++j) ss += v[j].x * v[j].x + v[j].y * v[j].y + v[j].z * v[j].z + v[j].w * v[j].w;
            const float rs = 1.0f / sqrtf(wave_sum(ss) * (1.0f / DM_) + 1e-6f);
#pragma unroll
            for (int j = 0; j < 8; ++j) v[j] = xv[j] + gv[j] * (v[j] * rs * wv[j]);
        }
        if (MODE == 2 && l == 1) {
            if (!s) {
#pragma unroll
                for (int j = 0; j < 8; ++j) *(f32x4*)(F.out + (size_t)(r - CTXL) * DM_ + (F.lane + 64 * j) * 4) = v[j];
            }
            continue;
        }
        float ss = 0.f;
        const float* wn = (MODE == 0 ? A.in[6] : MODE == 1 ? A.in[8] + (size_t)l * DM_ : A.in[6] + (size_t)(l + 1) * DM_);
        const float* modn = (MODE == 2) ? MOD + (size_t)((l + 1) * 2 + s) * 12288 : mod;
        const float* sh = modn + (MODE == 1 ? 3 : 0) * DM_; const float* sc = sh + DM_;
#pragma unroll
        for (int j = 0; j < 8; ++j) { *(f32x4*)(X + (size_t)r * DM_ + (F.lane + 64 * j) * 4) = v[j]; ss += v[j].x * v[j].x + v[j].y * v[j].y + v[j].z * v[j].z + v[j].w * v[j].w; }
        const float rs2 = 1.0f / sqrtf(wave_sum(ss) * (1.0f / DM_) + 1e-6f);
#pragma unroll
        for (int j = 0; j < 8; ++j) { const int c = (F.lane + 64 * j) * 4;
            const f32x4 wv = *(const f32x4*)(wn + c), shv = *(const f32x4*)(sh + c), scv = *(const f32x4*)(sc + c);
            const f32x4 h = (v[j] * rs2 * wv) * (1.0f + scv) + shv;
            v2u o; o.x = pk2(h.x, h.y); o.y = pk2(h.z, h.w);
            *(v2u*)(H + (size_t)r * DM_ + c) = o; }
    }
}
__device__ __forceinline__ void prep_phase(Frame& F, const Args& A, int l) {
    const int gw = F.bid * 8 + F.wave, NGW = F.G * 8, lane = F.lane;
    const bf16* Z = (const bf16*)(F.ws + WS_Z); const float* ZG = (const float*)(F.ws + WS_ZG);
    bf16* AQ = (bf16*)(F.ws + WS_AQ); bf16* AK = (bf16*)(F.ws + WS_AK); bf16* AV = (bf16*)(F.ws + WS_AV);
    bf16* DQ = (bf16*)(F.ws + WS_DQ); bf16* DK = (bf16*)(F.ws + WS_DK); bf16* DV = (bf16*)(F.ws + WS_DV);
    float* DG = (float*)(F.ws + WS_DGB); float* DB = DG + 16 * MROWS;
    const float* conv_w = A.in[16] + (size_t)l * 5 * 3072;
    const float* a_log = A.in[17] + l * 16; const float* dt_bias = A.in[18] + l * 16;
    constexpr float C2 = 0.125f * 1.4426950408889634f;
    for (int g_ = gw; g_ < (MROWS / 4) * REP_ROWS; g_ += NGW) {
        const int r0 = (g_ % (MROWS / 4)) * 4;
        const bool lat = r0 >= CTXL; const int lo = lat ? CTXL : 0, hi = lat ? MROWS : CTXL;
        for (int it = 0; it < 6; ++it) {
            const int ch0 = it * 512 + lane * 8, p = it >> 1;
            v4u xr[8];
#pragma unroll
            for (int j = 0; j < 8; ++j) { const int rr = r0 + j - 2; xr[j] = (rr >= lo && rr < hi) ? *(const v4u*)(Z + (size_t)rr * ZP + C_EQ + ch0) : (v4u){0u, 0u, 0u, 0u}; }
            float acc[4][8];
#pragma unroll
            for (int j = 0; j < 4; ++j)
#pragma unroll
                for (int e = 0; e < 8; ++e) acc[j][e] = 0.f;
#pragma unroll
            for (int i = 0; i < 5; ++i) {
                const f32x4 c0 = *(const f32x4*)(conv_w + i * 3072 + ch0), c1 = *(const f32x4*)(conv_w + i * 3072 + ch0 + 4);
#pragma unroll
                for (int j = 0; j < 4; ++j) { const v4u x = xr[j + i];
                    acc[j][0] += bflo(x.x) * c0.x; acc[j][1] += bfhi(x.x) * c0.y; acc[j][2] += bflo(x.y) * c0.z; acc[j][3] += bfhi(x.y) * c0.w;
                    acc[j][4] += bflo(x.z) * c1.x; acc[j][5] += bfhi(x.z) * c1.y; acc[j][6] += bflo(x.w) * c1.z; acc[j][7] += bfhi(x.w) * c1.w; }
            }
            bf16* dstb = (p == 0 ? DQ : p == 1 ? DK : DV) + (ch0 & 1023);
#pragma unroll
            for (int j = 0; j < 4; ++j) {
                float sv[8]; float ss = 0.f;
#pragma unroll
                for (int e = 0; e < 8; ++e) { sv[e] = siluf_(acc[j][e]); ss += sv[e] * sv[e]; }
                if (p < 2) {
                    ss += __shfl_xor(ss, 1); ss += __shfl_xor(ss, 2); ss += __shfl_xor(ss, 4); ss += __shfl_xor(ss, 8);
                    const float sc = (1.0f / sqrtf(ss + 1e-6f)) * (p == 0 ? 0.08838834764831845f : 1.0f);
#pragma unroll
                    for (int e = 0; e < 8; ++e) sv[e] *= sc;
                }
                v4u o; o.x = pk2(sv[0], sv[1]); o.y = pk2(sv[2], sv[3]); o.z = pk2(sv[4], sv[5]); o.w = pk2(sv[6], sv[7]);
                *(v4u*)(dstb + (size_t)(r0 + j) * 1024) = o;
            }
        }
        {
            const int r = r0 + (lane >> 4), gi = lane & 15;
            const float a = ZG[(size_t)r * 64 + 32 + gi], bt = ZG[(size_t)r * 64 + 48 + gi];
            const float xs = a + dt_bias[gi];
            const float sp = xs > 20.f ? xs : log1pf(expf(xs));
            DG[(size_t)gi * MROWS + r] = -expf(a_log[gi]) * sp;
            DB[(size_t)gi * MROWS + r] = 1.0f / (1.0f + expf(-bt));
        }
        for (int j = 0; j < 4; ++j) {
            const int r = r0 + j, t = r - CTXL; const bf16* zr = Z + (size_t)r * ZP;
            const v4u qv = *(const v4u*)(zr + C_DQ + lane * 8), kv = *(const v4u*)(zr + C_DK + lane * 8), vv = *(const v4u*)(zr + C_DV + lane * 8);
            *(v4u*)(AV + (size_t)r * 512 + lane * 8) = vv;
            float q[8], k[8];
            q[0] = bflo(qv.x); q[1] = bfhi(qv.x); q[2] = bflo(qv.y); q[3] = bfhi(qv.y); q[4] = bflo(qv.z); q[5] = bfhi(qv.z); q[6] = bflo(qv.w); q[7] = bfhi(qv.w);
            k[0] = bflo(kv.x); k[1] = bfhi(kv.x); k[2] = bflo(kv.y); k[3] = bfhi(kv.y); k[4] = bflo(kv.z); k[5] = bfhi(kv.z); k[6] = bflo(kv.w); k[7] = bfhi(kv.w);
            if (lat) {
                const int sub = lane & 3, part = (lane >> 2) & 1; const float pos = (float)(part ? (t & 63) : (t >> 6));
                const float sgn = (sub & 2) ? 1.0f : -1.0f;
#pragma unroll
                for (int e = 0; e < 8; ++e) {
                    const float qp = __shfl_xor(q[e], 2), kp = __shfl_xor(k[e], 2);
                    const int i = (sub & 1) * 8 + e;
                    const float inv = __builtin_amdgcn_exp2f(-(float)i * 0.8304820237218406f);
                    const float rev = (pos * inv) * 0.15915494309189535f;
                    const float cs = __builtin_amdgcn_cosf(rev), sn = __builtin_amdgcn_sinf(rev);
                    q[e] = q[e] * cs + sgn * qp * sn; k[e] = k[e] * cs + sgn * kp * sn;
                }
            }
            v4u qo, ko;
            qo.x = pk2(q[0] * C2, q[1] * C2); qo.y = pk2(q[2] * C2, q[3] * C2); qo.z = pk2(q[4] * C2, q[5] * C2); qo.w = pk2(q[6] * C2, q[7] * C2);
            ko.x = pk2(k[0], k[1]); ko.y = pk2(k[2], k[3]); ko.z = pk2(k[4], k[5]); ko.w = pk2(k[6], k[7]);
            *(v4u*)(AQ + (size_t)r * 512 + lane * 8) = qo; *(v4u*)(AK + (size_t)r * 512 + lane * 8) = ko;
        }
    }
}

__device__ __forceinline__ int scan_row(int dir, int n, int i) {
    if (dir == 0) return 64 * n + i;
    return (n < 4 ? 64 * (3 - n) : CTXL + 64 * (127 - (n - 4))) + 63 - i;
}

__device__ __forceinline__ void gla_chain_naive(Frame& F, const Args& A, int l, int chain) {
    const int dir = chain >> 2, h = chain & 3, tid = F.tid, lane = F.lane;
    const bf16* Z = (const bf16*)(F.ws + WS_Z); const float* ZG = (const float*)(F.ws + WS_ZG);
    float* OA = (float*)(F.ws + WS_YB) + (size_t)dir * MROWS * 512;
    const float* w2 = A.in[11] + ((size_t)(l * 2 + dir) * 16) * 512 + h * 128; const float* gb = A.in[12] + (size_t)(l * 2 + dir) * 512 + h * 128;
    LAS bf16* qs = (LAS bf16*)F.lds; LAS bf16* ks = qs + 64 * 128; LAS bf16* vs = ks + 64 * 128; LAS float* eg = (LAS float*)(F.lds + 49152);
    float S[64];
#pragma unroll
    for (int d = 0; d < 64; ++d) S[d] = 0.f;
    const int col = (tid >> 6) * 32 + (lane & 31), half = lane >> 5;
    for (int n = 0; n < 132; ++n) {
        for (int p = tid; p < 1024; p += 512) { const int i = p >> 4, c8 = (p & 15) * 8; const bf16* zr = Z + (size_t)scan_row(dir, n, i) * ZP + h * 128 + c8;
            *(LAS v4u*)(qs + i * 128 + c8) = *(const v4u*)(zr + C_GQ); *(LAS v4u*)(ks + i * 128 + c8) = *(const v4u*)(zr + C_GK); *(LAS v4u*)(vs + i * 128 + c8) = *(const v4u*)(zr + C_GV); }
        {   const int i = tid >> 3, dg = (tid & 7) * 16; const float* lr = ZG + (size_t)scan_row(dir, n, i) * 64 + dir * 16;
            float x[16];
#pragma unroll
            for (int jj = 0; jj < 16; ++jj) x[jj] = gb[dg + jj];
            for (int j = 0; j < 16; ++j) { const float lv = lr[j];
#pragma unroll
                for (int jj = 0; jj < 16; ++jj) x[jj] += lv * w2[j * 512 + dg + jj]; }
#pragma unroll
            for (int jj = 0; jj < 16; ++jj) { const float ls = fminf(x[jj], 0.f) - log1pf(expf(-fabsf(x[jj]))); eg[i * 128 + dg + jj] = expf(ls * 0.0625f); }
        }
        __syncthreads();
        if (tid < 256) {
            for (int i = 0; i < 64; ++i) {
                const float vv = bf2f(vs[i * 128 + col]); float o = 0.f;
#pragma unroll
                for (int d4 = 0; d4 < 16; ++d4) {
                    const f32x4 e4 = *(const LAS f32x4*)(eg + i * 128 + half * 64 + d4 * 4);
                    const v2u k2 = *(const LAS v2u*)(ks + i * 128 + half * 64 + d4 * 4), q2 = *(const LAS v2u*)(qs + i * 128 + half * 64 + d4 * 4);
                    S[d4 * 4 + 0] = S[d4 * 4 + 0] * e4.x + bflo(k2.x) * vv; o += S[d4 * 4 + 0] * bflo(q2.x);
                    S[d4 * 4 + 1] = S[d4 * 4 + 1] * e4.y + bfhi(k2.x) * vv; o += S[d4 * 4 + 1] * bfhi(q2.x);
                    S[d4 * 4 + 2] = S[d4 * 4 + 2] * e4.z + bflo(k2.y) * vv; o += S[d4 * 4 + 2] * bflo(q2.y);
                    S[d4 * 4 + 3] = S[d4 * 4 + 3] * e4.w + bfhi(k2.y) * vv; o += S[d4 * 4 + 3] * bfhi(q2.y);
                }
                o += __shfl_xor(o, 32);
                if (half == 0) OA[(size_t)scan_row(dir, n, i) * 512 + h * 128 + col] = o * 0.08838834764831845f;
            }
        }
        __syncthreads();
    }
}
__device__ __forceinline__ void delta_chain_naive(Frame& F, const Args& A, int chain) {
    const int dir = chain >> 3, h = chain & 7, tid = F.tid, lane = F.lane;
    const bf16* DQ = (const bf16*)(F.ws + WS_DQ); const bf16* DK = (const bf16*)(F.ws + WS_DK); const bf16* DV = (const bf16*)(F.ws + WS_DV);
    const float* DG = (const float*)(F.ws + WS_DGB) + (size_t)chain * MROWS; const float* DB = (const float*)(F.ws + WS_DGB) + (size_t)(16 + chain) * MROWS;
    float* OE = (float*)(F.ws + WS_R2) + (size_t)dir * MROWS * 1024;
    LAS bf16* qs = (LAS bf16*)F.lds; LAS bf16* ks = qs + 64 * 128; LAS bf16* vs = ks + 64 * 128; LAS float* gs = (LAS float*)(F.lds + 49152);
    float S[64];
#pragma unroll
    for (int d = 0; d < 64; ++d) S[d] = 0.f;
    const int col = (tid >> 6) * 32 + (lane & 31), half = lane >> 5;
    for (int n = 0; n < 132; ++n) {
        for (int p = tid; p < 1024; p += 512) { const int i = p >> 4, c8 = (p & 15) * 8; const size_t off = (size_t)scan_row(dir, n, i) * 1024 + h * 128 + c8;
            *(LAS v4u*)(qs + i * 128 + c8) = *(const v4u*)(DQ + off); *(LAS v4u*)(ks + i * 128 + c8) = *(const v4u*)(DK + off); *(LAS v4u*)(vs + i * 128 + c8) = *(const v4u*)(DV + off); }
        if (tid < 64) { const int r = scan_row(dir, n, tid); gs[tid] = expf(DG[r]); gs[64 + tid] = DB[r]; }
        __syncthreads();
        if (tid < 256) {
            for (int i = 0; i < 64; ++i) {
                const float vv = bf2f(vs[i * 128 + col]), egv = gs[i], beta = gs[64 + i];
                float kf[64]; float kS = 0.f;
#pragma unroll
                for (int d4 = 0; d4 < 16; ++d4) { const v2u k2 = *(const LAS v2u*)(ks + i * 128 + half * 64 + d4 * 4);
                    kf[d4 * 4 + 0] = bflo(k2.x); kf[d4 * 4 + 1] = bfhi(k2.x); kf[d4 * 4 + 2] = bflo(k2.y); kf[d4 * 4 + 3] = bfhi(k2.y);
                    kS += kf[d4 * 4 + 0] * S[d4 * 4 + 0] + kf[d4 * 4 + 1] * S[d4 * 4 + 1] + kf[d4 * 4 + 2] * S[d4 * 4 + 2] + kf[d4 * 4 + 3] * S[d4 * 4 + 3]; }
                kS += __shfl_xor(kS, 32);
                const float u = beta * (vv - egv * kS); float o = 0.f;
#pragma unroll
                for (int d4 = 0; d4 < 16; ++d4) { const v2u q2 = *(const LAS v2u*)(qs + i * 128 + half * 64 + d4 * 4);
                    S[d4 * 4 + 0] = S[d4 * 4 + 0] * egv + kf[d4 * 4 + 0] * u; o += S[d4 * 4 + 0] * bflo(q2.x);
                    S[d4 * 4 + 1] = S[d4 * 4 + 1] * egv + kf[d4 * 4 + 1] * u; o += S[d4 * 4 + 1] * bfhi(q2.x);
                    S[d4 * 4 + 2] = S[d4 * 4 + 2] * egv + kf[d4 * 4 + 2] * u; o += S[d4 * 4 + 2] * bflo(q2.y);
                    S[d4 * 4 + 3] = S[d4 * 4 + 3] * egv + kf[d4 * 4 + 3] * u; o += S[d4 * 4 + 3] * bfhi(q2.y); }
                o += __shfl_xor(o, 32);
                if (half == 0) OE[(size_t)scan_row(dir, n, i) * 1024 + h * 128 + col] = o;
            }
        }
        __syncthreads();
    }
}

__device__ __forceinline__ void out_phase(Frame& F, const Args& A, int l) {
    const int gw = F.bid * 8 + F.wave, NGW = F.G * 8, lane = F.lane;
    const bf16* Z = (const bf16*)(F.ws + WS_Z); const bf16* AO = (const bf16*)(F.ws + WS_AO);
    const float* OA = (const float*)(F.ws + WS_YB); const float* OE = (const float*)(F.ws + WS_R2);
    bf16* A_ = (bf16*)(F.ws + WS_A); bf16* D_ = (bf16*)(F.ws + WS_D); bf16* E_ = (bf16*)(F.ws + WS_E);
    const float lam_init = l == 0 ? 0.2f : 0.35550906759096924f;
    const float* lp = A.in[14] + l * 256;
    const float lam = expf(wave_sum(lp[lane] * lp[64 + lane])) - expf(wave_sum(lp[128 + lane] * lp[192 + lane])) + lam_init;
    const float* gnw = A.in[13] + l * 128 + lane * 2; const float* dnw = A.in[15] + l * 128 + lane * 2; const float* enw = A.in[19] + l * 128 + lane * 2;
    const float gw0 = gnw[0], gw1 = gnw[1], dw0 = dnw[0], dw1 = dnw[1], ew0 = enw[0], ew1 = enw[1];
    for (int r = gw; r < MROWS; r += NGW) {
        const bf16* zr = Z + (size_t)r * ZP;
        for (int h = 0; h < 4; ++h) {
            const int c = h * 128 + lane * 2;
            {   const float* o0 = OA + (size_t)r * 512 + c; const float* o1 = o0 + (size_t)MROWS * 512;
                const float x0 = o0[0] + o1[0], x1 = o0[1] + o1[1];
                const float rs = 1.0f / sqrtf(wave_sum(x0 * x0 + x1 * x1) * (1.0f / 128.f) + 1e-6f);
                const unsigned g = *(const unsigned*)(zr + C_GG + c);
                *(unsigned*)(A_ + (size_t)r * 512 + c) = pk2(x0 * rs * gw0 * siluf_(bflo(g)), x1 * rs * gw1 * siluf_(bfhi(g))); }
            {   const unsigned w1 = *(const unsigned*)(AO + (size_t)r * 1024 + (h * 2) * 128 + lane * 2), w2 = *(const unsigned*)(AO + (size_t)r * 1024 + (h * 2 + 1) * 128 + lane * 2);
                const float x0 = bflo(w1) - lam * bflo(w2), x1 = bfhi(w1) - lam * bfhi(w2);
                const float rs = 1.0f / sqrtf(wave_sum(x0 * x0 + x1 * x1) * (1.0f / 128.f) + 1e-6f) * (1.0f - lam_init);
                *(unsigned*)(D_ + (size_t)r * 512 + c) = pk2(x0 * rs * dw0, x1 * rs * dw1); }
        }
        for (int h = 0; h < 8; ++h) {
            const int c = h * 128 + lane * 2;
            const float* o0 = OE + (size_t)r * 1024 + c; const float* o1 = o0 + (size_t)MROWS * 1024;
            const float x0 = o0[0] + o1[0], x1 = o0[1] + o1[1];
            const float rs = 1.0f / sqrtf(wave_sum(x0 * x0 + x1 * x1) * (1.0f / 128.f) + 1e-6f);
            const unsigned g = *(const unsigned*)(zr + C_EG + c);
            *(unsigned*)(E_ + (size_t)r * 1024 + c) = pk2(x0 * rs * ew0 * siluf_(bflo(g)), x1 * rs * ew1 * siluf_(bfhi(g)));
        }
    }
}
typedef short bf16x8_t __attribute__((ext_vector_type(8)));
#define LBAR() do { asm volatile("s_waitcnt lgkmcnt(0)" ::: "memory"); __builtin_amdgcn_s_barrier(); asm volatile("" ::: "memory"); } while (0)
constexpr int P128 = 136, P64 = 72;
template <int K> __device__ __forceinline__ f32x4 mma16(const LAS bf16* A, int lda, const LAS bf16* Bt, int ldb, f32x4 acc, int lane) {
    const int r = lane & 15, q = lane >> 4;
    const LAS bf16* ap = A + r * lda + q * 8; const LAS bf16* bp = Bt + r * ldb + q * 8;
#pragma unroll
    for (int k0 = 0; k0 < K; k0 += 32) {
        const bf16x8_t a = *(const LAS bf16x8_t*)(ap + k0), b = *(const LAS bf16x8_t*)(bp + k0);
        acc = __builtin_amdgcn_mfma_f32_16x16x32_bf16(a, b, acc, 0, 0, 0);
    }
    return acc;
}
__device__ __forceinline__ int chunk_scan_index(int dir, int c) { return dir == 0 ? c : (c < 4 ? 3 - c : 135 - c); }
__device__ __forceinline__ float wave_incl_scan(float x, int lane) {
#pragma unroll
    for (int o = 1; o < 64; o <<= 1) { const float t = __shfl_up(x, o); if (lane >= o) x += t; }
    return x;
}
constexpr size_t WS_DS = WS_W0 + W_LAYER;
constexpr size_t WS_PP = WS_DS, WS_NT = WS_DS + 66 * MiB, WS_GL = WS_DS + 132 * MiB, WS_GD = WS_GL + 1 * MiB;
constexpr size_t WS_UG = WS_H, WS_WG = WS_END, WS_GS = WS_R2, WS_BS = WS_YB;
constexpr size_t WS_END2 = WS_END + 33 * MiB;

__device__ __forceinline__ void delta_prep2_item(Frame& F, int chain, int n) {
    const int dir = chain >> 3, h = chain & 7, tid = F.tid, lane = F.lane, w = F.wave;
    const bf16* DK = (const bf16*)(F.ws + WS_DK); const bf16* DV = (const bf16*)(F.ws + WS_DV);
    const float* DG = (const float*)(F.ws + WS_DGB) + (size_t)chain * MROWS; const float* DB = (const float*)(F.ws + WS_DGB) + (size_t)(16 + chain) * MROWS;
    const size_t item = (size_t)chain * 132 + n;
    bf16* Pp = (bf16*)(F.ws + WS_PP) + item * 16384; bf16* NT = (bf16*)(F.ws + WS_NT) + item * 16384;
    bf16* Ug = (bf16*)(F.ws + WS_UG) + item * 8192; bf16* Wg = (bf16*)(F.ws + WS_WG) + item * 8192;
    LAS bf16* Ks = (LAS bf16*)(F.lds);
    LAS float* AM = (LAS float*)(F.lds + 18432);
    LAS bf16* UT = (LAS bf16*)(F.lds);
    LAS bf16* KbT = (LAS bf16*)(F.lds + 35840);
    LAS bf16* KdT = (LAS bf16*)(F.lds + 54272);
    LAS bf16* VbT = (LAS bf16*)(F.lds + 72704);
    LAS bf16* TB = (LAS bf16*)(F.lds + 91136);
    LAS bf16* WT = (LAS bf16*)(F.lds + 100352);
    LAS float* gcs = (LAS float*)(F.lds + 118784); LAS float* bts = gcs + 64;
    const int ip = tid & 31, c8 = (tid >> 5) * 8, i0 = 2 * ip, i1 = i0 + 1;
    const size_t off0 = (size_t)scan_row(dir, n, i0) * 1024 + h * 128 + c8, off1 = (size_t)scan_row(dir, n, i1) * 1024 + h * 128 + c8;
    const v4u kv0 = *(const v4u*)(DK + off0), kv1 = *(const v4u*)(DK + off1), vv0 = *(const v4u*)(DV + off0), vv1 = *(const v4u*)(DV + off1);
    if (w == 0) { const int r = scan_row(dir, n, lane); gcs[lane] = wave_incl_scan(DG[r], lane); bts[lane] = DB[r]; }
    LBAR();
    const float gclast = gcs[63];
    {
        *(LAS v4u*)(Ks + i0 * P128 + c8) = kv0; *(LAS v4u*)(Ks + i1 * P128 + c8) = kv1;
        const float bt0 = bts[i0], bt1 = bts[i1], fb0 = bt0 * __expf(gcs[i0]), fb1 = bt1 * __expf(gcs[i1]), fd0 = __expf(gclast - gcs[i0]), fd1 = __expf(gclast - gcs[i1]);
        const unsigned k0w[4] = {kv0.x, kv0.y, kv0.z, kv0.w}, k1w[4] = {kv1.x, kv1.y, kv1.z, kv1.w}, v0w[4] = {vv0.x, vv0.y, vv0.z, vv0.w}, v1w[4] = {vv1.x, vv1.y, vv1.z, vv1.w};
#pragma unroll
        for (int e = 0; e < 4; ++e) {
            const float ka0 = bflo(k0w[e]), kb0 = bfhi(k0w[e]), ka1 = bflo(k1w[e]), kb1 = bfhi(k1w[e]);
            const float va0 = bflo(v0w[e]), vb0 = bfhi(v0w[e]), va1 = bflo(v1w[e]), vb1 = bfhi(v1w[e]);
            const int ca = (c8 + 2 * e) * P64 + i0, cb = (c8 + 2 * e + 1) * P64 + i0;
            *(LAS unsigned*)(KbT + ca) = pk2(ka0 * fb0, ka1 * fb1); *(LAS unsigned*)(KbT + cb) = pk2(kb0 * fb0, kb1 * fb1);
            *(LAS unsigned*)(KdT + ca) = pk2(ka0 * fd0, ka1 * fd1); *(LAS unsigned*)(KdT + cb) = pk2(kb0 * fd0, kb1 * fd1);
            *(LAS unsigned*)(VbT + ca) = pk2(va0 * bt0, va1 * bt1); *(LAS unsigned*)(VbT + cb) = pk2(vb0 * bt0, vb1 * bt1);
        }
    }
    LBAR();
    const int r = lane & 15, q = lane >> 4;
#pragma unroll
    for (int t2 = 0; t2 < 2; ++t2) {
        const int t = w * 2 + t2, mi = t >> 2, nj = t & 3;
        const f32x4 acc = mma16<128>(Ks + 16 * mi * P128, P128, Ks + 16 * nj * P128, P128, (f32x4){0.f, 0.f, 0.f, 0.f}, lane);
        const int j = 16 * nj + r; const float gj = gcs[j];
#pragma unroll
        for (int jj = 0; jj < 4; ++jj) { const int i = 16 * mi + 4 * q + jj;
            AM[i * 68 + j] = (j < i) ? bts[i] * acc[jj] * __expf(gcs[i] - gj) : 0.f; }
    }
    LBAR();
    {
        LAS float* TM = (LAS float*)(F.lds + 119296);
        LAS float* XM = (LAS float*)(F.lds + 136704);
        if (w == 0) {
            const int b16 = 16 * (lane >> 4), c = lane & 15;
            float t[16];
#pragma unroll
            for (int i = 0; i < 16; ++i) {
                float s_ = (i == c) ? 1.f : 0.f;
#pragma unroll
                for (int j4 = 0; j4 < (i + 3) / 4; ++j4) {
                    const f32x4 a = *(const LAS f32x4*)(AM + (b16 + i) * 68 + b16 + j4 * 4);
                    if (j4 * 4 + 0 < i) s_ -= a.x * t[j4 * 4 + 0];
                    if (j4 * 4 + 1 < i) s_ -= a.y * t[j4 * 4 + 1];
                    if (j4 * 4 + 2 < i) s_ -= a.z * t[j4 * 4 + 2];
                    if (j4 * 4 + 3 < i) s_ -= a.w * t[j4 * 4 + 3];
                }
                t[i] = s_;
                TM[(b16 + i) * 68 + b16 + c] = s_;
            }
        }
        LBAR();
        const int rr = (tid >> 4) & 15, cc = tid & 15;
#pragma unroll
        for (int d = 1; d < 4; ++d) {
            for (int blk = tid >> 8; blk < 4 - d; blk += 2) {
                const int bj = blk, bi = blk + d; float x = 0.f;
                for (int k = bj; k < bi; ++k)
#pragma unroll
                    for (int m = 0; m < 16; ++m) x += AM[(16 * bi + rr) * 68 + 16 * k + m] * TM[(16 * k + m) * 68 + 16 * bj + cc];
                XM[(blk * 16 + rr) * 17 + cc] = x;
            }
            LBAR();
            for (int blk = tid >> 8; blk < 4 - d; blk += 2) {
                const int bj = blk, bi = blk + d; float x = 0.f;
#pragma unroll
                for (int m = 0; m < 16; ++m) x -= TM[(16 * bi + rr) * 68 + 16 * bi + m] * XM[(blk * 16 + m) * 17 + cc];
                TM[(16 * bi + rr) * 68 + 16 * bj + cc] = x;
            }
            LBAR();
        }
        {   const int i = tid >> 3, j0 = (tid & 7) * 8; float v[8];
#pragma unroll
            for (int e = 0; e < 8; ++e) v[e] = ((j0 + e) >> 4) > (i >> 4) ? 0.f : TM[i * 68 + j0 + e];
            v4u o; o.x = pk2(v[0], v[1]); o.y = pk2(v[2], v[3]); o.z = pk2(v[4], v[5]); o.w = pk2(v[6], v[7]);
            *(LAS v4u*)(TB + i * P64 + j0) = o; }
    }
    LBAR();
#pragma unroll
    for (int t4 = 0; t4 < 4; ++t4) {
        const int t = w * 4 + t4, mi = t >> 3, nv = t & 7;
        const f32x4 u = mma16<64>(TB + 16 * mi * P64, P64, VbT + 16 * nv * P64, P64, (f32x4){0.f, 0.f, 0.f, 0.f}, lane);
        const f32x4 ww = mma16<64>(TB + 16 * mi * P64, P64, KbT + 16 * nv * P64, P64, (f32x4){0.f, 0.f, 0.f, 0.f}, lane);
        const int c = 16 * nv + r, i0 = 16 * mi + 4 * q;
        v2u up; up.x = pk2(u[0], u[1]); up.y = pk2(u[2], u[3]);
        v2u wp; wp.x = pk2(ww[0], ww[1]); wp.y = pk2(ww[2], ww[3]);
        *(LAS v2u*)(UT + c * P64 + i0) = up; *(LAS v2u*)(WT + c * P64 + i0) = wp;
        *(v2u*)(Ug + c * 64 + i0) = up;
#pragma unroll
        for (int jj = 0; jj < 4; ++jj) Wg[(i0 + jj) * 128 + c] = (bf16)f2bf(ww[jj]);
    }
    LBAR();
#pragma unroll
    for (int t8 = 0; t8 < 8; ++t8) {
        const int mb = w, na = t8;
        const f32x4 pt = mma16<64>(WT + 16 * mb * P64, P64, KdT + 16 * na * P64, P64, (f32x4){0.f, 0.f, 0.f, 0.f}, lane);
        v2u pp; pp.x = pk2(-pt[0], -pt[1]); pp.y = pk2(-pt[2], -pt[3]);
        *(v2u*)(Pp + ((size_t)((na * 4 + (mb >> 1)) * 64 + lane)) * 8 + 4 * (mb & 1)) = pp;
        const int ma = w, nv = t8;
        const f32x4 nn = mma16<64>(KdT + 16 * ma * P64, P64, UT + 16 * nv * P64, P64, (f32x4){0.f, 0.f, 0.f, 0.f}, lane);
        v2u np; np.x = pk2(nn[0], nn[1]); np.y = pk2(nn[2], nn[3]);
        *(v2u*)(NT + (size_t)(16 * nv + r) * 128 + 16 * ma + 4 * q) = np;
    }
    if (tid == 0) ((float*)(F.ws + WS_GL))[item] = __expf(gclast);
    LBAR();
}

constexpr int CH_SLOT = 32768 + 128 * P128 * 2;
#define CH_BAR() do { asm volatile("s_waitcnt lgkmcnt(0)" ::: "memory"); __builtin_amdgcn_s_barrier(); asm volatile("" ::: "memory"); } while (0)
__device__ __forceinline__ void delta_chain(Frame& F, int chain) {
    const int tid = F.tid, lane = F.lane, w = F.wave, r = lane & 15, q = lane >> 4;
    const bf16* Pp = (const bf16*)(F.ws + WS_PP) + (size_t)chain * 132 * 16384; bf16* NT = (bf16*)(F.ws + WS_NT) + (size_t)chain * 132 * 16384;
    LAS unsigned char* ring = F.lds; LAS float* gls = (LAS float*)(F.lds + 2 * CH_SLOT);
    if (tid < 132) gls[tid] = ((const float*)(F.ws + WS_GL))[chain * 132 + tid];
    if (w >= 4) {
        const int lt = tid - 256;
        unsigned ndst[8];
#pragma unroll
        for (int k = 0; k < 8; ++k) { const int p = lt + 256 * k; ndst[k] = 32768u + (unsigned)((p >> 4) * P128 + (p & 15) * 8) * 2u; }
        v4u rp[3][8], rn[3][8];
#define CH_LOAD(set, step) do { const v4u* ps_ = (const v4u*)(Pp + (size_t)(step) * 16384) + lt; const v4u* ns_ = (const v4u*)(NT + (size_t)(step) * 16384) + lt; \
        _Pragma("unroll") for (int k = 0; k < 8; ++k) { rp[set][k] = ps_[256 * k]; rn[set][k] = ns_[256 * k]; } } while (0)
#define CH_WRITE(set, slot) do { LAS unsigned char* sb_ = ring + (slot) * CH_SLOT; \
        _Pragma("unroll") for (int k = 0; k < 8; ++k) { *(LAS v4u*)(sb_ + (lt + 256 * k) * 16) = rp[set][k]; *(LAS v4u*)(sb_ + ndst[k]) = rn[set][k]; } } while (0)
        CH_LOAD(0, 0); CH_LOAD(1, 1); CH_LOAD(2, 2);
        CH_WRITE(0, 0);
        CH_BAR();
        for (int n = 0; n < 132; n += 3) {
            if (n + 3 < 132) CH_LOAD(0, n + 3);
            CH_WRITE(1, (n + 1) & 1);
            CH_BAR();
            if (n + 4 < 132) CH_LOAD(1, n + 4);
            CH_WRITE(2, (n + 2) & 1);
            CH_BAR();
            if (n + 5 < 132) CH_LOAD(2, n + 5);
            if (n + 3 < 132) CH_WRITE(0, (n + 3) & 1);
            CH_BAR();
        }
#undef CH_LOAD
#undef CH_WRITE
    } else {
        f32x4 acc[2][8];
#pragma unroll
        for (int nb = 0; nb < 2; ++nb)
#pragma unroll
            for (int m = 0; m < 8; ++m) acc[nb][m] = (f32x4){0.f, 0.f, 0.f, 0.f};
        bf16* srow = NT + (size_t)(32 * w + r) * 128 + 4 * q;
        const unsigned noff = 32768u + (unsigned)((32 * w + r) * P128 + 4 * q) * 2u;
        CH_BAR();
        for (int n = 0; n < 132; ++n) {
            const LAS unsigned char* slot = ring + (n & 1) * CH_SLOT;
            const float gl = gls[n];
            v2u sp[2][8];
#pragma unroll
            for (int nb = 0; nb < 2; ++nb)
#pragma unroll
                for (int m = 0; m < 8; ++m) {
                    sp[nb][m].x = pk2(acc[nb][m][0], acc[nb][m][1]); sp[nb][m].y = pk2(acc[nb][m][2], acc[nb][m][3]);
                    *(v2u*)(srow + (size_t)n * 16384 + nb * 2048 + 16 * m) = sp[nb][m];
                    const v2u nv = *(const LAS v2u*)(slot + noff + nb * (16 * P128 * 2) + m * 32);
                    acc[nb][m][0] = gl * acc[nb][m][0] + bflo(nv.x); acc[nb][m][1] = gl * acc[nb][m][1] + bfhi(nv.x);
                    acc[nb][m][2] = gl * acc[nb][m][2] + bflo(nv.y); acc[nb][m][3] = gl * acc[nb][m][3] + bfhi(nv.y);
                }
#pragma unroll
            for (int kb = 0; kb < 4; ++kb) {
                const v4u bu0 = {sp[0][2 * kb].x, sp[0][2 * kb].y, sp[0][2 * kb + 1].x, sp[0][2 * kb + 1].y};
                const v4u bu1 = {sp[1][2 * kb].x, sp[1][2 * kb].y, sp[1][2 * kb + 1].x, sp[1][2 * kb + 1].y};
                const bf16x8_t b0 = __builtin_bit_cast(bf16x8_t, bu0), b1 = __builtin_bit_cast(bf16x8_t, bu1);
#pragma unroll
                for (int m = 0; m < 8; ++m) {
                    const bf16x8_t a = *(const LAS bf16x8_t*)(slot + (m * 4 + kb) * 1024 + lane * 16);
                    acc[0][m] = __builtin_amdgcn_mfma_f32_16x16x32_bf16(a, b0, acc[0][m], 0, 0, 0);
                    acc[1][m] = __builtin_amdgcn_mfma_f32_16x16x32_bf16(a, b1, acc[1][m], 0, 0, 0);
                }
            }
            CH_BAR();
        }
    }
    asm volatile("s_waitcnt vmcnt(0)" ::: "memory");
    __syncthreads();
}

__device__ __forceinline__ void delta_out_item(Frame& F, const Args& A, int l, int c, int h) {
    const int tid = F.tid, lane = F.lane, w = F.wave, r = lane & 15, q = lane >> 4;
    const bf16* DQ = (const bf16*)(F.ws + WS_DQ); const bf16* DK = (const bf16*)(F.ws + WS_DK);
    const int row0 = 64 * c;
    LAS bf16* Qs = (LAS bf16*)(F.lds);
    LAS bf16* Ks = (LAS bf16*)(F.lds + 17408);
    LAS bf16* ST = (LAS bf16*)(F.lds + 35840);
    LAS bf16* Ws = (LAS bf16*)(F.lds + 70656);
    LAS bf16* ATT = (LAS bf16*)(F.lds + 88064);
    LAS float* gcs = (LAS float*)(F.lds + 97280);
    LAS bf16* VNT = (LAS bf16*)(F.lds + 97792);
    LAS float* OS = (LAS float*)(F.lds);
    const int mi = w >> 1, nvb = 4 * (w & 1);
    f32x4 oacc[4];
#pragma unroll
    for (int k = 0; k < 4; ++k) oacc[k] = (f32x4){0.f, 0.f, 0.f, 0.f};
    for (int dir = 0; dir < 2; ++dir) {
        const int chain = dir * 8 + h, n = chunk_scan_index(dir, c);
        const size_t item = (size_t)chain * 132 + n;
        const bf16* Sg = (const bf16*)(F.ws + WS_NT) + item * 16384; const bf16* Ug = (const bf16*)(F.ws + WS_UG) + item * 8192; const bf16* Wg = (const bf16*)(F.ws + WS_WG) + item * 8192;
        const float g_in = (w == 0) ? ((const float*)(F.ws + WS_DGB))[(size_t)chain * MROWS + row0 + (dir ? 63 - lane : lane)] : 0.f;
        v2u uu[4];
#pragma unroll
        for (int k = 0; k < 4; ++k) uu[k] = *(const v2u*)(Ug + (16 * (nvb + k) + r) * 64 + (dir ? 60 - (16 * mi + 4 * q) : (16 * mi + 4 * q)));
        {   v4u rq[2], rk[2], rw[2], rs[4];
#pragma unroll
            for (int i2 = 0; i2 < 2; ++i2) { const int p = tid + 512 * i2, t = p >> 4, c8 = (p & 15) * 8; const size_t off = (size_t)(row0 + t) * 1024 + h * 128 + c8;
                if (dir == 0) { rq[i2] = *(const v4u*)(DQ + off); rk[i2] = *(const v4u*)(DK + off); }
                rw[i2] = *(const v4u*)(Wg + (size_t)(dir ? 63 - t : t) * 128 + c8); }
#pragma unroll
            for (int i4 = 0; i4 < 4; ++i4) { const int p = tid + 512 * i4; rs[i4] = *(const v4u*)(Sg + (p >> 4) * 128 + (p & 15) * 8); }
#pragma unroll
            for (int i2 = 0; i2 < 2; ++i2) { const int p = tid + 512 * i2, t = p >> 4, c8 = (p & 15) * 8;
                if (dir == 0) { *(LAS v4u*)(Qs + t * P128 + c8) = rq[i2]; *(LAS v4u*)(Ks + t * P128 + c8) = rk[i2]; }
                *(LAS v4u*)(Ws + t * P128 + c8) = rw[i2]; }
#pragma unroll
            for (int i4 = 0; i4 < 4; ++i4) { const int p = tid + 512 * i4; *(LAS v4u*)(ST + (p >> 4) * P128 + (p & 15) * 8) = rs[i4]; }
        }
        if (w == 0) { const float s_ = wave_incl_scan(g_in, lane); gcs[dir ? 63 - lane : lane] = s_; }
        LBAR();
#pragma unroll
        for (int t2 = 0; t2 < 2; ++t2) {
            const int t = w * 2 + t2, ai = t >> 2, nj = t & 3;
            const f32x4 acc = mma16<128>(Qs + 16 * ai * P128, P128, Ks + 16 * nj * P128, P128, (f32x4){0.f, 0.f, 0.f, 0.f}, lane);
            const int tj = 16 * nj + r; const float gj = gcs[tj];
#pragma unroll
            for (int jj = 0; jj < 4; ++jj) { const int ti = 16 * ai + 4 * q + jj; const bool ok = dir ? (tj >= ti) : (tj <= ti);
                ATT[ti * P64 + tj] = (bf16)f2bf(ok ? acc[jj] * __expf(gcs[ti] - gj) : 0.f); }
        }
#pragma unroll
        for (int k = 0; k < 4; ++k) {
            const int nv = nvb + k;
            const f32x4 ws = mma16<128>(Ws + 16 * mi * P128, P128, ST + 16 * nv * P128, P128, (f32x4){0.f, 0.f, 0.f, 0.f}, lane);
            const int v = 16 * nv + r, t0 = 16 * mi + 4 * q;
            float u[4];
            if (dir == 0) { u[0] = bflo(uu[k].x); u[1] = bfhi(uu[k].x); u[2] = bflo(uu[k].y); u[3] = bfhi(uu[k].y); }
            else { u[3] = bflo(uu[k].x); u[2] = bfhi(uu[k].x); u[1] = bflo(uu[k].y); u[0] = bfhi(uu[k].y); }
            v2u o; o.x = pk2(u[0] - ws[0], u[1] - ws[1]); o.y = pk2(u[2] - ws[2], u[3] - ws[3]);
            *(LAS v2u*)(VNT + v * P64 + t0) = o;
        }
        LBAR();
#pragma unroll
        for (int k = 0; k < 4; ++k) {
            const int nv = nvb + k;
            f32x4 a = mma16<128>(Qs + 16 * mi * P128, P128, ST + 16 * nv * P128, P128, (f32x4){0.f, 0.f, 0.f, 0.f}, lane);
#pragma unroll
            for (int jj = 0; jj < 4; ++jj) a[jj] *= __expf(gcs[16 * mi + 4 * q + jj]);
            a = mma16<64>(ATT + 16 * mi * P64, P64, VNT + 16 * nv * P64, P64, a, lane);
            oacc[k] += a;
        }
        LBAR();
    }
#pragma unroll
    for (int k = 0; k < 4; ++k)
#pragma unroll
        for (int jj = 0; jj < 4; ++jj) OS[(16 * mi + 4 * q + jj) * 132 + 16 * (nvb + k) + r] = oacc[k][jj];
    LBAR();
    {   const float* enw = A.in[19] + l * 128 + lane * 2; const float ew0 = enw[0], ew1 = enw[1];
        const bf16* Z = (const bf16*)(F.ws + WS_Z); bf16* E_ = (bf16*)(F.ws + WS_E);
        unsigned gz[8];
#pragma unroll
        for (int t8 = 0; t8 < 8; ++t8) gz[t8] = *(const unsigned*)(Z + (size_t)(row0 + w * 8 + t8) * ZP + C_EG + h * 128 + lane * 2);
#pragma unroll
        for (int t8 = 0; t8 < 8; ++t8) { const int t = w * 8 + t8;
            const float x0 = OS[t * 132 + lane * 2], x1 = OS[t * 132 + lane * 2 + 1];
            const float rs = 1.0f / sqrtf(wave_sum(x0 * x0 + x1 * x1) * (1.0f / 128.f) + 1e-6f);
            const size_t row = row0 + t; const unsigned g = gz[t8];
            *(unsigned*)(E_ + row * 1024 + h * 128 + lane * 2) = pk2(x0 * rs * ew0 * siluf_(bflo(g)), x1 * rs * ew1 * siluf_(bfhi(g)));
        }
    }
    LBAR();
}
constexpr int NIN_MAIN = 13824;
__device__ __forceinline__ void g1_tail_item(Frame& F, int it) {
    const int tid = F.tid, lane = F.lane, w = F.wave, r = lane & 15, q = lane >> 4;
    const bf16* Hm = (const bf16*)(F.ws + WS_H) + (size_t)(64 * it) * DM_;
    const bf16* Wt = (const bf16*)(F.ws + WS_W0 + WO_IN) + (size_t)NIN_MAIN * DM_;
    LAS bf16* As = (LAS bf16*)F.lds; LAS bf16* Bs = As + 64 * 264;
    f32x4 acc[2] = {(f32x4){0.f, 0.f, 0.f, 0.f}, (f32x4){0.f, 0.f, 0.f, 0.f}};
    v4u pa[4], pb[4];
#pragma unroll
    for (int k = 0; k < 4; ++k) { const int p = tid + 512 * k, row = p >> 5, c8 = (p & 31) * 8; pa[k] = *(const v4u*)(Hm + (size_t)row * DM_ + c8); pb[k] = *(const v4u*)(Wt + (size_t)row * DM_ + c8); }
    for (int kc = 0; kc < 8; ++kc) {
#pragma unroll
        for (int k = 0; k < 4; ++k) { const int p = tid + 512 * k, row = p >> 5, c8 = (p & 31) * 8; *(LAS v4u*)(As + row * 264 + c8) = pa[k]; *(LAS v4u*)(Bs + row * 264 + c8) = pb[k]; }
        __syncthreads();
        if (kc + 1 < 8) {
#pragma unroll
            for (int k = 0; k < 4; ++k) { const int p = tid + 512 * k, row = p >> 5, c8 = (p & 31) * 8 + (kc + 1) * 256; pa[k] = *(const v4u*)(Hm + (size_t)row * DM_ + c8); pb[k] = *(const v4u*)(Wt + (size_t)row * DM_ + c8); }
        }
#pragma unroll
        for (int t2 = 0; t2 < 2; ++t2) { const int t = w * 2 + t2, mi = t >> 2, nj = t & 3;
            acc[t2] = mma16<256>(As + 16 * mi * 264, 264, Bs + 16 * nj * 264, 264, acc[t2], lane); }
        __syncthreads();
    }
    bf16* Z = (bf16*)(F.ws + WS_Z);
#pragma unroll
    for (int t2 = 0; t2 < 2; ++t2) { const int t = w * 2 + t2, mi = t >> 2, nj = t & 3;
#pragma unroll
        for (int jj = 0; jj < 4; ++jj) Z[(size_t)(64 * it + 16 * mi + 4 * q + jj) * ZP + NIN_MAIN + 16 * nj + r] = (bf16)f2bf(acc[t2][jj]); }
}

__device__ __forceinline__ f32x4 small_mm_acc(Frame& F, const bf16* Ap, int lda, const bf16* Bp, int ldb, int K, f32x4 acc) {
    const int tid = F.tid, lane = F.lane, w = F.wave;
    LAS bf16* As = (LAS bf16*)F.lds; LAS bf16* Bs = As + 32 * 264;
    v4u pa[2][2], pb[2][4];
#define SM_LOAD(set, kc_) do { \
    _Pragma("unroll") for (int k = 0; k < 2; ++k) { const int p = tid + 512 * k, row = p >> 5, c8 = (p & 31) * 8 + (kc_) * 256; pa[set][k] = *(const v4u*)(Ap + (size_t)row * lda + c8); } \
    _Pragma("unroll") for (int k = 0; k < 4; ++k) { const int p = tid + 512 * k, row = p >> 5, c8 = (p & 31) * 8 + (kc_) * 256; pb[set][k] = *(const v4u*)(Bp + (size_t)row * ldb + c8); } } while (0)
#define SM_STEP(set, kc_) do { \
    _Pragma("unroll") for (int k = 0; k < 2; ++k) { const int p = tid + 512 * k, row = p >> 5, c8 = (p & 31) * 8; *(LAS v4u*)(As + row * 264 + c8) = pa[set][k]; } \
    _Pragma("unroll") for (int k = 0; k < 4; ++k) { const int p = tid + 512 * k, row = p >> 5, c8 = (p & 31) * 8; *(LAS v4u*)(Bs + row * 264 + c8) = pb[set][k]; } \
    LBAR(); \
    if ((kc_) + 2 < nk) SM_LOAD(set, (kc_) + 2); \
    acc = mma16<256>(As + 16 * (w >> 2) * 264, 264, Bs + 16 * (w & 3) * 264, 264, acc, lane); \
    LBAR(); } while (0)
    const int nk = K >> 8;
    SM_LOAD(0, 0); SM_LOAD(1, 1);
    for (int kc = 0; kc < nk; kc += 2) { SM_STEP(0, kc); SM_STEP(1, kc + 1); }
#undef SM_LOAD
#undef SM_STEP
    return acc;
}
__device__ __forceinline__ void ctx_f32_item(Frame& F, int it, const bf16* A, int K, const bf16* Bt, float* Y) {
    const int rt = it >> 5, ct = it & 31, lane = F.lane, w = F.wave, r = lane & 15, q = lane >> 4;
    const f32x4 acc = small_mm_acc(F, A + (size_t)(32 * rt) * K, K, Bt + (size_t)(64 * ct) * K, K, K, (f32x4){0.f, 0.f, 0.f, 0.f});
#pragma unroll
    for (int jj = 0; jj < 4; ++jj) Y[(size_t)(32 * rt + 16 * (w >> 2) + 4 * q + jj) * DM_ + 64 * ct + 16 * (w & 3) + r] = acc[jj];
}
__device__ __forceinline__ void ctx_g2_item(Frame& F, int it) {
    const int rt = it >> 5, ct = it & 31, lane = F.lane, w = F.wave, r = lane & 15, q = lane >> 4;
    unsigned char* ws = F.ws; unsigned char* wb = ws + WS_W0;
    const bf16* Zm = (const bf16*)(ws + WS_Z) + C_MG;
    const int col = 64 * ct + 16 * (w & 3) + r, rowb = 32 * rt + 16 * (w >> 2) + 4 * q;
    f32x4 tot = {0.f, 0.f, 0.f, 0.f};
    {   const f32x4 a = small_mm_acc(F, (const bf16*)(ws + WS_A) + (size_t)(32 * rt) * 512, 512, (const bf16*)(wb + WO_UA) + (size_t)(64 * ct) * 512, 512, 512, (f32x4){0.f, 0.f, 0.f, 0.f});
#pragma unroll
        for (int jj = 0; jj < 4; ++jj) tot[jj] += a[jj] * sigmoidf_(bf2f(Zm[(size_t)(rowb + jj) * ZP + col])); }
    {   const f32x4 a = small_mm_acc(F, (const bf16*)(ws + WS_D) + (size_t)(32 * rt) * 512, 512, (const bf16*)(wb + WO_UD) + (size_t)(64 * ct) * 512, 512, 512, (f32x4){0.f, 0.f, 0.f, 0.f});
#pragma unroll
        for (int jj = 0; jj < 4; ++jj) tot[jj] += a[jj] * sigmoidf_(bf2f(Zm[(size_t)(rowb + jj) * ZP + DM_ + col])); }
    {   const f32x4 a = small_mm_acc(F, (const bf16*)(ws + WS_E) + (size_t)(32 * rt) * 1024, 1024, (const bf16*)(wb + WO_UE) + (size_t)(64 * ct) * 1024, 1024, 1024, (f32x4){0.f, 0.f, 0.f, 0.f});
#pragma unroll
        for (int jj = 0; jj < 4; ++jj) tot[jj] += a[jj] * sigmoidf_(bf2f(Zm[(size_t)(rowb + jj) * ZP + 2 * DM_ + col])); }
    bf16* YB = (bf16*)(ws + WS_YB);
#pragma unroll
    for (int jj = 0; jj < 4; ++jj) YB[(size_t)(rowb + jj) * DM_ + col] = (bf16)f2bf(tot[jj]);
}

__device__ __forceinline__ void gla_cum_decay(Frame& F, const Args& A, int l, int dir, int h, int row0, LAS float* bs, LAS float* part, float* bsg) {
    const int tg = F.wave >> 1, d = (F.wave & 1) * 64 + F.lane;
    const float* ZG = (const float*)(F.ws + WS_ZG);
    const float* w2 = A.in[11] + ((size_t)(l * 2 + dir) * 16) * 512 + h * 128 + d; const float bd = A.in[12][(size_t)(l * 2 + dir) * 512 + h * 128 + d];
    float wc[16], g[16];
#pragma unroll
    for (int j = 0; j < 16; ++j) wc[j] = w2[j * 512];
    LAS float* lrs = part + 512;
    {   const int t = F.tid >> 3, j2 = (F.tid & 7) * 2; const float* src = ZG + (size_t)(row0 + t) * 64 + dir * 16 + j2; lrs[t * 16 + j2] = src[0]; lrs[t * 16 + j2 + 1] = src[1]; }
    LBAR();
#pragma unroll
    for (int k = 0; k < 16; ++k) {
        const LAS float* lr = lrs + (tg * 16 + k) * 16;
        float x = bd;
#pragma unroll
        for (int j = 0; j < 16; ++j) x += lr[j] * wc[j];
        g[k] = (fminf(x, 0.f) - __logf(1.0f + __expf(-fabsf(x)))) * 0.0625f;
    }
    float run = 0.f;
    if (dir == 0) {
#pragma unroll
        for (int k = 0; k < 16; ++k) { run += g[k]; g[k] = run; }
    } else {
#pragma unroll
        for (int k = 15; k >= 0; --k) { run += g[k]; g[k] = run; }
    }
    part[tg * 128 + d] = run;
    LBAR();
    float off = 0.f;
#pragma unroll
    for (int t2 = 0; t2 < 4; ++t2) { const float pv = part[t2 * 128 + d]; if (dir == 0 ? (t2 < tg) : (t2 > tg)) off += pv; }
#pragma unroll
    for (int k = 0; k < 16; ++k) { bs[(tg * 16 + k) * 128 + d] = g[k] + off; bsg[(tg * 16 + k) * 128 + d] = g[k] + off; }
    LBAR();
}
__device__ __forceinline__ void gla_prep2_item(Frame& F, const Args& A, int l, int chain, int c) {
    const int dir = chain >> 2, h = chain & 3, tid = F.tid, lane = F.lane, w = F.wave, r = lane & 15, q = lane >> 4;
    const bf16* Z = (const bf16*)(F.ws + WS_Z);
    const int row0 = 64 * c, n = chunk_scan_index(dir, c);
    LAS float* bs = (LAS float*)F.lds;
    LAS bf16* KdT = (LAS bf16*)(F.lds + 32768);
    LAS bf16* VT = (LAS bf16*)(F.lds + 51200);
    gla_cum_decay(F, A, l, dir, h, row0, bs, (LAS float*)(F.lds + 69632), (float*)(F.ws + WS_BS) + ((size_t)chain * 132 + chunk_scan_index(dir, c)) * 8192);
    const int tl = dir ? 0 : 63;
    {   const int ip = tid & 31, c8 = (tid >> 5) * 8, t0 = 2 * ip, t1 = t0 + 1;
        const bf16* z0 = Z + (size_t)(row0 + t0) * ZP + h * 128 + c8; const bf16* z1 = z0 + ZP;
        const v4u kv0 = *(const v4u*)(z0 + C_GK), kv1 = *(const v4u*)(z1 + C_GK), vv0 = *(const v4u*)(z0 + C_GV), vv1 = *(const v4u*)(z1 + C_GV);
        const unsigned k0w[4] = {kv0.x, kv0.y, kv0.z, kv0.w}, k1w[4] = {kv1.x, kv1.y, kv1.z, kv1.w}, v0w[4] = {vv0.x, vv0.y, vv0.z, vv0.w}, v1w[4] = {vv1.x, vv1.y, vv1.z, vv1.w};
#pragma unroll
        for (int e = 0; e < 4; ++e) {
            const int d0 = c8 + 2 * e, d1 = d0 + 1;
            const float bl0 = bs[tl * 128 + d0], bl1 = bs[tl * 128 + d1];
            *(LAS unsigned*)(KdT + d0 * P64 + t0) = pk2(bflo(k0w[e]) * __expf(bl0 - bs[t0 * 128 + d0]), bflo(k1w[e]) * __expf(bl0 - bs[t1 * 128 + d0]));
            *(LAS unsigned*)(KdT + d1 * P64 + t0) = pk2(bfhi(k0w[e]) * __expf(bl1 - bs[t0 * 128 + d1]), bfhi(k1w[e]) * __expf(bl1 - bs[t1 * 128 + d1]));
            *(LAS unsigned*)(VT + d0 * P64 + t0) = (v0w[e] & 0xffffu) | (v1w[e] << 16);
            *(LAS unsigned*)(VT + d1 * P64 + t0) = (v0w[e] >> 16) | (v1w[e] & 0xffff0000u);
        }
    }
    LBAR();
    const size_t item = (size_t)chain * 132 + n;
    float* GS = (float*)(F.ws + WS_GS) + item * 16384;
#pragma unroll
    for (int t8 = 0; t8 < 8; ++t8) {
        const int mv = w, na = t8;
        const f32x4 d = mma16<64>(VT + 16 * mv * P64, P64, KdT + 16 * na * P64, P64, (f32x4){0.f, 0.f, 0.f, 0.f}, lane);
#pragma unroll
        for (int jj = 0; jj < 4; ++jj) GS[(16 * mv + 4 * q + jj) * 128 + 16 * na + r] = d[jj];
    }
    if (tid < 128) ((float*)(F.ws + WS_GD))[item * 128 + tid] = __expf(bs[tl * 128 + tid]);
    LBAR();
}
__device__ __forceinline__ void gla_scan_item(Frame& F, int it) {
    const int chain = it >> 3, e4 = (it & 7) * 512 + F.tid, v = e4 >> 5, a4 = (e4 & 31) * 4;
    float* p = (float*)(F.ws + WS_GS) + (size_t)chain * 132 * 16384 + v * 128 + a4;
    const float* gd = (const float*)(F.ws + WS_GD) + (size_t)chain * 132 * 128 + a4;
    f32x4 S = {0.f, 0.f, 0.f, 0.f};
    for (int n = 0; n < 132; n += 12) {
        f32x4 x[12]; f32x4 d[12];
#pragma unroll
        for (int k = 0; k < 12; ++k) { x[k] = *(const f32x4*)(p + (size_t)(n + k) * 16384); d[k] = *(const f32x4*)(gd + (n + k) * 128); }
#pragma unroll
        for (int k = 0; k < 12; ++k) { *(f32x4*)(p + (size_t)(n + k) * 16384) = S; S = S * d[k] + x[k]; }
    }
}
__device__ __forceinline__ void gla_out_item(Frame& F, const Args& A, int l, int c, int h) {
    const int tid = F.tid, lane = F.lane, w = F.wave, r = lane & 15, q = lane >> 4;
    const bf16* Z = (const bf16*)(F.ws + WS_Z);
    const int row0 = 64 * c;
    LAS float* bs = (LAS float*)F.lds;
    LAS bf16* Qt = (LAS bf16*)(F.lds + 32768);
    LAS bf16* Kt = (LAS bf16*)(F.lds + 50176);
    LAS bf16* VT = (LAS bf16*)(F.lds + 67584);
    LAS bf16* ST = (LAS bf16*)(F.lds + 86016);
    LAS bf16* ATT = (LAS bf16*)(F.lds + 120832);
    LAS float* OS = (LAS float*)F.lds;
    const int mi = w >> 1, nvb = 4 * (w & 1);
    f32x4 oacc[4];
#pragma unroll
    for (int k = 0; k < 4; ++k) oacc[k] = (f32x4){0.f, 0.f, 0.f, 0.f};
    for (int dir = 0; dir < 2; ++dir) {
        const int chain = dir * 4 + h, n = chunk_scan_index(dir, c);
        const float* Sg = (const float*)(F.ws + WS_GS) + ((size_t)chain * 132 + n) * 16384;
        const float* bsg = (const float*)(F.ws + WS_BS) + ((size_t)chain * 132 + n) * 8192;
        {
            v4u qv[2], kv[2]; f32x4 bA[2], bB[2], sv[8]; v4u vv0 = {0u, 0u, 0u, 0u}, vv1 = {0u, 0u, 0u, 0u};
#pragma unroll
            for (int i2 = 0; i2 < 2; ++i2) { const int p = tid + 512 * i2, t = p >> 4, c8 = (p & 15) * 8; const bf16* zr = Z + (size_t)(row0 + t) * ZP + h * 128 + c8;
                qv[i2] = *(const v4u*)(zr + C_GQ); kv[i2] = *(const v4u*)(zr + C_GK); bA[i2] = *(const f32x4*)(bsg + t * 128 + c8); bB[i2] = *(const f32x4*)(bsg + t * 128 + c8 + 4); }
#pragma unroll
            for (int i8 = 0; i8 < 8; ++i8) { const int p = tid + 512 * i8; sv[i8] = *(const f32x4*)(Sg + (p >> 5) * 128 + (p & 31) * 4); }
            const int ipv = tid & 31, c8v = (tid >> 5) * 8, t0v = 2 * ipv;
            if (dir == 0) { const bf16* z0 = Z + (size_t)(row0 + t0v) * ZP + h * 128 + c8v + C_GV; vv0 = *(const v4u*)z0; vv1 = *(const v4u*)(z0 + ZP); }
#pragma unroll
            for (int i2 = 0; i2 < 2; ++i2) { const int p = tid + 512 * i2, t = p >> 4, c8 = (p & 15) * 8;
                const unsigned qw[4] = {qv[i2].x, qv[i2].y, qv[i2].z, qv[i2].w}, kw[4] = {kv[i2].x, kv[i2].y, kv[i2].z, kv[i2].w};
                const float bb[8] = {bA[i2].x, bA[i2].y, bA[i2].z, bA[i2].w, bB[i2].x, bB[i2].y, bB[i2].z, bB[i2].w};
                unsigned qo[4], ko[4];
#pragma unroll
                for (int e = 0; e < 4; ++e) { const float b0 = bb[2 * e], b1 = bb[2 * e + 1];
                    qo[e] = pk2(bflo(qw[e]) * __expf(b0), bfhi(qw[e]) * __expf(b1)); ko[e] = pk2(bflo(kw[e]) * __expf(-b0), bfhi(kw[e]) * __expf(-b1)); }
                *(LAS v4u*)(Qt + t * P128 + c8) = (v4u){qo[0], qo[1], qo[2], qo[3]}; *(LAS v4u*)(Kt + t * P128 + c8) = (v4u){ko[0], ko[1], ko[2], ko[3]}; }
            if (dir == 0) {
                const unsigned v0w[4] = {vv0.x, vv0.y, vv0.z, vv0.w}, v1w[4] = {vv1.x, vv1.y, vv1.z, vv1.w};
#pragma unroll
                for (int e = 0; e < 4; ++e) {
                    *(LAS unsigned*)(VT + (c8v + 2 * e) * P64 + t0v) = (v0w[e] & 0xffffu) | (v1w[e] << 16);
                    *(LAS unsigned*)(VT + (c8v + 2 * e + 1) * P64 + t0v) = (v0w[e] >> 16) | (v1w[e] & 0xffff0000u); }
            }
#pragma unroll
            for (int i8 = 0; i8 < 8; ++i8) { const int p = tid + 512 * i8; v2u o; o.x = pk2(sv[i8].x, sv[i8].y); o.y = pk2(sv[i8].z, sv[i8].w);
                *(LAS v2u*)(ST + (p >> 5) * P128 + (p & 31) * 4) = o; }
        }
        LBAR();
#pragma unroll
        for (int t2 = 0; t2 < 2; ++t2) {
            const int t = w * 2 + t2, ai = t >> 2, nj = t & 3;
            const f32x4 acc = mma16<128>(Qt + 16 * ai * P128, P128, Kt + 16 * nj * P128, P128, (f32x4){0.f, 0.f, 0.f, 0.f}, lane);
            const int tj = 16 * nj + r;
#pragma unroll
            for (int jj = 0; jj < 4; ++jj) { const int ti = 16 * ai + 4 * q + jj; const bool ok = dir ? (tj >= ti) : (tj <= ti);
                ATT[ti * P64 + tj] = (bf16)f2bf(ok ? acc[jj] : 0.f); }
        }
        LBAR();
#pragma unroll
        for (int k = 0; k < 4; ++k) {
            const int nv = nvb + k;
            oacc[k] = mma16<64>(ATT + 16 * mi * P64, P64, VT + 16 * nv * P64, P64, oacc[k], lane);
            oacc[k] = mma16<128>(Qt + 16 * mi * P128, P128, ST + 16 * nv * P128, P128, oacc[k], lane);
        }
        LBAR();
    }
#pragma unroll
    for (int k = 0; k < 4; ++k)
#pragma unroll
        for (int jj = 0; jj < 4; ++jj) OS[(16 * mi + 4 * q + jj) * 132 + 16 * (nvb + k) + r] = oacc[k][jj] * 0.08838834764831845f;
    LBAR();
    {   const float* gnw = A.in[13] + l * 128 + lane * 2; const float gw0 = gnw[0], gw1 = gnw[1];
        bf16* A_ = (bf16*)(F.ws + WS_A);
        unsigned gz[8];
#pragma unroll
        for (int t8 = 0; t8 < 8; ++t8) gz[t8] = *(const unsigned*)(Z + (size_t)(row0 + w * 8 + t8) * ZP + C_GG + h * 128 + lane * 2);
#pragma unroll
        for (int t8 = 0; t8 < 8; ++t8) { const int t = w * 8 + t8;
            const float x0 = OS[t * 132 + lane * 2], x1 = OS[t * 132 + lane * 2 + 1];
            const float rs = 1.0f / sqrtf(wave_sum(x0 * x0 + x1 * x1) * (1.0f / 128.f) + 1e-6f);
            const size_t row = row0 + t; const unsigned g = gz[t8];
            *(unsigned*)(A_ + row * 512 + h * 128 + lane * 2) = pk2(x0 * rs * gw0 * siluf_(bflo(g)), x1 * rs * gw1 * siluf_(bfhi(g)));
        }
    }
    LBAR();
}
__device__ __forceinline__ void diff_out_rows(Frame& F, const Args& A, int l) {
    const int gw = F.bid * 8 + F.wave, NGW = F.G * 8, lane = F.lane;
    const bf16* AO = (const bf16*)(F.ws + WS_AO); bf16* D_ = (bf16*)(F.ws + WS_D);
    const float lam_init = l == 0 ? 0.2f : 0.35550906759096924f;
    const float* lp = A.in[14] + l * 256;
    const float lam = expf(wave_sum(lp[lane] * lp[64 + lane])) - expf(wave_sum(lp[128 + lane] * lp[192 + lane])) + lam_init;
    const float* dnw = A.in[15] + l * 128 + lane * 2; const float dw0 = dnw[0], dw1 = dnw[1];
    for (int r = gw; r < MROWS; r += NGW) {
        unsigned wa[4], wb_[4];
#pragma unroll
        for (int h = 0; h < 4; ++h) { wa[h] = *(const unsigned*)(AO + (size_t)r * 1024 + (h * 2) * 128 + lane * 2); wb_[h] = *(const unsigned*)(AO + (size_t)r * 1024 + (h * 2 + 1) * 128 + lane * 2); }
#pragma unroll
        for (int h = 0; h < 4; ++h) {
            const int c = h * 128 + lane * 2;
            const unsigned w1 = wa[h], w2 = wb_[h];
            const float x0 = bflo(w1) - lam * bflo(w2), x1 = bfhi(w1) - lam * bfhi(w2);
            const float rs = 1.0f / sqrtf(wave_sum(x0 * x0 + x1 * x1) * (1.0f / 128.f) + 1e-6f) * (1.0f - lam_init);
            *(unsigned*)(D_ + (size_t)r * 512 + c) = pk2(x0 * rs * dw0, x1 * rs * dw1);
        }
    }
}
#ifndef MK_SINGLE
#define MK_SINGLE 1
#endif
template <int l> __device__ __forceinline__ void layer_phases(Frame& F, const Args& args, unsigned char* lds, const int lo, const int hi, const XcdBarrier& bar) {
    unsigned char* ws = args.ws;
#define IN(k) (lo <= (k) && (k) < hi)
#define SEAM(k) do { if (IN(k) && IN((k) + 1)) { xcd_barrier(bar); if (REP_SYNC > 1) xcd_barrier(bar); } } while (0)
    const int pb = 2 + 11 * l;
    unsigned char* wb = ws + WS_W0;
    if (IN(pb + 0) && !SKIP_G1) {
        pg8::Gemm g{(const bf16*)(ws + WS_H), (const bf16*)(wb + WO_IN), MROWS, NIN_MAIN, DM_}; pg8::StaticOrder S; S.init(MROWS, NIN_MAIN, F.G, F.bid); S.rep = REP_G1;
        pg8::EpiZ E{(bf16*)(ws + WS_Z), ZP, (float*)(ws + WS_ZG)};
        pg8::gemm_phase<pg8::EpiZ, pg8::StaticOrder, true, true>(F.lds, g, S, E);
    } SEAM(pb + 0);
    if (IN(pb + 1)) { if (F.bid < 132) g1_tail_item(F, F.bid); prep_phase(F, args, l); } SEAM(pb + 1);
    if (IN(pb + 2)) {
        for (int it = F.bid; it < 2112 * REP_C1; it += F.G) delta_prep2_item(F, (it % 2112) / 132, it % 132);
        for (int it = F.G - 1 - F.bid; it < 1056 * REP_C2; it += F.G) gla_prep2_item(F, args, l, (it % 1056) / 132, it % 132);
    } SEAM(pb + 2);
    if (IN(pb + 3)) {
        if (F.bid < 16) delta_chain(F, F.bid);
        else if (F.bid - 16 < 64) gla_scan_item(F, F.bid - 16);
        {
            const attn_body::bf16* AQ = (const attn_body::bf16*)(ws + WS_AQ); const attn_body::bf16* AK = (const attn_body::bf16*)(ws + WS_AK);
            const attn_body::bf16* AV = (const attn_body::bf16*)(ws + WS_AV); attn_body::bf16* AO = (attn_body::bf16*)(ws + WS_AO);
            unsigned* cnt = (unsigned*)(ws + WS_CNT) + 64 * l;
            volatile LAS unsigned* slot = (volatile LAS unsigned*)(F.lds + MISC_OFF) + 16;
            for (;;) {
                if (F.tid == 0) slot[0] = __hip_atomic_fetch_add(cnt, 1u, __ATOMIC_RELAXED, __HIP_MEMORY_SCOPE_AGENT);
                __syncthreads();
                const int ui = (int)slot[0];
                __syncthreads();
                if (ui >= 528 * REP_ATTN) break;
                const int uj = ui % 528; const int qb = 32 - uj / 16, rem = uj % 16, hm = rem >> 1, half = rem & 1;
                attn_body::attn_unit<8>(AQ + (size_t)qb * 256 * 512 + hm * 64, AK + hm * 64, AV + (hm >> 1) * 128 + half * 64,
                                        AO + (size_t)qb * 256 * 1024 + hm * 128 + half * 64, qb == 0 ? 4 : 132, (char*)lds);
            }
        }
        if (l == 0) p0_dynamic(F, args, 0, (unsigned*)(ws + WS_CNT) + 128, I_IN, PER_L);
        else p0_dynamic(F, args, 1, (unsigned*)(ws + WS_CNT) + 256, I_IN, PER_L - I_2);
    } SEAM(pb + 3);
    if (IN(pb + 4)) {
        for (int it = F.bid; it < 1056 * REP_C3; it += F.G) delta_out_item(F, args, l, (it % 1056) >> 3, it & 7);
        for (int it = F.G - 1 - F.bid; it < 528 * REP_C4; it += F.G) gla_out_item(F, args, l, (it % 528) >> 2, it & 3);
        diff_out_rows(F, args, l);
    } SEAM(pb + 4);
    if (IN(pb + 5) && !SKIP_G2) {
        const bf16* Zm = (const bf16*)(ws + WS_Z) + C_MG; float* YF = (float*)(ws + WS_R2); bf16* YB = (bf16*)(ws + WS_YB);
        pg8::StaticOrder S; S.init(MROWS - CTXL, DM_, F.G, F.bid); S.pmoff = 1;
        { pg8::Gemm g{(const bf16*)(ws + WS_A), (const bf16*)(wb + WO_UA), MROWS, DM_, 512}; pg8::EpiGate<0> E{Zm, ZP, YF, YB, DM_};
          pg8::gemm_phase<pg8::EpiGate<0>, pg8::StaticOrder, true, true>(F.lds, g, S, E); }
        { pg8::Gemm g{(const bf16*)(ws + WS_D), (const bf16*)(wb + WO_UD), MROWS, DM_, 512}; pg8::EpiGate<1> E{Zm + DM_, ZP, YF, YB, DM_};
          pg8::gemm_phase<pg8::EpiGate<1>, pg8::StaticOrder, true, true>(F.lds, g, S, E); }
        { pg8::Gemm g{(const bf16*)(ws + WS_E), (const bf16*)(wb + WO_UE), MROWS, DM_, 1024}; pg8::EpiGate<2> E{Zm + 2 * DM_, ZP, YF, YB, DM_};
          pg8::gemm_phase<pg8::EpiGate<2>, pg8::StaticOrder, true, true>(F.lds, g, S, E); }
        if (l == 0) for (int it = F.bid; it < 256; it += F.G) ctx_g2_item(F, it);
    } SEAM(pb + 5);
    if (IN(pb + 6) && !SKIP_G3) {
        pg8::Gemm g{(const bf16*)(ws + WS_YB), (const bf16*)(wb + WO_O), MROWS, DM_, DM_}; pg8::StaticOrder S; S.init(MROWS - CTXL, DM_, F.G, F.bid); S.pmoff = 1; S.rep = REP_G3;
        pg8::EpiF32 E{(float*)(ws + WS_R2), DM_};
        pg8::gemm_phase<pg8::EpiF32, pg8::StaticOrder, true, true>(F.lds, g, S, E);
        if (l == 0) for (int it = F.bid; it < 256; it += F.G) ctx_f32_item(F, it, (const bf16*)(ws + WS_YB), DM_, (const bf16*)(wb + WO_O), (float*)(ws + WS_R2));
    } SEAM(pb + 6);
    if (IN(pb + 7)) { row_phase<1>(F, args, l); } SEAM(pb + 7);
    if (IN(pb + 8) && !SKIP_G4) {
        pg8::Gemm g{(const bf16*)(ws + WS_H), (const bf16*)(wb + WO_13), MROWS, 2 * DFF, DM_}; pg8::StaticOrder S; S.init(MROWS - CTXL * l, 2 * DFF, F.G, F.bid); S.pmoff = l; S.rep = REP_G4;
        pg8::EpiSwiglu E{(bf16*)(ws + WS_HFF), DFF};
        pg8::gemm_phase<pg8::EpiSwiglu, pg8::StaticOrder, true, true>(F.lds, g, S, E);
        if (l == 0) p0_dynamic(F, args, 1, (unsigned*)(ws + WS_CNT) + 192, 0, I_IN);
        else p0_dynamic(F, args, 1, (unsigned*)(ws + WS_CNT) + 320, PER_L - I_2, PER_L);
    } SEAM(pb + 8);
    if (IN(pb + 9) && !SKIP_G5) {
        pg8::Gemm g{(const bf16*)(ws + WS_HFF), (const bf16*)(wb + WO_2), MROWS, DM_, DFF}; pg8::StaticOrder S; S.init(MROWS - CTXL, DM_, F.G, F.bid); S.pmoff = 1; S.rep = REP_G5;
        pg8::EpiF32 E{(float*)(ws + WS_R2), DM_};
        pg8::gemm_phase<pg8::EpiF32, pg8::StaticOrder, true, true>(F.lds, g, S, E);
        if (l == 0) { for (int it = F.bid; it < 256; it += F.G) ctx_f32_item(F, it, (const bf16*)(ws + WS_HFF), DFF, (const bf16*)(wb + WO_2), (float*)(ws + WS_R2));
                    }
    } SEAM(pb + 9);
    if (IN(pb + 10)) { row_phase<2>(F, args, l); } SEAM(pb + 10);
#undef IN
#undef SEAM
}
__global__ void __launch_bounds__(512, 2) mega_fwd(Args args) {
    extern __shared__ __attribute__((aligned(16))) unsigned char lds[];
    Frame F;
    F.lds = (LAS unsigned char*)lds; F.tid = threadIdx.x; F.lane = F.tid & 63; F.wave = __builtin_amdgcn_readfirstlane(F.tid >> 6);
    F.G = gridDim.x; F.bid = blockIdx.x; F.ws = args.ws; F.out = args.out;
    const int lo = args.ph_lo, hi = args.ph_hi;
    if (lo < 0) cg::this_grid().sync();
    for (int u = F.tid; u < 64; u += 512) ((LAS unsigned*)(F.lds + MISC_OFF))[u] = 0u;
    __syncthreads();
    XcdBarrier bar; bar.bar = (unsigned*)(args.ws + WS_BAR); bar.x = 0; bar.st = nullptr;
    if (hi - lo > 1) bar = xcd_barrier_post((unsigned*)(args.ws + WS_BAR), (volatile LAS unsigned*)(F.lds + MISC_OFF) + 8);
#define IN(k) (lo <= (k) && (k) < hi)
#define SEAM(k) do { if (IN(k) && IN((k) + 1)) { xcd_barrier(bar); if (REP_SYNC > 1) xcd_barrier(bar); } } while (0)
    unsigned char* ws = args.ws;
    if (IN(0)) { p0_phase(F, args, 0, true, 0, I_IN); } SEAM(0);
    if (IN(1)) { row_phase<0>(F, args, 0); } SEAM(1);
    layer_phases<0>(F, args, lds, lo, hi, bar);
    layer_phases<1>(F, args, lds, lo, hi, bar);
#undef IN
#undef SEAM
}

extern "C" void kernel_launch(void* const* d_in, const int* in_sizes, int n_in, void* d_out, int out_size, void* d_ws, size_t ws_size, hipStream_t stream) {
    static int grid = 0;
    if (grid == 0) {
        if (n_in != 27 || out_size != SEQ_ * DM_ || ws_size < WS_END2) { fprintf(stderr, "kernel_launch: unexpected shapes (n_in %d, out %d, ws %zu < %zu)\n", n_in, out_size, ws_size, (size_t)WS_END2); grid = -1; return; }
        if (hipFuncSetAttribute((const void*)mega_fwd, hipFuncAttributeMaxDynamicSharedMemorySize, LDS_BYTES) != hipSuccess) { fprintf(stderr, "kernel_launch: hipFuncSetAttribute failed\n"); grid = -1; return; }
        int dev = 0, cus = 0, per_cu = 0;
        hipGetDevice(&dev); hipDeviceGetAttribute(&cus, hipDeviceAttributeMultiprocessorCount, dev);
        hipOccupancyMaxActiveBlocksPerMultiprocessor(&per_cu, (const void*)mega_fwd, 512, LDS_BYTES);
        if (per_cu < 1) { fprintf(stderr, "kernel_launch: occupancy query says %d blocks per CU\n", per_cu); per_cu = 1; }
        (void)hipGetLastError();
        grid = cus;
    }
    if (grid < 0) return;
    Args a{};
    for (int i = 0; i < 27; ++i) a.in[i] = (const float*)d_in[i];
    a.out = (float*)d_out; a.ws = (unsigned char*)d_ws;
#if MK_SINGLE
    if (hipMemsetAsync((char*)d_ws + WS_BAR, 0, BAR_BYTES, stream) != hipSuccess) { fprintf(stderr, "kernel_launch: memset failed\n"); return; }
    a.ph_lo = 0; a.ph_hi = NPH;
    void* kargs[] = {&a};
    hipError_t e = hipLaunchCooperativeKernel((const void*)mega_fwd, dim3(grid), dim3(512), kargs, LDS_BYTES, stream);
    if (e != hipSuccess) fprintf(stderr, "cooperative launch failed: %s (grid %d)\n", hipGetErrorString(e), grid);
#else
    for (int p = 0; p < NPH; ++p) { a.ph_lo = p; a.ph_hi = p + 1; hipLaunchKernelGGL(mega_fwd, dim3(grid), dim3(512), LDS_BYTES, stream, a); }
#endif
}
```

```cpp
#include <hip/hip_runtime.h>
#include <hip/hip_cooperative_groups.h>
#include <hip/hip_bf16.h>
#include <cstdio>
#include <cstdint>
#include <cmath>
namespace cg = cooperative_groups;
#ifndef SKIP_G1
#define SKIP_G1 0
#endif
#ifndef SKIP_G2
#define SKIP_G2 0
#endif
#ifndef SKIP_G3
#define SKIP_G3 0
#endif
#ifndef SKIP_G4
#define SKIP_G4 0
#endif
#ifndef SKIP_G5
#define SKIP_G5 0
#endif
#ifndef REP_G1
#define REP_G1 1
#endif
#ifndef REP_G3
#define REP_G3 1
#endif
#ifndef REP_G4
#define REP_G4 1
#endif
#ifndef REP_G5
#define REP_G5 1
#endif
#ifndef REP_C1
#define REP_C1 1
#endif
#ifndef REP_C2
#define REP_C2 1
#endif
#ifndef REP_C3
#define REP_C3 1
#endif
#ifndef REP_C4
#define REP_C4 1
#endif
#ifndef REP_GEMM
#define REP_GEMM 1
#endif
#ifndef REP_CHUNK
#define REP_CHUNK 1
#endif
#ifndef REP_ATTN
#define REP_ATTN 1
#endif
#ifndef REP_ROWS
#define REP_ROWS 1
#endif
#ifndef REP_P0
#define REP_P0 1
#endif
#ifndef REP_SYNC
#define REP_SYNC 1
#endif
namespace pg8 {
#define PG8_LAS __attribute__((address_space(3)))
typedef unsigned short bf16_t;
typedef short bf16x8 __attribute__((ext_vector_type(8)));
typedef float f32x4 __attribute__((ext_vector_type(4)));
typedef unsigned u32x4 __attribute__((ext_vector_type(4)));
constexpr int BM = 256, BK = 64, HALF = 128, HTB = HALF * BK * 2  , STAGE_BYTES = 8 * HTB, NXCD = 8, WGM = 8;

__host__ __device__ __forceinline__ int lds_byte(int r, int c) { const int st = (r >> 4) * 2 + (c >> 5), rr = r & 15, cc = c & 31, ob = rr * 64 + cc * 2; return st * 1024 + (ob ^ (((ob >> 9) & 1) << 5)); }
__host__ __device__ __forceinline__ void stage_rc(int b, int& R, int& C) { const int st = b / 1024, sb = b % 1024, swz = sb ^ (((sb >> 9) & 1) << 5); R = (st >> 1) * 16 + swz / 64; C = (st & 1) * 32 + (swz % 64) / 2; }
__host__ __device__ __forceinline__ int perm32(int rho) { const int n = rho >> 4, i = rho & 15; return 8 * (i >> 2) + 4 * n + (i & 3); }

struct Unit { int pm, pn; };
struct Gemm { const bf16_t* A; const bf16_t* Bt; int M, N, K; };

struct StaticOrder {
    int nM, nN, nwg, G, c, rep = 1, pmoff = 0;
    __host__ __device__ void init(int M, int N, int G_, int c_) { nM = M / BM; nN = N / BM; nwg = nM * nN; G = G_; c = c_; }
    __host__ __device__ bool next(int i, Unit& u) const {
        const long L = (long)(i / rep) * G + c; if (L >= nwg) return false;
        int wgid = (int)L; { const int q = nwg / NXCD, r = nwg % NXCD, xcd = wgid % NXCD, off = wgid / NXCD; wgid = (xcd < r ? xcd * (q + 1) : r * (q + 1) + (xcd - r) * q) + off; }
        const int nig = WGM * nN, gid = wgid / nig, fm = gid * WGM, gsz = (nM - fm) < WGM ? (nM - fm) : WGM;
        u.pm = pmoff + fm + ((wgid % nig) % gsz); u.pn = (wgid % nig) / gsz; return true;
    }
    __device__ __forceinline__ void a_ready(const Unit&) const {}
    __device__ __forceinline__ void done(const Unit&) const {}
};

__device__ __forceinline__ unsigned cvt_pk_bf16(float lo, float hi) { unsigned r; asm volatile("v_cvt_pk_bf16_f32 %0, %1, %2" : "=v"(r) : "v"(lo), "v"(hi)); return r; }
typedef float f32x2 __attribute__((ext_vector_type(2)));
typedef unsigned u32x2 __attribute__((ext_vector_type(2)));
__device__ __forceinline__ float ep_sigmoid(float x) { return __builtin_amdgcn_rcpf(1.0f + __expf(-x)); }
struct EpiZ {
    static constexpr bool PERM = true, AFTER_DRAIN = false;
    bf16_t* Z; int ldz; float* ZG;
    __device__ __forceinline__ void operator()(const f32x4 (&acc)[2][2][4][2], const Unit& u, int wr, int wc, int fr, int fq) const {
        const int row0 = u.pm * BM + wr * 64 + fr, col0 = u.pn * BM + wc * 32 + 8 * fq;
#pragma unroll
        for (int ai = 0; ai < 2; ++ai)
#pragma unroll
            for (int m = 0; m < 4; ++m) { const int row = row0 + ai * HALF + m * 16;
#pragma unroll
                for (int bj = 0; bj < 2; ++bj) { const int c = col0 + bj * HALF; const f32x4 v0 = acc[ai][bj][m][0], v1 = acc[ai][bj][m][1];
                    u32x4 w; w.x = cvt_pk_bf16(v0[0], v0[1]); w.y = cvt_pk_bf16(v0[2], v0[3]); w.z = cvt_pk_bf16(v1[0], v1[1]); w.w = cvt_pk_bf16(v1[2], v1[3]);
                    *(u32x4*)(Z + (size_t)row * ldz + c) = w;
                    int gc = -1; if (c >= 1536 && c < 1568) gc = c - 1536; else if (c >= 6688 && c < 6720) gc = 32 + c - 6688;
                    if (gc >= 0) { float* g = ZG + (size_t)row * 64 + gc; *(f32x4*)g = v0; *(f32x4*)(g + 4) = v1; } } }
    }
};
template <int MODE> struct EpiGate {
    static constexpr bool PERM = true, AFTER_DRAIN = false;
    const bf16_t* Zg; int ldz; float* YF; bf16_t* YB; int ldc;
    __device__ __forceinline__ void operator()(const f32x4 (&acc)[2][2][4][2], const Unit& u, int wr, int wc, int fr, int fq) const {
        const int row0 = u.pm * BM + wr * 64 + fr, col0 = u.pn * BM + wc * 32 + 8 * fq;
#pragma unroll
        for (int ai = 0; ai < 2; ++ai)
#pragma unroll
            for (int m = 0; m < 4; ++m) { const int row = row0 + ai * HALF + m * 16;
#pragma unroll
                for (int bj = 0; bj < 2; ++bj) { const int c = col0 + bj * HALF;
                    const u32x4 gz = *(const u32x4*)(Zg + (size_t)row * ldz + c);
                    f32x4 g0, g1;
                    g0[0] = ep_sigmoid(__builtin_bit_cast(float, gz.x << 16)); g0[1] = ep_sigmoid(__builtin_bit_cast(float, gz.x & 0xffff0000u));
                    g0[2] = ep_sigmoid(__builtin_bit_cast(float, gz.y << 16)); g0[3] = ep_sigmoid(__builtin_bit_cast(float, gz.y & 0xffff0000u));
                    g1[0] = ep_sigmoid(__builtin_bit_cast(float, gz.z << 16)); g1[1] = ep_sigmoid(__builtin_bit_cast(float, gz.z & 0xffff0000u));
                    g1[2] = ep_sigmoid(__builtin_bit_cast(float, gz.w << 16)); g1[3] = ep_sigmoid(__builtin_bit_cast(float, gz.w & 0xffff0000u));
                    f32x4 v0 = acc[ai][bj][m][0] * g0, v1 = acc[ai][bj][m][1] * g1;
                    float* y = YF + (size_t)row * ldc + c;
                    if (MODE >= 1) { v0 += *(const f32x4*)y; v1 += *(const f32x4*)(y + 4); }
                    if (MODE <= 1) { *(f32x4*)y = v0; *(f32x4*)(y + 4) = v1; }
                    else { u32x4 w; w.x = cvt_pk_bf16(v0[0], v0[1]); w.y = cvt_pk_bf16(v0[2], v0[3]); w.z = cvt_pk_bf16(v1[0], v1[1]); w.w = cvt_pk_bf16(v1[2], v1[3]);
                        *(u32x4*)(YB + (size_t)row * ldc + c) = w; } } }
    }
};
struct EpiF32 {
    static constexpr bool PERM = true, AFTER_DRAIN = false;
    float* Y; int ldc;
    __device__ __forceinline__ void operator()(const f32x4 (&acc)[2][2][4][2], const Unit& u, int wr, int wc, int fr, int fq) const {
        const int row0 = u.pm * BM + wr * 64 + fr, col0 = u.pn * BM + wc * 32 + 8 * fq;
#pragma unroll
        for (int ai = 0; ai < 2; ++ai)
#pragma unroll
            for (int m = 0; m < 4; ++m) { const int row = row0 + ai * HALF + m * 16;
#pragma unroll
                for (int bj = 0; bj < 2; ++bj) { float* y = Y + (size_t)row * ldc + col0 + bj * HALF; *(f32x4*)y = acc[ai][bj][m][0]; *(f32x4*)(y + 4) = acc[ai][bj][m][1]; } }
    }
};
struct EpiSwiglu {
    static constexpr bool PERM = true, AFTER_DRAIN = false;
    bf16_t* Hf; int ldc;
    __device__ __forceinline__ void operator()(const f32x4 (&acc)[2][2][4][2], const Unit& u, int wr, int wc, int fr, int fq) const {
        const int row0 = u.pm * BM + wr * 64 + fr, col0 = u.pn * HALF + wc * 32 + 8 * fq;
#pragma unroll
        for (int ai = 0; ai < 2; ++ai)
#pragma unroll
            for (int m = 0; m < 4; ++m) { const int row = row0 + ai * HALF + m * 16; float o[8];
#pragma unroll
                for (int n = 0; n < 2; ++n)
#pragma unroll
                    for (int j = 0; j < 4; ++j) { const float a = acc[ai][0][m][n][j], b = acc[ai][1][m][n][j]; o[n * 4 + j] = a * __builtin_amdgcn_rcpf(1.0f + __expf(-a)) * b; }
                u32x4 w; w.x = cvt_pk_bf16(o[0], o[1]); w.y = cvt_pk_bf16(o[2], o[3]); w.z = cvt_pk_bf16(o[4], o[5]); w.w = cvt_pk_bf16(o[6], o[7]);
                *(u32x4*)(Hf + (size_t)row * ldc + col0) = w; }
    }
};
template <class Epi, class Sched, bool ALIGN_EPI = false, bool SP2 = false>
__device__ __forceinline__ void gemm_phase(PG8_LAS unsigned char* lds, const Gemm g, const Sched& S, const Epi& E) {
    const int tid = threadIdx.x, wid = __builtin_amdgcn_readfirstlane(tid >> 6), lane = tid & 63, wr = wid >> 2, wc = wid & 3, fr = lane & 15, fq = lane >> 4;
    const int K = g.K, nt = K / BK;
    unsigned voffA[2], voffB[2];
#pragma unroll
    for (int i = 0; i < 2; ++i) { int R, C; stage_rc(tid * 16 + i * 8192, R, C); const int Rb = Epi::PERM ? ((R & ~31) + perm32(R & 31)) : R;
        voffA[i] = (unsigned)(R * K + C) * 2u; voffB[i] = (unsigned)(Rb * K + C) * 2u; }
    const size_t kstep = (size_t)(BK * 2);
    const size_t hstep = (size_t)HALF * K * 2;
    const size_t tstep = 2 * hstep;
    const unsigned ldsw = (unsigned)wid * 1024u;
    const int aoff = lds_byte(wr * 64 + fr, fq * 8), boff = lds_byte(wc * 32 + fr, fq * 8);
#define PG8_SA(b, h) (((b) * 2 + (h)) * HTB)
#define PG8_SB(b, h) ((4 + (b) * 2 + (h)) * HTB)
#define PG8_STAGE(bufoff, gbase, voff) do { _Pragma("unroll") for (int _i = 0; _i < 2; ++_i) \
        __builtin_amdgcn_global_load_lds((const unsigned*)((const char*)(gbase) + (voff)[_i]), (PG8_LAS unsigned*)(lds + (bufoff) + ldsw + _i * 8192), 16, 0, 0); } while (0)
#define PG8_LDA(dst, b, h) do { _Pragma("unroll") for (int m = 0; m < 4; ++m) _Pragma("unroll") for (int k = 0; k < 2; ++k) dst[m][k] = *(const PG8_LAS bf16x8*)(lds + PG8_SA(b, h) + aoff + m * 2048 + k * 1024); } while (0)
#define PG8_LDB(dst, b, h) do { _Pragma("unroll") for (int n = 0; n < 2; ++n) _Pragma("unroll") for (int k = 0; k < 2; ++k) dst[n][k] = *(const PG8_LAS bf16x8*)(lds + PG8_SB(b, h) + boff + n * 2048 + k * 1024); } while (0)
#define PG8_MMA(ai, bj, At, Bt) do { __builtin_amdgcn_s_setprio(1); _Pragma("unroll") for (int m = 0; m < 4; ++m) _Pragma("unroll") for (int n = 0; n < 2; ++n) _Pragma("unroll") for (int k = 0; k < 2; ++k) \
        acc[ai][bj][m][n] = __builtin_amdgcn_mfma_f32_16x16x32_bf16(Bt[n][k], At[m][k], acc[ai][bj][m][n], 0, 0, 0); __builtin_amdgcn_s_setprio(0); } while (0)
#define PG8_WAIT_V(n) asm volatile("s_waitcnt vmcnt(" #n ")" ::: "memory")
#define PG8_WAIT_L(n) asm volatile("s_waitcnt lgkmcnt(" #n ")" ::: "memory")
#define PG8_BAR __builtin_amdgcn_s_barrier()
#define PG8_SCHED __builtin_amdgcn_sched_barrier(0)
    Unit cur, nxt; int ui = 0;
    if (!S.next(0, cur)) return;
    f32x4 acc[2][2][4][2];
#pragma unroll
    for (int a = 0; a < 2; ++a)
#pragma unroll
        for (int b = 0; b < 2; ++b)
#pragma unroll
            for (int m = 0; m < 4; ++m)
#pragma unroll
                for (int n = 0; n < 2; ++n) acc[a][b][m][n] = (f32x4){0.f, 0.f, 0.f, 0.f};
    bf16x8 At[4][2], B0[2][2], B1[2][2];
    const char* cA = (const char*)g.A + (size_t)cur.pm * tstep; const char* cB = (const char*)g.Bt + (size_t)cur.pn * tstep;
    S.a_ready(cur);
    if constexpr (SP2) {
        PG8_STAGE(PG8_SB(0, 0), cB, voffB); PG8_STAGE(PG8_SB(0, 1), cB + hstep, voffB); PG8_STAGE(PG8_SA(0, 0), cA, voffA); PG8_STAGE(PG8_SA(0, 1), cA + hstep, voffA);
        if (wr == 1) PG8_BAR;
        PG8_WAIT_V(2); PG8_BAR;
        PG8_STAGE(PG8_SB(1, 0), cB + kstep, voffB); PG8_STAGE(PG8_SA(1, 0), cA + kstep, voffA); PG8_STAGE(PG8_SB(1, 1), cB + hstep + kstep, voffB);
        PG8_WAIT_V(6); PG8_BAR;
    } else {
        PG8_STAGE(PG8_SB(0, 0), cB, voffB); PG8_STAGE(PG8_SA(0, 0), cA, voffA); PG8_STAGE(PG8_SB(0, 1), cB + hstep, voffB); PG8_STAGE(PG8_SA(0, 1), cA + hstep, voffA);
        if (wr == 1) PG8_BAR;
        PG8_WAIT_V(4); PG8_BAR;
        PG8_STAGE(PG8_SB(1, 0), cB + kstep, voffB); PG8_STAGE(PG8_SA(1, 0), cA + kstep, voffA); PG8_STAGE(PG8_SB(1, 1), cB + hstep + kstep, voffB);
        PG8_WAIT_V(6); PG8_BAR;
    }
    for (;;) {
        const bool has_next = S.next(ui + 1, nxt);
        const char* nA = has_next ? (const char*)g.A + (size_t)nxt.pm * tstep : cA; const char* nB = has_next ? (const char*)g.Bt + (size_t)nxt.pn * tstep : cB;
        for (int t = 0; t < nt; t += 2) {
            const bool last = (t == nt - 2);
            const char* a1 = cA + (size_t)(t + 1) * kstep;
            const char* a2 = last ? nA : cA + (size_t)(t + 2) * kstep; const char* b2 = last ? nB : cB + (size_t)(t + 2) * kstep;
            const char* a3 = a2 + kstep; const char* b3 = b2 + kstep;
            if (last && has_next) S.a_ready(nxt);
            if constexpr (SP2) {
            PG8_LDB(B0, 0, 0); PG8_LDB(B1, 0, 1); PG8_SCHED; PG8_LDA(At, 0, 0); PG8_STAGE(PG8_SA(1, 1), a1 + hstep, voffA);
            PG8_WAIT_V(8); PG8_WAIT_L(0); PG8_BAR; PG8_MMA(0, 0, At, B0); PG8_MMA(0, 1, At, B1); PG8_BAR; PG8_SCHED;
            PG8_LDA(At, 0, 1); PG8_STAGE(PG8_SB(0, 0), b2, voffB); PG8_STAGE(PG8_SB(0, 1), b2 + hstep, voffB); PG8_STAGE(PG8_SA(0, 0), a2, voffA);
            PG8_WAIT_V(8); PG8_WAIT_L(0); PG8_BAR; PG8_MMA(1, 0, At, B0); PG8_MMA(1, 1, At, B1); PG8_BAR; PG8_SCHED;
            PG8_LDB(B0, 1, 0); PG8_LDB(B1, 1, 1); PG8_SCHED; PG8_LDA(At, 1, 0); PG8_STAGE(PG8_SA(0, 1), a2 + hstep, voffA);
            PG8_WAIT_V(8); PG8_WAIT_L(0); PG8_BAR; PG8_MMA(0, 0, At, B0); PG8_MMA(0, 1, At, B1); PG8_BAR; PG8_SCHED;
            PG8_LDA(At, 1, 1); PG8_STAGE(PG8_SB(1, 0), b3, voffB); PG8_STAGE(PG8_SB(1, 1), b3 + hstep, voffB); PG8_STAGE(PG8_SA(1, 0), a3, voffA);
            PG8_WAIT_V(8); PG8_WAIT_L(0); PG8_BAR; PG8_MMA(1, 0, At, B0); PG8_MMA(1, 1, At, B1); PG8_BAR; PG8_SCHED;
            } else {
            PG8_LDB(B0, 0, 0); PG8_SCHED; PG8_LDA(At, 0, 0); PG8_STAGE(PG8_SA(1, 1), a1 + hstep, voffA);
            PG8_WAIT_L(8); PG8_BAR; PG8_WAIT_L(0); PG8_MMA(0, 0, At, B0); PG8_BAR; PG8_SCHED;
            PG8_LDB(B1, 0, 1); PG8_STAGE(PG8_SB(0, 0), b2, voffB);
            PG8_BAR; PG8_WAIT_L(0); PG8_MMA(0, 1, At, B1); PG8_BAR;
            PG8_LDA(At, 0, 1); PG8_STAGE(PG8_SA(0, 0), a2, voffA);
            PG8_BAR; PG8_WAIT_L(0); PG8_MMA(1, 0, At, B0); PG8_BAR; PG8_SCHED;
            PG8_STAGE(PG8_SB(0, 1), b2 + hstep, voffB);
            PG8_WAIT_V(6); PG8_BAR; PG8_MMA(1, 1, At, B1); PG8_BAR;
            PG8_LDB(B0, 1, 0); PG8_SCHED; PG8_LDA(At, 1, 0); PG8_STAGE(PG8_SA(0, 1), a2 + hstep, voffA);
            PG8_WAIT_L(8); PG8_BAR; PG8_WAIT_L(0); PG8_MMA(0, 0, At, B0); PG8_BAR; PG8_SCHED;
            PG8_LDB(B1, 1, 1); PG8_STAGE(PG8_SB(1, 0), b3, voffB);
            PG8_BAR; PG8_WAIT_L(0); PG8_MMA(0, 1, At, B1); PG8_BAR;
            PG8_LDA(At, 1, 1); PG8_STAGE(PG8_SA(1, 0), a3, voffA);
            PG8_BAR; PG8_WAIT_L(0); PG8_MMA(1, 0, At, B0); PG8_BAR; PG8_SCHED;
            PG8_STAGE(PG8_SB(1, 1), b3 + hstep, voffB);
            PG8_WAIT_V(6); PG8_BAR; PG8_MMA(1, 1, At, B1); PG8_BAR;
            }
        }
        if constexpr (ALIGN_EPI) { if (wr == 0) PG8_BAR; }
        if constexpr (!Epi::AFTER_DRAIN) { E(acc, cur, wr, wc, fr, fq); S.done(cur); }
        if (!has_next) break;
#pragma unroll
        for (int a = 0; a < 2; ++a)
#pragma unroll
            for (int b = 0; b < 2; ++b)
#pragma unroll
                for (int m = 0; m < 4; ++m)
#pragma unroll
                    for (int n = 0; n < 2; ++n) acc[a][b][m][n] = (f32x4){0.f, 0.f, 0.f, 0.f};
        cur = nxt; cA = nA; cB = nB; ++ui;
        if constexpr (ALIGN_EPI) { if (wr == 1) PG8_BAR; }
    }
    PG8_WAIT_V(0);
    if constexpr (!ALIGN_EPI) { if (wr == 0) PG8_BAR; }
    PG8_BAR;
    if constexpr (Epi::AFTER_DRAIN) { E.fused(acc, cur, wr, wc, fr, fq, lds, wid, lane); S.done(cur); }
#undef PG8_SA
#undef PG8_SB
#undef PG8_STAGE
#undef PG8_LDA
#undef PG8_LDB
#undef PG8_MMA
#undef PG8_WAIT_V
#undef PG8_WAIT_L
#undef PG8_BAR
#undef PG8_SCHED
}
}
#include <hip/hip_bf16.h>
#include <cmath>
namespace attn_body {
using bf16=__hip_bfloat16;
using bf16x8=__attribute__((ext_vector_type(8)))short;
using s16x4=__attribute__((ext_vector_type(4)))short;
using f32x16=__attribute__((ext_vector_type(16)))float;
using u32x4=__attribute__((ext_vector_type(4)))unsigned;
constexpr int D=64,DM=512,OPITCH=1024;
constexpr int NW=8,QBLK=32,QB=QBLK*NW,KVBLK=64;
constexpr int ATTN_PITCH=DM, ATTN_UNIT_ROWS=QB;
__device__ __forceinline__ int crow(int r,int hi){return (r&3)+8*(r>>2)+4*hi;}
#define SBAR() __builtin_amdgcn_sched_barrier(0)
__device__ __forceinline__ void cmask(f32x16&p0,f32x16&p1,int jb,int qrel,int hi){
  const float NEG=-INFINITY; int kb=64*jb+4*hi;
  #pragma unroll
  for(int r=0;r<16;++r){int kv=kb+(r&3)+8*(r>>2); if(kv>qrel)p0[r]=NEG; if(kv+32>qrel)p1[r]=NEG;}
}

constexpr int NSLOT=3, SLOTB=8192;
constexpr int LDS_K=0, LDS_V=NSLOT*SLOTB, LDS_WS=2*NSLOT*SLOTB, LDS_OST=LDS_WS+NW*64*4, LDS_BYTES=LDS_OST+NW*4096;
constexpr float C2=0.125f*1.4426950408889634f;
__device__ __forceinline__ void glds16(const void*gsrc,unsigned lds_dst){unsigned keep;
  asm volatile("s_mov_b32 %0, m0\n\ts_mov_b32 m0, %2\n\ts_nop 0\n\tglobal_load_lds_dwordx4 %1, off\n\ts_mov_b32 m0, %0":"=&s"(keep):"v"(gsrc),"s"(lds_dst):"memory");}
__device__ __forceinline__ float max3f(float a,float b,float c){float r;asm("v_max3_f32 %0, %1, %2, %3":"=v"(r):"v"(a),"v"(b),"v"(c));return r;}
__device__ __forceinline__ float max2f(float a,float b){float r;asm("v_max_f32_e32 %0, %1, %2":"=v"(r):"v"(a),"v"(b));return r;}
__device__ __forceinline__ float fadd_s(float a,float b){float r;asm("v_add_f32_e32 %0, %1, %2":"=v"(r):"v"(a),"v"(b));return r;}
__device__ __forceinline__ float fsub_s(float a,float b){float r;asm("v_sub_f32_e32 %0, %1, %2":"=v"(r):"v"(a),"v"(b));return r;}
typedef float f32x2_t __attribute__((ext_vector_type(2))); typedef __bf16 bf16x2_t __attribute__((ext_vector_type(2)));
__device__ __forceinline__ unsigned cvtpk_s(float lo,float hi){f32x2_t v={lo,hi};bf16x2_t b=__builtin_convertvector(v,bf16x2_t);return __builtin_bit_cast(unsigned,b);}
#define WAIT_BAR(N) asm volatile("s_waitcnt vmcnt(" #N ") lgkmcnt(0)\n\ts_barrier":::"memory")

__device__ __forceinline__ void qkt(f32x16&p0,f32x16&p1,const char*Kslot,const bf16x8*qr,const f32x16&negm,int r32,int hi){
  const char*kb=Kslot+hi*1024+r32*16;
  #pragma unroll
  for(int d0=0;d0<4;++d0){
    const bf16x8 b0=*reinterpret_cast<const bf16x8*>(kb+d0*2048);
    const bf16x8 b1=*reinterpret_cast<const bf16x8*>(kb+d0*2048+512);
    if(d0==0){p0=__builtin_amdgcn_mfma_f32_32x32x16_bf16(b0,qr[0],negm,0,0,0);p1=__builtin_amdgcn_mfma_f32_32x32x16_bf16(b1,qr[0],negm,0,0,0);}
    else{p0=__builtin_amdgcn_mfma_f32_32x32x16_bf16(b0,qr[d0],p0,0,0,0);p1=__builtin_amdgcn_mfma_f32_32x32x16_bf16(b1,qr[d0],p1,0,0,0);}}
}
typedef __attribute__((address_space(3))) const char* lds_cptr;
typedef short v4i16_t __attribute__((ext_vector_type(4)));
__device__ __forceinline__ void kload8(bf16x8*kf,lds_cptr kp){
  kf[0]=*(const __attribute__((address_space(3))) bf16x8*)(kp);      kf[1]=*(const __attribute__((address_space(3))) bf16x8*)(kp+512);
  kf[2]=*(const __attribute__((address_space(3))) bf16x8*)(kp+2048); kf[3]=*(const __attribute__((address_space(3))) bf16x8*)(kp+2560);
  kf[4]=*(const __attribute__((address_space(3))) bf16x8*)(kp+4096); kf[5]=*(const __attribute__((address_space(3))) bf16x8*)(kp+4608);
  kf[6]=*(const __attribute__((address_space(3))) bf16x8*)(kp+6144); kf[7]=*(const __attribute__((address_space(3))) bf16x8*)(kp+6656);
}
__device__ __forceinline__ void kload2(bf16x8*kf,lds_cptr kp,int j){ kf[2*j]=*(const __attribute__((address_space(3))) bf16x8*)(kp+j*2048); kf[2*j+1]=*(const __attribute__((address_space(3))) bf16x8*)(kp+j*2048+512); }
__device__ __forceinline__ s16x4 vtr(lds_cptr p){ return __builtin_bit_cast(s16x4,__builtin_amdgcn_ds_read_tr16_b64_v4i16((__attribute__((address_space(3))) v4i16_t*)p)); }
__device__ __forceinline__ float rowmax(const f32x16&p0,const f32x16&p1){
  float a=max3f(p0[0],p0[1],p1[0]),b=max3f(p0[2],p0[3],p1[1]);a=max3f(a,p1[2],p1[3]);
  #pragma unroll
  for(int r=4;r<16;r+=4){a=max3f(a,p0[r],p0[r+1]);b=max3f(b,p0[r+2],p0[r+3]);a=max3f(a,p1[r],p1[r+1]);b=max3f(b,p1[r+2],p1[r+3]);}
  const float m=max2f(a,b);
  auto rr=__builtin_amdgcn_permlane32_swap(__float_as_uint(m),__float_as_uint(m),false,false);
  return max2f(__uint_as_float(rr[0]),__uint_as_float(rr[1]));
}
__device__ __forceinline__ void pv(f32x16*o,int vb,bf16x8 pa0,bf16x8 pa1,bf16x8 pa2,bf16x8 pa3){
  #pragma unroll
  for(int d0=0;d0<2;++d0){s16x4 lo[4],hi[4];
    #pragma unroll
    for(int ks=0;ks<4;++ks){
      asm volatile("ds_read_b64_tr_b16 %0,%1 offset:%c2":"=&v"(lo[ks]):"v"(vb),"i"(d0*4096+ks*1024):"memory");
      asm volatile("ds_read_b64_tr_b16 %0,%1 offset:%c2":"=&v"(hi[ks]):"v"(vb),"i"(d0*4096+ks*1024+512):"memory");}
    asm volatile("s_waitcnt lgkmcnt(0)":::"memory");SBAR();
    #define PK(k) (bf16x8){lo[k][0],lo[k][1],lo[k][2],lo[k][3],hi[k][0],hi[k][1],hi[k][2],hi[k][3]}
    o[d0]=__builtin_amdgcn_mfma_f32_32x32x16_bf16(pa0,PK(0),o[d0],0,0,0);
    o[d0]=__builtin_amdgcn_mfma_f32_32x32x16_bf16(pa1,PK(1),o[d0],0,0,0);
    o[d0]=__builtin_amdgcn_mfma_f32_32x32x16_bf16(pa2,PK(2),o[d0],0,0,0);
    o[d0]=__builtin_amdgcn_mfma_f32_32x32x16_bf16(pa3,PK(3),o[d0],0,0,0);
    #undef PK
  }
}

#ifndef ATTN_STORE16
#define ATTN_STORE16(p,v) (*(u32x4*)(p)=(v))
#endif
template<int THRL> __device__ __forceinline__ void attn_unit(const bf16*Qu,const bf16*__restrict__ Kh,const bf16*__restrict__ Vh,bf16*Ou,const int NT,char*shm){
  const int tid=threadIdx.x,lane=tid&63,r32=lane&31,hi=lane>>5; const int wid=__builtin_amdgcn_readfirstlane(tid>>6);
  const bf16*Qw=Qu+(long)(wid*QBLK)*DM;
  const unsigned lds0=(unsigned)(uintptr_t)shm;
  float*wsf=(float*)(shm+LDS_WS)+wid*64;
  const bf16*ksrc=Kh+(long)lane*DM+wid*8;
  const bf16*vsrc=Vh+(long)(16*(wid&3)+(lane>>2))*DM+(wid>>2)*32+(lane&3)*8;
  const unsigned kdst=lds0+LDS_K+wid*1024, vdst=lds0+LDS_V+wid*1024;
  #define DMA_K(t,slot) glds16(ksrc+(long)(t)*KVBLK*DM,(unsigned)__builtin_amdgcn_readfirstlane(kdst+(slot)))
  #define DMA_V(t,slot) glds16(vsrc+(long)(t)*KVBLK*DM,(unsigned)__builtin_amdgcn_readfirstlane(vdst+(slot)))
  const int vb0=(int)(lds0+LDS_V)+((lane>>4)&1)*32+(lane&3)*8+(4*hi+((lane&15)>>2))*64;
  const char*Kbase=shm+LDS_K; bf16x8 kf[8];
  const lds_cptr shm3=(lds_cptr)shm; const lds_cptr kp0=shm3+LDS_K+hi*1024+r32*16; const lds_cptr vp0=shm3+LDS_V+((lane>>4)&1)*32+(lane&3)*8+(4*hi+((lane&15)>>2))*64;
  DMA_K(0,0);DMA_V(0,0);DMA_K(1,SLOTB);
  bf16x8 qr[4];
  #pragma unroll
  for(int d0=0;d0<4;++d0)qr[d0]=*reinterpret_cast<const bf16x8*>(&Qw[(long)r32*DM+d0*16+hi*8]);
  float mhat=0.f,l_reg=0.f;f32x16 o[2];o[0]=f32x16{};o[1]=f32x16{};f32x16 negm=f32x16{};asm volatile("":"+v"(negm));
  #define CMASK(P0,P1,t) do{}while(0)
  bool resc=false;
  #define START(P0,P1) do{ const float rm=rowmax(P0,P1); resc=false; \
    { const float dl=rm; mhat=fadd_s(mhat,dl); \
      _Pragma("unroll") for(int r=0;r<16;++r){P0[r]=fsub_s(P0[r],dl);P1[r]=fsub_s(P1[r],dl);} \
      _Pragma("unroll") for(int r=0;r<16;++r)negm[r]=-mhat; asm volatile("":"+v"(negm)); } \
    _Pragma("unroll") for(int r=0;r<16;++r)P0[r]=__builtin_amdgcn_exp2f(P0[r]); }while(0)
  #define RESC() do{ if(resc){ asm volatile("s_waitcnt lgkmcnt(0)":::"memory"); \
      _Pragma("unroll") for(int d_=0;d_<2;++d_) _Pragma("unroll") for(int r=0;r<16;++r)o[d_][r]*=wsf[crow(r,hi)]; } }while(0)
  f32x16 pA0,pA1,pB0,pB1;
  int sl_prev=0,sl_cur=0,sl_next=SLOTB;
  #define ROT() do{sl_prev=sl_cur;sl_cur=sl_next;sl_next=(sl_next==(NSLOT-1)*SLOTB)?0:sl_next+SLOTB;}while(0)
  DMA_K(2,2*SLOTB);
  WAIT_BAR(3);
  qkt(pA0,pA1,Kbase,qr,negm,r32,hi);asm volatile("s_nop 15\n\ts_nop 7":"+v"(pA0),"+v"(pA1));CMASK(pA0,pA1,0);
  START(pA0,pA1);
  _Pragma("unroll") for(int r=0;r<16;++r)pA1[r]=__builtin_amdgcn_exp2f(pA1[r]);
  WAIT_BAR(0);
  DMA_K(3,0);DMA_V(1,SLOTB);
  ROT();
  kload8(kf,kp0+sl_cur);
  WAIT_BAR(2);
  s16x4 vlo[8],vhi[8]; u32x4 pw0,pw1,pw2,pw3;
  #define PKW(P,B) cvtpk_s(P[B],P[B+1])
  #define PAF(k) __builtin_bit_cast(bf16x8,pw##k)
  #define VFR(i) (bf16x8){vlo[i][0],vlo[i][1],vlo[i][2],vlo[i][3],vhi[i][0],vhi[i][1],vhi[i][2],vhi[i][3]}
  #define PIN(x) asm volatile("":"+v"(x))
  #define MX3(a,b,c) __builtin_fmaxf(__builtin_fmaxf((a),(b)),(c))
  #define GAPA(MF,A0,A1,A2,A3,W0,W1,PW) do{ MF; sacc+=A0; sacc+=A1; sacc+=A2; sacc+=A3; PIN(sacc); W0; W1; PIN(PW); SBAR(); }while(0)
  #define EX(v) __builtin_amdgcn_exp2f(v)
  #define GAPB(MF,X,B) do{ MF; X[B]=EX(X[B]); X[B+1]=EX(X[B+1]); X[B+2]=EX(X[B+2]); X[B+3]=EX(X[B+3]); PIN(X); SBAR(); }while(0)
  #define VRD(i) do{ vlo[i]=vtr(vp_+(((i)>>2)*4096+((i)&3)*1024)); vhi[i]=vtr(vp_+(((i)>>2)*4096+((i)&3)*1024+512)); }while(0)
  #define KRD(G,j) do{ if(G){ kload2(kf,kp0+sl_next,j); SBAR(); } }while(0)
  #define STEP(C0,C1,P0,P1,t,GK,GV,GL) do{ SBAR(); \
    const lds_cptr vp_=vp0+sl_prev; \
    VRD(0); SBAR(); float sacc=(P0[0]+P0[1]); \
    GAPA(C0=__builtin_amdgcn_mfma_f32_32x32x16_bf16(kf[0],qr[0],negm,0,0,0), P0[2],P0[3],P0[4],P0[5],     pw0[0]=PKW(P0,0), pw0[1]=PKW(P0,2), pw0); \
    VRD(4); SBAR(); GAPA(C1=__builtin_amdgcn_mfma_f32_32x32x16_bf16(kf[1],qr[0],negm,0,0,0), P0[6],P0[7],P0[8],P0[9],     pw0[2]=PKW(P0,4), pw0[3]=PKW(P0,6), pw0); \
    VRD(1); SBAR(); GAPA(C0=__builtin_amdgcn_mfma_f32_32x32x16_bf16(kf[2],qr[1],C0,0,0,0),   P0[10],P0[11],P0[12],P0[13], pw1[0]=PKW(P0,8), pw1[1]=PKW(P0,10), pw1); \
    VRD(5); SBAR(); GAPA(C1=__builtin_amdgcn_mfma_f32_32x32x16_bf16(kf[3],qr[1],C1,0,0,0),   P0[14],P0[15],P1[0],P1[1],   pw1[2]=PKW(P0,12),pw1[3]=PKW(P0,14), pw1); \
    VRD(2); SBAR(); GAPA(C0=__builtin_amdgcn_mfma_f32_32x32x16_bf16(kf[4],qr[2],C0,0,0,0),   P1[2],P1[3],P1[4],P1[5],     pw2[0]=PKW(P1,0), pw2[1]=PKW(P1,2), pw2); \
    VRD(6); SBAR(); GAPA(C1=__builtin_amdgcn_mfma_f32_32x32x16_bf16(kf[5],qr[2],C1,0,0,0),   P1[6],P1[7],P1[8],P1[9],     pw2[2]=PKW(P1,4), pw2[3]=PKW(P1,6), pw2); \
    VRD(3); SBAR(); GAPA(C0=__builtin_amdgcn_mfma_f32_32x32x16_bf16(kf[6],qr[3],C0,0,0,0),   P1[10],P1[11],P1[12],P1[13], pw3[0]=PKW(P1,8), pw3[1]=PKW(P1,10), pw3); \
    VRD(7); SBAR(); GAPA(C1=__builtin_amdgcn_mfma_f32_32x32x16_bf16(kf[7],qr[3],C1,0,0,0),   P1[14],P1[15],0.f,0.f,       pw3[2]=PKW(P1,12),pw3[3]=PKW(P1,14), pw3); \
    l_reg+=sacc; \
    if(GK){DMA_K((t)+3,sl_cur);} if(GV){DMA_V((t)+1,sl_next);} \
    CMASK(C0,C1,t); \
    { float a=MX3(C0[0],C0[1],C1[0]),b=MX3(C0[2],C0[3],C1[1]); a=MX3(a,C1[2],C1[3]); \
      _Pragma("unroll") for(int r=4;r<16;r+=4){a=MX3(a,C0[r],C0[r+1]);b=MX3(b,C0[r+2],C0[r+3]);a=MX3(a,C1[r],C1[r+1]);b=MX3(b,C1[r+2],C1[r+3]);} \
      float rm=__builtin_fmaxf(a,b); { auto rr=__builtin_amdgcn_permlane32_swap(__float_as_uint(rm),__float_as_uint(rm),false,false); rm=__builtin_fmaxf(__uint_as_float(rr[0]),__uint_as_float(rr[1])); } \
      resc=false; \
      if(__builtin_expect(__any(rm>(float)THRL),0)){ const float dl=__builtin_fmaxf(rm,0.f); mhat+=dl; \
        _Pragma("unroll") for(int r=0;r<16;++r){C0[r]-=dl;C1[r]-=dl;} \
        _Pragma("unroll") for(int r=0;r<16;++r)negm[r]=-mhat; asm volatile("":"+v"(negm)); \
        const float f=__builtin_amdgcn_exp2f(-dl); l_reg*=f; if(hi==0)wsf[r32]=f; resc=true; } } \
    SBAR(); \
    GAPB(o[0]=__builtin_amdgcn_mfma_f32_32x32x16_bf16(PAF(0),VFR(0),o[0],0,0,0), C0,0); \
    GAPB(o[1]=__builtin_amdgcn_mfma_f32_32x32x16_bf16(PAF(0),VFR(4),o[1],0,0,0), C0,4); \
    KRD(GL,0); GAPB(o[0]=__builtin_amdgcn_mfma_f32_32x32x16_bf16(PAF(1),VFR(1),o[0],0,0,0), C0,8); \
    KRD(GL,1); GAPB(o[1]=__builtin_amdgcn_mfma_f32_32x32x16_bf16(PAF(1),VFR(5),o[1],0,0,0), C0,12); \
    KRD(GL,2); GAPB(o[0]=__builtin_amdgcn_mfma_f32_32x32x16_bf16(PAF(2),VFR(2),o[0],0,0,0), C1,0); \
    KRD(GL,3); GAPB(o[1]=__builtin_amdgcn_mfma_f32_32x32x16_bf16(PAF(2),VFR(6),o[1],0,0,0), C1,4); \
    GAPB(o[0]=__builtin_amdgcn_mfma_f32_32x32x16_bf16(PAF(3),VFR(3),o[0],0,0,0), C1,8); \
    GAPB(o[1]=__builtin_amdgcn_mfma_f32_32x32x16_bf16(PAF(3),VFR(7),o[1],0,0,0), C1,12); \
    }while(0)
  int t=1;
  #undef CMASK
  #define CMASK(P0,P1,t) do{}while(0)
  for(;t+5<NT;t+=2){
    STEP(pB0,pB1,pA0,pA1,t,true,true,true);     WAIT_BAR(2); RESC(); ROT();
    STEP(pA0,pA1,pB0,pB1,t+1,true,true,true);   WAIT_BAR(2); RESC(); ROT();
  }
  #undef CMASK
  #define CMASK(P0,P1,t) do{}while(0)
  #define ENDW(tt) do{ if((tt)+3<NT){WAIT_BAR(2);} else if((tt)+2<NT){WAIT_BAR(1);} else {WAIT_BAR(0);} }while(0)
  for(;t+1<NT;t+=2){
    STEP(pB0,pB1,pA0,pA1,t,(t+3<NT),(t+1<NT),(t+1<NT));       ENDW(t);   RESC(); ROT();
    STEP(pA0,pA1,pB0,pB1,t+1,(t+4<NT),(t+2<NT),(t+2<NT));     ENDW(t+1); RESC(); ROT();
  }
  STEP(pB0,pB1,pA0,pA1,NT-1,false,false,false); RESC();
  { float sacc=pB0[0]+pB0[1]; _Pragma("unroll") for(int r=2;r<16;++r)sacc+=pB0[r]; _Pragma("unroll") for(int r=0;r<16;++r)sacc+=pB1[r]; l_reg+=sacc;
    pw0=(u32x4){PKW(pB0,0),PKW(pB0,2),PKW(pB0,4),PKW(pB0,6)};pw1=(u32x4){PKW(pB0,8),PKW(pB0,10),PKW(pB0,12),PKW(pB0,14)};pw2=(u32x4){PKW(pB1,0),PKW(pB1,2),PKW(pB1,4),PKW(pB1,6)};pw3=(u32x4){PKW(pB1,8),PKW(pB1,10),PKW(pB1,12),PKW(pB1,14)};
    SBAR(); pv(o,vb0+sl_cur,PAF(0),PAF(1),PAF(2),PAF(3)); }
  #undef PKW
  #undef PAF
  #undef VFR
  #undef PIN
  #undef MX3
  #undef GAPA
  #undef GAPB
  #undef EX
  #undef VRD
  #undef KRD
  #undef STEP
  #undef ENDW
  {auto rr=__builtin_amdgcn_permlane32_swap(__float_as_uint(l_reg),__float_as_uint(l_reg),false,false);l_reg=__uint_as_float(rr[0])+__uint_as_float(rr[1]);}
  if(hi==0)wsf[32+r32]=l_reg;asm volatile("s_waitcnt lgkmcnt(0)":::"memory");
  float rli[16];
  #pragma unroll
  for(int r=0;r<16;++r)rli[r]=__builtin_amdgcn_rcpf(wsf[32+crow(r,hi)]);
  bf16*Ow=Ou+(long)(wid*QBLK)*OPITCH;
  { bf16*stg=(bf16*)(shm+LDS_OST)+wid*2048;
    #pragma unroll
    for(int r=0;r<16;++r){const int orow=crow(r,hi);
      #pragma unroll
      for(int d0=0;d0<2;++d0)stg[orow*64+d0*32+r32]=__float2bfloat16(o[d0][r]*rli[r]);}
    asm volatile("s_waitcnt lgkmcnt(0)":::"memory");
    #pragma unroll
    for(int i=0;i<4;++i){const int row=i*8+(lane>>3),ch=lane&7; const u32x4 v=*(const u32x4*)(stg+row*64+ch*8); ATTN_STORE16(Ow+(long)row*OPITCH+ch*8,v);} }
  asm volatile("s_waitcnt lgkmcnt(0)\n\ts_barrier":::"memory");
  #undef DMA_K
  #undef DMA_V
  #undef CMASK
  #undef START
  #undef RESC
  #undef ROT
}
constexpr int ATTN_LDS_BYTES=LDS_BYTES;
#undef SBAR
#undef WAIT_BAR
}
#define GAS __attribute__((address_space(1)))
#define LAS __attribute__((address_space(3)))
typedef unsigned short bf16;
typedef unsigned v4u __attribute__((ext_vector_type(4)));
typedef unsigned v2u __attribute__((ext_vector_type(2)));
typedef float f32x4 __attribute__((ext_vector_type(4)));
#define LDS_WAIT() asm volatile("s_waitcnt lgkmcnt(0)" ::: "memory")

constexpr int DM_ = 2048, SEQ_ = 8192, CTXL = 256, MROWS = SEQ_ + CTXL;
constexpr int NIN = 13888, NINP = 14080, DFF = 5632;
constexpr int ZP = NINP;
constexpr int C_GQ = 0, C_GK = 512, C_GV = 1024, C_GLR = 1536, C_GG = 1568, C_DQ = 2080, C_DK = 2592, C_DV = 3104,
              C_EQ = 3616, C_EA = 6688, C_EB = 6704, C_EG = 6720, C_MG = 7744;
constexpr size_t MiB = 1u << 20;
constexpr size_t WS_MOD = 0;
constexpr size_t WS_BAR = 512 * 1024, BAR_BYTES = 16384;
constexpr int MISC_OFF = 147456 - 256;
constexpr size_t WS_CNT = WS_BAR + 14336;
constexpr size_t WS_W0 = 1 * MiB, W_LAYER = 137 * MiB;
constexpr size_t WO_IN = 0, WO_UA = 55 * MiB, WO_UD = 57 * MiB, WO_UE = 59 * MiB, WO_O = 63 * MiB, WO_13 = 71 * MiB, WO_2 = 115 * MiB;
constexpr size_t WS_X = WS_W0 + 2 * W_LAYER;
constexpr size_t WS_H = WS_X + 66 * MiB;
constexpr size_t WS_Z = WS_H + 33 * MiB;
constexpr size_t WS_ZG = WS_Z + 227 * MiB;
constexpr size_t WS_AQ = WS_ZG + 3 * MiB, WS_AK = WS_AQ + 9 * MiB, WS_AV = WS_AK + 9 * MiB, WS_AO = WS_AV + 9 * MiB;
constexpr size_t WS_DQ = WS_AO + 17 * MiB, WS_DK = WS_DQ + 17 * MiB, WS_DV = WS_DK + 17 * MiB, WS_DGB = WS_DV + 17 * MiB;
constexpr size_t WS_A = WS_DGB + 2 * MiB, WS_D = WS_A + 9 * MiB, WS_E = WS_D + 9 * MiB;
constexpr size_t WS_R2 = WS_E + 17 * MiB;
constexpr size_t WS_YB = WS_R2 + 66 * MiB;
constexpr size_t WS_END = WS_YB + 33 * MiB;
constexpr size_t WS_HFF = WS_Z;

constexpr int LDS_BYTES = 147456;
constexpr int NPH = 24;

typedef float pk_f32x2 __attribute__((ext_vector_type(2))); typedef __bf16 pk_bf16x2 __attribute__((ext_vector_type(2)));
__device__ __forceinline__ unsigned pk2(float lo, float hi) { const pk_f32x2 v = {lo, hi}; const pk_bf16x2 b = __builtin_convertvector(v, pk_bf16x2); return __builtin_bit_cast(unsigned, b); }
__device__ __forceinline__ unsigned f2bf(float f) { return pk2(f, 0.f) & 0xffffu; }
__device__ __forceinline__ float bf2f(unsigned short b) { return __builtin_bit_cast(float, (unsigned)b << 16); }
__device__ __forceinline__ float bflo(unsigned w) { return __builtin_bit_cast(float, w << 16); }
__device__ __forceinline__ float bfhi(unsigned w) { return __builtin_bit_cast(float, w & 0xffff0000u); }
__device__ __forceinline__ float wave_sum(float v) {
#pragma unroll
    for (int o = 1; o < 64; o <<= 1) v += __shfl_xor(v, o);
    return v;
}
__device__ __forceinline__ float sigmoidf_(float x) { return __builtin_amdgcn_rcpf(1.0f + __expf(-x)); }
__device__ __forceinline__ float siluf_(float x) { return x * __builtin_amdgcn_rcpf(1.0f + __expf(-x)); }

struct Args { const float* in[27]; float* out; unsigned char* ws; int ph_lo, ph_hi; };

struct Frame {
    LAS unsigned char* lds;
    int tid, lane, wave, G, bid;
    unsigned char* ws; float* out;
};

#define XB_TMO      128
#define XB_XCNT(j)  (256  + 64 * (j))
#define XB_XSUB(j)  (1280 + 64 * (j))
#define XB_XGEN(j)  (2304 + 64 * (j))
#define XB_TOP      3328
#define XB_TOPGEN   3392
#define XCD_BAR_WORDS 3456
#define XB_SPIN_CAP (1u << 18)

__device__ __forceinline__ unsigned xb_ld(unsigned* p)              { return __hip_atomic_load(p, __ATOMIC_RELAXED, __HIP_MEMORY_SCOPE_AGENT); }
__device__ __forceinline__ unsigned xb_add(unsigned* p, unsigned v) { return __hip_atomic_fetch_add(p, v, __ATOMIC_RELAXED, __HIP_MEMORY_SCOPE_AGENT); }
__device__ __forceinline__ unsigned xb_xcc_id() { return (unsigned)__builtin_amdgcn_s_getreg((3 << 11) | 20) & 0xFu; }
#define XB_SPIN(cond, bar) do { unsigned _sp = 0; while (cond) { __builtin_amdgcn_s_sleep(1); \
    if ((++_sp & 255u) == 0u) { if (xb_ld(&(bar)[XB_TMO])) break; if (_sp > XB_SPIN_CAP) { atomicAdd(&(bar)[XB_TMO], 1u); break; } } } } while (0)

struct XcdBarrier {
    unsigned* bar; unsigned x;
    volatile LAS unsigned* st;
};

__device__ __forceinline__ XcdBarrier xcd_barrier_post(unsigned* bar, volatile LAS unsigned* st) {
    XcdBarrier b; b.bar = bar; b.x = xb_xcc_id(); b.st = st;
    if (threadIdx.x == 0) (void)xb_add(&bar[XB_XCNT(b.x)], 1u);
    return b;
}
__device__ __forceinline__ void xcd_barrier_complete(unsigned* bar, unsigned x, unsigned& nloc, unsigned& nx) {
    const unsigned G = gridDim.x * gridDim.y * gridDim.z;
    unsigned sum, cnt, mine, sp = 0u;
    for (;;) {
        sum = 0u; cnt = 0u; mine = 0u;
#pragma unroll
        for (unsigned j = 0; j < 16; ++j) { const unsigned c = xb_ld(&bar[XB_XCNT(j)]); sum += c; cnt += (c > 0u) ? 1u : 0u; mine = (j == x) ? c : mine; }
        if (sum == G) break;
        __builtin_amdgcn_s_sleep(1);
        if ((++sp & 255u) == 0u) { if (xb_ld(&bar[XB_TMO])) break; if (sp > XB_SPIN_CAP) { atomicAdd(&bar[XB_TMO], 1u); break; } }
    }
    nloc = mine > 0u ? mine : 1u; nx = cnt > 0u ? cnt : 1u;
}

__device__ __forceinline__ void xcd_barrier(const XcdBarrier& b) {
    asm volatile("s_waitcnt vmcnt(0)" ::: "memory");
    __syncthreads();
    if (threadIdx.x == 0) {
        unsigned* bar = b.bar;
        __builtin_amdgcn_s_waitcnt(0);
        unsigned nloc = b.st[0], nx = b.st[1];
        if (nloc == 0u) { xcd_barrier_complete(bar, b.x, nloc, nx); b.st[0] = nloc; b.st[1] = nx; }
        const unsigned old = xb_add(&bar[XB_XSUB(b.x)], 1u);
        const unsigned gen = old / nloc;
        if (old + 1u == (gen + 1u) * nloc) {
            __builtin_amdgcn_fence(__ATOMIC_RELEASE, "agent");
            asm volatile("s_waitcnt vmcnt(0)" ::: "memory");
            const unsigned og = xb_add(&bar[XB_TOP], 1u);
            const unsigned tg = og / nx;
            if (og + 1u == (tg + 1u) * nx) xb_add(&bar[XB_TOPGEN], 1u);
            else XB_SPIN(xb_ld(&bar[XB_TOPGEN]) == tg, bar);
            __builtin_amdgcn_fence(__ATOMIC_ACQUIRE, "agent");
            xb_add(&bar[XB_XGEN(b.x)], 1u);
            asm volatile("s_waitcnt vmcnt(0)" ::: "memory");
        } else {
            XB_SPIN(xb_ld(&bar[XB_XGEN(b.x)]) == gen, bar);
            __builtin_amdgcn_fence(__ATOMIC_ACQUIRE, "agent");
            asm volatile("s_waitcnt vmcnt(0)" ::: "memory");
        }
    }
    __syncthreads();
}

__device__ __forceinline__ void p0_transpose_item(const float* W, int K, int N, bf16* WT, int k0, int n0, int drow, LAS float* scr, int lane) {
#pragma unroll 8
    for (int i = 0; i < 32; ++i) { const int kk = 2 * i + (lane >> 5); scr[kk * 33 + (lane & 31)] = W[(size_t)(k0 + kk) * N + n0 + (lane & 31)]; }
    LDS_WAIT(); asm volatile("" ::: "memory");
    const int c = lane & 7;
#pragma unroll
    for (int j = 0; j < 4; ++j) { const int n = (lane >> 3) + 8 * j; const LAS float* s = scr + (8 * c) * 33 + n;
        v4u o; o.x = pk2(s[0 * 33], s[1 * 33]); o.y = pk2(s[2 * 33], s[3 * 33]); o.z = pk2(s[4 * 33], s[5 * 33]); o.w = pk2(s[6 * 33], s[7 * 33]);
        *(v4u*)(WT + (size_t)(drow + n) * K + k0 + 8 * c) = o; }
    LDS_WAIT(); asm volatile("" ::: "memory");
}
__device__ __forceinline__ void tr_plain(const float* W, int K, int N, bf16* WT, int item, LAS float* scr, int lane) {
    const int nblk = N / 32, kb = item / nblk, nb = item % nblk;
    p0_transpose_item(W, K, N, WT, 64 * kb, 32 * nb, 32 * nb, scr, lane);
}
__device__ __forceinline__ void tr_ffn13(const float* W, bf16* WT, int item, int which, LAS float* scr, int lane) {
    const int nblk = DFF / 32, kb = item / nblk, nb = item % nblk, n0 = 32 * nb;
    p0_transpose_item(W, DM_, DFF, WT, 64 * kb, n0, 256 * (n0 >> 7) + (n0 & 127) + 128 * which, scr, lane);
}
constexpr int I_IN = 32 * (NIN / 32), I_UA = 8 * 64, I_UE = 16 * 64, I_O = 32 * 64, I_F = 32 * (DFF / 32), I_2 = (DFF / 64) * 64;
constexpr int PER_L = I_IN + 2 * I_UA + I_UE + I_O + 2 * I_F + I_2;
__device__ __forceinline__ void p0_item(Frame& F, const Args& A, const int l, int r, LAS float* scr) {
    unsigned char* wb = F.ws + WS_W0;
    if (r < I_IN) { tr_plain(A.in[10] + (size_t)l * DM_ * NIN, DM_, NIN, (bf16*)(wb + WO_IN), r, scr, F.lane); return; } r -= I_IN;
    if (r < I_UA) { tr_plain(A.in[20] + (size_t)l * 512 * DM_, 512, DM_, (bf16*)(wb + WO_UA), r, scr, F.lane); return; } r -= I_UA;
    if (r < I_UA) { tr_plain(A.in[21] + (size_t)l * 512 * DM_, 512, DM_, (bf16*)(wb + WO_UD), r, scr, F.lane); return; } r -= I_UA;
    if (r < I_UE) { tr_plain(A.in[22] + (size_t)l * 1024 * DM_, 1024, DM_, (bf16*)(wb + WO_UE), r, scr, F.lane); return; } r -= I_UE;
    if (r < I_O) { tr_plain(A.in[23] + (size_t)l * DM_ * DM_, DM_, DM_, (bf16*)(wb + WO_O), r, scr, F.lane); return; } r -= I_O;
    if (r < I_F) { tr_ffn13(A.in[24] + (size_t)l * DM_ * DFF, (bf16*)(wb + WO_13), r, 0, scr, F.lane); return; } r -= I_F;
    if (r < I_F) { tr_ffn13(A.in[25] + (size_t)l * DM_ * DFF, (bf16*)(wb + WO_13), r, 1, scr, F.lane); return; } r -= I_F;
    tr_plain(A.in[26] + (size_t)l * DFF * DM_, DFF, DM_, (bf16*)(wb + WO_2), r, scr, F.lane);
}
__device__ __forceinline__ void p0_dynamic(Frame& F, const Args& A, const int l, unsigned* cnt, const int lo_, const int hi) {
    LAS float* scr = (LAS float*)(F.lds + F.wave * 16384);
    volatile LAS unsigned* slot = (volatile LAS unsigned*)(F.lds + MISC_OFF) + 16;
    for (;;) {
        if (F.tid == 0) slot[0] = __hip_atomic_fetch_add(cnt, 64u, __ATOMIC_RELAXED, __HIP_MEMORY_SCOPE_AGENT);
        __syncthreads();
        const int base = lo_ + (int)slot[0];
        __syncthreads();
        if (base >= hi) break;
        for (int k = 0; k < 8; ++k) { const int it = base + F.wave * 8 + k; if (it < hi) p0_item(F, A, l, it, scr); }
    }
}
__device__ __forceinline__ void p0_phase(Frame& F, const Args& A, const int l, const bool gemv, const int ilo, const int ihi) {
    LAS float* scr = (LAS float*)(F.lds + F.wave * 16384);
    const int gw = F.bid * 8 + F.wave, NGW = F.G * 8;
    for (int it = ilo + gw; it < ilo + (ihi - ilo) * REP_P0; it += NGW) p0_item(F, A, l, ilo + (it - ilo) % (ihi - ilo), scr);
    __syncthreads();
    if (!gemv) return;
    LAS float* red = (LAS float*)F.lds;
    const float* cl = A.in[1]; const float* cc = A.in[3];
    for (int it = F.bid; it < 2 * 192; it += F.G) {
        const int lg = it / 192, jb = it % 192, kg = F.tid >> 4, jl = F.tid & 15;
        const float* wp = A.in[4] + ((size_t)lg * DM_ + kg * 64) * 12288 + jb * 64 + jl * 4;
        f32x4 al = {0.f, 0.f, 0.f, 0.f}, ac = {0.f, 0.f, 0.f, 0.f};
#pragma unroll 8
        for (int kk = 0; kk < 64; ++kk) {
            const f32x4 w = *(const f32x4*)(wp + (size_t)kk * 12288);
            const float sl = siluf_(cl[kg * 64 + kk]), sc = siluf_(cc[kg * 64 + kk]);
            al += w * sl; ac += w * sc;
        }
        LAS float* rp = red + (kg * 16 + jl) * 8;
        rp[0] = al.x; rp[1] = al.y; rp[2] = al.z; rp[3] = al.w; rp[4] = ac.x; rp[5] = ac.y; rp[6] = ac.z; rp[7] = ac.w;
        __syncthreads();
        if (F.tid < 128) {
            const int j2 = F.tid & 15, comp = F.tid >> 4; float s = 0.f;
            for (int g = 0; g < 32; ++g) s += red[(g * 16 + j2) * 8 + comp];
            const int sidx = comp >> 2, col = jb * 64 + j2 * 4 + (comp & 3);
            ((float*)(F.ws + WS_MOD))[(size_t)(lg * 2 + sidx) * 12288 + col] = s + A.in[5][(size_t)lg * 12288 + col];
        }
        __syncthreads();
    }
}

template <int MODE> __device__ __forceinline__ void row_phase(Frame& F, const Args& A, int l) {
    const int gw = F.bid * 8 + F.wave, NGW = F.G * 8;
    float* X = (float*)(F.ws + WS_X); const float* Y2 = (const float*)(F.ws + WS_R2); bf16* H = (bf16*)(F.ws + WS_H);
    const float* MOD = (const float*)(F.ws + WS_MOD);
    for (int r = gw + ((MODE >= 1 && l == 1) ? CTXL : 0); r < MROWS; r += NGW) {
        const int s = r < CTXL ? 1 : 0;
        const float* mod = MOD + (size_t)(l * 2 + s) * 12288;
        f32x4 v[8];
        if (MODE == 0) {
            const float* src = s ? A.in[2] + (size_t)r * DM_ : A.in[0] + (size_t)(r - CTXL) * DM_;
#pragma unroll
            for (int j = 0; j < 8; ++j) v[j] = *(const f32x4*)(src + (F.lane + 64 * j) * 4);
        } else {
            const float* y = Y2 + (size_t)r * DM_; float ss = 0.f;
            const float* w = (MODE == 1 ? A.in[7] : A.in[9]) + (size_t)l * DM_;
            const float* gate = mod + (MODE == 1 ? 2 : 5) * DM_;
            f32x4 xv[8], wv[8], gv[8];
#pragma unroll
            for (int j = 0; j < 8; ++j) { const int c = (F.lane + 64 * j) * 4; v[j] = *(const f32x4*)(y + c); xv[j] = *(const f32x4*)(X + (size_t)r * DM_ + c); wv[j] = *(const f32x4*)(w + c); gv[j] = *(const f32x4*)(gate + c); }
#pragma unroll
            for (int j = 0; j < 8; ++j) ss += v[j].x * v[j].x + v[j].y * v[j].y + v[j].z * v[j].z + v[j].w * v[j].w;
            const float rs = __builtin_amdgcn_rsqf(wave_sum(ss) * (1.0f / DM_) + 1e-6f);
#pragma unroll
            for (int j = 0; j < 8; ++j) v[j] = xv[j] + gv[j] * (v[j] * rs * wv[j]);
        }
        if (MODE == 2 && l == 1) {
            if (!s) {
#pragma unroll
                for (int j = 0; j < 8; ++j) *(f32x4*)(F.out + (size_t)(r - CTXL) * DM_ + (F.lane + 64 * j) * 4) = v[j];
            }
            continue;
        }
        float ss = 0.f;
        const float* wn = (MODE == 0 ? A.in[6] : MODE == 1 ? A.in[8] + (size_t)l * DM_ : A.in[6] + (size_t)(l + 1) * DM_);
        const float* modn = (MODE == 2) ? MOD + (size_t)((l + 1) * 2 + s) * 12288 : mod;
        const float* sh = modn + (MODE == 1 ? 3 : 0) * DM_; const float* sc = sh + DM_;
#pragma unroll
        for (int j = 0; j < 8; ++j) { *(f32x4*)(X + (size_t)r * DM_ + (F.lane + 64 * j) * 4) = v[j]; ss += v[j].x * v[j].x + v[j].y * v[j].y + v[j].z * v[j].z + v[j].w * v[j].w; }
        const float rs2 = __builtin_amdgcn_rsqf(wave_sum(ss) * (1.0f / DM_) + 1e-6f);
#pragma unroll
        for (int j = 0; j < 8; ++j) { const int c = (F.lane + 64 * j) * 4;
            const f32x4 wv = *(const f32x4*)(wn + c), shv = *(const f32x4*)(sh + c), scv = *(const f32x4*)(sc + c);
            const f32x4 h = (v[j] * rs2 * wv) * (1.0f + scv) + shv;
            v2u o; o.x = pk2(h.x, h.y); o.y = pk2(h.z, h.w);
            *(v2u*)(H + (size_t)r * DM_ + c) = o; }
    }
}
__device__ __forceinline__ void prep_phase(Frame& F, const Args& A, int l) {
    const int gw = F.bid * 8 + F.wave, NGW = F.G * 8, lane = F.lane;
    const bf16* Z = (const bf16*)(F.ws + WS_Z); const float* ZG = (const float*)(F.ws + WS_ZG);
    bf16* AQ = (bf16*)(F.ws + WS_AQ); bf16* AK = (bf16*)(F.ws + WS_AK); bf16* AV = (bf16*)(F.ws + WS_AV);
    bf16* DQ = (bf16*)(F.ws + WS_DQ); bf16* DK = (bf16*)(F.ws + WS_DK); bf16* DV = (bf16*)(F.ws + WS_DV);
    float* DG = (float*)(F.ws + WS_DGB); float* DB = DG + 16 * MROWS;
    const float* conv_w = A.in[16] + (size_t)l * 5 * 3072;
    const float* a_log = A.in[17] + l * 16; const float* dt_bias = A.in[18] + l * 16;
    constexpr float C2 = 0.125f * 1.4426950408889634f;
    for (int g_ = gw; g_ < (MROWS / 4) * REP_ROWS; g_ += NGW) {
        const int r0 = (g_ % (MROWS / 4)) * 4;
        const bool lat = r0 >= CTXL; const int lo = lat ? CTXL : 0, hi = lat ? MROWS : CTXL;
        for (int it = 0; it < 6; ++it) {
            const int ch0 = it * 512 + lane * 8, p = it >> 1;
            v4u xr[8];
#pragma unroll
            for (int j = 0; j < 8; ++j) { const int rr = r0 + j - 2; xr[j] = (rr >= lo && rr < hi) ? *(const v4u*)(Z + (size_t)rr * ZP + C_EQ + ch0) : (v4u){0u, 0u, 0u, 0u}; }
            float acc[4][8];
#pragma unroll
            for (int j = 0; j < 4; ++j)
#pragma unroll
                for (int e = 0; e < 8; ++e) acc[j][e] = 0.f;
#pragma unroll
            for (int i = 0; i < 5; ++i) {
                const f32x4 c0 = *(const f32x4*)(conv_w + i * 3072 + ch0), c1 = *(const f32x4*)(conv_w + i * 3072 + ch0 + 4);
#pragma unroll
                for (int j = 0; j < 4; ++j) { const v4u x = xr[j + i];
                    acc[j][0] += bflo(x.x) * c0.x; acc[j][1] += bfhi(x.x) * c0.y; acc[j][2] += bflo(x.y) * c0.z; acc[j][3] += bfhi(x.y) * c0.w;
                    acc[j][4] += bflo(x.z) * c1.x; acc[j][5] += bfhi(x.z) * c1.y; acc[j][6] += bflo(x.w) * c1.z; acc[j][7] += bfhi(x.w) * c1.w; }
            }
            bf16* dstb = (p == 0 ? DQ : p == 1 ? DK : DV) + (ch0 & 1023);
#pragma unroll
            for (int j = 0; j < 4; ++j) {
                float sv[8]; float ss = 0.f;
#pragma unroll
                for (int e = 0; e < 8; ++e) { sv[e] = siluf_(acc[j][e]); ss += sv[e] * sv[e]; }
                if (p < 2) {
                    ss += __shfl_xor(ss, 1); ss += __shfl_xor(ss, 2); ss += __shfl_xor(ss, 4); ss += __shfl_xor(ss, 8);
                    const float sc = __builtin_amdgcn_rsqf(ss + 1e-6f) * (p == 0 ? 0.08838834764831845f : 1.0f);
#pragma unroll
                    for (int e = 0; e < 8; ++e) sv[e] *= sc;
                }
                v4u o; o.x = pk2(sv[0], sv[1]); o.y = pk2(sv[2], sv[3]); o.z = pk2(sv[4], sv[5]); o.w = pk2(sv[6], sv[7]);
                *(v4u*)(dstb + (size_t)(r0 + j) * 1024) = o;
            }
        }
        {
            const int r = r0 + (lane >> 4), gi = lane & 15;
            const float a = ZG[(size_t)r * 64 + 32 + gi], bt = ZG[(size_t)r * 64 + 48 + gi];
            const float xs = a + dt_bias[gi];
            const float sp = xs > 20.f ? xs : log1pf(expf(xs));
            DG[(size_t)gi * MROWS + r] = -expf(a_log[gi]) * sp;
            DB[(size_t)gi * MROWS + r] = 1.0f / (1.0f + expf(-bt));
        }
        for (int j = 0; j < 4; ++j) {
            const int r = r0 + j, t = r - CTXL; const bf16* zr = Z + (size_t)r * ZP;
            const v4u qv = *(const v4u*)(zr + C_DQ + lane * 8), kv = *(const v4u*)(zr + C_DK + lane * 8), vv = *(const v4u*)(zr + C_DV + lane * 8);
            *(v4u*)(AV + (size_t)r * 512 + lane * 8) = vv;
            float q[8], k[8];
            q[0] = bflo(qv.x); q[1] = bfhi(qv.x); q[2] = bflo(qv.y); q[3] = bfhi(qv.y); q[4] = bflo(qv.z); q[5] = bfhi(qv.z); q[6] = bflo(qv.w); q[7] = bfhi(qv.w);
            k[0] = bflo(kv.x); k[1] = bfhi(kv.x); k[2] = bflo(kv.y); k[3] = bfhi(kv.y); k[4] = bflo(kv.z); k[5] = bfhi(kv.z); k[6] = bflo(kv.w); k[7] = bfhi(kv.w);
            if (lat) {
                const int sub = lane & 3, part = (lane >> 2) & 1; const float pos = (float)(part ? (t & 63) : (t >> 6));
                const float sgn = (sub & 2) ? 1.0f : -1.0f;
#pragma unroll
                for (int e = 0; e < 8; ++e) {
                    const float qp = __shfl_xor(q[e], 2), kp = __shfl_xor(k[e], 2);
                    const int i = (sub & 1) * 8 + e;
                    const float inv = __builtin_amdgcn_exp2f(-(float)i * 0.8304820237218406f);
                    const float rev = (pos * inv) * 0.15915494309189535f;
                    const float cs = __builtin_amdgcn_cosf(rev), sn = __builtin_amdgcn_sinf(rev);
                    q[e] = q[e] * cs + sgn * qp * sn; k[e] = k[e] * cs + sgn * kp * sn;
                }
            }
            v4u qo, ko;
            qo.x = pk2(q[0] * C2, q[1] * C2); qo.y = pk2(q[2] * C2, q[3] * C2); qo.z = pk2(q[4] * C2, q[5] * C2); qo.w = pk2(q[6] * C2, q[7] * C2);
            ko.x = pk2(k[0], k[1]); ko.y = pk2(k[2], k[3]); ko.z = pk2(k[4], k[5]); ko.w = pk2(k[6], k[7]);
            *(v4u*)(AQ + (size_t)r * 512 + lane * 8) = qo; *(v4u*)(AK + (size_t)r * 512 + lane * 8) = ko;
        }
    }
}

__device__ __forceinline__ int scan_row(int dir, int n, int i) {
    if (dir == 0) return 64 * n + i;
    return (n < 4 ? 64 * (3 - n) : CTXL + 64 * (127 - (n - 4))) + 63 - i;
}

__device__ __forceinline__ void gla_chain_naive(Frame& F, const Args& A, int l, int chain) {
    const int dir = chain >> 2, h = chain & 3, tid = F.tid, lane = F.lane;
    const bf16* Z = (const bf16*)(F.ws + WS_Z); const float* ZG = (const float*)(F.ws + WS_ZG);
    float* OA = (float*)(F.ws + WS_YB) + (size_t)dir * MROWS * 512;
    const float* w2 = A.in[11] + ((size_t)(l * 2 + dir) * 16) * 512 + h * 128; const float* gb = A.in[12] + (size_t)(l * 2 + dir) * 512 + h * 128;
    LAS bf16* qs = (LAS bf16*)F.lds; LAS bf16* ks = qs + 64 * 128; LAS bf16* vs = ks + 64 * 128; LAS float* eg = (LAS float*)(F.lds + 49152);
    float S[64];
#pragma unroll
    for (int d = 0; d < 64; ++d) S[d] = 0.f;
    const int col = (tid >> 6) * 32 + (lane & 31), half = lane >> 5;
    for (int n = 0; n < 132; ++n) {
        for (int p = tid; p < 1024; p += 512) { const int i = p >> 4, c8 = (p & 15) * 8; const bf16* zr = Z + (size_t)scan_row(dir, n, i) * ZP + h * 128 + c8;
            *(LAS v4u*)(qs + i * 128 + c8) = *(const v4u*)(zr + C_GQ); *(LAS v4u*)(ks + i * 128 + c8) = *(const v4u*)(zr + C_GK); *(LAS v4u*)(vs + i * 128 + c8) = *(const v4u*)(zr + C_GV); }
        {   const int i = tid >> 3, dg = (tid & 7) * 16; const float* lr = ZG + (size_t)scan_row(dir, n, i) * 64 + dir * 16;
            float x[16];
#pragma unroll
            for (int jj = 0; jj < 16; ++jj) x[jj] = gb[dg + jj];
            for (int j = 0; j < 16; ++j) { const float lv = lr[j];
#pragma unroll
                for (int jj = 0; jj < 16; ++jj) x[jj] += lv * w2[j * 512 + dg + jj]; }
#pragma unroll
            for (int jj = 0; jj < 16; ++jj) { const float ls = fminf(x[jj], 0.f) - log1pf(expf(-fabsf(x[jj]))); eg[i * 128 + dg + jj] = expf(ls * 0.0625f); }
        }
        __syncthreads();
        if (tid < 256) {
            for (int i = 0; i < 64; ++i) {
                const float vv = bf2f(vs[i * 128 + col]); float o = 0.f;
#pragma unroll
                for (int d4 = 0; d4 < 16; ++d4) {
                    const f32x4 e4 = *(const LAS f32x4*)(eg + i * 128 + half * 64 + d4 * 4);
                    const v2u k2 = *(const LAS v2u*)(ks + i * 128 + half * 64 + d4 * 4), q2 = *(const LAS v2u*)(qs + i * 128 + half * 64 + d4 * 4);
                    S[d4 * 4 + 0] = S[d4 * 4 + 0] * e4.x + bflo(k2.x) * vv; o += S[d4 * 4 + 0] * bflo(q2.x);
                    S[d4 * 4 + 1] = S[d4 * 4 + 1] * e4.y + bfhi(k2.x) * vv; o += S[d4 * 4 + 1] * bfhi(q2.x);
                    S[d4 * 4 + 2] = S[d4 * 4 + 2] * e4.z + bflo(k2.y) * vv; o += S[d4 * 4 + 2] * bflo(q2.y);
                    S[d4 * 4 + 3] = S[d4 * 4 + 3] * e4.w + bfhi(k2.y) * vv; o += S[d4 * 4 + 3] * bfhi(q2.y);
                }
                o += __shfl_xor(o, 32);
                if (half == 0) OA[(size_t)scan_row(dir, n, i) * 512 + h * 128 + col] = o * 0.08838834764831845f;
            }
        }
        __syncthreads();
    }
}
__device__ __forceinline__ void delta_chain_naive(Frame& F, const Args& A, int chain) {
    const int dir = chain >> 3, h = chain & 7, tid = F.tid, lane = F.lane;
    const bf16* DQ = (const bf16*)(F.ws + WS_DQ); const bf16* DK = (const bf16*)(F.ws + WS_DK); const bf16* DV = (const bf16*)(F.ws + WS_DV);
    const float* DG = (const float*)(F.ws + WS_DGB) + (size_t)chain * MROWS; const float* DB = (const float*)(F.ws + WS_DGB) + (size_t)(16 + chain) * MROWS;
    float* OE = (float*)(F.ws + WS_R2) + (size_t)dir * MROWS * 1024;
    LAS bf16* qs = (LAS bf16*)F.lds; LAS bf16* ks = qs + 64 * 128; LAS bf16* vs = ks + 64 * 128; LAS float* gs = (LAS float*)(F.lds + 49152);
    float S[64];
#pragma unroll
    for (int d = 0; d < 64; ++d) S[d] = 0.f;
    const int col = (tid >> 6) * 32 + (lane & 31), half = lane >> 5;
    for (int n = 0; n < 132; ++n) {
        for (int p = tid; p < 1024; p += 512) { const int i = p >> 4, c8 = (p & 15) * 8; const size_t off = (size_t)scan_row(dir, n, i) * 1024 + h * 128 + c8;
            *(LAS v4u*)(qs + i * 128 + c8) = *(const v4u*)(DQ + off); *(LAS v4u*)(ks + i * 128 + c8) = *(const v4u*)(DK + off); *(LAS v4u*)(vs + i * 128 + c8) = *(const v4u*)(DV + off); }
        if (tid < 64) { const int r = scan_row(dir, n, tid); gs[tid] = expf(DG[r]); gs[64 + tid] = DB[r]; }
        __syncthreads();
        if (tid < 256) {
            for (int i = 0; i < 64; ++i) {
                const float vv = bf2f(vs[i * 128 + col]), egv = gs[i], beta = gs[64 + i];
                float kf[64]; float kS = 0.f;
#pragma unroll
                for (int d4 = 0; d4 < 16; ++d4) { const v2u k2 = *(const LAS v2u*)(ks + i * 128 + half * 64 + d4 * 4);
                    kf[d4 * 4 + 0] = bflo(k2.x); kf[d4 * 4 + 1] = bfhi(k2.x); kf[d4 * 4 + 2] = bflo(k2.y); kf[d4 * 4 + 3] = bfhi(k2.y);
                    kS += kf[d4 * 4 + 0] * S[d4 * 4 + 0] + kf[d4 * 4 + 1] * S[d4 * 4 + 1] + kf[d4 * 4 + 2] * S[d4 * 4 + 2] + kf[d4 * 4 + 3] * S[d4 * 4 + 3]; }
                kS += __shfl_xor(kS, 32);
                const float u = beta * (vv - egv * kS); float o = 0.f;
#pragma unroll
                for (int d4 = 0; d4 < 16; ++d4) { const v2u q2 = *(const LAS v2u*)(qs + i * 128 + half * 64 + d4 * 4);
                    S[d4 * 4 + 0] = S[d4 * 4 + 0] * egv + kf[d4 * 4 + 0] * u; o += S[d4 * 4 + 0] * bflo(q2.x);
                    S[d4 * 4 + 1] = S[d4 * 4 + 1] * egv + kf[d4 * 4 + 1] * u; o += S[d4 * 4 + 1] * bfhi(q2.x);
                    S[d4 * 4 + 2] = S[d4 * 4 + 2] * egv + kf[d4 * 4 + 2] * u; o += S[d4 * 4 + 2] * bflo(q2.y);
                    S[d4 * 4 + 3] = S[d4 * 4 + 3] * egv + kf[d4 * 4 + 3] * u; o += S[d4 * 4 + 3] * bfhi(q2.y); }
                o += __shfl_xor(o, 32);
                if (half == 0) OE[(size_t)scan_row(dir, n, i) * 1024 + h * 128 + col] = o;
            }
        }
        __syncthreads();
    }
}

__device__ __forceinline__ void out_phase(Frame& F, const Args& A, int l) {
    const int gw = F.bid * 8 + F.wave, NGW = F.G * 8, lane = F.lane;
    const bf16* Z = (const bf16*)(F.ws + WS_Z); const bf16* AO = (const bf16*)(F.ws + WS_AO);
    const float* OA = (const float*)(F.ws + WS_YB); const float* OE = (const float*)(F.ws + WS_R2);
    bf16* A_ = (bf16*)(F.ws + WS_A); bf16* D_ = (bf16*)(F.ws + WS_D); bf16* E_ = (bf16*)(F.ws + WS_E);
    const float lam_init = l == 0 ? 0.2f : 0.35550906759096924f;
    const float* lp = A.in[14] + l * 256;
    const float lam = expf(wave_sum(lp[lane] * lp[64 + lane])) - expf(wave_sum(lp[128 + lane] * lp[192 + lane])) + lam_init;
    const float* gnw = A.in[13] + l * 128 + lane * 2; const float* dnw = A.in[15] + l * 128 + lane * 2; const float* enw = A.in[19] + l * 128 + lane * 2;
    const float gw0 = gnw[0], gw1 = gnw[1], dw0 = dnw[0], dw1 = dnw[1], ew0 = enw[0], ew1 = enw[1];
    for (int r = gw; r < MROWS; r += NGW) {
        const bf16* zr = Z + (size_t)r * ZP;
        for (int h = 0; h < 4; ++h) {
            const int c = h * 128 + lane * 2;
            {   const float* o0 = OA + (size_t)r * 512 + c; const float* o1 = o0 + (size_t)MROWS * 512;
                const float x0 = o0[0] + o1[0], x1 = o0[1] + o1[1];
                const float rs = __builtin_amdgcn_rsqf(wave_sum(x0 * x0 + x1 * x1) * (1.0f / 128.f) + 1e-6f);
                const unsigned g = *(const unsigned*)(zr + C_GG + c);
                *(unsigned*)(A_ + (size_t)r * 512 + c) = pk2(x0 * rs * gw0 * siluf_(bflo(g)), x1 * rs * gw1 * siluf_(bfhi(g))); }
            {   const unsigned w1 = *(const unsigned*)(AO + (size_t)r * 1024 + (h * 2) * 128 + lane * 2), w2 = *(const unsigned*)(AO + (size_t)r * 1024 + (h * 2 + 1) * 128 + lane * 2);
                const float x0 = bflo(w1) - lam * bflo(w2), x1 = bfhi(w1) - lam * bfhi(w2);
                const float rs = __builtin_amdgcn_rsqf(wave_sum(x0 * x0 + x1 * x1) * (1.0f / 128.f) + 1e-6f) * (1.0f - lam_init);
                *(unsigned*)(D_ + (size_t)r * 512 + c) = pk2(x0 * rs * dw0, x1 * rs * dw1); }
        }
        for (int h = 0; h < 8; ++h) {
            const int c = h * 128 + lane * 2;
            const float* o0 = OE + (size_t)r * 1024 + c; const float* o1 = o0 + (size_t)MROWS * 1024;
            const float x0 = o0[0] + o1[0], x1 = o0[1] + o1[1];
            const float rs = __builtin_amdgcn_rsqf(wave_sum(x0 * x0 + x1 * x1) * (1.0f / 128.f) + 1e-6f);
            const unsigned g = *(const unsigned*)(zr + C_EG + c);
            *(unsigned*)(E_ + (size_t)r * 1024 + c) = pk2(x0 * rs * ew0 * siluf_(bflo(g)), x1 * rs * ew1 * siluf_(bfhi(g)));
        }
    }
}
typedef short bf16x8_t __attribute__((ext_vector_type(8)));
#define LBAR() do { asm volatile("s_waitcnt lgkmcnt(0)" ::: "memory"); __builtin_amdgcn_s_barrier(); asm volatile("" ::: "memory"); } while (0)
constexpr int P128 = 136, P64 = 72;
template <int K> __device__ __forceinline__ f32x4 mma16(const LAS bf16* A, int lda, const LAS bf16* Bt, int ldb, f32x4 acc, int lane) {
    const int r = lane & 15, q = lane >> 4;
    const LAS bf16* ap = A + r * lda + q * 8; const LAS bf16* bp = Bt + r * ldb + q * 8;
#pragma unroll
    for (int k0 = 0; k0 < K; k0 += 32) {
        const bf16x8_t a = *(const LAS bf16x8_t*)(ap + k0), b = *(const LAS bf16x8_t*)(bp + k0);
        acc = __builtin_amdgcn_mfma_f32_16x16x32_bf16(a, b, acc, 0, 0, 0);
    }
    return acc;
}
__device__ __forceinline__ int chunk_scan_index(int dir, int c) { return dir == 0 ? c : (c < 4 ? 3 - c : 135 - c); }
__device__ __forceinline__ float wave_incl_scan(float x, int lane) {
#pragma unroll
    for (int o = 1; o < 64; o <<= 1) { const float t = __shfl_up(x, o); if (lane >= o) x += t; }
    return x;
}
constexpr size_t WS_DS = WS_W0 + W_LAYER;
constexpr size_t WS_PP = WS_DS, WS_NT = WS_DS + 66 * MiB, WS_GL = WS_DS + 132 * MiB, WS_GD = WS_GL + 1 * MiB;
constexpr size_t WS_UG = WS_H, WS_WG = WS_END, WS_GS = WS_R2, WS_BS = WS_YB;
constexpr size_t WS_END2 = WS_END + 33 * MiB;

__device__ __forceinline__ void delta_prep2_item(Frame& F, int chain, int n) {
    const int dir = chain >> 3, h = chain & 7, tid = F.tid, lane = F.lane, w = F.wave;
    const bf16* DK = (const bf16*)(F.ws + WS_DK); const bf16* DV = (const bf16*)(F.ws + WS_DV);
    const float* DG = (const float*)(F.ws + WS_DGB) + (size_t)chain * MROWS; const float* DB = (const float*)(F.ws + WS_DGB) + (size_t)(16 + chain) * MROWS;
    const size_t item = (size_t)chain * 132 + n;
    bf16* Pp = (bf16*)(F.ws + WS_PP) + item * 16384; bf16* NT = (bf16*)(F.ws + WS_NT) + item * 16384;
    bf16* Ug = (bf16*)(F.ws + WS_UG) + item * 8192; bf16* Wg = (bf16*)(F.ws + WS_WG) + item * 8192;
    LAS bf16* Ks = (LAS bf16*)(F.lds);
    LAS float* AM = (LAS float*)(F.lds + 18432);
    LAS bf16* UT = (LAS bf16*)(F.lds);
    LAS bf16* KbT = (LAS bf16*)(F.lds + 35840);
    LAS bf16* KdT = (LAS bf16*)(F.lds + 54272);
    LAS bf16* VbT = (LAS bf16*)(F.lds + 72704);
    LAS bf16* TB = (LAS bf16*)(F.lds + 91136);
    LAS bf16* WT = (LAS bf16*)(F.lds + 100352);
    LAS float* gcs = (LAS float*)(F.lds + 118784); LAS float* bts = gcs + 64;
    const int ip = tid & 31, c8 = (tid >> 5) * 8, i0 = 2 * ip, i1 = i0 + 1;
    const size_t off0 = (size_t)scan_row(dir, n, i0) * 1024 + h * 128 + c8, off1 = (size_t)scan_row(dir, n, i1) * 1024 + h * 128 + c8;
    const v4u kv0 = *(const v4u*)(DK + off0), kv1 = *(const v4u*)(DK + off1), vv0 = *(const v4u*)(DV + off0), vv1 = *(const v4u*)(DV + off1);
    if (w == 0) { const int r = scan_row(dir, n, lane); gcs[lane] = wave_incl_scan(DG[r], lane); bts[lane] = DB[r]; }
    LBAR();
    const float gclast = gcs[63];
    {
        *(LAS v4u*)(Ks + i0 * P128 + c8) = kv0; *(LAS v4u*)(Ks + i1 * P128 + c8) = kv1;
        const float bt0 = bts[i0], bt1 = bts[i1], fb0 = bt0 * __expf(gcs[i0]), fb1 = bt1 * __expf(gcs[i1]), fd0 = __expf(gclast - gcs[i0]), fd1 = __expf(gclast - gcs[i1]);
        const unsigned k0w[4] = {kv0.x, kv0.y, kv0.z, kv0.w}, k1w[4] = {kv1.x, kv1.y, kv1.z, kv1.w}, v0w[4] = {vv0.x, vv0.y, vv0.z, vv0.w}, v1w[4] = {vv1.x, vv1.y, vv1.z, vv1.w};
#pragma unroll
        for (int e = 0; e < 4; ++e) {
            const float ka0 = bflo(k0w[e]), kb0 = bfhi(k0w[e]), ka1 = bflo(k1w[e]), kb1 = bfhi(k1w[e]);
            const float va0 = bflo(v0w[e]), vb0 = bfhi(v0w[e]), va1 = bflo(v1w[e]), vb1 = bfhi(v1w[e]);
            const int ca = (c8 + 2 * e) * P64 + i0, cb = (c8 + 2 * e + 1) * P64 + i0;
            *(LAS unsigned*)(KbT + ca) = pk2(ka0 * fb0, ka1 * fb1); *(LAS unsigned*)(KbT + cb) = pk2(kb0 * fb0, kb1 * fb1);
            *(LAS unsigned*)(KdT + ca) = pk2(ka0 * fd0, ka1 * fd1); *(LAS unsigned*)(KdT + cb) = pk2(kb0 * fd0, kb1 * fd1);
            *(LAS unsigned*)(VbT + ca) = pk2(va0 * bt0, va1 * bt1); *(LAS unsigned*)(VbT + cb) = pk2(vb0 * bt0, vb1 * bt1);
        }
    }
    LBAR();
    const int r = lane & 15, q = lane >> 4;
#pragma unroll
    for (int t2 = 0; t2 < 2; ++t2) {
        const int t = w * 2 + t2, mi = t >> 2, nj = t & 3;
        const f32x4 acc = mma16<128>(Ks + 16 * mi * P128, P128, Ks + 16 * nj * P128, P128, (f32x4){0.f, 0.f, 0.f, 0.f}, lane);
        const int j = 16 * nj + r; const float gj = gcs[j];
#pragma unroll
        for (int jj = 0; jj < 4; ++jj) { const int i = 16 * mi + 4 * q + jj;
            AM[i * 68 + j] = (j < i) ? bts[i] * acc[jj] * __expf(gcs[i] - gj) : 0.f; }
    }
    LBAR();
    {
        LAS float* TM = (LAS float*)(F.lds + 119296);
        LAS float* XM = (LAS float*)(F.lds + 136704);
        if (w == 0) {
            const int b16 = 16 * (lane >> 4), c = lane & 15;
            float t[16];
#pragma unroll
            for (int i = 0; i < 16; ++i) {
                float s_ = (i == c) ? 1.f : 0.f;
#pragma unroll
                for (int j4 = 0; j4 < (i + 3) / 4; ++j4) {
                    const f32x4 a = *(const LAS f32x4*)(AM + (b16 + i) * 68 + b16 + j4 * 4);
                    if (j4 * 4 + 0 < i) s_ -= a.x * t[j4 * 4 + 0];
                    if (j4 * 4 + 1 < i) s_ -= a.y * t[j4 * 4 + 1];
                    if (j4 * 4 + 2 < i) s_ -= a.z * t[j4 * 4 + 2];
                    if (j4 * 4 + 3 < i) s_ -= a.w * t[j4 * 4 + 3];
                }
                t[i] = s_;
                TM[(b16 + i) * 68 + b16 + c] = s_;
            }
        }
        LBAR();
        const int rr = (tid >> 4) & 15, cc = tid & 15;
#pragma unroll
        for (int d = 1; d < 4; ++d) {
            for (int blk = tid >> 8; blk < 4 - d; blk += 2) {
                const int bj = blk, bi = blk + d; float x = 0.f;
                for (int k = bj; k < bi; ++k)
#pragma unroll
                    for (int m = 0; m < 16; ++m) x += AM[(16 * bi + rr) * 68 + 16 * k + m] * TM[(16 * k + m) * 68 + 16 * bj + cc];
                XM[(blk * 16 + rr) * 17 + cc] = x;
            }
            LBAR();
            for (int blk = tid >> 8; blk < 4 - d; blk += 2) {
                const int bj = blk, bi = blk + d; float x = 0.f;
#pragma unroll
                for (int m = 0; m < 16; ++m) x -= TM[(16 * bi + rr) * 68 + 16 * bi + m] * XM[(blk * 16 + m) * 17 + cc];
                TM[(16 * bi + rr) * 68 + 16 * bj + cc] = x;
            }
            LBAR();
        }
        {   const int i = tid >> 3, j0 = (tid & 7) * 8; float v[8];
#pragma unroll
            for (int e = 0; e < 8; ++e) v[e] = ((j0 + e) >> 4) > (i >> 4) ? 0.f : TM[i * 68 + j0 + e];
            v4u o; o.x = pk2(v[0], v[1]); o.y = pk2(v[2], v[3]); o.z = pk2(v[4], v[5]); o.w = pk2(v[6], v[7]);
            *(LAS v4u*)(TB + i * P64 + j0) = o; }
    }
    LBAR();
#pragma unroll
    for (int t4 = 0; t4 < 4; ++t4) {
        const int t = w * 4 + t4, mi = t >> 3, nv = t & 7;
        const f32x4 u = mma16<64>(TB + 16 * mi * P64, P64, VbT + 16 * nv * P64, P64, (f32x4){0.f, 0.f, 0.f, 0.f}, lane);
        const f32x4 ww = mma16<64>(TB + 16 * mi * P64, P64, KbT + 16 * nv * P64, P64, (f32x4){0.f, 0.f, 0.f, 0.f}, lane);
        const int c = 16 * nv + r, i0 = 16 * mi + 4 * q;
        v2u up; up.x = pk2(u[0], u[1]); up.y = pk2(u[2], u[3]);
        v2u wp; wp.x = pk2(ww[0], ww[1]); wp.y = pk2(ww[2], ww[3]);
        *(LAS v2u*)(UT + c * P64 + i0) = up; *(LAS v2u*)(WT + c * P64 + i0) = wp;
        *(v2u*)(Ug + c * 64 + i0) = up;
#pragma unroll
        for (int jj = 0; jj < 4; ++jj) Wg[(i0 + jj) * 128 + c] = (bf16)f2bf(ww[jj]);
    }
    LBAR();
#pragma unroll
    for (int t8 = 0; t8 < 8; ++t8) {
        const int mb = w, na = t8;
        const f32x4 pt = mma16<64>(WT + 16 * mb * P64, P64, KdT + 16 * na * P64, P64, (f32x4){0.f, 0.f, 0.f, 0.f}, lane);
        v2u pp; pp.x = pk2(-pt[0], -pt[1]); pp.y = pk2(-pt[2], -pt[3]);
        *(v2u*)(Pp + ((size_t)((na * 4 + (mb >> 1)) * 64 + lane)) * 8 + 4 * (mb & 1)) = pp;
        const int ma = w, nv = t8;
        const f32x4 nn = mma16<64>(KdT + 16 * ma * P64, P64, UT + 16 * nv * P64, P64, (f32x4){0.f, 0.f, 0.f, 0.f}, lane);
        v2u np; np.x = pk2(nn[0], nn[1]); np.y = pk2(nn[2], nn[3]);
        *(v2u*)(NT + (size_t)(16 * nv + r) * 128 + 16 * ma + 4 * q) = np;
    }
    if (tid == 0) ((float*)(F.ws + WS_GL))[item] = __expf(gclast);
    LBAR();
}

constexpr int CH_SLOT = 32768 + 128 * P128 * 2;
#define CH_BAR() do { asm volatile("s_waitcnt lgkmcnt(0)" ::: "memory"); __builtin_amdgcn_s_barrier(); asm volatile("" ::: "memory"); } while (0)
__device__ __forceinline__ void delta_chain(Frame& F, int chain) {
    const int tid = F.tid, lane = F.lane, w = F.wave, r = lane & 15, q = lane >> 4;
    const bf16* Pp = (const bf16*)(F.ws + WS_PP) + (size_t)chain * 132 * 16384; bf16* NT = (bf16*)(F.ws + WS_NT) + (size_t)chain * 132 * 16384;
    LAS unsigned char* ring = F.lds; LAS float* gls = (LAS float*)(F.lds + 2 * CH_SLOT);
    if (tid < 132) gls[tid] = ((const float*)(F.ws + WS_GL))[chain * 132 + tid];
    if (w >= 4) {
        const int lt = tid - 256;
        unsigned ndst[8];
#pragma unroll
        for (int k = 0; k < 8; ++k) { const int p = lt + 256 * k; ndst[k] = 32768u + (unsigned)((p >> 4) * P128 + (p & 15) * 8) * 2u; }
        v4u rp[3][8], rn[3][8];
#define CH_LOAD(set, step) do { const v4u* ps_ = (const v4u*)(Pp + (size_t)(step) * 16384) + lt; const v4u* ns_ = (const v4u*)(NT + (size_t)(step) * 16384) + lt; \
        _Pragma("unroll") for (int k = 0; k < 8; ++k) { rp[set][k] = ps_[256 * k]; rn[set][k] = ns_[256 * k]; } } while (0)
#define CH_WRITE(set, slot) do { LAS unsigned char* sb_ = ring + (slot) * CH_SLOT; \
        _Pragma("unroll") for (int k = 0; k < 8; ++k) { *(LAS v4u*)(sb_ + (lt + 256 * k) * 16) = rp[set][k]; *(LAS v4u*)(sb_ + ndst[k]) = rn[set][k]; } } while (0)
        CH_LOAD(0, 0); CH_LOAD(1, 1); CH_LOAD(2, 2);
        CH_WRITE(0, 0);
        CH_BAR();
        for (int n = 0; n < 132; n += 3) {
            if (n + 3 < 132) CH_LOAD(0, n + 3);
            CH_WRITE(1, (n + 1) & 1);
            CH_BAR();
            if (n + 4 < 132) CH_LOAD(1, n + 4);
            CH_WRITE(2, (n + 2) & 1);
            CH_BAR();
            if (n + 5 < 132) CH_LOAD(2, n + 5);
            if (n + 3 < 132) CH_WRITE(0, (n + 3) & 1);
            CH_BAR();
        }
#undef CH_LOAD
#undef CH_WRITE
    } else {
        f32x4 acc[2][8];
#pragma unroll
        for (int nb = 0; nb < 2; ++nb)
#pragma unroll
            for (int m = 0; m < 8; ++m) acc[nb][m] = (f32x4){0.f, 0.f, 0.f, 0.f};
        bf16* srow = NT + (size_t)(32 * w + r) * 128 + 4 * q;
        const unsigned noff = 32768u + (unsigned)((32 * w + r) * P128 + 4 * q) * 2u;
        CH_BAR();
        for (int n = 0; n < 132; ++n) {
            const LAS unsigned char* slot = ring + (n & 1) * CH_SLOT;
            const float gl = gls[n];
            v2u sp[2][8];
#pragma unroll
            for (int nb = 0; nb < 2; ++nb)
#pragma unroll
                for (int m = 0; m < 8; ++m) {
                    sp[nb][m].x = pk2(acc[nb][m][0], acc[nb][m][1]); sp[nb][m].y = pk2(acc[nb][m][2], acc[nb][m][3]);
                    *(v2u*)(srow + (size_t)n * 16384 + nb * 2048 + 16 * m) = sp[nb][m];
                    const v2u nv = *(const LAS v2u*)(slot + noff + nb * (16 * P128 * 2) + m * 32);
                    acc[nb][m][0] = gl * acc[nb][m][0] + bflo(nv.x); acc[nb][m][1] = gl * acc[nb][m][1] + bfhi(nv.x);
                    acc[nb][m][2] = gl * acc[nb][m][2] + bflo(nv.y); acc[nb][m][3] = gl * acc[nb][m][3] + bfhi(nv.y);
                }
#pragma unroll
            for (int kb = 0; kb < 4; ++kb) {
                const v4u bu0 = {sp[0][2 * kb].x, sp[0][2 * kb].y, sp[0][2 * kb + 1].x, sp[0][2 * kb + 1].y};
                const v4u bu1 = {sp[1][2 * kb].x, sp[1][2 * kb].y, sp[1][2 * kb + 1].x, sp[1][2 * kb + 1].y};
                const bf16x8_t b0 = __builtin_bit_cast(bf16x8_t, bu0), b1 = __builtin_bit_cast(bf16x8_t, bu1);
#pragma unroll
                for (int m = 0; m < 8; ++m) {
                    const bf16x8_t a = *(const LAS bf16x8_t*)(slot + (m * 4 + kb) * 1024 + lane * 16);
                    acc[0][m] = __builtin_amdgcn_mfma_f32_16x16x32_bf16(a, b0, acc[0][m], 0, 0, 0);
                    acc[1][m] = __builtin_amdgcn_mfma_f32_16x16x32_bf16(a, b1, acc[1][m], 0, 0, 0);
                }
            }
            CH_BAR();
        }
    }
    asm volatile("s_waitcnt vmcnt(0)" ::: "memory");
    __syncthreads();
}

__device__ __forceinline__ void delta_out_item(Frame& F, const Args& A, int l, int c, int h) {
    const int tid = F.tid, lane = F.lane, w = F.wave, r = lane & 15, q = lane >> 4;
    const bf16* DQ = (const bf16*)(F.ws + WS_DQ); const bf16* DK = (const bf16*)(F.ws + WS_DK);
    const int row0 = 64 * c;
    LAS bf16* Qs = (LAS bf16*)(F.lds);
    LAS bf16* Ks = (LAS bf16*)(F.lds + 17408);
    LAS bf16* ST = (LAS bf16*)(F.lds + 35840);
    LAS bf16* Ws = (LAS bf16*)(F.lds + 70656);
    LAS bf16* ATT = (LAS bf16*)(F.lds + 88064);
    LAS float* gcs = (LAS float*)(F.lds + 97280);
    LAS bf16* VNT = (LAS bf16*)(F.lds + 97792);
    LAS float* OS = (LAS float*)(F.lds);
    const int mi = w >> 1, nvb = 4 * (w & 1);
    f32x4 oacc[4];
#pragma unroll
    for (int k = 0; k < 4; ++k) oacc[k] = (f32x4){0.f, 0.f, 0.f, 0.f};
    for (int dir = 0; dir < 2; ++dir) {
        const int chain = dir * 8 + h, n = chunk_scan_index(dir, c);
        const size_t item = (size_t)chain * 132 + n;
        const bf16* Sg = (const bf16*)(F.ws + WS_NT) + item * 16384; const bf16* Ug = (const bf16*)(F.ws + WS_UG) + item * 8192; const bf16* Wg = (const bf16*)(F.ws + WS_WG) + item * 8192;
        const float g_in = (w == 0) ? ((const float*)(F.ws + WS_DGB))[(size_t)chain * MROWS + row0 + (dir ? 63 - lane : lane)] : 0.f;
        v2u uu[4];
#pragma unroll
        for (int k = 0; k < 4; ++k) uu[k] = *(const v2u*)(Ug + (16 * (nvb + k) + r) * 64 + (dir ? 60 - (16 * mi + 4 * q) : (16 * mi + 4 * q)));
        {   v4u rq[2], rk[2], rw[2], rs[4];
#pragma unroll
            for (int i2 = 0; i2 < 2; ++i2) { const int p = tid + 512 * i2, t = p >> 4, c8 = (p & 15) * 8; const size_t off = (size_t)(row0 + t) * 1024 + h * 128 + c8;
                if (dir == 0) { rq[i2] = *(const v4u*)(DQ + off); rk[i2] = *(const v4u*)(DK + off); }
                rw[i2] = *(const v4u*)(Wg + (size_t)(dir ? 63 - t : t) * 128 + c8); }
#pragma unroll
            for (int i4 = 0; i4 < 4; ++i4) { const int p = tid + 512 * i4; rs[i4] = *(const v4u*)(Sg + (p >> 4) * 128 + (p & 15) * 8); }
#pragma unroll
            for (int i2 = 0; i2 < 2; ++i2) { const int p = tid + 512 * i2, t = p >> 4, c8 = (p & 15) * 8;
                if (dir == 0) { *(LAS v4u*)(Qs + t * P128 + c8) = rq[i2]; *(LAS v4u*)(Ks + t * P128 + c8) = rk[i2]; }
                *(LAS v4u*)(Ws + t * P128 + c8) = rw[i2]; }
#pragma unroll
            for (int i4 = 0; i4 < 4; ++i4) { const int p = tid + 512 * i4; *(LAS v4u*)(ST + (p >> 4) * P128 + (p & 15) * 8) = rs[i4]; }
        }
        if (w == 0) { const float s_ = wave_incl_scan(g_in, lane); gcs[dir ? 63 - lane : lane] = s_; }
        LBAR();
#pragma unroll
        for (int t2 = 0; t2 < 2; ++t2) {
            const int t = w * 2 + t2, ai = t >> 2, nj = t & 3;
            const f32x4 acc = mma16<128>(Qs + 16 * ai * P128, P128, Ks + 16 * nj * P128, P128, (f32x4){0.f, 0.f, 0.f, 0.f}, lane);
            const int tj = 16 * nj + r; const float gj = gcs[tj];
#pragma unroll
            for (int jj = 0; jj < 4; ++jj) { const int ti = 16 * ai + 4 * q + jj; const bool ok = dir ? (tj >= ti) : (tj <= ti);
                ATT[ti * P64 + tj] = (bf16)f2bf(ok ? acc[jj] * __expf(gcs[ti] - gj) : 0.f); }
        }
#pragma unroll
        for (int k = 0; k < 4; ++k) {
            const int nv = nvb + k;
            const f32x4 ws = mma16<128>(Ws + 16 * mi * P128, P128, ST + 16 * nv * P128, P128, (f32x4){0.f, 0.f, 0.f, 0.f}, lane);
            const int v = 16 * nv + r, t0 = 16 * mi + 4 * q;
            float u[4];
            if (dir == 0) { u[0] = bflo(uu[k].x); u[1] = bfhi(uu[k].x); u[2] = bflo(uu[k].y); u[3] = bfhi(uu[k].y); }
            else { u[3] = bflo(uu[k].x); u[2] = bfhi(uu[k].x); u[1] = bflo(uu[k].y); u[0] = bfhi(uu[k].y); }
            v2u o; o.x = pk2(u[0] - ws[0], u[1] - ws[1]); o.y = pk2(u[2] - ws[2], u[3] - ws[3]);
            *(LAS v2u*)(VNT + v * P64 + t0) = o;
        }
        LBAR();
#pragma unroll
        for (int k = 0; k < 4; ++k) {
            const int nv = nvb + k;
            f32x4 a = mma16<128>(Qs + 16 * mi * P128, P128, ST + 16 * nv * P128, P128, (f32x4){0.f, 0.f, 0.f, 0.f}, lane);
#pragma unroll
            for (int jj = 0; jj < 4; ++jj) a[jj] *= __expf(gcs[16 * mi + 4 * q + jj]);
            a = mma16<64>(ATT + 16 * mi * P64, P64, VNT + 16 * nv * P64, P64, a, lane);
            oacc[k] += a;
        }
        LBAR();
    }
#pragma unroll
    for (int k = 0; k < 4; ++k)
#pragma unroll
        for (int jj = 0; jj < 4; ++jj) OS[(16 * mi + 4 * q + jj) * 132 + 16 * (nvb + k) + r] = oacc[k][jj];
    LBAR();
    {   const float* enw = A.in[19] + l * 128 + lane * 2; const float ew0 = enw[0], ew1 = enw[1];
        const bf16* Z = (const bf16*)(F.ws + WS_Z); bf16* E_ = (bf16*)(F.ws + WS_E);
        unsigned gz[8];
#pragma unroll
        for (int t8 = 0; t8 < 8; ++t8) gz[t8] = *(const unsigned*)(Z + (size_t)(row0 + w * 8 + t8) * ZP + C_EG + h * 128 + lane * 2);
#pragma unroll
        for (int t8 = 0; t8 < 8; ++t8) { const int t = w * 8 + t8;
            const float x0 = OS[t * 132 + lane * 2], x1 = OS[t * 132 + lane * 2 + 1];
            const float rs = __builtin_amdgcn_rsqf(wave_sum(x0 * x0 + x1 * x1) * (1.0f / 128.f) + 1e-6f);
            const size_t row = row0 + t; const unsigned g = gz[t8];
            *(unsigned*)(E_ + row * 1024 + h * 128 + lane * 2) = pk2(x0 * rs * ew0 * siluf_(bflo(g)), x1 * rs * ew1 * siluf_(bfhi(g)));
        }
    }
    LBAR();
}
constexpr int NIN_MAIN = 13824;
__device__ __forceinline__ void g1_tail_item(Frame& F, int it) {
    const int tid = F.tid, lane = F.lane, w = F.wave, r = lane & 15, q = lane >> 4;
    const bf16* Hm = (const bf16*)(F.ws + WS_H) + (size_t)(64 * it) * DM_;
    const bf16* Wt = (const bf16*)(F.ws + WS_W0 + WO_IN) + (size_t)NIN_MAIN * DM_;
    LAS bf16* As = (LAS bf16*)F.lds; LAS bf16* Bs = As + 64 * 264;
    f32x4 acc[2] = {(f32x4){0.f, 0.f, 0.f, 0.f}, (f32x4){0.f, 0.f, 0.f, 0.f}};
    v4u pa[4], pb[4];
#pragma unroll
    for (int k = 0; k < 4; ++k) { const int p = tid + 512 * k, row = p >> 5, c8 = (p & 31) * 8; pa[k] = *(const v4u*)(Hm + (size_t)row * DM_ + c8); pb[k] = *(const v4u*)(Wt + (size_t)row * DM_ + c8); }
    for (int kc = 0; kc < 8; ++kc) {
#pragma unroll
        for (int k = 0; k < 4; ++k) { const int p = tid + 512 * k, row = p >> 5, c8 = (p & 31) * 8; *(LAS v4u*)(As + row * 264 + c8) = pa[k]; *(LAS v4u*)(Bs + row * 264 + c8) = pb[k]; }
        __syncthreads();
        if (kc + 1 < 8) {
#pragma unroll
            for (int k = 0; k < 4; ++k) { const int p = tid + 512 * k, row = p >> 5, c8 = (p & 31) * 8 + (kc + 1) * 256; pa[k] = *(const v4u*)(Hm + (size_t)row * DM_ + c8); pb[k] = *(const v4u*)(Wt + (size_t)row * DM_ + c8); }
        }
#pragma unroll
        for (int t2 = 0; t2 < 2; ++t2) { const int t = w * 2 + t2, mi = t >> 2, nj = t & 3;
            acc[t2] = mma16<256>(As + 16 * mi * 264, 264, Bs + 16 * nj * 264, 264, acc[t2], lane); }
        __syncthreads();
    }
    bf16* Z = (bf16*)(F.ws + WS_Z);
#pragma unroll
    for (int t2 = 0; t2 < 2; ++t2) { const int t = w * 2 + t2, mi = t >> 2, nj = t & 3;
#pragma unroll
        for (int jj = 0; jj < 4; ++jj) Z[(size_t)(64 * it + 16 * mi + 4 * q + jj) * ZP + NIN_MAIN + 16 * nj + r] = (bf16)f2bf(acc[t2][jj]); }
}

__device__ __forceinline__ f32x4 small_mm_acc(Frame& F, const bf16* Ap, int lda, const bf16* Bp, int ldb, int K, f32x4 acc) {
    const int tid = F.tid, lane = F.lane, w = F.wave;
    LAS bf16* As = (LAS bf16*)F.lds; LAS bf16* Bs = As + 32 * 264;
    v4u pa[2][2], pb[2][4];
#define SM_LOAD(set, kc_) do { \
    _Pragma("unroll") for (int k = 0; k < 2; ++k) { const int p = tid + 512 * k, row = p >> 5, c8 = (p & 31) * 8 + (kc_) * 256; pa[set][k] = *(const v4u*)(Ap + (size_t)row * lda + c8); } \
    _Pragma("unroll") for (int k = 0; k < 4; ++k) { const int p = tid + 512 * k, row = p >> 5, c8 = (p & 31) * 8 + (kc_) * 256; pb[set][k] = *(const v4u*)(Bp + (size_t)row * ldb + c8); } } while (0)
#define SM_STEP(set, kc_) do { \
    _Pragma("unroll") for (int k = 0; k < 2; ++k) { const int p = tid + 512 * k, row = p >> 5, c8 = (p & 31) * 8; *(LAS v4u*)(As + row * 264 + c8) = pa[set][k]; } \
    _Pragma("unroll") for (int k = 0; k < 4; ++k) { const int p = tid + 512 * k, row = p >> 5, c8 = (p & 31) * 8; *(LAS v4u*)(Bs + row * 264 + c8) = pb[set][k]; } \
    LBAR(); \
    if ((kc_) + 2 < nk) SM_LOAD(set, (kc_) + 2); \
    acc = mma16<256>(As + 16 * (w >> 2) * 264, 264, Bs + 16 * (w & 3) * 264, 264, acc, lane); \
    LBAR(); } while (0)
    const int nk = K >> 8;
    SM_LOAD(0, 0); SM_LOAD(1, 1);
    for (int kc = 0; kc < nk; kc += 2) { SM_STEP(0, kc); SM_STEP(1, kc + 1); }
#undef SM_LOAD
#undef SM_STEP
    return acc;
}
__device__ __forceinline__ void ctx_f32_item(Frame& F, int it, const bf16* A, int K, const bf16* Bt, float* Y) {
    const int rt = it >> 5, ct = it & 31, lane = F.lane, w = F.wave, r = lane & 15, q = lane >> 4;
    const f32x4 acc = small_mm_acc(F, A + (size_t)(32 * rt) * K, K, Bt + (size_t)(64 * ct) * K, K, K, (f32x4){0.f, 0.f, 0.f, 0.f});
#pragma unroll
    for (int jj = 0; jj < 4; ++jj) Y[(size_t)(32 * rt + 16 * (w >> 2) + 4 * q + jj) * DM_ + 64 * ct + 16 * (w & 3) + r] = acc[jj];
}
__device__ __forceinline__ void ctx_g2_item(Frame& F, int it) {
    const int rt = it >> 5, ct = it & 31, lane = F.lane, w = F.wave, r = lane & 15, q = lane >> 4;
    unsigned char* ws = F.ws; unsigned char* wb = ws + WS_W0;
    const bf16* Zm = (const bf16*)(ws + WS_Z) + C_MG;
    const int col = 64 * ct + 16 * (w & 3) + r, rowb = 32 * rt + 16 * (w >> 2) + 4 * q;
    f32x4 tot = {0.f, 0.f, 0.f, 0.f};
    {   const f32x4 a = small_mm_acc(F, (const bf16*)(ws + WS_A) + (size_t)(32 * rt) * 512, 512, (const bf16*)(wb + WO_UA) + (size_t)(64 * ct) * 512, 512, 512, (f32x4){0.f, 0.f, 0.f, 0.f});
#pragma unroll
        for (int jj = 0; jj < 4; ++jj) tot[jj] += a[jj] * sigmoidf_(bf2f(Zm[(size_t)(rowb + jj) * ZP + col])); }
    {   const f32x4 a = small_mm_acc(F, (const bf16*)(ws + WS_D) + (size_t)(32 * rt) * 512, 512, (const bf16*)(wb + WO_UD) + (size_t)(64 * ct) * 512, 512, 512, (f32x4){0.f, 0.f, 0.f, 0.f});
#pragma unroll
        for (int jj = 0; jj < 4; ++jj) tot[jj] += a[jj] * sigmoidf_(bf2f(Zm[(size_t)(rowb + jj) * ZP + DM_ + col])); }
    {   const f32x4 a = small_mm_acc(F, (const bf16*)(ws + WS_E) + (size_t)(32 * rt) * 1024, 1024, (const bf16*)(wb + WO_UE) + (size_t)(64 * ct) * 1024, 1024, 1024, (f32x4){0.f, 0.f, 0.f, 0.f});
#pragma unroll
        for (int jj = 0; jj < 4; ++jj) tot[jj] += a[jj] * sigmoidf_(bf2f(Zm[(size_t)(rowb + jj) * ZP + 2 * DM_ + col])); }
    bf16* YB = (bf16*)(ws + WS_YB);
#pragma unroll
    for (int jj = 0; jj < 4; ++jj) YB[(size_t)(rowb + jj) * DM_ + col] = (bf16)f2bf(tot[jj]);
}

__device__ __forceinline__ void gla_cum_decay(Frame& F, const Args& A, int l, int dir, int h, int row0, LAS float* bs, LAS float* part, float* bsg) {
    const int tg = F.wave >> 1, d = (F.wave & 1) * 64 + F.lane;
    const float* ZG = (const float*)(F.ws + WS_ZG);
    const float* w2 = A.in[11] + ((size_t)(l * 2 + dir) * 16) * 512 + h * 128 + d; const float bd = A.in[12][(size_t)(l * 2 + dir) * 512 + h * 128 + d];
    float wc[16], g[16];
#pragma unroll
    for (int j = 0; j < 16; ++j) wc[j] = w2[j * 512];
    LAS float* lrs = part + 512;
    {   const int t = F.tid >> 3, j2 = (F.tid & 7) * 2; const float* src = ZG + (size_t)(row0 + t) * 64 + dir * 16 + j2; lrs[t * 16 + j2] = src[0]; lrs[t * 16 + j2 + 1] = src[1]; }
    LBAR();
#pragma unroll
    for (int k = 0; k < 16; ++k) {
        const LAS float* lr = lrs + (tg * 16 + k) * 16;
        float x = bd;
#pragma unroll
        for (int j = 0; j < 16; ++j) x += lr[j] * wc[j];
        g[k] = (fminf(x, 0.f) - __logf(1.0f + __expf(-fabsf(x)))) * 0.0625f;
    }
    float run = 0.f;
    if (dir == 0) {
#pragma unroll
        for (int k = 0; k < 16; ++k) { run += g[k]; g[k] = run; }
    } else {
#pragma unroll
        for (int k = 15; k >= 0; --k) { run += g[k]; g[k] = run; }
    }
    part[tg * 128 + d] = run;
    LBAR();
    float off = 0.f;
#pragma unroll
    for (int t2 = 0; t2 < 4; ++t2) { const float pv = part[t2 * 128 + d]; if (dir == 0 ? (t2 < tg) : (t2 > tg)) off += pv; }
#pragma unroll
    for (int k = 0; k < 16; ++k) { bs[(tg * 16 + k) * 128 + d] = g[k] + off; bsg[(tg * 16 + k) * 128 + d] = g[k] + off; }
    LBAR();
}
__device__ __forceinline__ void gla_prep2_item(Frame& F, const Args& A, int l, int chain, int c) {
    const int dir = chain >> 2, h = chain & 3, tid = F.tid, lane = F.lane, w = F.wave, r = lane & 15, q = lane >> 4;
    const bf16* Z = (const bf16*)(F.ws + WS_Z);
    const int row0 = 64 * c, n = chunk_scan_index(dir, c);
    LAS float* bs = (LAS float*)F.lds;
    LAS bf16* KdT = (LAS bf16*)(F.lds + 32768);
    LAS bf16* VT = (LAS bf16*)(F.lds + 51200);
    gla_cum_decay(F, A, l, dir, h, row0, bs, (LAS float*)(F.lds + 69632), (float*)(F.ws + WS_BS) + ((size_t)chain * 132 + chunk_scan_index(dir, c)) * 8192);
    const int tl = dir ? 0 : 63;
    {   const int ip = tid & 31, c8 = (tid >> 5) * 8, t0 = 2 * ip, t1 = t0 + 1;
        const bf16* z0 = Z + (size_t)(row0 + t0) * ZP + h * 128 + c8; const bf16* z1 = z0 + ZP;
        const v4u kv0 = *(const v4u*)(z0 + C_GK), kv1 = *(const v4u*)(z1 + C_GK), vv0 = *(const v4u*)(z0 + C_GV), vv1 = *(const v4u*)(z1 + C_GV);
        const unsigned k0w[4] = {kv0.x, kv0.y, kv0.z, kv0.w}, k1w[4] = {kv1.x, kv1.y, kv1.z, kv1.w}, v0w[4] = {vv0.x, vv0.y, vv0.z, vv0.w}, v1w[4] = {vv1.x, vv1.y, vv1.z, vv1.w};
#pragma unroll
        for (int e = 0; e < 4; ++e) {
            const int d0 = c8 + 2 * e, d1 = d0 + 1;
            const float bl0 = bs[tl * 128 + d0], bl1 = bs[tl * 128 + d1];
            *(LAS unsigned*)(KdT + d0 * P64 + t0) = pk2(bflo(k0w[e]) * __expf(bl0 - bs[t0 * 128 + d0]), bflo(k1w[e]) * __expf(bl0 - bs[t1 * 128 + d0]));
            *(LAS unsigned*)(KdT + d1 * P64 + t0) = pk2(bfhi(k0w[e]) * __expf(bl1 - bs[t0 * 128 + d1]), bfhi(k1w[e]) * __expf(bl1 - bs[t1 * 128 + d1]));
            *(LAS unsigned*)(VT + d0 * P64 + t0) = (v0w[e] & 0xffffu) | (v1w[e] << 16);
            *(LAS unsigned*)(VT + d1 * P64 + t0) = (v0w[e] >> 16) | (v1w[e] & 0xffff0000u);
        }
    }
    LBAR();
    const size_t item = (size_t)chain * 132 + n;
    float* GS = (float*)(F.ws + WS_GS) + item * 16384;
#pragma unroll
    for (int t8 = 0; t8 < 8; ++t8) {
        const int mv = w, na = t8;
        const f32x4 d = mma16<64>(VT + 16 * mv * P64, P64, KdT + 16 * na * P64, P64, (f32x4){0.f, 0.f, 0.f, 0.f}, lane);
#pragma unroll
        for (int jj = 0; jj < 4; ++jj) GS[(16 * mv + 4 * q + jj) * 128 + 16 * na + r] = d[jj];
    }
    if (tid < 128) ((float*)(F.ws + WS_GD))[item * 128 + tid] = __expf(bs[tl * 128 + tid]);
    LBAR();
}
__device__ __forceinline__ void gla_scan_item(Frame& F, int it) {
    const int chain = it >> 3, e4 = (it & 7) * 512 + F.tid, v = e4 >> 5, a4 = (e4 & 31) * 4;
    float* p = (float*)(F.ws + WS_GS) + (size_t)chain * 132 * 16384 + v * 128 + a4;
    const float* gd = (const float*)(F.ws + WS_GD) + (size_t)chain * 132 * 128 + a4;
    f32x4 S = {0.f, 0.f, 0.f, 0.f};
    for (int n = 0; n < 132; n += 12) {
        f32x4 x[12]; f32x4 d[12];
#pragma unroll
        for (int k = 0; k < 12; ++k) { x[k] = *(const f32x4*)(p + (size_t)(n + k) * 16384); d[k] = *(const f32x4*)(gd + (n + k) * 128); }
#pragma unroll
        for (int k = 0; k < 12; ++k) { *(f32x4*)(p + (size_t)(n + k) * 16384) = S; S = S * d[k] + x[k]; }
    }
}
__device__ __forceinline__ void gla_out_item(Frame& F, const Args& A, int l, int c, int h) {
    const int tid = F.tid, lane = F.lane, w = F.wave, r = lane & 15, q = lane >> 4;
    const bf16* Z = (const bf16*)(F.ws + WS_Z);
    const int row0 = 64 * c;
    LAS float* bs = (LAS float*)F.lds;
    LAS bf16* Qt = (LAS bf16*)(F.lds + 32768);
    LAS bf16* Kt = (LAS bf16*)(F.lds + 50176);
    LAS bf16* VT = (LAS bf16*)(F.lds + 67584);
    LAS bf16* ST = (LAS bf16*)(F.lds + 86016);
    LAS bf16* ATT = (LAS bf16*)(F.lds + 120832);
    LAS float* OS = (LAS float*)F.lds;
    const int mi = w >> 1, nvb = 4 * (w & 1);
    f32x4 oacc[4];
#pragma unroll
    for (int k = 0; k < 4; ++k) oacc[k] = (f32x4){0.f, 0.f, 0.f, 0.f};
    for (int dir = 0; dir < 2; ++dir) {
        const int chain = dir * 4 + h, n = chunk_scan_index(dir, c);
        const float* Sg = (const float*)(F.ws + WS_GS) + ((size_t)chain * 132 + n) * 16384;
        const float* bsg = (const float*)(F.ws + WS_BS) + ((size_t)chain * 132 + n) * 8192;
        {
            v4u qv[2], kv[2]; f32x4 bA[2], bB[2], sv[8]; v4u vv0 = {0u, 0u, 0u, 0u}, vv1 = {0u, 0u, 0u, 0u};
#pragma unroll
            for (int i2 = 0; i2 < 2; ++i2) { const int p = tid + 512 * i2, t = p >> 4, c8 = (p & 15) * 8; const bf16* zr = Z + (size_t)(row0 + t) * ZP + h * 128 + c8;
                qv[i2] = *(const v4u*)(zr + C_GQ); kv[i2] = *(const v4u*)(zr + C_GK); bA[i2] = *(const f32x4*)(bsg + t * 128 + c8); bB[i2] = *(const f32x4*)(bsg + t * 128 + c8 + 4); }
#pragma unroll
            for (int i8 = 0; i8 < 8; ++i8) { const int p = tid + 512 * i8; sv[i8] = *(const f32x4*)(Sg + (p >> 5) * 128 + (p & 31) * 4); }
            const int ipv = tid & 31, c8v = (tid >> 5) * 8, t0v = 2 * ipv;
            if (dir == 0) { const bf16* z0 = Z + (size_t)(row0 + t0v) * ZP + h * 128 + c8v + C_GV; vv0 = *(const v4u*)z0; vv1 = *(const v4u*)(z0 + ZP); }
#pragma unroll
            for (int i2 = 0; i2 < 2; ++i2) { const int p = tid + 512 * i2, t = p >> 4, c8 = (p & 15) * 8;
                const unsigned qw[4] = {qv[i2].x, qv[i2].y, qv[i2].z, qv[i2].w}, kw[4] = {kv[i2].x, kv[i2].y, kv[i2].z, kv[i2].w};
                const float bb[8] = {bA[i2].x, bA[i2].y, bA[i2].z, bA[i2].w, bB[i2].x, bB[i2].y, bB[i2].z, bB[i2].w};
                unsigned qo[4], ko[4];
#pragma unroll
                for (int e = 0; e < 4; ++e) { const float b0 = bb[2 * e], b1 = bb[2 * e + 1];
                    qo[e] = pk2(bflo(qw[e]) * __expf(b0), bfhi(qw[e]) * __expf(b1)); ko[e] = pk2(bflo(kw[e]) * __expf(-b0), bfhi(kw[e]) * __expf(-b1)); }
                *(LAS v4u*)(Qt + t * P128 + c8) = (v4u){qo[0], qo[1], qo[2], qo[3]}; *(LAS v4u*)(Kt + t * P128 + c8) = (v4u){ko[0], ko[1], ko[2], ko[3]}; }
            if (dir == 0) {
                const unsigned v0w[4] = {vv0.x, vv0.y, vv0.z, vv0.w}, v1w[4] = {vv1.x, vv1.y, vv1.z, vv1.w};
#pragma unroll
                for (int e = 0; e < 4; ++e) {
                    *(LAS unsigned*)(VT + (c8v + 2 * e) * P64 + t0v) = (v0w[e] & 0xffffu) | (v1w[e] << 16);
                    *(LAS unsigned*)(VT + (c8v + 2 * e + 1) * P64 + t0v) = (v0w[e] >> 16) | (v1w[e] & 0xffff0000u); }
            }
#pragma unroll
            for (int i8 = 0; i8 < 8; ++i8) { const int p = tid + 512 * i8; v2u o; o.x = pk2(sv[i8].x, sv[i8].y); o.y = pk2(sv[i8].z, sv[i8].w);
                *(LAS v2u*)(ST + (p >> 5) * P128 + (p & 31) * 4) = o; }
        }
        LBAR();
#pragma unroll
        for (int t2 = 0; t2 < 2; ++t2) {
            const int t = w * 2 + t2, ai = t >> 2, nj = t & 3;
            const f32x4 acc = mma16<128>(Qt + 16 * ai * P128, P128, Kt + 16 * nj * P128, P128, (f32x4){0.f, 0.f, 0.f, 0.f}, lane);
            const int tj = 16 * nj + r;
#pragma unroll
            for (int jj = 0; jj < 4; ++jj) { const int ti = 16 * ai + 4 * q + jj; const bool ok = dir ? (tj >= ti) : (tj <= ti);
                ATT[ti * P64 + tj] = (bf16)f2bf(ok ? acc[jj] : 0.f); }
        }
        LBAR();
#pragma unroll
        for (int k = 0; k < 4; ++k) {
            const int nv = nvb + k;
            oacc[k] = mma16<64>(ATT + 16 * mi * P64, P64, VT + 16 * nv * P64, P64, oacc[k], lane);
            oacc[k] = mma16<128>(Qt + 16 * mi * P128, P128, ST + 16 * nv * P128, P128, oacc[k], lane);
        }
        LBAR();
    }
#pragma unroll
    for (int k = 0; k < 4; ++k)
#pragma unroll
        for (int jj = 0; jj < 4; ++jj) OS[(16 * mi + 4 * q + jj) * 132 + 16 * (nvb + k) + r] = oacc[k][jj] * 0.08838834764831845f;
    LBAR();
    {   const float* gnw = A.in[13] + l * 128 + lane * 2; const float gw0 = gnw[0], gw1 = gnw[1];
        bf16* A_ = (bf16*)(F.ws + WS_A);
        unsigned gz[8];
#pragma unroll
        for (int t8 = 0; t8 < 8; ++t8) gz[t8] = *(const unsigned*)(Z + (size_t)(row0 + w * 8 + t8) * ZP + C_GG + h * 128 + lane * 2);
#pragma unroll
        for (int t8 = 0; t8 < 8; ++t8) { const int t = w * 8 + t8;
            const float x0 = OS[t * 132 + lane * 2], x1 = OS[t * 132 + lane * 2 + 1];
            const float rs = __builtin_amdgcn_rsqf(wave_sum(x0 * x0 + x1 * x1) * (1.0f / 128.f) + 1e-6f);
            const size_t row = row0 + t; const unsigned g = gz[t8];
            *(unsigned*)(A_ + row * 512 + h * 128 + lane * 2) = pk2(x0 * rs * gw0 * siluf_(bflo(g)), x1 * rs * gw1 * siluf_(bfhi(g)));
        }
    }
    LBAR();
}
__device__ __forceinline__ void diff_out_rows(Frame& F, const Args& A, int l) {
    const int gw = F.bid * 8 + F.wave, NGW = F.G * 8, lane = F.lane;
    const bf16* AO = (const bf16*)(F.ws + WS_AO); bf16* D_ = (bf16*)(F.ws + WS_D);
    const float lam_init = l == 0 ? 0.2f : 0.35550906759096924f;
    const float* lp = A.in[14] + l * 256;
    const float lam = expf(wave_sum(lp[lane] * lp[64 + lane])) - expf(wave_sum(lp[128 + lane] * lp[192 + lane])) + lam_init;
    const float* dnw = A.in[15] + l * 128 + lane * 2; const float dw0 = dnw[0], dw1 = dnw[1];
    for (int r = gw; r < MROWS; r += NGW) {
        unsigned wa[4], wb_[4];
#pragma unroll
        for (int h = 0; h < 4; ++h) { wa[h] = *(const unsigned*)(AO + (size_t)r * 1024 + (h * 2) * 128 + lane * 2); wb_[h] = *(const unsigned*)(AO + (size_t)r * 1024 + (h * 2 + 1) * 128 + lane * 2); }
#pragma unroll
        for (int h = 0; h < 4; ++h) {
            const int c = h * 128 + lane * 2;
            const unsigned w1 = wa[h], w2 = wb_[h];
            const float x0 = bflo(w1) - lam * bflo(w2), x1 = bfhi(w1) - lam * bfhi(w2);
            const float rs = __builtin_amdgcn_rsqf(wave_sum(x0 * x0 + x1 * x1) * (1.0f / 128.f) + 1e-6f) * (1.0f - lam_init);
            *(unsigned*)(D_ + (size_t)r * 512 + c) = pk2(x0 * rs * dw0, x1 * rs * dw1);
        }
    }
}
#ifndef MK_SINGLE
#define MK_SINGLE 1
#endif
template <int l> __device__ __forceinline__ void layer_phases(Frame& F, const Args& args, unsigned char* lds, const int lo, const int hi, const XcdBarrier& bar) {
    unsigned char* ws = args.ws;
#define IN(k) (lo <= (k) && (k) < hi)
#define SEAM(k) do { if (IN(k) && IN((k) + 1)) { xcd_barrier(bar); if (REP_SYNC > 1) xcd_barrier(bar); } } while (0)
    const int pb = 2 + 11 * l;
    unsigned char* wb = ws + WS_W0;
    if (IN(pb + 0) && !SKIP_G1) {
        pg8::Gemm g{(const bf16*)(ws + WS_H), (const bf16*)(wb + WO_IN), MROWS, NIN_MAIN, DM_}; pg8::StaticOrder S; S.init(MROWS, NIN_MAIN, F.G, F.bid); S.rep = REP_G1;
        pg8::EpiZ E{(bf16*)(ws + WS_Z), ZP, (float*)(ws + WS_ZG)};
        pg8::gemm_phase<pg8::EpiZ, pg8::StaticOrder, true, true>(F.lds, g, S, E);
    } SEAM(pb + 0);
    if (IN(pb + 1)) { if (F.bid < 132) g1_tail_item(F, F.bid); prep_phase(F, args, l); } SEAM(pb + 1);
    if (IN(pb + 2)) {
        for (int it = F.bid; it < 2112 * REP_C1; it += F.G) delta_prep2_item(F, (it % 2112) / 132, it % 132);
        for (int it = F.G - 1 - F.bid; it < 1056 * REP_C2; it += F.G) gla_prep2_item(F, args, l, (it % 1056) / 132, it % 132);
    } SEAM(pb + 2);
    if (IN(pb + 3)) {
        if (F.bid < 16) delta_chain(F, F.bid);
        else if (F.bid - 16 < 64) gla_scan_item(F, F.bid - 16);
        {
            const attn_body::bf16* AQ = (const attn_body::bf16*)(ws + WS_AQ); const attn_body::bf16* AK = (const attn_body::bf16*)(ws + WS_AK);
            const attn_body::bf16* AV = (const attn_body::bf16*)(ws + WS_AV); attn_body::bf16* AO = (attn_body::bf16*)(ws + WS_AO);
            unsigned* cnt = (unsigned*)(ws + WS_CNT) + 64 * l;
            volatile LAS unsigned* slot = (volatile LAS unsigned*)(F.lds + MISC_OFF) + 16;
            for (;;) {
                if (F.tid == 0) slot[0] = __hip_atomic_fetch_add(cnt, 1u, __ATOMIC_RELAXED, __HIP_MEMORY_SCOPE_AGENT);
                __syncthreads();
                const int ui = (int)slot[0];
                __syncthreads();
                if (ui >= 528 * REP_ATTN) break;
                const int uj = ui % 528; const int qb = 32 - uj / 16, rem = uj % 16, hm = rem >> 1, half = rem & 1;
                attn_body::attn_unit<8>(AQ + (size_t)qb * 256 * 512 + hm * 64, AK + hm * 64, AV + (hm >> 1) * 128 + half * 64,
                                        AO + (size_t)qb * 256 * 1024 + hm * 128 + half * 64, qb == 0 ? 4 : 132, (char*)lds);
            }
        }
        if (l == 0) p0_dynamic(F, args, 0, (unsigned*)(ws + WS_CNT) + 128, I_IN, PER_L);
        else p0_dynamic(F, args, 1, (unsigned*)(ws + WS_CNT) + 256, I_IN, PER_L - I_2);
    } SEAM(pb + 3);
    if (IN(pb + 4)) {
        for (int it = F.bid; it < 1056 * REP_C3; it += F.G) delta_out_item(F, args, l, (it % 1056) >> 3, it & 7);
        for (int it = F.G - 1 - F.bid; it < 528 * REP_C4; it += F.G) gla_out_item(F, args, l, (it % 528) >> 2, it & 3);
        diff_out_rows(F, args, l);
    } SEAM(pb + 4);
    if (IN(pb + 5) && !SKIP_G2) {
        const bf16* Zm = (const bf16*)(ws + WS_Z) + C_MG; float* YF = (float*)(ws + WS_R2); bf16* YB = (bf16*)(ws + WS_YB);
        pg8::StaticOrder S; S.init(MROWS - CTXL, DM_, F.G, F.bid); S.pmoff = 1;
        { pg8::Gemm g{(const bf16*)(ws + WS_A), (const bf16*)(wb + WO_UA), MROWS, DM_, 512}; pg8::EpiGate<0> E{Zm, ZP, YF, YB, DM_};
          pg8::gemm_phase<pg8::EpiGate<0>, pg8::StaticOrder, true, true>(F.lds, g, S, E); }
        { pg8::Gemm g{(const bf16*)(ws + WS_D), (const bf16*)(wb + WO_UD), MROWS, DM_, 512}; pg8::EpiGate<1> E{Zm + DM_, ZP, YF, YB, DM_};
          pg8::gemm_phase<pg8::EpiGate<1>, pg8::StaticOrder, true, true>(F.lds, g, S, E); }
        { pg8::Gemm g{(const bf16*)(ws + WS_E), (const bf16*)(wb + WO_UE), MROWS, DM_, 1024}; pg8::EpiGate<2> E{Zm + 2 * DM_, ZP, YF, YB, DM_};
          pg8::gemm_phase<pg8::EpiGate<2>, pg8::StaticOrder, true, true>(F.lds, g, S, E); }
        if (l == 0) for (int it = F.bid; it < 256; it += F.G) ctx_g2_item(F, it);
    } SEAM(pb + 5);
    if (IN(pb + 6) && !SKIP_G3) {
        pg8::Gemm g{(const bf16*)(ws + WS_YB), (const bf16*)(wb + WO_O), MROWS, DM_, DM_}; pg8::StaticOrder S; S.init(MROWS - CTXL, DM_, F.G, F.bid); S.pmoff = 1; S.rep = REP_G3;
        pg8::EpiF32 E{(float*)(ws + WS_R2), DM_};
        pg8::gemm_phase<pg8::EpiF32, pg8::StaticOrder, true, true>(F.lds, g, S, E);
        if (l == 0) for (int it = F.bid; it < 256; it += F.G) ctx_f32_item(F, it, (const bf16*)(ws + WS_YB), DM_, (const bf16*)(wb + WO_O), (float*)(ws + WS_R2));
    } SEAM(pb + 6);
    if (IN(pb + 7)) { row_phase<1>(F, args, l); } SEAM(pb + 7);
    if (IN(pb + 8) && !SKIP_G4) {
        pg8::Gemm g{(const bf16*)(ws + WS_H), (const bf16*)(wb + WO_13), MROWS, 2 * DFF, DM_}; pg8::StaticOrder S; S.init(MROWS - CTXL * l, 2 * DFF, F.G, F.bid); S.pmoff = l; S.rep = REP_G4;
        pg8::EpiSwiglu E{(bf16*)(ws + WS_HFF), DFF};
        pg8::gemm_phase<pg8::EpiSwiglu, pg8::StaticOrder, true, true>(F.lds, g, S, E);
        if (l == 0) p0_dynamic(F, args, 1, (unsigned*)(ws + WS_CNT) + 192, 0, I_IN);
        else p0_dynamic(F, args, 1, (unsigned*)(ws + WS_CNT) + 320, PER_L - I_2, PER_L);
    } SEAM(pb + 8);
    if (IN(pb + 9) && !SKIP_G5) {
        pg8::Gemm g{(const bf16*)(ws + WS_HFF), (const bf16*)(wb + WO_2), MROWS, DM_, DFF}; pg8::StaticOrder S; S.init(MROWS - CTXL, DM_, F.G, F.bid); S.pmoff = 1; S.rep = REP_G5;
        pg8::EpiF32 E{(float*)(ws + WS_R2), DM_};
        pg8::gemm_phase<pg8::EpiF32, pg8::StaticOrder, true, true>(F.lds, g, S, E);
        if (l == 0) { for (int it = F.bid; it < 256; it += F.G) ctx_f32_item(F, it, (const bf16*)(ws + WS_HFF), DFF, (const bf16*)(wb + WO_2), (float*)(ws + WS_R2));
                    }
    } SEAM(pb + 9);
    if (IN(pb + 10)) { row_phase<2>(F, args, l); } SEAM(pb + 10);
#undef IN
#undef SEAM
}
__global__ void __launch_bounds__(512, 2) mega_fwd(Args args) {
    extern __shared__ __attribute__((aligned(16))) unsigned char lds[];
    Frame F;
    F.lds = (LAS unsigned char*)lds; F.tid = threadIdx.x; F.lane = F.tid & 63; F.wave = __builtin_amdgcn_readfirstlane(F.tid >> 6);
    F.G = gridDim.x; F.bid = blockIdx.x; F.ws = args.ws; F.out = args.out;
    const int lo = args.ph_lo, hi = args.ph_hi;
    if (lo < 0) cg::this_grid().sync();
    for (int u = F.tid; u < 64; u += 512) ((LAS unsigned*)(F.lds + MISC_OFF))[u] = 0u;
    __syncthreads();
    XcdBarrier bar; bar.bar = (unsigned*)(args.ws + WS_BAR); bar.x = 0; bar.st = nullptr;
    if (hi - lo > 1) bar = xcd_barrier_post((unsigned*)(args.ws + WS_BAR), (volatile LAS unsigned*)(F.lds + MISC_OFF) + 8);
#define IN(k) (lo <= (k) && (k) < hi)
#define SEAM(k) do { if (IN(k) && IN((k) + 1)) { xcd_barrier(bar); if (REP_SYNC > 1) xcd_barrier(bar); } } while (0)
    unsigned char* ws = args.ws;
    if (IN(0)) { p0_phase(F, args, 0, true, 0, I_IN); } SEAM(0);
    if (IN(1)) { row_phase<0>(F, args, 0); } SEAM(1);
    layer_phases<0>(F, args, lds, lo, hi, bar);
    layer_phases<1>(F, args, lds, lo, hi, bar);
#undef IN
#undef SEAM
}

extern "C" void kernel_launch(void* const* d_in, const int* in_sizes, int n_in, void* d_out, int out_size, void* d_ws, size_t ws_size, hipStream_t stream) {
    static int grid = 0;
    if (grid == 0) {
        if (n_in != 27 || out_size != SEQ_ * DM_ || ws_size < WS_END2) { fprintf(stderr, "kernel_launch: unexpected shapes (n_in %d, out %d, ws %zu < %zu)\n", n_in, out_size, ws_size, (size_t)WS_END2); grid = -1; return; }
        if (hipFuncSetAttribute((const void*)mega_fwd, hipFuncAttributeMaxDynamicSharedMemorySize, LDS_BYTES) != hipSuccess) { fprintf(stderr, "kernel_launch: hipFuncSetAttribute failed\n"); grid = -1; return; }
        int dev = 0, cus = 0, per_cu = 0;
        hipGetDevice(&dev); hipDeviceGetAttribute(&cus, hipDeviceAttributeMultiprocessorCount, dev);
        hipOccupancyMaxActiveBlocksPerMultiprocessor(&per_cu, (const void*)mega_fwd, 512, LDS_BYTES);
        if (per_cu < 1) { fprintf(stderr, "kernel_launch: occupancy query says %d blocks per CU\n", per_cu); per_cu = 1; }
        (void)hipGetLastError();
        grid = cus;
    }
    if (grid < 0) return;
    Args a{};
    for (int i = 0; i < 27; ++i) a.in[i] = (const float*)d_in[i];
    a.out = (float*)d_out; a.ws = (unsigned char*)d_ws;
#if MK_SINGLE
    if (hipMemsetAsync((char*)d_ws + WS_BAR, 0, BAR_BYTES, stream) != hipSuccess) { fprintf(stderr, "kernel_launch: memset failed\n"); return; }
    a.ph_lo = 0; a.ph_hi = NPH;
    void* kargs[] = {&a};
    hipError_t e = hipLaunchCooperativeKernel((const void*)mega_fwd, dim3(grid), dim3(512), kargs, LDS_BYTES, stream);
    if (e != hipSuccess) fprintf(stderr, "cooperative launch failed: %s (grid %d)\n", hipGetErrorString(e), grid);
#else
    for (int p = 0; p < NPH; ++p) { a.ph_lo = p; a.ph_hi = p + 1; hipLaunchKernelGGL(mega_fwd, dim3(grid), dim3(512), LDS_BYTES, stream, a); }
#endif
}
```

```cpp
#include <hip/hip_runtime.h>
#include <hip/hip_cooperative_groups.h>
#include <hip/hip_bf16.h>
#include <cstdio>
#include <cstdint>
#include <cmath>
namespace cg = cooperative_groups;
#ifndef SKIP_G1
#define SKIP_G1 0
#endif
#ifndef SKIP_G2
#define SKIP_G2 0
#endif
#ifndef SKIP_G3
#define SKIP_G3 0
#endif
#ifndef SKIP_G4
#define SKIP_G4 0
#endif
#ifndef SKIP_G5
#define SKIP_G5 0
#endif
#ifndef REP_G1
#define REP_G1 1
#endif
#ifndef REP_G3
#define REP_G3 1
#endif
#ifndef REP_G4
#define REP_G4 1
#endif
#ifndef REP_G5
#define REP_G5 1
#endif
#ifndef REP_C1
#define REP_C1 1
#endif
#ifndef REP_C2
#define REP_C2 1
#endif
#ifndef REP_C3
#define REP_C3 1
#endif
#ifndef REP_C4
#define REP_C4 1
#endif
#ifndef REP_GEMM
#define REP_GEMM 1
#endif
#ifndef REP_CHUNK
#define REP_CHUNK 1
#endif
#ifndef REP_ATTN
#define REP_ATTN 1
#endif
#ifndef REP_ROWS
#define REP_ROWS 1
#endif
#ifndef REP_P0
#define REP_P0 1
#endif
#ifndef REP_SYNC
#define REP_SYNC 1
#endif
namespace pg8 {
#define PG8_LAS __attribute__((address_space(3)))
typedef unsigned short bf16_t;
typedef short bf16x8 __attribute__((ext_vector_type(8)));
typedef float f32x4 __attribute__((ext_vector_type(4)));
typedef unsigned u32x4 __attribute__((ext_vector_type(4)));
constexpr int BM = 256, BK = 64, HALF = 128, HTB = HALF * BK * 2  , STAGE_BYTES = 8 * HTB, NXCD = 8, WGM = 8;

__host__ __device__ __forceinline__ int lds_byte(int r, int c) { const int st = (r >> 4) * 2 + (c >> 5), rr = r & 15, cc = c & 31, ob = rr * 64 + cc * 2; return st * 1024 + (ob ^ (((ob >> 9) & 1) << 5)); }
__host__ __device__ __forceinline__ void stage_rc(int b, int& R, int& C) { const int st = b / 1024, sb = b % 1024, swz = sb ^ (((sb >> 9) & 1) << 5); R = (st >> 1) * 16 + swz / 64; C = (st & 1) * 32 + (swz % 64) / 2; }
__host__ __device__ __forceinline__ int perm32(int rho) { const int n = rho >> 4, i = rho & 15; return 8 * (i >> 2) + 4 * n + (i & 3); }

struct Unit { int pm, pn; };
struct Gemm { const bf16_t* A; const bf16_t* Bt; int M, N, K; };

struct StaticOrder {
    int nM, nN, nwg, G, c, rep = 1, pmoff = 0;
    __host__ __device__ void init(int M, int N, int G_, int c_) { nM = M / BM; nN = N / BM; nwg = nM * nN; G = G_; c = c_; }
    __host__ __device__ bool next(int i, Unit& u) const {
        const long L = (long)(i / rep) * G + c; if (L >= nwg) return false;
        int wgid = (int)L; { const int q = nwg / NXCD, r = nwg % NXCD, xcd = wgid % NXCD, off = wgid / NXCD; wgid = (xcd < r ? xcd * (q + 1) : r * (q + 1) + (xcd - r) * q) + off; }
        const int nig = WGM * nN, gid = wgid / nig, fm = gid * WGM, gsz = (nM - fm) < WGM ? (nM - fm) : WGM;
        u.pm = pmoff + fm + ((wgid % nig) % gsz); u.pn = (wgid % nig) / gsz; return true;
    }
    __device__ __forceinline__ void a_ready(const Unit&) const {}
    __device__ __forceinline__ void done(const Unit&) const {}
};

__device__ __forceinline__ unsigned cvt_pk_bf16(float lo, float hi) { unsigned r; asm volatile("v_cvt_pk_bf16_f32 %0, %1, %2" : "=v"(r) : "v"(lo), "v"(hi)); return r; }
typedef float f32x2 __attribute__((ext_vector_type(2)));
typedef unsigned u32x2 __attribute__((ext_vector_type(2)));
__device__ __forceinline__ float ep_sigmoid(float x) { return __builtin_amdgcn_rcpf(1.0f + __expf(-x)); }
struct EpiZ {
    static constexpr bool PERM = true, AFTER_DRAIN = false;
    bf16_t* Z; int ldz; float* ZG;
    __device__ __forceinline__ void operator()(const f32x4 (&acc)[2][2][4][2], const Unit& u, int wr, int wc, int fr, int fq) const {
        const int row0 = u.pm * BM + wr * 64 + fr, col0 = u.pn * BM + wc * 32 + 8 * fq;
#pragma unroll
        for (int ai = 0; ai < 2; ++ai)
#pragma unroll
            for (int m = 0; m < 4; ++m) { const int row = row0 + ai * HALF + m * 16;
#pragma unroll
                for (int bj = 0; bj < 2; ++bj) { const int c = col0 + bj * HALF; const f32x4 v0 = acc[ai][bj][m][0], v1 = acc[ai][bj][m][1];
                    u32x4 w; w.x = cvt_pk_bf16(v0[0], v0[1]); w.y = cvt_pk_bf16(v0[2], v0[3]); w.z = cvt_pk_bf16(v1[0], v1[1]); w.w = cvt_pk_bf16(v1[2], v1[3]);
                    *(u32x4*)(Z + (size_t)row * ldz + c) = w;
                    int gc = -1; if (c >= 1536 && c < 1568) gc = c - 1536; else if (c >= 6688 && c < 6720) gc = 32 + c - 6688;
                    if (gc >= 0) { float* g = ZG + (size_t)row * 64 + gc; *(f32x4*)g = v0; *(f32x4*)(g + 4) = v1; } } }
    }
};
template <int MODE> struct EpiGate {
    static constexpr bool PERM = true, AFTER_DRAIN = false;
    const bf16_t* Zg; int ldz; float* YF; bf16_t* YB; int ldc;
    __device__ __forceinline__ void operator()(const f32x4 (&acc)[2][2][4][2], const Unit& u, int wr, int wc, int fr, int fq) const {
        const int row0 = u.pm * BM + wr * 64 + fr, col0 = u.pn * BM + wc * 32 + 8 * fq;
#pragma unroll
        for (int ai = 0; ai < 2; ++ai)
#pragma unroll
            for (int m = 0; m < 4; ++m) { const int row = row0 + ai * HALF + m * 16;
#pragma unroll
                for (int bj = 0; bj < 2; ++bj) { const int c = col0 + bj * HALF;
                    const u32x4 gz = *(const u32x4*)(Zg + (size_t)row * ldz + c);
                    f32x4 g0, g1;
                    g0[0] = ep_sigmoid(__builtin_bit_cast(float, gz.x << 16)); g0[1] = ep_sigmoid(__builtin_bit_cast(float, gz.x & 0xffff0000u));
                    g0[2] = ep_sigmoid(__builtin_bit_cast(float, gz.y << 16)); g0[3] = ep_sigmoid(__builtin_bit_cast(float, gz.y & 0xffff0000u));
                    g1[0] = ep_sigmoid(__builtin_bit_cast(float, gz.z << 16)); g1[1] = ep_sigmoid(__builtin_bit_cast(float, gz.z & 0xffff0000u));
                    g1[2] = ep_sigmoid(__builtin_bit_cast(float, gz.w << 16)); g1[3] = ep_sigmoid(__builtin_bit_cast(float, gz.w & 0xffff0000u));
                    f32x4 v0 = acc[ai][bj][m][0] * g0, v1 = acc[ai][bj][m][1] * g1;
                    float* y = YF + (size_t)row * ldc + c;
                    if (MODE >= 1) { v0 += *(const f32x4*)y; v1 += *(const f32x4*)(y + 4); }
                    if (MODE <= 1) { *(f32x4*)y = v0; *(f32x4*)(y + 4) = v1; }
                    else { u32x4 w; w.x = cvt_pk_bf16(v0[0], v0[1]); w.y = cvt_pk_bf16(v0[2], v0[3]); w.z = cvt_pk_bf16(v1[0], v1[1]); w.w = cvt_pk_bf16(v1[2], v1[3]);
                        *(u32x4*)(YB + (size_t)row * ldc + c) = w; } } }
    }
};
struct EpiF32 {
    static constexpr bool PERM = true, AFTER_DRAIN = false;
    float* Y; int ldc;
    __device__ __forceinline__ void operator()(const f32x4 (&acc)[2][2][4][2], const Unit& u, int wr, int wc, int fr, int fq) const {
        const int row0 = u.pm * BM + wr * 64 + fr, col0 = u.pn * BM + wc * 32 + 8 * fq;
#pragma unroll
        for (int ai = 0; ai < 2; ++ai)
#pragma unroll
            for (int m = 0; m < 4; ++m) { const int row = row0 + ai * HALF + m * 16;
#pragma unroll
                for (int bj = 0; bj < 2; ++bj) { float* y = Y + (size_t)row * ldc + col0 + bj * HALF; *(f32x4*)y = acc[ai][bj][m][0]; *(f32x4*)(y + 4) = acc[ai][bj][m][1]; } }
    }
};
struct EpiSwiglu {
    static constexpr bool PERM = true, AFTER_DRAIN = false;
    bf16_t* Hf; int ldc;
    __device__ __forceinline__ void operator()(const f32x4 (&acc)[2][2][4][2], const Unit& u, int wr, int wc, int fr, int fq) const {
        const int row0 = u.pm * BM + wr * 64 + fr, col0 = u.pn * HALF + wc * 32 + 8 * fq;
#pragma unroll
        for (int ai = 0; ai < 2; ++ai)
#pragma unroll
            for (int m = 0; m < 4; ++m) { const int row = row0 + ai * HALF + m * 16; float o[8];
#pragma unroll
                for (int n = 0; n < 2; ++n)
#pragma unroll
                    for (int j = 0; j < 4; ++j) { const float a = acc[ai][0][m][n][j], b = acc[ai][1][m][n][j]; o[n * 4 + j] = a * __builtin_amdgcn_rcpf(1.0f + __expf(-a)) * b; }
                u32x4 w; w.x = cvt_pk_bf16(o[0], o[1]); w.y = cvt_pk_bf16(o[2], o[3]); w.z = cvt_pk_bf16(o[4], o[5]); w.w = cvt_pk_bf16(o[6], o[7]);
                *(u32x4*)(Hf + (size_t)row * ldc + col0) = w; }
    }
};
template <class Epi, class Sched, bool ALIGN_EPI = false, bool SP2 = false>
__device__ __forceinline__ void gemm_phase(PG8_LAS unsigned char* lds, const Gemm g, const Sched& S, const Epi& E) {
    const int tid = threadIdx.x, wid = __builtin_amdgcn_readfirstlane(tid >> 6), lane = tid & 63, wr = wid >> 2, wc = wid & 3, fr = lane & 15, fq = lane >> 4;
    const int K = g.K, nt = K / BK;
    unsigned voffA[2], voffB[2];
#pragma unroll
    for (int i = 0; i < 2; ++i) { int R, C; stage_rc(tid * 16 + i * 8192, R, C); const int Rb = Epi::PERM ? ((R & ~31) + perm32(R & 31)) : R;
        voffA[i] = (unsigned)(R * K + C) * 2u; voffB[i] = (unsigned)(Rb * K + C) * 2u; }
    const size_t kstep = (size_t)(BK * 2);
    const size_t hstep = (size_t)HALF * K * 2;
    const size_t tstep = 2 * hstep;
    const unsigned ldsw = (unsigned)wid * 1024u;
    const int aoff = lds_byte(wr * 64 + fr, fq * 8), boff = lds_byte(wc * 32 + fr, fq * 8);
#define PG8_SA(b, h) (((b) * 2 + (h)) * HTB)
#define PG8_SB(b, h) ((4 + (b) * 2 + (h)) * HTB)
#define PG8_STAGE(bufoff, gbase, voff) do { _Pragma("unroll") for (int _i = 0; _i < 2; ++_i) \
        __builtin_amdgcn_global_load_lds((const unsigned*)((const char*)(gbase) + (voff)[_i]), (PG8_LAS unsigned*)(lds + (bufoff) + ldsw + _i * 8192), 16, 0, 0); } while (0)
#define PG8_LDA(dst, b, h) do { _Pragma("unroll") for (int m = 0; m < 4; ++m) _Pragma("unroll") for (int k = 0; k < 2; ++k) dst[m][k] = *(const PG8_LAS bf16x8*)(lds + PG8_SA(b, h) + aoff + m * 2048 + k * 1024); } while (0)
#define PG8_LDB(dst, b, h) do { _Pragma("unroll") for (int n = 0; n < 2; ++n) _Pragma("unroll") for (int k = 0; k < 2; ++k) dst[n][k] = *(const PG8_LAS bf16x8*)(lds + PG8_SB(b, h) + boff + n * 2048 + k * 1024); } while (0)
#define PG8_MMA(ai, bj, At, Bt) do { __builtin_amdgcn_s_setprio(1); _Pragma("unroll") for (int m = 0; m < 4; ++m) _Pragma("unroll") for (int n = 0; n < 2; ++n) _Pragma("unroll") for (int k = 0; k < 2; ++k) \
        acc[ai][bj][m][n] = __builtin_amdgcn_mfma_f32_16x16x32_bf16(Bt[n][k], At[m][k], acc[ai][bj][m][n], 0, 0, 0); __builtin_amdgcn_s_setprio(0); } while (0)
#define PG8_WAIT_V(n) asm volatile("s_waitcnt vmcnt(" #n ")" ::: "memory")
#define PG8_WAIT_L(n) asm volatile("s_waitcnt lgkmcnt(" #n ")" ::: "memory")
#define PG8_BAR __builtin_amdgcn_s_barrier()
#define PG8_SCHED __builtin_amdgcn_sched_barrier(0)
    Unit cur, nxt; int ui = 0;
    if (!S.next(0, cur)) return;
    f32x4 acc[2][2][4][2];
#pragma unroll
    for (int a = 0; a < 2; ++a)
#pragma unroll
        for (int b = 0; b < 2; ++b)
#pragma unroll
            for (int m = 0; m < 4; ++m)
#pragma unroll
                for (int n = 0; n < 2; ++n) acc[a][b][m][n] = (f32x4){0.f, 0.f, 0.f, 0.f};
    bf16x8 At[4][2], B0[2][2], B1[2][2];
    const char* cA = (const char*)g.A + (size_t)cur.pm * tstep; const char* cB = (const char*)g.Bt + (size_t)cur.pn * tstep;
    S.a_ready(cur);
    if constexpr (SP2) {
        PG8_STAGE(PG8_SB(0, 0), cB, voffB); PG8_STAGE(PG8_SB(0, 1), cB + hstep, voffB); PG8_STAGE(PG8_SA(0, 0), cA, voffA); PG8_STAGE(PG8_SA(0, 1), cA + hstep, voffA);
        if (wr == 1) PG8_BAR;
        PG8_WAIT_V(2); PG8_BAR;
        PG8_STAGE(PG8_SB(1, 0), cB + kstep, voffB); PG8_STAGE(PG8_SA(1, 0), cA + kstep, voffA); PG8_STAGE(PG8_SB(1, 1), cB + hstep + kstep, voffB);
        PG8_WAIT_V(6); PG8_BAR;
    } else {
        PG8_STAGE(PG8_SB(0, 0), cB, voffB); PG8_STAGE(PG8_SA(0, 0), cA, voffA); PG8_STAGE(PG8_SB(0, 1), cB + hstep, voffB); PG8_STAGE(PG8_SA(0, 1), cA + hstep, voffA);
        if (wr == 1) PG8_BAR;
        PG8_WAIT_V(4); PG8_BAR;
        PG8_STAGE(PG8_SB(1, 0), cB + kstep, voffB); PG8_STAGE(PG8_SA(1, 0), cA + kstep, voffA); PG8_STAGE(PG8_SB(1, 1), cB + hstep + kstep, voffB);
        PG8_WAIT_V(6); PG8_BAR;
    }
    for (;;) {
        const bool has_next = S.next(ui + 1, nxt);
        const char* nA = has_next ? (const char*)g.A + (size_t)nxt.pm * tstep : cA; const char* nB = has_next ? (const char*)g.Bt + (size_t)nxt.pn * tstep : cB;
        for (int t = 0; t < nt; t += 2) {
            const bool last = (t == nt - 2);
            const char* a1 = cA + (size_t)(t + 1) * kstep;
            const char* a2 = last ? nA : cA + (size_t)(t + 2) * kstep; const char* b2 = last ? nB : cB + (size_t)(t + 2) * kstep;
            const char* a3 = a2 + kstep; const char* b3 = b2 + kstep;
            if (last && has_next) S.a_ready(nxt);
            if constexpr (SP2) {
            PG8_LDB(B0, 0, 0); PG8_LDB(B1, 0, 1); PG8_SCHED; PG8_LDA(At, 0, 0); PG8_STAGE(PG8_SA(1, 1), a1 + hstep, voffA);
            PG8_WAIT_V(8); PG8_WAIT_L(0); PG8_BAR; PG8_MMA(0, 0, At, B0); PG8_MMA(0, 1, At, B1); PG8_BAR; PG8_SCHED;
            PG8_LDA(At, 0, 1); PG8_STAGE(PG8_SB(0, 0), b2, voffB); PG8_STAGE(PG8_SB(0, 1), b2 + hstep, voffB); PG8_STAGE(PG8_SA(0, 0), a2, voffA);
            PG8_WAIT_V(8); PG8_WAIT_L(0); PG8_BAR; PG8_MMA(1, 0, At, B0); PG8_MMA(1, 1, At, B1); PG8_BAR; PG8_SCHED;
            PG8_LDB(B0, 1, 0); PG8_LDB(B1, 1, 1); PG8_SCHED; PG8_LDA(At, 1, 0); PG8_STAGE(PG8_SA(0, 1), a2 + hstep, voffA);
            PG8_WAIT_V(8); PG8_WAIT_L(0); PG8_BAR; PG8_MMA(0, 0, At, B0); PG8_MMA(0, 1, At, B1); PG8_BAR; PG8_SCHED;
            PG8_LDA(At, 1, 1); PG8_STAGE(PG8_SB(1, 0), b3, voffB); PG8_STAGE(PG8_SB(1, 1), b3 + hstep, voffB); PG8_STAGE(PG8_SA(1, 0), a3, voffA);
            PG8_WAIT_V(8); PG8_WAIT_L(0); PG8_BAR; PG8_MMA(1, 0, At, B0); PG8_MMA(1, 1, At, B1); PG8_BAR; PG8_SCHED;
            } else {
            PG8_LDB(B0, 0, 0); PG8_SCHED; PG8_LDA(At, 0, 0); PG8_STAGE(PG8_SA(1, 1), a1 + hstep, voffA);
            PG8_WAIT_L(8); PG8_BAR; PG8_WAIT_L(0); PG8_MMA(0, 0, At, B0); PG8_BAR; PG8_SCHED;
            PG8_LDB(B1, 0, 1); PG8_STAGE(PG8_SB(0, 0), b2, voffB);
            PG8_BAR; PG8_WAIT_L(0); PG8_MMA(0, 1, At, B1); PG8_BAR;
            PG8_LDA(At, 0, 1); PG8_STAGE(PG8_SA(0, 0), a2, voffA);
            PG8_BAR; PG8_WAIT_L(0); PG8_MMA(1, 0, At, B0); PG8_BAR; PG8_SCHED;
            PG8_STAGE(PG8_SB(0, 1), b2 + hstep, voffB);
            PG8_WAIT_V(6); PG8_BAR; PG8_MMA(1, 1, At, B1); PG8_BAR;
            PG8_LDB(B0, 1, 0); PG8_SCHED; PG8_LDA(At, 1, 0); PG8_STAGE(PG8_SA(0, 1), a2 + hstep, voffA);
            PG8_WAIT_L(8); PG8_BAR; PG8_WAIT_L(0); PG8_MMA(0, 0, At, B0); PG8_BAR; PG8_SCHED;
            PG8_LDB(B1, 1, 1); PG8_STAGE(PG8_SB(1, 0), b3, voffB);
            PG8_BAR; PG8_WAIT_L(0); PG8_MMA(0, 1, At, B1); PG8_BAR;
            PG8_LDA(At, 1, 1); PG8_STAGE(PG8_SA(1, 0), a3, voffA);
            PG8_BAR; PG8_WAIT_L(0); PG8_MMA(1, 0, At, B0); PG8_BAR; PG8_SCHED;
            PG8_STAGE(PG8_SB(1, 1), b3 + hstep, voffB);
            PG8_WAIT_V(6); PG8_BAR; PG8_MMA(1, 1, At, B1); PG8_BAR;
            }
        }
        if constexpr (ALIGN_EPI) { if (wr == 0) PG8_BAR; }
        if constexpr (!Epi::AFTER_DRAIN) { E(acc, cur, wr, wc, fr, fq); S.done(cur); }
        if (!has_next) break;
#pragma unroll
        for (int a = 0; a < 2; ++a)
#pragma unroll
            for (int b = 0; b < 2; ++b)
#pragma unroll
                for (int m = 0; m < 4; ++m)
#pragma unroll
                    for (int n = 0; n < 2; ++n) acc[a][b][m][n] = (f32x4){0.f, 0.f, 0.f, 0.f};
        cur = nxt; cA = nA; cB = nB; ++ui;
        if constexpr (ALIGN_EPI) { if (wr == 1) PG8_BAR; }
    }
    PG8_WAIT_V(0);
    if constexpr (!ALIGN_EPI) { if (wr == 0) PG8_BAR; }
    PG8_BAR;
    if constexpr (Epi::AFTER_DRAIN) { E.fused(acc, cur, wr, wc, fr, fq, lds, wid, lane); S.done(cur); }
#undef PG8_SA
#undef PG8_SB
#undef PG8_STAGE
#undef PG8_LDA
#undef PG8_LDB
#undef PG8_MMA
#undef PG8_WAIT_V
#undef PG8_WAIT_L
#undef PG8_BAR
#undef PG8_SCHED
}
}
#include <hip/hip_bf16.h>
#include <cmath>
namespace attn_body {
using bf16=__hip_bfloat16;
using bf16x8=__attribute__((ext_vector_type(8)))short;
using s16x4=__attribute__((ext_vector_type(4)))short;
using f32x16=__attribute__((ext_vector_type(16)))float;
using u32x4=__attribute__((ext_vector_type(4)))unsigned;
constexpr int D=64,DM=512,OPITCH=1024;
constexpr int NW=8,QBLK=32,QB=QBLK*NW,KVBLK=64;
constexpr int ATTN_PITCH=DM, ATTN_UNIT_ROWS=QB;
__device__ __forceinline__ int crow(int r,int hi){return (r&3)+8*(r>>2)+4*hi;}
#define SBAR() __builtin_amdgcn_sched_barrier(0)
__device__ __forceinline__ void cmask(f32x16&p0,f32x16&p1,int jb,int qrel,int hi){
  const float NEG=-INFINITY; int kb=64*jb+4*hi;
  #pragma unroll
  for(int r=0;r<16;++r){int kv=kb+(r&3)+8*(r>>2); if(kv>qrel)p0[r]=NEG; if(kv+32>qrel)p1[r]=NEG;}
}

constexpr int NSLOT=3, SLOTB=8192;
constexpr int LDS_K=0, LDS_V=NSLOT*SLOTB, LDS_WS=2*NSLOT*SLOTB, LDS_OST=LDS_WS+NW*64*4, LDS_BYTES=LDS_OST+NW*4096;
constexpr float C2=0.125f*1.4426950408889634f;
__device__ __forceinline__ void glds16(const void*gsrc,unsigned lds_dst){unsigned keep;
  asm volatile("s_mov_b32 %0, m0\n\ts_mov_b32 m0, %2\n\ts_nop 0\n\tglobal_load_lds_dwordx4 %1, off\n\ts_mov_b32 m0, %0":"=&s"(keep):"v"(gsrc),"s"(lds_dst):"memory");}
__device__ __forceinline__ float max3f(float a,float b,float c){float r;asm("v_max3_f32 %0, %1, %2, %3":"=v"(r):"v"(a),"v"(b),"v"(c));return r;}
__device__ __forceinline__ float max2f(float a,float b){float r;asm("v_max_f32_e32 %0, %1, %2":"=v"(r):"v"(a),"v"(b));return r;}
__device__ __forceinline__ float fadd_s(float a,float b){float r;asm("v_add_f32_e32 %0, %1, %2":"=v"(r):"v"(a),"v"(b));return r;}
__device__ __forceinline__ float fsub_s(float a,float b){float r;asm("v_sub_f32_e32 %0, %1, %2":"=v"(r):"v"(a),"v"(b));return r;}
typedef float f32x2_t __attribute__((ext_vector_type(2))); typedef __bf16 bf16x2_t __attribute__((ext_vector_type(2)));
__device__ __forceinline__ unsigned cvtpk_s(float lo,float hi){f32x2_t v={lo,hi};bf16x2_t b=__builtin_convertvector(v,bf16x2_t);return __builtin_bit_cast(unsigned,b);}
#define WAIT_BAR(N) asm volatile("s_waitcnt vmcnt(" #N ") lgkmcnt(0)\n\ts_barrier":::"memory")

__device__ __forceinline__ void qkt(f32x16&p0,f32x16&p1,const char*Kslot,const bf16x8*qr,const f32x16&negm,int r32,int hi){
  const char*kb=Kslot+hi*1024+r32*16;
  #pragma unroll
  for(int d0=0;d0<4;++d0){
    const bf16x8 b0=*reinterpret_cast<const bf16x8*>(kb+d0*2048);
    const bf16x8 b1=*reinterpret_cast<const bf16x8*>(kb+d0*2048+512);
    if(d0==0){p0=__builtin_amdgcn_mfma_f32_32x32x16_bf16(b0,qr[0],negm,0,0,0);p1=__builtin_amdgcn_mfma_f32_32x32x16_bf16(b1,qr[0],negm,0,0,0);}
    else{p0=__builtin_amdgcn_mfma_f32_32x32x16_bf16(b0,qr[d0],p0,0,0,0);p1=__builtin_amdgcn_mfma_f32_32x32x16_bf16(b1,qr[d0],p1,0,0,0);}}
}
typedef __attribute__((address_space(3))) const char* lds_cptr;
typedef short v4i16_t __attribute__((ext_vector_type(4)));
__device__ __forceinline__ void kload8(bf16x8*kf,lds_cptr kp){
  kf[0]=*(const __attribute__((address_space(3))) bf16x8*)(kp);      kf[1]=*(const __attribute__((address_space(3))) bf16x8*)(kp+512);
  kf[2]=*(const __attribute__((address_space(3))) bf16x8*)(kp+2048); kf[3]=*(const __attribute__((address_space(3))) bf16x8*)(kp+2560);
  kf[4]=*(const __attribute__((address_space(3))) bf16x8*)(kp+4096); kf[5]=*(const __attribute__((address_space(3))) bf16x8*)(kp+4608);
  kf[6]=*(const __attribute__((address_space(3))) bf16x8*)(kp+6144); kf[7]=*(const __attribute__((address_space(3))) bf16x8*)(kp+6656);
}
__device__ __forceinline__ void kload2(bf16x8*kf,lds_cptr kp,int j){ kf[2*j]=*(const __attribute__((address_space(3))) bf16x8*)(kp+j*2048); kf[2*j+1]=*(const __attribute__((address_space(3))) bf16x8*)(kp+j*2048+512); }
__device__ __forceinline__ s16x4 vtr(lds_cptr p){ return __builtin_bit_cast(s16x4,__builtin_amdgcn_ds_read_tr16_b64_v4i16((__attribute__((address_space(3))) v4i16_t*)p)); }
__device__ __forceinline__ float rowmax(const f32x16&p0,const f32x16&p1){
  float a=max3f(p0[0],p0[1],p1[0]),b=max3f(p0[2],p0[3],p1[1]);a=max3f(a,p1[2],p1[3]);
  #pragma unroll
  for(int r=4;r<16;r+=4){a=max3f(a,p0[r],p0[r+1]);b=max3f(b,p0[r+2],p0[r+3]);a=max3f(a,p1[r],p1[r+1]);b=max3f(b,p1[r+2],p1[r+3]);}
  const float m=max2f(a,b);
  auto rr=__builtin_amdgcn_permlane32_swap(__float_as_uint(m),__float_as_uint(m),false,false);
  return max2f(__uint_as_float(rr[0]),__uint_as_float(rr[1]));
}
__device__ __forceinline__ void pv(f32x16*o,int vb,bf16x8 pa0,bf16x8 pa1,bf16x8 pa2,bf16x8 pa3){
  #pragma unroll
  for(int d0=0;d0<2;++d0){s16x4 lo[4],hi[4];
    #pragma unroll
    for(int ks=0;ks<4;++ks){
      asm volatile("ds_read_b64_tr_b16 %0,%1 offset:%c2":"=&v"(lo[ks]):"v"(vb),"i"(d0*4096+ks*1024):"memory");
      asm volatile("ds_read_b64_tr_b16 %0,%1 offset:%c2":"=&v"(hi[ks]):"v"(vb),"i"(d0*4096+ks*1024+512):"memory");}
    asm volatile("s_waitcnt lgkmcnt(0)":::"memory");SBAR();
    #define PK(k) (bf16x8){lo[k][0],lo[k][1],lo[k][2],lo[k][3],hi[k][0],hi[k][1],hi[k][2],hi[k][3]}
    o[d0]=__builtin_amdgcn_mfma_f32_32x32x16_bf16(pa0,PK(0),o[d0],0,0,0);
    o[d0]=__builtin_amdgcn_mfma_f32_32x32x16_bf16(pa1,PK(1),o[d0],0,0,0);
    o[d0]=__builtin_amdgcn_mfma_f32_32x32x16_bf16(pa2,PK(2),o[d0],0,0,0);
    o[d0]=__builtin_amdgcn_mfma_f32_32x32x16_bf16(pa3,PK(3),o[d0],0,0,0);
    #undef PK
  }
}

#ifndef ATTN_STORE16
#define ATTN_STORE16(p,v) (*(u32x4*)(p)=(v))
#endif
template<int THRL> __device__ __forceinline__ void attn_unit(const bf16*Qu,const bf16*__restrict__ Kh,const bf16*__restrict__ Vh,bf16*Ou,const int NT,char*shm){
  const int tid=threadIdx.x,lane=tid&63,r32=lane&31,hi=lane>>5; const int wid=__builtin_amdgcn_readfirstlane(tid>>6);
  const bf16*Qw=Qu+(long)(wid*QBLK)*DM;
  const unsigned lds0=(unsigned)(uintptr_t)shm;
  float*wsf=(float*)(shm+LDS_WS)+wid*64;
  const bf16*ksrc=Kh+(long)lane*DM+wid*8;
  const bf16*vsrc=Vh+(long)(16*(wid&3)+(lane>>2))*DM+(wid>>2)*32+(lane&3)*8;
  const unsigned kdst=lds0+LDS_K+wid*1024, vdst=lds0+LDS_V+wid*1024;
  #define DMA_K(t,slot) glds16(ksrc+(long)(t)*KVBLK*DM,(unsigned)__builtin_amdgcn_readfirstlane(kdst+(slot)))
  #define DMA_V(t,slot) glds16(vsrc+(long)(t)*KVBLK*DM,(unsigned)__builtin_amdgcn_readfirstlane(vdst+(slot)))
  const int vb0=(int)(lds0+LDS_V)+((lane>>4)&1)*32+(lane&3)*8+(4*hi+((lane&15)>>2))*64;
  const char*Kbase=shm+LDS_K; bf16x8 kf[8];
  const lds_cptr shm3=(lds_cptr)shm; const lds_cptr kp0=shm3+LDS_K+hi*1024+r32*16; const lds_cptr vp0=shm3+LDS_V+((lane>>4)&1)*32+(lane&3)*8+(4*hi+((lane&15)>>2))*64;
  DMA_K(0,0);DMA_V(0,0);DMA_K(1,SLOTB);
  bf16x8 qr[4];
  #pragma unroll
  for(int d0=0;d0<4;++d0)qr[d0]=*reinterpret_cast<const bf16x8*>(&Qw[(long)r32*DM+d0*16+hi*8]);
  float mhat=0.f,l_reg=0.f;f32x16 o[2];o[0]=f32x16{};o[1]=f32x16{};f32x16 negm=f32x16{};asm volatile("":"+v"(negm));
  #define CMASK(P0,P1,t) do{}while(0)
  bool resc=false;
  #define START(P0,P1) do{ const float rm=rowmax(P0,P1); resc=false; \
    { const float dl=rm; mhat=fadd_s(mhat,dl); \
      _Pragma("unroll") for(int r=0;r<16;++r){P0[r]=fsub_s(P0[r],dl);P1[r]=fsub_s(P1[r],dl);} \
      _Pragma("unroll") for(int r=0;r<16;++r)negm[r]=-mhat; asm volatile("":"+v"(negm)); } \
    _Pragma("unroll") for(int r=0;r<16;++r)P0[r]=__builtin_amdgcn_exp2f(P0[r]); }while(0)
  #define RESC() do{ if(resc){ asm volatile("s_waitcnt lgkmcnt(0)":::"memory"); \
      _Pragma("unroll") for(int d_=0;d_<2;++d_) _Pragma("unroll") for(int r=0;r<16;++r)o[d_][r]*=wsf[crow(r,hi)]; } }while(0)
  f32x16 pA0,pA1,pB0,pB1;
  int sl_prev=0,sl_cur=0,sl_next=SLOTB;
  #define ROT() do{sl_prev=sl_cur;sl_cur=sl_next;sl_next=(sl_next==(NSLOT-1)*SLOTB)?0:sl_next+SLOTB;}while(0)
  DMA_K(2,2*SLOTB);
  WAIT_BAR(3);
  qkt(pA0,pA1,Kbase,qr,negm,r32,hi);asm volatile("s_nop 15\n\ts_nop 7":"+v"(pA0),"+v"(pA1));CMASK(pA0,pA1,0);
  START(pA0,pA1);
  _Pragma("unroll") for(int r=0;r<16;++r)pA1[r]=__builtin_amdgcn_exp2f(pA1[r]);
  WAIT_BAR(0);
  DMA_K(3,0);DMA_V(1,SLOTB);
  ROT();
  kload8(kf,kp0+sl_cur);
  WAIT_BAR(2);
  s16x4 vlo[8],vhi[8]; u32x4 pw0,pw1,pw2,pw3;
  #define PKW(P,B) cvtpk_s(P[B],P[B+1])
  #define PAF(k) __builtin_bit_cast(bf16x8,pw##k)
  #define VFR(i) (bf16x8){vlo[i][0],vlo[i][1],vlo[i][2],vlo[i][3],vhi[i][0],vhi[i][1],vhi[i][2],vhi[i][3]}
  #define PIN(x) asm volatile("":"+v"(x))
  #define MX3(a,b,c) __builtin_fmaxf(__builtin_fmaxf((a),(b)),(c))
  #define GAPA(MF,A0,A1,A2,A3,W0,W1,PW) do{ MF; sacc+=A0; sacc+=A1; sacc+=A2; sacc+=A3; PIN(sacc); W0; W1; PIN(PW); SBAR(); }while(0)
  #define EX(v) __builtin_amdgcn_exp2f(v)
  #define GAPB(MF,X,B) do{ MF; X[B]=EX(X[B]); X[B+1]=EX(X[B+1]); X[B+2]=EX(X[B+2]); X[B+3]=EX(X[B+3]); PIN(X); SBAR(); }while(0)
  #define VRD(i) do{ vlo[i]=vtr(vp_+(((i)>>2)*4096+((i)&3)*1024)); vhi[i]=vtr(vp_+(((i)>>2)*4096+((i)&3)*1024+512)); }while(0)
  #define KRD(G,j) do{ if(G){ kload2(kf,kp0+sl_next,j); SBAR(); } }while(0)
  #define STEP(C0,C1,P0,P1,t,GK,GV,GL) do{ SBAR(); \
    const lds_cptr vp_=vp0+sl_prev; \
    VRD(0); SBAR(); float sacc=(P0[0]+P0[1]); \
    GAPA(C0=__builtin_amdgcn_mfma_f32_32x32x16_bf16(kf[0],qr[0],negm,0,0,0), P0[2],P0[3],P0[4],P0[5],     pw0[0]=PKW(P0,0), pw0[1]=PKW(P0,2), pw0); \
    VRD(4); SBAR(); GAPA(C1=__builtin_amdgcn_mfma_f32_32x32x16_bf16(kf[1],qr[0],negm,0,0,0), P0[6],P0[7],P0[8],P0[9],     pw0[2]=PKW(P0,4), pw0[3]=PKW(P0,6), pw0); \
    VRD(1); SBAR(); GAPA(C0=__builtin_amdgcn_mfma_f32_32x32x16_bf16(kf[2],qr[1],C0,0,0,0),   P0[10],P0[11],P0[12],P0[13], pw1[0]=PKW(P0,8), pw1[1]=PKW(P0,10), pw1); \
    VRD(5); SBAR(); GAPA(C1=__builtin_amdgcn_mfma_f32_32x32x16_bf16(kf[3],qr[1],C1,0,0,0),   P0[14],P0[15],P1[0],P1[1],   pw1[2]=PKW(P0,12),pw1[3]=PKW(P0,14), pw1); \
    VRD(2); SBAR(); GAPA(C0=__builtin_amdgcn_mfma_f32_32x32x16_bf16(kf[4],qr[2],C0,0,0,0),   P1[2],P1[3],P1[4],P1[5],     pw2[0]=PKW(P1,0), pw2[1]=PKW(P1,2), pw2); \
    VRD(6); SBAR(); GAPA(C1=__builtin_amdgcn_mfma_f32_32x32x16_bf16(kf[5],qr[2],C1,0,0,0),   P1[6],P1[7],P1[8],P1[9],     pw2[2]=PKW(P1,4), pw2[3]=PKW(P1,6), pw2); \
    VRD(3); SBAR(); GAPA(C0=__builtin_amdgcn_mfma_f32_32x32x16_bf16(kf[6],qr[3],C0,0,0,0),   P1[10],P1[11],P1[12],P1[13], pw3[0]=PKW(P1,8), pw3[1]=PKW(P1,10), pw3); \
    VRD(7); SBAR(); GAPA(C1=__builtin_amdgcn_mfma_f32_32x32x16_bf16(kf[7],qr[3],C1,0,0,0),   P1[14],P1[15],0.f,0.f,       pw3[2]=PKW(P1,12),pw3[3]=PKW(P1,14), pw3); \
    l_reg+=sacc; \
    if(GK){DMA_K((t)+3,sl_cur);} if(GV){DMA_V((t)+1,sl_next);} \
    CMASK(C0,C1,t); \
    { float a=MX3(C0[0],C0[1],C1[0]),b=MX3(C0[2],C0[3],C1[1]); a=MX3(a,C1[2],C1[3]); \
      _Pragma("unroll") for(int r=4;r<16;r+=4){a=MX3(a,C0[r],C0[r+1]);b=MX3(b,C0[r+2],C0[r+3]);a=MX3(a,C1[r],C1[r+1]);b=MX3(b,C1[r+2],C1[r+3]);} \
      float rm=__builtin_fmaxf(a,b); { auto rr=__builtin_amdgcn_permlane32_swap(__float_as_uint(rm),__float_as_uint(rm),false,false); rm=__builtin_fmaxf(__uint_as_float(rr[0]),__uint_as_float(rr[1])); } \
      resc=false; \
      if(__builtin_expect(__any(rm>(float)THRL),0)){ const float dl=__builtin_fmaxf(rm,0.f); mhat+=dl; \
        _Pragma("unroll") for(int r=0;r<16;++r){C0[r]-=dl;C1[r]-=dl;} \
        _Pragma("unroll") for(int r=0;r<16;++r)negm[r]=-mhat; asm volatile("":"+v"(negm)); \
        const float f=__builtin_amdgcn_exp2f(-dl); l_reg*=f; if(hi==0)wsf[r32]=f; resc=true; } } \
    SBAR(); \
    GAPB(o[0]=__builtin_amdgcn_mfma_f32_32x32x16_bf16(PAF(0),VFR(0),o[0],0,0,0), C0,0); \
    GAPB(o[1]=__builtin_amdgcn_mfma_f32_32x32x16_bf16(PAF(0),VFR(4),o[1],0,0,0), C0,4); \
    KRD(GL,0); GAPB(o[0]=__builtin_amdgcn_mfma_f32_32x32x16_bf16(PAF(1),VFR(1),o[0],0,0,0), C0,8); \
    KRD(GL,1); GAPB(o[1]=__builtin_amdgcn_mfma_f32_32x32x16_bf16(PAF(1),VFR(5),o[1],0,0,0), C0,12); \
    KRD(GL,2); GAPB(o[0]=__builtin_amdgcn_mfma_f32_32x32x16_bf16(PAF(2),VFR(2),o[0],0,0,0), C1,0); \
    KRD(GL,3); GAPB(o[1]=__builtin_amdgcn_mfma_f32_32x32x16_bf16(PAF(2),VFR(6),o[1],0,0,0), C1,4); \
    GAPB(o[0]=__builtin_amdgcn_mfma_f32_32x32x16_bf16(PAF(3),VFR(3),o[0],0,0,0), C1,8); \
    GAPB(o[1]=__builtin_amdgcn_mfma_f32_32x32x16_bf16(PAF(3),VFR(7),o[1],0,0,0), C1,12); \
    }while(0)
  int t=1;
  #undef CMASK
  #define CMASK(P0,P1,t) do{}while(0)
  for(;t+5<NT;t+=2){
    STEP(pB0,pB1,pA0,pA1,t,true,true,true);     WAIT_BAR(2); RESC(); ROT();
    STEP(pA0,pA1,pB0,pB1,t+1,true,true,true);   WAIT_BAR(2); RESC(); ROT();
  }
  #undef CMASK
  #define CMASK(P0,P1,t) do{}while(0)
  #define ENDW(tt) do{ if((tt)+3<NT){WAIT_BAR(2);} else if((tt)+2<NT){WAIT_BAR(1);} else {WAIT_BAR(0);} }while(0)
  for(;t+1<NT;t+=2){
    STEP(pB0,pB1,pA0,pA1,t,(t+3<NT),(t+1<NT),(t+1<NT));       ENDW(t);   RESC(); ROT();
    STEP(pA0,pA1,pB0,pB1,t+1,(t+4<NT),(t+2<NT),(t+2<NT));     ENDW(t+1); RESC(); ROT();
  }
  STEP(pB0,pB1,pA0,pA1,NT-1,false,false,false); RESC();
  { float sacc=pB0[0]+pB0[1]; _Pragma("unroll") for(int r=2;r<16;++r)sacc+=pB0[r]; _Pragma("unroll") for(int r=0;r<16;++r)sacc+=pB1[r]; l_reg+=sacc;
    pw0=(u32x4){PKW(pB0,0),PKW(pB0,2),PKW(pB0,4),PKW(pB0,6)};pw1=(u32x4){PKW(pB0,8),PKW(pB0,10),PKW(pB0,12),PKW(pB0,14)};pw2=(u32x4){PKW(pB1,0),PKW(pB1,2),PKW(pB1,4),PKW(pB1,6)};pw3=(u32x4){PKW(pB1,8),PKW(pB1,10),PKW(pB1,12),PKW(pB1,14)};
    SBAR(); pv(o,vb0+sl_cur,PAF(0),PAF(1),PAF(2),PAF(3)); }
  #undef PKW
  #undef PAF
  #undef VFR
  #undef PIN
  #undef MX3
  #undef GAPA
  #undef GAPB
  #undef EX
  #undef VRD
  #undef KRD
  #undef STEP
  #undef ENDW
  {auto rr=__builtin_amdgcn_permlane32_swap(__float_as_uint(l_reg),__float_as_uint(l_reg),false,false);l_reg=__uint_as_float(rr[0])+__uint_as_float(rr[1]);}
  if(hi==0)wsf[32+r32]=l_reg;asm volatile("s_waitcnt lgkmcnt(0)":::"memory");
  float rli[16];
  #pragma unroll
  for(int r=0;r<16;++r)rli[r]=__builtin_amdgcn_rcpf(wsf[32+crow(r,hi)]);
  bf16*Ow=Ou+(long)(wid*QBLK)*OPITCH;
  { bf16*stg=(bf16*)(shm+LDS_OST)+wid*2048;
    #pragma unroll
    for(int r=0;r<16;++r){const int orow=crow(r,hi);
      #pragma unroll
      for(int d0=0;d0<2;++d0)stg[orow*64+d0*32+r32]=__float2bfloat16(o[d0][r]*rli[r]);}
    asm volatile("s_waitcnt lgkmcnt(0)":::"memory");
    #pragma unroll
    for(int i=0;i<4;++i){const int row=i*8+(lane>>3),ch=lane&7; const u32x4 v=*(const u32x4*)(stg+row*64+ch*8); ATTN_STORE16(Ow+(long)row*OPITCH+ch*8,v);} }
  asm volatile("s_waitcnt lgkmcnt(0)\n\ts_barrier":::"memory");
  #undef DMA_K
  #undef DMA_V
  #undef CMASK
  #undef START
  #undef RESC
  #undef ROT
}
constexpr int ATTN_LDS_BYTES=LDS_BYTES;
#undef SBAR
#undef WAIT_BAR
}
#define GAS __attribute__((address_space(1)))
#define LAS __attribute__((address_space(3)))
typedef unsigned short bf16;
typedef unsigned v4u __attribute__((ext_vector_type(4)));
typedef unsigned v2u __attribute__((ext_vector_type(2)));
typedef float f32x4 __attribute__((ext_vector_type(4)));
#define LDS_WAIT() asm volatile("s_waitcnt lgkmcnt(0)" ::: "memory")

constexpr int DM_ = 2048, SEQ_ = 8192, CTXL = 256, MROWS = SEQ_ + CTXL;
constexpr int NIN = 13888, NINP = 14080, DFF = 5632;
constexpr int ZP = NINP;
constexpr int C_GQ = 0, C_GK = 512, C_GV = 1024, C_GLR = 1536, C_GG = 1568, C_DQ = 2080, C_DK = 2592, C_DV = 3104,
              C_EQ = 3616, C_EA = 6688, C_EB = 6704, C_EG = 6720, C_MG = 7744;
constexpr size_t MiB = 1u << 20;
constexpr size_t WS_MOD = 0;
constexpr size_t WS_BAR = 512 * 1024, BAR_BYTES = 16384;
constexpr int MISC_OFF = 147456 - 256;
constexpr size_t WS_CNT = WS_BAR + 14336;
constexpr size_t WS_W0 = 1 * MiB, W_LAYER = 137 * MiB;
constexpr size_t WO_IN = 0, WO_UA = 55 * MiB, WO_UD = 57 * MiB, WO_UE = 59 * MiB, WO_O = 63 * MiB, WO_13 = 71 * MiB, WO_2 = 115 * MiB;
constexpr size_t WS_X = WS_W0 + 2 * W_LAYER;
constexpr size_t WS_H = WS_X + 66 * MiB;
constexpr size_t WS_Z = WS_H + 33 * MiB;
constexpr size_t WS_ZG = WS_Z + 227 * MiB;
constexpr size_t WS_AQ = WS_ZG + 3 * MiB, WS_AK = WS_AQ + 9 * MiB, WS_AV = WS_AK + 9 * MiB, WS_AO = WS_AV + 9 * MiB;
constexpr size_t WS_DQ = WS_AO + 17 * MiB, WS_DK = WS_DQ + 17 * MiB, WS_DV = WS_DK + 17 * MiB, WS_DGB = WS_DV + 17 * MiB;
constexpr size_t WS_A = WS_DGB + 2 * MiB, WS_D = WS_A + 9 * MiB, WS_E = WS_D + 9 * MiB;
constexpr size_t WS_R2 = WS_E + 17 * MiB;
constexpr size_t WS_YB = WS_R2 + 66 * MiB;
constexpr size_t WS_END = WS_YB + 33 * MiB;
constexpr size_t WS_HFF = WS_Z;

constexpr int LDS_BYTES = 147456;
constexpr int NPH = 24;

typedef float pk_f32x2 __attribute__((ext_vector_type(2))); typedef __bf16 pk_bf16x2 __attribute__((ext_vector_type(2)));
__device__ __forceinline__ unsigned pk2(float lo, float hi) { const pk_f32x2 v = {lo, hi}; const pk_bf16x2 b = __builtin_convertvector(v, pk_bf16x2); return __builtin_bit_cast(unsigned, b); }
__device__ __forceinline__ unsigned f2bf(float f) { return pk2(f, 0.f) & 0xffffu; }
__device__ __forceinline__ float bf2f(unsigned short b) { return __builtin_bit_cast(float, (unsigned)b << 16); }
__device__ __forceinline__ float bflo(unsigned w) { return __builtin_bit_cast(float, w << 16); }
__device__ __forceinline__ float bfhi(unsigned w) { return __builtin_bit_cast(float, w & 0xffff0000u); }
__device__ __forceinline__ float wave_sum(float v) {
#pragma unroll
    for (int o = 1; o < 64; o <<= 1) v += __shfl_xor(v, o);
    return v;
}
__device__ __forceinline__ float sigmoidf_(float x) { return __builtin_amdgcn_rcpf(1.0f + __expf(-x)); }
__device__ __forceinline__ float siluf_(float x) { return x * __builtin_amdgcn_rcpf(1.0f + __expf(-x)); }

struct Args { const float* in[27]; float* out; unsigned char* ws; int ph_lo, ph_hi; };

struct Frame {
    LAS unsigned char* lds;
    int tid, lane, wave, G, bid;
    unsigned char* ws; float* out;
};

#define XB_TMO      128
#define XB_XCNT(j)  (256  + 64 * (j))
#define XB_XSUB(j)  (1280 + 64 * (j))
#define XB_XGEN(j)  (2304 + 64 * (j))
#define XB_TOP      3328
#define XB_TOPGEN   3392
#define XCD_BAR_WORDS 3456
#define XB_SPIN_CAP (1u << 18)

__device__ __forceinline__ unsigned xb_ld(unsigned* p)              { return __hip_atomic_load(p, __ATOMIC_RELAXED, __HIP_MEMORY_SCOPE_AGENT); }
__device__ __forceinline__ unsigned xb_add(unsigned* p, unsigned v) { return __hip_atomic_fetch_add(p, v, __ATOMIC_RELAXED, __HIP_MEMORY_SCOPE_AGENT); }
__device__ __forceinline__ unsigned xb_xcc_id() { return (unsigned)__builtin_amdgcn_s_getreg((3 << 11) | 20) & 0xFu; }
#define XB_SPIN(cond, bar) do { unsigned _sp = 0; while (cond) { __builtin_amdgcn_s_sleep(1); \
    if ((++_sp & 255u) == 0u) { if (xb_ld(&(bar)[XB_TMO])) break; if (_sp > XB_SPIN_CAP) { atomicAdd(&(bar)[XB_TMO], 1u); break; } } } } while (0)

struct XcdBarrier {
    unsigned* bar; unsigned x;
    volatile LAS unsigned* st;
};

__device__ __forceinline__ XcdBarrier xcd_barrier_post(unsigned* bar, volatile LAS unsigned* st) {
    XcdBarrier b; b.bar = bar; b.x = xb_xcc_id(); b.st = st;
    if (threadIdx.x == 0) (void)xb_add(&bar[XB_XCNT(b.x)], 1u);
    return b;
}
__device__ __forceinline__ void xcd_barrier_complete(unsigned* bar, unsigned x, unsigned& nloc, unsigned& nx) {
    const unsigned G = gridDim.x * gridDim.y * gridDim.z;
    unsigned sum, cnt, mine, sp = 0u;
    for (;;) {
        sum = 0u; cnt = 0u; mine = 0u;
#pragma unroll
        for (unsigned j = 0; j < 16; ++j) { const unsigned c = xb_ld(&bar[XB_XCNT(j)]); sum += c; cnt += (c > 0u) ? 1u : 0u; mine = (j == x) ? c : mine; }
        if (sum == G) break;
        __builtin_amdgcn_s_sleep(1);
        if ((++sp & 255u) == 0u) { if (xb_ld(&bar[XB_TMO])) break; if (sp > XB_SPIN_CAP) { atomicAdd(&bar[XB_TMO], 1u); break; } }
    }
    nloc = mine > 0u ? mine : 1u; nx = cnt > 0u ? cnt : 1u;
}

__device__ __forceinline__ void xcd_barrier(const XcdBarrier& b) {
    asm volatile("s_waitcnt vmcnt(0)" ::: "memory");
    __syncthreads();
    if (threadIdx.x == 0) {
        unsigned* bar = b.bar;
        __builtin_amdgcn_s_waitcnt(0);
        unsigned nloc = b.st[0], nx = b.st[1];
        if (nloc == 0u) { xcd_barrier_complete(bar, b.x, nloc, nx); b.st[0] = nloc; b.st[1] = nx; }
        const unsigned old = xb_add(&bar[XB_XSUB(b.x)], 1u);
        const unsigned gen = old / nloc;
        if (old + 1u == (gen + 1u) * nloc) {
            __builtin_amdgcn_fence(__ATOMIC_RELEASE, "agent");
            asm volatile("s_waitcnt vmcnt(0)" ::: "memory");
            const unsigned og = xb_add(&bar[XB_TOP], 1u);
            const unsigned tg = og / nx;
            if (og + 1u == (tg + 1u) * nx) xb_add(&bar[XB_TOPGEN], 1u);
            else XB_SPIN(xb_ld(&bar[XB_TOPGEN]) == tg, bar);
            __builtin_amdgcn_fence(__ATOMIC_ACQUIRE, "agent");
            xb_add(&bar[XB_XGEN(b.x)], 1u);
            asm volatile("s_waitcnt vmcnt(0)" ::: "memory");
        } else {
            XB_SPIN(xb_ld(&bar[XB_XGEN(b.x)]) == gen, bar);
            __builtin_amdgcn_fence(__ATOMIC_ACQUIRE, "agent");
            asm volatile("s_waitcnt vmcnt(0)" ::: "memory");
        }
    }
    __syncthreads();
}

__device__ __forceinline__ void p0_transpose_item(const float* W, int K, int N, bf16* WT, int k0, int n0, int drow, LAS float* scr, int lane) {
#pragma unroll 8
    for (int i = 0; i < 32; ++i) { const int kk = 2 * i + (lane >> 5); scr[kk * 33 + (lane & 31)] = __builtin_nontemporal_load(W + (size_t)(k0 + kk) * N + n0 + (lane & 31)); }
    LDS_WAIT(); asm volatile("" ::: "memory");
    const int c = lane & 7;
#pragma unroll
    for (int j = 0; j < 4; ++j) { const int n = (lane >> 3) + 8 * j; const LAS float* s = scr + (8 * c) * 33 + n;
        v4u o; o.x = pk2(s[0 * 33], s[1 * 33]); o.y = pk2(s[2 * 33], s[3 * 33]); o.z = pk2(s[4 * 33], s[5 * 33]); o.w = pk2(s[6 * 33], s[7 * 33]);
        *(v4u*)(WT + (size_t)(drow + n) * K + k0 + 8 * c) = o; }
    LDS_WAIT(); asm volatile("" ::: "memory");
}
__device__ __forceinline__ void tr_plain(const float* W, int K, int N, bf16* WT, int item, LAS float* scr, int lane) {
    const int nblk = N / 32, kb = item / nblk, nb = item % nblk;
    p0_transpose_item(W, K, N, WT, 64 * kb, 32 * nb, 32 * nb, scr, lane);
}
__device__ __forceinline__ void tr_ffn13(const float* W, bf16* WT, int item, int which, LAS float* scr, int lane) {
    const int nblk = DFF / 32, kb = item / nblk, nb = item % nblk, n0 = 32 * nb;
    p0_transpose_item(W, DM_, DFF, WT, 64 * kb, n0, 256 * (n0 >> 7) + (n0 & 127) + 128 * which, scr, lane);
}
constexpr int I_IN = 32 * (NIN / 32), I_UA = 8 * 64, I_UE = 16 * 64, I_O = 32 * 64, I_F = 32 * (DFF / 32), I_2 = (DFF / 64) * 64;
constexpr int PER_L = I_IN + 2 * I_UA + I_UE + I_O + 2 * I_F + I_2;
__device__ __forceinline__ void p0_item(Frame& F, const Args& A, const int l, int r, LAS float* scr) {
    unsigned char* wb = F.ws + WS_W0;
    if (r < I_IN) { tr_plain(A.in[10] + (size_t)l * DM_ * NIN, DM_, NIN, (bf16*)(wb + WO_IN), r, scr, F.lane); return; } r -= I_IN;
    if (r < I_UA) { tr_plain(A.in[20] + (size_t)l * 512 * DM_, 512, DM_, (bf16*)(wb + WO_UA), r, scr, F.lane); return; } r -= I_UA;
    if (r < I_UA) { tr_plain(A.in[21] + (size_t)l * 512 * DM_, 512, DM_, (bf16*)(wb + WO_UD), r, scr, F.lane); return; } r -= I_UA;
    if (r < I_UE) { tr_plain(A.in[22] + (size_t)l * 1024 * DM_, 1024, DM_, (bf16*)(wb + WO_UE), r, scr, F.lane); return; } r -= I_UE;
    if (r < I_O) { tr_plain(A.in[23] + (size_t)l * DM_ * DM_, DM_, DM_, (bf16*)(wb + WO_O), r, scr, F.lane); return; } r -= I_O;
    if (r < I_F) { tr_ffn13(A.in[24] + (size_t)l * DM_ * DFF, (bf16*)(wb + WO_13), r, 0, scr, F.lane); return; } r -= I_F;
    if (r < I_F) { tr_ffn13(A.in[25] + (size_t)l * DM_ * DFF, (bf16*)(wb + WO_13), r, 1, scr, F.lane); return; } r -= I_F;
    tr_plain(A.in[26] + (size_t)l * DFF * DM_, DFF, DM_, (bf16*)(wb + WO_2), r, scr, F.lane);
}
__device__ __forceinline__ void p0_dynamic(Frame& F, const Args& A, const int l, unsigned* cnt, const int lo_, const int hi) {
    LAS float* scr = (LAS float*)(F.lds + F.wave * 16384);
    volatile LAS unsigned* slot = (volatile LAS unsigned*)(F.lds + MISC_OFF) + 16;
    for (;;) {
        if (F.tid == 0) slot[0] = __hip_atomic_fetch_add(cnt, 64u, __ATOMIC_RELAXED, __HIP_MEMORY_SCOPE_AGENT);
        __syncthreads();
        const int base = lo_ + (int)slot[0];
        __syncthreads();
        if (base >= hi) break;
        for (int k = 0; k < 8; ++k) { const int it = base + F.wave * 8 + k; if (it < hi) p0_item(F, A, l, it, scr); }
    }
}
__device__ __forceinline__ void p0_phase(Frame& F, const Args& A, const int l, const bool gemv, const int ilo, const int ihi) {
    LAS float* scr = (LAS float*)(F.lds + F.wave * 16384);
    const int gw = F.bid * 8 + F.wave, NGW = F.G * 8;
    for (int it = ilo + gw; it < ilo + (ihi - ilo) * REP_P0; it += NGW) p0_item(F, A, l, ilo + (it - ilo) % (ihi - ilo), scr);
    __syncthreads();
    if (!gemv) return;
    LAS float* red = (LAS float*)F.lds;
    const float* cl = A.in[1]; const float* cc = A.in[3];
    for (int it = F.bid; it < 2 * 192; it += F.G) {
        const int lg = it / 192, jb = it % 192, kg = F.tid >> 4, jl = F.tid & 15;
        const float* wp = A.in[4] + ((size_t)lg * DM_ + kg * 64) * 12288 + jb * 64 + jl * 4;
        f32x4 al = {0.f, 0.f, 0.f, 0.f}, ac = {0.f, 0.f, 0.f, 0.f};
#pragma unroll 8
        for (int kk = 0; kk < 64; ++kk) {
            const f32x4 w = __builtin_nontemporal_load((const f32x4*)(wp + (size_t)kk * 12288));
            const float sl = siluf_(cl[kg * 64 + kk]), sc = siluf_(cc[kg * 64 + kk]);
            al += w * sl; ac += w * sc;
        }
        LAS float* rp = red + (kg * 16 + jl) * 8;
        rp[0] = al.x; rp[1] = al.y; rp[2] = al.z; rp[3] = al.w; rp[4] = ac.x; rp[5] = ac.y; rp[6] = ac.z; rp[7] = ac.w;
        __syncthreads();
        if (F.tid < 128) {
            const int j2 = F.tid & 15, comp = F.tid >> 4; float s = 0.f;
            for (int g = 0; g < 32; ++g) s += red[(g * 16 + j2) * 8 + comp];
            const int sidx = comp >> 2, col = jb * 64 + j2 * 4 + (comp & 3);
            ((float*)(F.ws + WS_MOD))[(size_t)(lg * 2 + sidx) * 12288 + col] = s + A.in[5][(size_t)lg * 12288 + col];
        }
        __syncthreads();
    }
}

template <int MODE> __device__ __forceinline__ void row_phase(Frame& F, const Args& A, int l) {
    const int gw = F.bid * 8 + F.wave, NGW = F.G * 8;
    float* X = (float*)(F.ws + WS_X); const float* Y2 = (const float*)(F.ws + WS_R2); bf16* H = (bf16*)(F.ws + WS_H);
    const float* MOD = (const float*)(F.ws + WS_MOD);
    for (int r = gw + ((MODE >= 1 && l == 1) ? CTXL : 0); r < MROWS; r += NGW) {
        const int s = r < CTXL ? 1 : 0;
        const float* mod = MOD + (size_t)(l * 2 + s) * 12288;
        f32x4 v[8];
        if (MODE == 0) {
            const float* src = s ? A.in[2] + (size_t)r * DM_ : A.in[0] + (size_t)(r - CTXL) * DM_;
#pragma unroll
            for (int j = 0; j < 8; ++j) v[j] = *(const f32x4*)(src + (F.lane + 64 * j) * 4);
        } else {
            const float* y = Y2 + (size_t)r * DM_; float ss = 0.f;
            const float* w = (MODE == 1 ? A.in[7] : A.in[9]) + (size_t)l * DM_;
            const float* gate = mod + (MODE == 1 ? 2 : 5) * DM_;
            f32x4 xv[8], wv[8], gv[8];
#pragma unroll
            for (int j = 0; j < 8; ++j) { const int c = (F.lane + 64 * j) * 4; v[j] = *(const f32x4*)(y + c); xv[j] = *(const f32x4*)(X + (size_t)r * DM_ + c); wv[j] = *(const f32x4*)(w + c); gv[j] = *(const f32x4*)(gate + c); }
#pragma unroll
            for (int j = 0; j < 8; ++j) ss += v[j].x * v[j].x + v[j].y * v[j].y + v[j].z * v[j].z + v[j].w * v[j].w;
            const float rs = __builtin_amdgcn_rsqf(wave_sum(ss) * (1.0f / DM_) + 1e-6f);
#pragma unroll
            for (int j = 0; j < 8; ++j) v[j] = xv[j] + gv[j] * (v[j] * rs * wv[j]);
        }
        if (MODE == 2 && l == 1) {
            if (!s) {
#pragma unroll
                for (int j = 0; j < 8; ++j) *(f32x4*)(F.out + (size_t)(r - CTXL) * DM_ + (F.lane + 64 * j) * 4) = v[j];
            }
            continue;
        }
        float ss = 0.f;
        const float* wn = (MODE == 0 ? A.in[6] : MODE == 1 ? A.in[8] + (size_t)l * DM_ : A.in[6] + (size_t)(l + 1) * DM_);
        const float* modn = (MODE == 2) ? MOD + (size_t)((l + 1) * 2 + s) * 12288 : mod;
        const float* sh = modn + (MODE == 1 ? 3 : 0) * DM_; const float* sc = sh + DM_;
#pragma unroll
        for (int j = 0; j < 8; ++j) { *(f32x4*)(X + (size_t)r * DM_ + (F.lane + 64 * j) * 4) = v[j]; ss += v[j].x * v[j].x + v[j].y * v[j].y + v[j].z * v[j].z + v[j].w * v[j].w; }
        const float rs2 = __builtin_amdgcn_rsqf(wave_sum(ss) * (1.0f / DM_) + 1e-6f);
#pragma unroll
        for (int j = 0; j < 8; ++j) { const int c = (F.lane + 64 * j) * 4;
            const f32x4 wv = *(const f32x4*)(wn + c), shv = *(const f32x4*)(sh + c), scv = *(const f32x4*)(sc + c);
            const f32x4 h = (v[j] * rs2 * wv) * (1.0f + scv) + shv;
            v2u o; o.x = pk2(h.x, h.y); o.y = pk2(h.z, h.w);
            *(v2u*)(H + (size_t)r * DM_ + c) = o; }
    }
}
__device__ __forceinline__ void prep_phase(Frame& F, const Args& A, int l) {
    const int gw = F.bid * 8 + F.wave, NGW = F.G * 8, lane = F.lane;
    const bf16* Z = (const bf16*)(F.ws + WS_Z); const float* ZG = (const float*)(F.ws + WS_ZG);
    bf16* AQ = (bf16*)(F.ws + WS_AQ); bf16* AK = (bf16*)(F.ws + WS_AK); bf16* AV = (bf16*)(F.ws + WS_AV);
    bf16* DQ = (bf16*)(F.ws + WS_DQ); bf16* DK = (bf16*)(F.ws + WS_DK); bf16* DV = (bf16*)(F.ws + WS_DV);
    float* DG = (float*)(F.ws + WS_DGB); float* DB = DG + 16 * MROWS;
    const float* conv_w = A.in[16] + (size_t)l * 5 * 3072;
    const float* a_log = A.in[17] + l * 16; const float* dt_bias = A.in[18] + l * 16;
    constexpr float C2 = 0.125f * 1.4426950408889634f;
    for (int g_ = gw; g_ < (MROWS / 4) * REP_ROWS; g_ += NGW) {
        const int r0 = (g_ % (MROWS / 4)) * 4;
        const bool lat = r0 >= CTXL; const int lo = lat ? CTXL : 0, hi = lat ? MROWS : CTXL;
        for (int it = 0; it < 6; ++it) {
            const int ch0 = it * 512 + lane * 8, p = it >> 1;
            v4u xr[8];
#pragma unroll
            for (int j = 0; j < 8; ++j) { const int rr = r0 + j - 2; xr[j] = (rr >= lo && rr < hi) ? *(const v4u*)(Z + (size_t)rr * ZP + C_EQ + ch0) : (v4u){0u, 0u, 0u, 0u}; }
            float acc[4][8];
#pragma unroll
            for (int j = 0; j < 4; ++j)
#pragma unroll
                for (int e = 0; e < 8; ++e) acc[j][e] = 0.f;
#pragma unroll
            for (int i = 0; i < 5; ++i) {
                const f32x4 c0 = *(const f32x4*)(conv_w + i * 3072 + ch0), c1 = *(const f32x4*)(conv_w + i * 3072 + ch0 + 4);
#pragma unroll
                for (int j = 0; j < 4; ++j) { const v4u x = xr[j + i];
                    acc[j][0] += bflo(x.x) * c0.x; acc[j][1] += bfhi(x.x) * c0.y; acc[j][2] += bflo(x.y) * c0.z; acc[j][3] += bfhi(x.y) * c0.w;
                    acc[j][4] += bflo(x.z) * c1.x; acc[j][5] += bfhi(x.z) * c1.y; acc[j][6] += bflo(x.w) * c1.z; acc[j][7] += bfhi(x.w) * c1.w; }
            }
            bf16* dstb = (p == 0 ? DQ : p == 1 ? DK : DV) + (ch0 & 1023);
#pragma unroll
            for (int j = 0; j < 4; ++j) {
                float sv[8]; float ss = 0.f;
#pragma unroll
                for (int e = 0; e < 8; ++e) { sv[e] = siluf_(acc[j][e]); ss += sv[e] * sv[e]; }
                if (p < 2) {
                    ss += __shfl_xor(ss, 1); ss += __shfl_xor(ss, 2); ss += __shfl_xor(ss, 4); ss += __shfl_xor(ss, 8);
                    const float sc = __builtin_amdgcn_rsqf(ss + 1e-6f) * (p == 0 ? 0.08838834764831845f : 1.0f);
#pragma unroll
                    for (int e = 0; e < 8; ++e) sv[e] *= sc;
                }
                v4u o; o.x = pk2(sv[0], sv[1]); o.y = pk2(sv[2], sv[3]); o.z = pk2(sv[4], sv[5]); o.w = pk2(sv[6], sv[7]);
                *(v4u*)(dstb + (size_t)(r0 + j) * 1024) = o;
            }
        }
        {
            const int r = r0 + (lane >> 4), gi = lane & 15;
            const float a = ZG[(size_t)r * 64 + 32 + gi], bt = ZG[(size_t)r * 64 + 48 + gi];
            const float xs = a + dt_bias[gi];
            const float sp = xs > 20.f ? xs : log1pf(expf(xs));
            DG[(size_t)gi * MROWS + r] = -expf(a_log[gi]) * sp;
            DB[(size_t)gi * MROWS + r] = 1.0f / (1.0f + expf(-bt));
        }
        for (int j = 0; j < 4; ++j) {
            const int r = r0 + j, t = r - CTXL; const bf16* zr = Z + (size_t)r * ZP;
            const v4u qv = *(const v4u*)(zr + C_DQ + lane * 8), kv = *(const v4u*)(zr + C_DK + lane * 8), vv = *(const v4u*)(zr + C_DV + lane * 8);
            *(v4u*)(AV + (size_t)r * 512 + lane * 8) = vv;
            float q[8], k[8];
            q[0] = bflo(qv.x); q[1] = bfhi(qv.x); q[2] = bflo(qv.y); q[3] = bfhi(qv.y); q[4] = bflo(qv.z); q[5] = bfhi(qv.z); q[6] = bflo(qv.w); q[7] = bfhi(qv.w);
            k[0] = bflo(kv.x); k[1] = bfhi(kv.x); k[2] = bflo(kv.y); k[3] = bfhi(kv.y); k[4] = bflo(kv.z); k[5] = bfhi(kv.z); k[6] = bflo(kv.w); k[7] = bfhi(kv.w);
            if (lat) {
                const int sub = lane & 3, part = (lane >> 2) & 1; const float pos = (float)(part ? (t & 63) : (t >> 6));
                const float sgn = (sub & 2) ? 1.0f : -1.0f;
#pragma unroll
                for (int e = 0; e < 8; ++e) {
                    const float qp = __shfl_xor(q[e], 2), kp = __shfl_xor(k[e], 2);
                    const int i = (sub & 1) * 8 + e;
                    const float inv = __builtin_amdgcn_exp2f(-(float)i * 0.8304820237218406f);
                    const float rev = (pos * inv) * 0.15915494309189535f;
                    const float cs = __builtin_amdgcn_cosf(rev), sn = __builtin_amdgcn_sinf(rev);
                    q[e] = q[e] * cs + sgn * qp * sn; k[e] = k[e] * cs + sgn * kp * sn;
                }
            }
            v4u qo, ko;
            qo.x = pk2(q[0] * C2, q[1] * C2); qo.y = pk2(q[2] * C2, q[3] * C2); qo.z = pk2(q[4] * C2, q[5] * C2); qo.w = pk2(q[6] * C2, q[7] * C2);
            ko.x = pk2(k[0], k[1]); ko.y = pk2(k[2], k[3]); ko.z = pk2(k[4], k[5]); ko.w = pk2(k[6], k[7]);
            *(v4u*)(AQ + (size_t)r * 512 + lane * 8) = qo; *(v4u*)(AK + (size_t)r * 512 + lane * 8) = ko;
        }
    }
}

__device__ __forceinline__ int scan_row(int dir, int n, int i) {
    if (dir == 0) return 64 * n + i;
    return (n < 4 ? 64 * (3 - n) : CTXL + 64 * (127 - (n - 4))) + 63 - i;
}

__device__ __forceinline__ void gla_chain_naive(Frame& F, const Args& A, int l, int chain) {
    const int dir = chain >> 2, h = chain & 3, tid = F.tid, lane = F.lane;
    const bf16* Z = (const bf16*)(F.ws + WS_Z); const float* ZG = (const float*)(F.ws + WS_ZG);
    float* OA = (float*)(F.ws + WS_YB) + (size_t)dir * MROWS * 512;
    const float* w2 = A.in[11] + ((size_t)(l * 2 + dir) * 16) * 512 + h * 128; const float* gb = A.in[12] + (size_t)(l * 2 + dir) * 512 + h * 128;
    LAS bf16* qs = (LAS bf16*)F.lds; LAS bf16* ks = qs + 64 * 128; LAS bf16* vs = ks + 64 * 128; LAS float* eg = (LAS float*)(F.lds + 49152);
    float S[64];
#pragma unroll
    for (int d = 0; d < 64; ++d) S[d] = 0.f;
    const int col = (tid >> 6) * 32 + (lane & 31), half = lane >> 5;
    for (int n = 0; n < 132; ++n) {
        for (int p = tid; p < 1024; p += 512) { const int i = p >> 4, c8 = (p & 15) * 8; const bf16* zr = Z + (size_t)scan_row(dir, n, i) * ZP + h * 128 + c8;
            *(LAS v4u*)(qs + i * 128 + c8) = *(const v4u*)(zr + C_GQ); *(LAS v4u*)(ks + i * 128 + c8) = *(const v4u*)(zr + C_GK); *(LAS v4u*)(vs + i * 128 + c8) = *(const v4u*)(zr + C_GV); }
        {   const int i = tid >> 3, dg = (tid & 7) * 16; const float* lr = ZG + (size_t)scan_row(dir, n, i) * 64 + dir * 16;
            float x[16];
#pragma unroll
            for (int jj = 0; jj < 16; ++jj) x[jj] = gb[dg + jj];
            for (int j = 0; j < 16; ++j) { const float lv = lr[j];
#pragma unroll
                for (int jj = 0; jj < 16; ++jj) x[jj] += lv * w2[j * 512 + dg + jj]; }
#pragma unroll
            for (int jj = 0; jj < 16; ++jj) { const float ls = fminf(x[jj], 0.f) - log1pf(expf(-fabsf(x[jj]))); eg[i * 128 + dg + jj] = expf(ls * 0.0625f); }
        }
        __syncthreads();
        if (tid < 256) {
            for (int i = 0; i < 64; ++i) {
                const float vv = bf2f(vs[i * 128 + col]); float o = 0.f;
#pragma unroll
                for (int d4 = 0; d4 < 16; ++d4) {
                    const f32x4 e4 = *(const LAS f32x4*)(eg + i * 128 + half * 64 + d4 * 4);
                    const v2u k2 = *(const LAS v2u*)(ks + i * 128 + half * 64 + d4 * 4), q2 = *(const LAS v2u*)(qs + i * 128 + half * 64 + d4 * 4);
                    S[d4 * 4 + 0] = S[d4 * 4 + 0] * e4.x + bflo(k2.x) * vv; o += S[d4 * 4 + 0] * bflo(q2.x);
                    S[d4 * 4 + 1] = S[d4 * 4 + 1] * e4.y + bfhi(k2.x) * vv; o += S[d4 * 4 + 1] * bfhi(q2.x);
                    S[d4 * 4 + 2] = S[d4 * 4 + 2] * e4.z + bflo(k2.y) * vv; o += S[d4 * 4 + 2] * bflo(q2.y);
                    S[d4 * 4 + 3] = S[d4 * 4 + 3] * e4.w + bfhi(k2.y) * vv; o += S[d4 * 4 + 3] * bfhi(q2.y);
                }
                o += __shfl_xor(o, 32);
                if (half == 0) OA[(size_t)scan_row(dir, n, i) * 512 + h * 128 + col] = o * 0.08838834764831845f;
            }
        }
        __syncthreads();
    }
}
__device__ __forceinline__ void delta_chain_naive(Frame& F, const Args& A, int chain) {
    const int dir = chain >> 3, h = chain & 7, tid = F.tid, lane = F.lane;
    const bf16* DQ = (const bf16*)(F.ws + WS_DQ); const bf16* DK = (const bf16*)(F.ws + WS_DK); const bf16* DV = (const bf16*)(F.ws + WS_DV);
    const float* DG = (const float*)(F.ws + WS_DGB) + (size_t)chain * MROWS; const float* DB = (const float*)(F.ws + WS_DGB) + (size_t)(16 + chain) * MROWS;
    float* OE = (float*)(F.ws + WS_R2) + (size_t)dir * MROWS * 1024;
    LAS bf16* qs = (LAS bf16*)F.lds; LAS bf16* ks = qs + 64 * 128; LAS bf16* vs = ks + 64 * 128; LAS float* gs = (LAS float*)(F.lds + 49152);
    float S[64];
#pragma unroll
    for (int d = 0; d < 64; ++d) S[d] = 0.f;
    const int col = (tid >> 6) * 32 + (lane & 31), half = lane >> 5;
    for (int n = 0; n < 132; ++n) {
        for (int p = tid; p < 1024; p += 512) { const int i = p >> 4, c8 = (p & 15) * 8; const size_t off = (size_t)scan_row(dir, n, i) * 1024 + h * 128 + c8;
            *(LAS v4u*)(qs + i * 128 + c8) = *(const v4u*)(DQ + off); *(LAS v4u*)(ks + i * 128 + c8) = *(const v4u*)(DK + off); *(LAS v4u*)(vs + i * 128 + c8) = *(const v4u*)(DV + off); }
        if (tid < 64) { const int r = scan_row(dir, n, tid); gs[tid] = expf(DG[r]); gs[64 + tid] = DB[r]; }
        __syncthreads();
        if (tid < 256) {
            for (int i = 0; i < 64; ++i) {
                const float vv = bf2f(vs[i * 128 + col]), egv = gs[i], beta = gs[64 + i];
                float kf[64]; float kS = 0.f;
#pragma unroll
                for (int d4 = 0; d4 < 16; ++d4) { const v2u k2 = *(const LAS v2u*)(ks + i * 128 + half * 64 + d4 * 4);
                    kf[d4 * 4 + 0] = bflo(k2.x); kf[d4 * 4 + 1] = bfhi(k2.x); kf[d4 * 4 + 2] = bflo(k2.y); kf[d4 * 4 + 3] = bfhi(k2.y);
                    kS += kf[d4 * 4 + 0] * S[d4 * 4 + 0] + kf[d4 * 4 + 1] * S[d4 * 4 + 1] + kf[d4 * 4 + 2] * S[d4 * 4 + 2] + kf[d4 * 4 + 3] * S[d4 * 4 + 3]; }
                kS += __shfl_xor(kS, 32);
                const float u = beta * (vv - egv * kS); float o = 0.f;
#pragma unroll
                for (int d4 = 0; d4 < 16; ++d4) { const v2u q2 = *(const LAS v2u*)(qs + i * 128 + half * 64 + d4 * 4);
                    S[d4 * 4 + 0] = S[d4 * 4 + 0] * egv + kf[d4 * 4 + 0] * u; o += S[d4 * 4 + 0] * bflo(q2.x);
                    S[d4 * 4 + 1] = S[d4 * 4 + 1] * egv + kf[d4 * 4 + 1] * u; o += S[d4 * 4 + 1] * bfhi(q2.x);
                    S[d4 * 4 + 2] = S[d4 * 4 + 2] * egv + kf[d4 * 4 + 2] * u; o += S[d4 * 4 + 2] * bflo(q2.y);
                    S[d4 * 4 + 3] = S[d4 * 4 + 3] * egv + kf[d4 * 4 + 3] * u; o += S[d4 * 4 + 3] * bfhi(q2.y); }
                o += __shfl_xor(o, 32);
                if (half == 0) OE[(size_t)scan_row(dir, n, i) * 1024 + h * 128 + col] = o;
            }
        }
        __syncthreads();
    }
}

__device__ __forceinline__ void out_phase(Frame& F, const Args& A, int l) {
    const int gw = F.bid * 8 + F.wave, NGW = F.G * 8, lane = F.lane;
    const bf16* Z = (const bf16*)(F.ws + WS_Z); const bf16* AO = (const bf16*)(F.ws + WS_AO);
    const float* OA = (const float*)(F.ws + WS_YB); const float* OE = (const float*)(F.ws + WS_R2);
    bf16* A_ = (bf16*)(F.ws + WS_A); bf16* D_ = (bf16*)(F.ws + WS_D); bf16* E_ = (bf16*)(F.ws + WS_E);
    const float lam_init = l == 0 ? 0.2f : 0.35550906759096924f;
    const float* lp = A.in[14] + l * 256;
    const float lam = expf(wave_sum(lp[lane] * lp[64 + lane])) - expf(wave_sum(lp[128 + lane] * lp[192 + lane])) + lam_init;
    const float* gnw = A.in[13] + l * 128 + lane * 2; const float* dnw = A.in[15] + l * 128 + lane * 2; const float* enw = A.in[19] + l * 128 + lane * 2;
    const float gw0 = gnw[0], gw1 = gnw[1], dw0 = dnw[0], dw1 = dnw[1], ew0 = enw[0], ew1 = enw[1];
    for (int r = gw; r < MROWS; r += NGW) {
        const bf16* zr = Z + (size_t)r * ZP;
        for (int h = 0; h < 4; ++h) {
            const int c = h * 128 + lane * 2;
            {   const float* o0 = OA + (size_t)r * 512 + c; const float* o1 = o0 + (size_t)MROWS * 512;
                const float x0 = o0[0] + o1[0], x1 = o0[1] + o1[1];
                const float rs = __builtin_amdgcn_rsqf(wave_sum(x0 * x0 + x1 * x1) * (1.0f / 128.f) + 1e-6f);
                const unsigned g = *(const unsigned*)(zr + C_GG + c);
                *(unsigned*)(A_ + (size_t)r * 512 + c) = pk2(x0 * rs * gw0 * siluf_(bflo(g)), x1 * rs * gw1 * siluf_(bfhi(g))); }
            {   const unsigned w1 = *(const unsigned*)(AO + (size_t)r * 1024 + (h * 2) * 128 + lane * 2), w2 = *(const unsigned*)(AO + (size_t)r * 1024 + (h * 2 + 1) * 128 + lane * 2);
                const float x0 = bflo(w1) - lam * bflo(w2), x1 = bfhi(w1) - lam * bfhi(w2);
                const float rs = __builtin_amdgcn_rsqf(wave_sum(x0 * x0 + x1 * x1) * (1.0f / 128.f) + 1e-6f) * (1.0f - lam_init);
                *(unsigned*)(D_ + (size_t)r * 512 + c) = pk2(x0 * rs * dw0, x1 * rs * dw1); }
        }
        for (int h = 0; h < 8; ++h) {
            const int c = h * 128 + lane * 2;
            const float* o0 = OE + (size_t)r * 1024 + c; const float* o1 = o0 + (size_t)MROWS * 1024;
            const float x0 = o0[0] + o1[0], x1 = o0[1] + o1[1];
            const float rs = __builtin_amdgcn_rsqf(wave_sum(x0 * x0 + x1 * x1) * (1.0f / 128.f) + 1e-6f);
            const unsigned g = *(const unsigned*)(zr + C_EG + c);
            *(unsigned*)(E_ + (size_t)r * 1024 + c) = pk2(x0 * rs * ew0 * siluf_(bflo(g)), x1 * rs * ew1 * siluf_(bfhi(g)));
        }
    }
}
typedef short bf16x8_t __attribute__((ext_vector_type(8)));
#define LBAR() do { asm volatile("s_waitcnt lgkmcnt(0)" ::: "memory"); __builtin_amdgcn_s_barrier(); asm volatile("" ::: "memory"); } while (0)
constexpr int P128 = 136, P64 = 72;
template <int K> __device__ __forceinline__ f32x4 mma16(const LAS bf16* A, int lda, const LAS bf16* Bt, int ldb, f32x4 acc, int lane) {
    const int r = lane & 15, q = lane >> 4;
    const LAS bf16* ap = A + r * lda + q * 8; const LAS bf16* bp = Bt + r * ldb + q * 8;
#pragma unroll
    for (int k0 = 0; k0 < K; k0 += 32) {
        const bf16x8_t a = *(const LAS bf16x8_t*)(ap + k0), b = *(const LAS bf16x8_t*)(bp + k0);
        acc = __builtin_amdgcn_mfma_f32_16x16x32_bf16(a, b, acc, 0, 0, 0);
    }
    return acc;
}
__device__ __forceinline__ int chunk_scan_index(int dir, int c) { return dir == 0 ? c : (c < 4 ? 3 - c : 135 - c); }
__device__ __forceinline__ float wave_incl_scan(float x, int lane) {
#pragma unroll
    for (int o = 1; o < 64; o <<= 1) { const float t = __shfl_up(x, o); if (lane >= o) x += t; }
    return x;
}
constexpr size_t WS_DS = WS_W0 + W_LAYER;
constexpr size_t WS_PP = WS_DS, WS_NT = WS_DS + 66 * MiB, WS_GL = WS_DS + 132 * MiB, WS_GD = WS_GL + 1 * MiB;
constexpr size_t WS_UG = WS_H, WS_WG = WS_END, WS_GS = WS_R2, WS_BS = WS_YB;
constexpr size_t WS_END2 = WS_END + 33 * MiB;

__device__ __forceinline__ void delta_prep2_item(Frame& F, int chain, int n) {
    const int dir = chain >> 3, h = chain & 7, tid = F.tid, lane = F.lane, w = F.wave;
    const bf16* DK = (const bf16*)(F.ws + WS_DK); const bf16* DV = (const bf16*)(F.ws + WS_DV);
    const float* DG = (const float*)(F.ws + WS_DGB) + (size_t)chain * MROWS; const float* DB = (const float*)(F.ws + WS_DGB) + (size_t)(16 + chain) * MROWS;
    const size_t item = (size_t)chain * 132 + n;
    bf16* Pp = (bf16*)(F.ws + WS_PP) + item * 16384; bf16* NT = (bf16*)(F.ws + WS_NT) + item * 16384;
    bf16* Ug = (bf16*)(F.ws + WS_UG) + item * 8192; bf16* Wg = (bf16*)(F.ws + WS_WG) + item * 8192;
    LAS bf16* Ks = (LAS bf16*)(F.lds);
    LAS float* AM = (LAS float*)(F.lds + 18432);
    LAS bf16* UT = (LAS bf16*)(F.lds);
    LAS bf16* KbT = (LAS bf16*)(F.lds + 35840);
    LAS bf16* KdT = (LAS bf16*)(F.lds + 54272);
    LAS bf16* VbT = (LAS bf16*)(F.lds + 72704);
    LAS bf16* TB = (LAS bf16*)(F.lds + 91136);
    LAS bf16* WT = (LAS bf16*)(F.lds + 100352);
    LAS float* gcs = (LAS float*)(F.lds + 118784); LAS float* bts = gcs + 64;
    const int ip = tid & 31, c8 = (tid >> 5) * 8, i0 = 2 * ip, i1 = i0 + 1;
    const size_t off0 = (size_t)scan_row(dir, n, i0) * 1024 + h * 128 + c8, off1 = (size_t)scan_row(dir, n, i1) * 1024 + h * 128 + c8;
    const v4u kv0 = *(const v4u*)(DK + off0), kv1 = *(const v4u*)(DK + off1), vv0 = *(const v4u*)(DV + off0), vv1 = *(const v4u*)(DV + off1);
    if (w == 0) { const int r = scan_row(dir, n, lane); gcs[lane] = wave_incl_scan(DG[r], lane); bts[lane] = DB[r]; }
    LBAR();
    const float gclast = gcs[63];
    {
        *(LAS v4u*)(Ks + i0 * P128 + c8) = kv0; *(LAS v4u*)(Ks + i1 * P128 + c8) = kv1;
        const float bt0 = bts[i0], bt1 = bts[i1], fb0 = bt0 * __expf(gcs[i0]), fb1 = bt1 * __expf(gcs[i1]), fd0 = __expf(gclast - gcs[i0]), fd1 = __expf(gclast - gcs[i1]);
        const unsigned k0w[4] = {kv0.x, kv0.y, kv0.z, kv0.w}, k1w[4] = {kv1.x, kv1.y, kv1.z, kv1.w}, v0w[4] = {vv0.x, vv0.y, vv0.z, vv0.w}, v1w[4] = {vv1.x, vv1.y, vv1.z, vv1.w};
#pragma unroll
        for (int e = 0; e < 4; ++e) {
            const float ka0 = bflo(k0w[e]), kb0 = bfhi(k0w[e]), ka1 = bflo(k1w[e]), kb1 = bfhi(k1w[e]);
            const float va0 = bflo(v0w[e]), vb0 = bfhi(v0w[e]), va1 = bflo(v1w[e]), vb1 = bfhi(v1w[e]);
            const int ca = (c8 + 2 * e) * P64 + i0, cb = (c8 + 2 * e + 1) * P64 + i0;
            *(LAS unsigned*)(KbT + ca) = pk2(ka0 * fb0, ka1 * fb1); *(LAS unsigned*)(KbT + cb) = pk2(kb0 * fb0, kb1 * fb1);
            *(LAS unsigned*)(KdT + ca) = pk2(ka0 * fd0, ka1 * fd1); *(LAS unsigned*)(KdT + cb) = pk2(kb0 * fd0, kb1 * fd1);
            *(LAS unsigned*)(VbT + ca) = pk2(va0 * bt0, va1 * bt1); *(LAS unsigned*)(VbT + cb) = pk2(vb0 * bt0, vb1 * bt1);
        }
    }
    LBAR();
    const int r = lane & 15, q = lane >> 4;
#pragma unroll
    for (int t2 = 0; t2 < 2; ++t2) {
        const int t = w * 2 + t2, mi = t >> 2, nj = t & 3;
        const f32x4 acc = mma16<128>(Ks + 16 * mi * P128, P128, Ks + 16 * nj * P128, P128, (f32x4){0.f, 0.f, 0.f, 0.f}, lane);
        const int j = 16 * nj + r; const float gj = gcs[j];
#pragma unroll
        for (int jj = 0; jj < 4; ++jj) { const int i = 16 * mi + 4 * q + jj;
            AM[i * 68 + j] = (j < i) ? bts[i] * acc[jj] * __expf(gcs[i] - gj) : 0.f; }
    }
    LBAR();
    {
        LAS float* TM = (LAS float*)(F.lds + 119296);
        LAS float* XM = (LAS float*)(F.lds + 136704);
        if (w == 0) {
            const int b16 = 16 * (lane >> 4), c = lane & 15;
            float t[16];
#pragma unroll
            for (int i = 0; i < 16; ++i) {
                float s_ = (i == c) ? 1.f : 0.f;
#pragma unroll
                for (int j4 = 0; j4 < (i + 3) / 4; ++j4) {
                    const f32x4 a = *(const LAS f32x4*)(AM + (b16 + i) * 68 + b16 + j4 * 4);
                    if (j4 * 4 + 0 < i) s_ -= a.x * t[j4 * 4 + 0];
                    if (j4 * 4 + 1 < i) s_ -= a.y * t[j4 * 4 + 1];
                    if (j4 * 4 + 2 < i) s_ -= a.z * t[j4 * 4 + 2];
                    if (j4 * 4 + 3 < i) s_ -= a.w * t[j4 * 4 + 3];
                }
                t[i] = s_;
                TM[(b16 + i) * 68 + b16 + c] = s_;
            }
        }
        LBAR();
        const int rr = (tid >> 4) & 15, cc = tid & 15;
#pragma unroll
        for (int d = 1; d < 4; ++d) {
            for (int blk = tid >> 8; blk < 4 - d; blk += 2) {
                const int bj = blk, bi = blk + d; float x = 0.f;
                for (int k = bj; k < bi; ++k)
#pragma unroll
                    for (int m = 0; m < 16; ++m) x += AM[(16 * bi + rr) * 68 + 16 * k + m] * TM[(16 * k + m) * 68 + 16 * bj + cc];
                XM[(blk * 16 + rr) * 17 + cc] = x;
            }
            LBAR();
            for (int blk = tid >> 8; blk < 4 - d; blk += 2) {
                const int bj = blk, bi = blk + d; float x = 0.f;
#pragma unroll
                for (int m = 0; m < 16; ++m) x -= TM[(16 * bi + rr) * 68 + 16 * bi + m] * XM[(blk * 16 + m) * 17 + cc];
                TM[(16 * bi + rr) * 68 + 16 * bj + cc] = x;
            }
            LBAR();
        }
        {   const int i = tid >> 3, j0 = (tid & 7) * 8; float v[8];
#pragma unroll
            for (int e = 0; e < 8; ++e) v[e] = ((j0 + e) >> 4) > (i >> 4) ? 0.f : TM[i * 68 + j0 + e];
            v4u o; o.x = pk2(v[0], v[1]); o.y = pk2(v[2], v[3]); o.z = pk2(v[4], v[5]); o.w = pk2(v[6], v[7]);
            *(LAS v4u*)(TB + i * P64 + j0) = o; }
    }
    LBAR();
#pragma unroll
    for (int t4 = 0; t4 < 4; ++t4) {
        const int t = w * 4 + t4, mi = t >> 3, nv = t & 7;
        const f32x4 u = mma16<64>(TB + 16 * mi * P64, P64, VbT + 16 * nv * P64, P64, (f32x4){0.f, 0.f, 0.f, 0.f}, lane);
        const f32x4 ww = mma16<64>(TB + 16 * mi * P64, P64, KbT + 16 * nv * P64, P64, (f32x4){0.f, 0.f, 0.f, 0.f}, lane);
        const int c = 16 * nv + r, i0 = 16 * mi + 4 * q;
        v2u up; up.x = pk2(u[0], u[1]); up.y = pk2(u[2], u[3]);
        v2u wp; wp.x = pk2(ww[0], ww[1]); wp.y = pk2(ww[2], ww[3]);
        *(LAS v2u*)(UT + c * P64 + i0) = up; *(LAS v2u*)(WT + c * P64 + i0) = wp;
        *(v2u*)(Ug + c * 64 + i0) = up;
#pragma unroll
        for (int jj = 0; jj < 4; ++jj) Wg[(i0 + jj) * 128 + c] = (bf16)f2bf(ww[jj]);
    }
    LBAR();
#pragma unroll
    for (int t8 = 0; t8 < 8; ++t8) {
        const int mb = w, na = t8;
        const f32x4 pt = mma16<64>(WT + 16 * mb * P64, P64, KdT + 16 * na * P64, P64, (f32x4){0.f, 0.f, 0.f, 0.f}, lane);
        v2u pp; pp.x = pk2(-pt[0], -pt[1]); pp.y = pk2(-pt[2], -pt[3]);
        *(v2u*)(Pp + ((size_t)((na * 4 + (mb >> 1)) * 64 + lane)) * 8 + 4 * (mb & 1)) = pp;
        const int ma = w, nv = t8;
        const f32x4 nn = mma16<64>(KdT + 16 * ma * P64, P64, UT + 16 * nv * P64, P64, (f32x4){0.f, 0.f, 0.f, 0.f}, lane);
        v2u np; np.x = pk2(nn[0], nn[1]); np.y = pk2(nn[2], nn[3]);
        *(v2u*)(NT + (size_t)(16 * nv + r) * 128 + 16 * ma + 4 * q) = np;
    }
    if (tid == 0) ((float*)(F.ws + WS_GL))[item] = __expf(gclast);
    LBAR();
}

constexpr int CH_SLOT = 32768 + 128 * P128 * 2;
#define CH_BAR() do { asm volatile("s_waitcnt lgkmcnt(0)" ::: "memory"); __builtin_amdgcn_s_barrier(); asm volatile("" ::: "memory"); } while (0)
__device__ __forceinline__ void delta_chain(Frame& F, int chain) {
    const int tid = F.tid, lane = F.lane, w = F.wave, r = lane & 15, q = lane >> 4;
    const bf16* Pp = (const bf16*)(F.ws + WS_PP) + (size_t)chain * 132 * 16384; bf16* NT = (bf16*)(F.ws + WS_NT) + (size_t)chain * 132 * 16384;
    LAS unsigned char* ring = F.lds; LAS float* gls = (LAS float*)(F.lds + 2 * CH_SLOT);
    if (tid < 132) gls[tid] = ((const float*)(F.ws + WS_GL))[chain * 132 + tid];
    if (w >= 4) {
        const int lt = tid - 256;
        unsigned ndst[8];
#pragma unroll
        for (int k = 0; k < 8; ++k) { const int p = lt + 256 * k; ndst[k] = 32768u + (unsigned)((p >> 4) * P128 + (p & 15) * 8) * 2u; }
        v4u rp[3][8], rn[3][8];
#define CH_LOAD(set, step) do { const v4u* ps_ = (const v4u*)(Pp + (size_t)(step) * 16384) + lt; const v4u* ns_ = (const v4u*)(NT + (size_t)(step) * 16384) + lt; \
        _Pragma("unroll") for (int k = 0; k < 8; ++k) { rp[set][k] = ps_[256 * k]; rn[set][k] = ns_[256 * k]; } } while (0)
#define CH_WRITE(set, slot) do { LAS unsigned char* sb_ = ring + (slot) * CH_SLOT; \
        _Pragma("unroll") for (int k = 0; k < 8; ++k) { *(LAS v4u*)(sb_ + (lt + 256 * k) * 16) = rp[set][k]; *(LAS v4u*)(sb_ + ndst[k]) = rn[set][k]; } } while (0)
        CH_LOAD(0, 0); CH_LOAD(1, 1); CH_LOAD(2, 2);
        CH_WRITE(0, 0);
        CH_BAR();
        for (int n = 0; n < 132; n += 3) {
            if (n + 3 < 132) CH_LOAD(0, n + 3);
            CH_WRITE(1, (n + 1) & 1);
            CH_BAR();
            if (n + 4 < 132) CH_LOAD(1, n + 4);
            CH_WRITE(2, (n + 2) & 1);
            CH_BAR();
            if (n + 5 < 132) CH_LOAD(2, n + 5);
            if (n + 3 < 132) CH_WRITE(0, (n + 3) & 1);
            CH_BAR();
        }
#undef CH_LOAD
#undef CH_WRITE
    } else {
        f32x4 acc[2][8];
#pragma unroll
        for (int nb = 0; nb < 2; ++nb)
#pragma unroll
            for (int m = 0; m < 8; ++m) acc[nb][m] = (f32x4){0.f, 0.f, 0.f, 0.f};
        bf16* srow = NT + (size_t)(32 * w + r) * 128 + 4 * q;
        const unsigned noff = 32768u + (unsigned)((32 * w + r) * P128 + 4 * q) * 2u;
        CH_BAR();
        for (int n = 0; n < 132; ++n) {
            const LAS unsigned char* slot = ring + (n & 1) * CH_SLOT;
            const float gl = gls[n];
            v2u sp[2][8];
#pragma unroll
            for (int nb = 0; nb < 2; ++nb)
#pragma unroll
                for (int m = 0; m < 8; ++m) {
                    sp[nb][m].x = pk2(acc[nb][m][0], acc[nb][m][1]); sp[nb][m].y = pk2(acc[nb][m][2], acc[nb][m][3]);
                    *(v2u*)(srow + (size_t)n * 16384 + nb * 2048 + 16 * m) = sp[nb][m];
                    const v2u nv = *(const LAS v2u*)(slot + noff + nb * (16 * P128 * 2) + m * 32);
                    acc[nb][m][0] = gl * acc[nb][m][0] + bflo(nv.x); acc[nb][m][1] = gl * acc[nb][m][1] + bfhi(nv.x);
                    acc[nb][m][2] = gl * acc[nb][m][2] + bflo(nv.y); acc[nb][m][3] = gl * acc[nb][m][3] + bfhi(nv.y);
                }
#pragma unroll
            for (int kb = 0; kb < 4; ++kb) {
                const v4u bu0 = {sp[0][2 * kb].x, sp[0][2 * kb].y, sp[0][2 * kb + 1].x, sp[0][2 * kb + 1].y};
                const v4u bu1 = {sp[1][2 * kb].x, sp[1][2 * kb].y, sp[1][2 * kb + 1].x, sp[1][2 * kb + 1].y};
                const bf16x8_t b0 = __builtin_bit_cast(bf16x8_t, bu0), b1 = __builtin_bit_cast(bf16x8_t, bu1);
#pragma unroll
                for (int m = 0; m < 8; ++m) {
                    const bf16x8_t a = *(const LAS bf16x8_t*)(slot + (m * 4 + kb) * 1024 + lane * 16);
                    acc[0][m] = __builtin_amdgcn_mfma_f32_16x16x32_bf16(a, b0, acc[0][m], 0, 0, 0);
                    acc[1][m] = __builtin_amdgcn_mfma_f32_16x16x32_bf16(a, b1, acc[1][m], 0, 0, 0);
                }
            }
            CH_BAR();
        }
    }
    asm volatile("s_waitcnt vmcnt(0)" ::: "memory");
    __syncthreads();
}

__device__ __forceinline__ void delta_out_item(Frame& F, const Args& A, int l, int c, int h) {
    const int tid = F.tid, lane = F.lane, w = F.wave, r = lane & 15, q = lane >> 4;
    const bf16* DQ = (const bf16*)(F.ws + WS_DQ); const bf16* DK = (const bf16*)(F.ws + WS_DK);
    const int row0 = 64 * c;
    LAS bf16* Qs = (LAS bf16*)(F.lds);
    LAS bf16* Ks = (LAS bf16*)(F.lds + 17408);
    LAS bf16* ST = (LAS bf16*)(F.lds + 35840);
    LAS bf16* Ws = (LAS bf16*)(F.lds + 70656);
    LAS bf16* ATT = (LAS bf16*)(F.lds + 88064);
    LAS float* gcs = (LAS float*)(F.lds + 97280);
    LAS bf16* VNT = (LAS bf16*)(F.lds + 97792);
    LAS float* OS = (LAS float*)(F.lds);
    const int mi = w >> 1, nvb = 4 * (w & 1);
    f32x4 oacc[4];
#pragma unroll
    for (int k = 0; k < 4; ++k) oacc[k] = (f32x4){0.f, 0.f, 0.f, 0.f};
    for (int dir = 0; dir < 2; ++dir) {
        const int chain = dir * 8 + h, n = chunk_scan_index(dir, c);
        const size_t item = (size_t)chain * 132 + n;
        const bf16* Sg = (const bf16*)(F.ws + WS_NT) + item * 16384; const bf16* Ug = (const bf16*)(F.ws + WS_UG) + item * 8192; const bf16* Wg = (const bf16*)(F.ws + WS_WG) + item * 8192;
        const float g_in = (w == 0) ? ((const float*)(F.ws + WS_DGB))[(size_t)chain * MROWS + row0 + (dir ? 63 - lane : lane)] : 0.f;
        v2u uu[4];
#pragma unroll
        for (int k = 0; k < 4; ++k) uu[k] = *(const v2u*)(Ug + (16 * (nvb + k) + r) * 64 + (dir ? 60 - (16 * mi + 4 * q) : (16 * mi + 4 * q)));
        {   v4u rq[2], rk[2], rw[2], rs[4];
#pragma unroll
            for (int i2 = 0; i2 < 2; ++i2) { const int p = tid + 512 * i2, t = p >> 4, c8 = (p & 15) * 8; const size_t off = (size_t)(row0 + t) * 1024 + h * 128 + c8;
                if (dir == 0) { rq[i2] = *(const v4u*)(DQ + off); rk[i2] = *(const v4u*)(DK + off); }
                rw[i2] = *(const v4u*)(Wg + (size_t)(dir ? 63 - t : t) * 128 + c8); }
#pragma unroll
            for (int i4 = 0; i4 < 4; ++i4) { const int p = tid + 512 * i4; rs[i4] = *(const v4u*)(Sg + (p >> 4) * 128 + (p & 15) * 8); }
#pragma unroll
            for (int i2 = 0; i2 < 2; ++i2) { const int p = tid + 512 * i2, t = p >> 4, c8 = (p & 15) * 8;
                if (dir == 0) { *(LAS v4u*)(Qs + t * P128 + c8) = rq[i2]; *(LAS v4u*)(Ks + t * P128 + c8) = rk[i2]; }
                *(LAS v4u*)(Ws + t * P128 + c8) = rw[i2]; }
#pragma unroll
            for (int i4 = 0; i4 < 4; ++i4) { const int p = tid + 512 * i4; *(LAS v4u*)(ST + (p >> 4) * P128 + (p & 15) * 8) = rs[i4]; }
        }
        if (w == 0) { const float s_ = wave_incl_scan(g_in, lane); gcs[dir ? 63 - lane : lane] = s_; }
        LBAR();
#pragma unroll
        for (int t2 = 0; t2 < 2; ++t2) {
            const int t = w * 2 + t2, ai = t >> 2, nj = t & 3;
            const f32x4 acc = mma16<128>(Qs + 16 * ai * P128, P128, Ks + 16 * nj * P128, P128, (f32x4){0.f, 0.f, 0.f, 0.f}, lane);
            const int tj = 16 * nj + r; const float gj = gcs[tj];
#pragma unroll
            for (int jj = 0; jj < 4; ++jj) { const int ti = 16 * ai + 4 * q + jj; const bool ok = dir ? (tj >= ti) : (tj <= ti);
                ATT[ti * P64 + tj] = (bf16)f2bf(ok ? acc[jj] * __expf(gcs[ti] - gj) : 0.f); }
        }
#pragma unroll
        for (int k = 0; k < 4; ++k) {
            const int nv = nvb + k;
            const f32x4 ws = mma16<128>(Ws + 16 * mi * P128, P128, ST + 16 * nv * P128, P128, (f32x4){0.f, 0.f, 0.f, 0.f}, lane);
            const int v = 16 * nv + r, t0 = 16 * mi + 4 * q;
            float u[4];
            if (dir == 0) { u[0] = bflo(uu[k].x); u[1] = bfhi(uu[k].x); u[2] = bflo(uu[k].y); u[3] = bfhi(uu[k].y); }
            else { u[3] = bflo(uu[k].x); u[2] = bfhi(uu[k].x); u[1] = bflo(uu[k].y); u[0] = bfhi(uu[k].y); }
            v2u o; o.x = pk2(u[0] - ws[0], u[1] - ws[1]); o.y = pk2(u[2] - ws[2], u[3] - ws[3]);
            *(LAS v2u*)(VNT + v * P64 + t0) = o;
        }
        LBAR();
#pragma unroll
        for (int k = 0; k < 4; ++k) {
            const int nv = nvb + k;
            f32x4 a = mma16<128>(Qs + 16 * mi * P128, P128, ST + 16 * nv * P128, P128, (f32x4){0.f, 0.f, 0.f, 0.f}, lane);
#pragma unroll
            for (int jj = 0; jj < 4; ++jj) a[jj] *= __expf(gcs[16 * mi + 4 * q + jj]);
            a = mma16<64>(ATT + 16 * mi * P64, P64, VNT + 16 * nv * P64, P64, a, lane);
            oacc[k] += a;
        }
        LBAR();
    }
#pragma unroll
    for (int k = 0; k < 4; ++k)
#pragma unroll
        for (int jj = 0; jj < 4; ++jj) OS[(16 * mi + 4 * q + jj) * 132 + 16 * (nvb + k) + r] = oacc[k][jj];
    LBAR();
    {   const float* enw = A.in[19] + l * 128 + lane * 2; const float ew0 = enw[0], ew1 = enw[1];
        const bf16* Z = (const bf16*)(F.ws + WS_Z); bf16* E_ = (bf16*)(F.ws + WS_E);
        unsigned gz[8];
#pragma unroll
        for (int t8 = 0; t8 < 8; ++t8) gz[t8] = *(const unsigned*)(Z + (size_t)(row0 + w * 8 + t8) * ZP + C_EG + h * 128 + lane * 2);
#pragma unroll
        for (int t8 = 0; t8 < 8; ++t8) { const int t = w * 8 + t8;
            const float x0 = OS[t * 132 + lane * 2], x1 = OS[t * 132 + lane * 2 + 1];
            const float rs = __builtin_amdgcn_rsqf(wave_sum(x0 * x0 + x1 * x1) * (1.0f / 128.f) + 1e-6f);
            const size_t row = row0 + t; const unsigned g = gz[t8];
            *(unsigned*)(E_ + row * 1024 + h * 128 + lane * 2) = pk2(x0 * rs * ew0 * siluf_(bflo(g)), x1 * rs * ew1 * siluf_(bfhi(g)));
        }
    }
    LBAR();
}
constexpr int NIN_MAIN = 13824;
__device__ __forceinline__ void g1_tail_item(Frame& F, int it) {
    const int tid = F.tid, lane = F.lane, w = F.wave, r = lane & 15, q = lane >> 4;
    const bf16* Hm = (const bf16*)(F.ws + WS_H) + (size_t)(64 * it) * DM_;
    const bf16* Wt = (const bf16*)(F.ws + WS_W0 + WO_IN) + (size_t)NIN_MAIN * DM_;
    LAS bf16* As = (LAS bf16*)F.lds; LAS bf16* Bs = As + 64 * 264;
    f32x4 acc[2] = {(f32x4){0.f, 0.f, 0.f, 0.f}, (f32x4){0.f, 0.f, 0.f, 0.f}};
    v4u pa[4], pb[4];
#pragma unroll
    for (int k = 0; k < 4; ++k) { const int p = tid + 512 * k, row = p >> 5, c8 = (p & 31) * 8; pa[k] = *(const v4u*)(Hm + (size_t)row * DM_ + c8); pb[k] = *(const v4u*)(Wt + (size_t)row * DM_ + c8); }
    for (int kc = 0; kc < 8; ++kc) {
#pragma unroll
        for (int k = 0; k < 4; ++k) { const int p = tid + 512 * k, row = p >> 5, c8 = (p & 31) * 8; *(LAS v4u*)(As + row * 264 + c8) = pa[k]; *(LAS v4u*)(Bs + row * 264 + c8) = pb[k]; }
        __syncthreads();
        if (kc + 1 < 8) {
#pragma unroll
            for (int k = 0; k < 4; ++k) { const int p = tid + 512 * k, row = p >> 5, c8 = (p & 31) * 8 + (kc + 1) * 256; pa[k] = *(const v4u*)(Hm + (size_t)row * DM_ + c8); pb[k] = *(const v4u*)(Wt + (size_t)row * DM_ + c8); }
        }
#pragma unroll
        for (int t2 = 0; t2 < 2; ++t2) { const int t = w * 2 + t2, mi = t >> 2, nj = t & 3;
            acc[t2] = mma16<256>(As + 16 * mi * 264, 264, Bs + 16 * nj * 264, 264, acc[t2], lane); }
        __syncthreads();
    }
    bf16* Z = (bf16*)(F.ws + WS_Z);
#pragma unroll
    for (int t2 = 0; t2 < 2; ++t2) { const int t = w * 2 + t2, mi = t >> 2, nj = t & 3;
#pragma unroll
        for (int jj = 0; jj < 4; ++jj) Z[(size_t)(64 * it + 16 * mi + 4 * q + jj) * ZP + NIN_MAIN + 16 * nj + r] = (bf16)f2bf(acc[t2][jj]); }
}

__device__ __forceinline__ f32x4 small_mm_acc(Frame& F, const bf16* Ap, int lda, const bf16* Bp, int ldb, int K, f32x4 acc) {
    const int tid = F.tid, lane = F.lane, w = F.wave;
    LAS bf16* As = (LAS bf16*)F.lds; LAS bf16* Bs = As + 32 * 264;
    v4u pa[2][2], pb[2][4];
#define SM_LOAD(set, kc_) do { \
    _Pragma("unroll") for (int k = 0; k < 2; ++k) { const int p = tid + 512 * k, row = p >> 5, c8 = (p & 31) * 8 + (kc_) * 256; pa[set][k] = *(const v4u*)(Ap + (size_t)row * lda + c8); } \
    _Pragma("unroll") for (int k = 0; k < 4; ++k) { const int p = tid + 512 * k, row = p >> 5, c8 = (p & 31) * 8 + (kc_) * 256; pb[set][k] = *(const v4u*)(Bp + (size_t)row * ldb + c8); } } while (0)
#define SM_STEP(set, kc_) do { \
    _Pragma("unroll") for (int k = 0; k < 2; ++k) { const int p = tid + 512 * k, row = p >> 5, c8 = (p & 31) * 8; *(LAS v4u*)(As + row * 264 + c8) = pa[set][k]; } \
    _Pragma("unroll") for (int k = 0; k < 4; ++k) { const int p = tid + 512 * k, row = p >> 5, c8 = (p & 31) * 8; *(LAS v4u*)(Bs + row * 264 + c8) = pb[set][k]; } \
    LBAR(); \
    if ((kc_) + 2 < nk) SM_LOAD(set, (kc_) + 2); \
    acc = mma16<256>(As + 16 * (w >> 2) * 264, 264, Bs + 16 * (w & 3) * 264, 264, acc, lane); \
    LBAR(); } while (0)
    const int nk = K >> 8;
    SM_LOAD(0, 0); SM_LOAD(1, 1);
    for (int kc = 0; kc < nk; kc += 2) { SM_STEP(0, kc); SM_STEP(1, kc + 1); }
#undef SM_LOAD
#undef SM_STEP
    return acc;
}
__device__ __forceinline__ void ctx_f32_item(Frame& F, int it, const bf16* A, int K, const bf16* Bt, float* Y) {
    const int rt = it >> 5, ct = it & 31, lane = F.lane, w = F.wave, r = lane & 15, q = lane >> 4;
    const f32x4 acc = small_mm_acc(F, A + (size_t)(32 * rt) * K, K, Bt + (size_t)(64 * ct) * K, K, K, (f32x4){0.f, 0.f, 0.f, 0.f});
#pragma unroll
    for (int jj = 0; jj < 4; ++jj) Y[(size_t)(32 * rt + 16 * (w >> 2) + 4 * q + jj) * DM_ + 64 * ct + 16 * (w & 3) + r] = acc[jj];
}
__device__ __forceinline__ void ctx_g2_item(Frame& F, int it) {
    const int rt = it >> 5, ct = it & 31, lane = F.lane, w = F.wave, r = lane & 15, q = lane >> 4;
    unsigned char* ws = F.ws; unsigned char* wb = ws + WS_W0;
    const bf16* Zm = (const bf16*)(ws + WS_Z) + C_MG;
    const int col = 64 * ct + 16 * (w & 3) + r, rowb = 32 * rt + 16 * (w >> 2) + 4 * q;
    f32x4 tot = {0.f, 0.f, 0.f, 0.f};
    {   const f32x4 a = small_mm_acc(F, (const bf16*)(ws + WS_A) + (size_t)(32 * rt) * 512, 512, (const bf16*)(wb + WO_UA) + (size_t)(64 * ct) * 512, 512, 512, (f32x4){0.f, 0.f, 0.f, 0.f});
#pragma unroll
        for (int jj = 0; jj < 4; ++jj) tot[jj] += a[jj] * sigmoidf_(bf2f(Zm[(size_t)(rowb + jj) * ZP + col])); }
    {   const f32x4 a = small_mm_acc(F, (const bf16*)(ws + WS_D) + (size_t)(32 * rt) * 512, 512, (const bf16*)(wb + WO_UD) + (size_t)(64 * ct) * 512, 512, 512, (f32x4){0.f, 0.f, 0.f, 0.f});
#pragma unroll
        for (int jj = 0; jj < 4; ++jj) tot[jj] += a[jj] * sigmoidf_(bf2f(Zm[(size_t)(rowb + jj) * ZP + DM_ + col])); }
    {   const f32x4 a = small_mm_acc(F, (const bf16*)(ws + WS_E) + (size_t)(32 * rt) * 1024, 1024, (const bf16*)(wb + WO_UE) + (size_t)(64 * ct) * 1024, 1024, 1024, (f32x4){0.f, 0.f, 0.f, 0.f});
#pragma unroll
        for (int jj = 0; jj < 4; ++jj) tot[jj] += a[jj] * sigmoidf_(bf2f(Zm[(size_t)(rowb + jj) * ZP + 2 * DM_ + col])); }
    bf16* YB = (bf16*)(ws + WS_YB);
#pragma unroll
    for (int jj = 0; jj < 4; ++jj) YB[(size_t)(rowb + jj) * DM_ + col] = (bf16)f2bf(tot[jj]);
}

__device__ __forceinline__ void gla_cum_decay(Frame& F, const Args& A, int l, int dir, int h, int row0, LAS float* bs, LAS float* part, float* bsg) {
    const int tg = F.wave >> 1, d = (F.wave & 1) * 64 + F.lane;
    const float* ZG = (const float*)(F.ws + WS_ZG);
    const float* w2 = A.in[11] + ((size_t)(l * 2 + dir) * 16) * 512 + h * 128 + d; const float bd = A.in[12][(size_t)(l * 2 + dir) * 512 + h * 128 + d];
    float wc[16], g[16];
#pragma unroll
    for (int j = 0; j < 16; ++j) wc[j] = w2[j * 512];
    LAS float* lrs = part + 512;
    {   const int t = F.tid >> 3, j2 = (F.tid & 7) * 2; const float* src = ZG + (size_t)(row0 + t) * 64 + dir * 16 + j2; lrs[t * 16 + j2] = src[0]; lrs[t * 16 + j2 + 1] = src[1]; }
    LBAR();
#pragma unroll
    for (int k = 0; k < 16; ++k) {
        const LAS float* lr = lrs + (tg * 16 + k) * 16;
        float x = bd;
#pragma unroll
        for (int j = 0; j < 16; ++j) x += lr[j] * wc[j];
        g[k] = (fminf(x, 0.f) - __logf(1.0f + __expf(-fabsf(x)))) * 0.0625f;
    }
    float run = 0.f;
    if (dir == 0) {
#pragma unroll
        for (int k = 0; k < 16; ++k) { run += g[k]; g[k] = run; }
    } else {
#pragma unroll
        for (int k = 15; k >= 0; --k) { run += g[k]; g[k] = run; }
    }
    part[tg * 128 + d] = run;
    LBAR();
    float off = 0.f;
#pragma unroll
    for (int t2 = 0; t2 < 4; ++t2) { const float pv = part[t2 * 128 + d]; if (dir == 0 ? (t2 < tg) : (t2 > tg)) off += pv; }
#pragma unroll
    for (int k = 0; k < 16; ++k) { bs[(tg * 16 + k) * 128 + d] = g[k] + off; bsg[(tg * 16 + k) * 128 + d] = g[k] + off; }
    LBAR();
}
__device__ __forceinline__ void gla_prep2_item(Frame& F, const Args& A, int l, int chain, int c) {
    const int dir = chain >> 2, h = chain & 3, tid = F.tid, lane = F.lane, w = F.wave, r = lane & 15, q = lane >> 4;
    const bf16* Z = (const bf16*)(F.ws + WS_Z);
    const int row0 = 64 * c, n = chunk_scan_index(dir, c);
    LAS float* bs = (LAS float*)F.lds;
    LAS bf16* KdT = (LAS bf16*)(F.lds + 32768);
    LAS bf16* VT = (LAS bf16*)(F.lds + 51200);
    gla_cum_decay(F, A, l, dir, h, row0, bs, (LAS float*)(F.lds + 69632), (float*)(F.ws + WS_BS) + ((size_t)chain * 132 + chunk_scan_index(dir, c)) * 8192);
    const int tl = dir ? 0 : 63;
    {   const int ip = tid & 31, c8 = (tid >> 5) * 8, t0 = 2 * ip, t1 = t0 + 1;
        const bf16* z0 = Z + (size_t)(row0 + t0) * ZP + h * 128 + c8; const bf16* z1 = z0 + ZP;
        const v4u kv0 = *(const v4u*)(z0 + C_GK), kv1 = *(const v4u*)(z1 + C_GK), vv0 = *(const v4u*)(z0 + C_GV), vv1 = *(const v4u*)(z1 + C_GV);
        const unsigned k0w[4] = {kv0.x, kv0.y, kv0.z, kv0.w}, k1w[4] = {kv1.x, kv1.y, kv1.z, kv1.w}, v0w[4] = {vv0.x, vv0.y, vv0.z, vv0.w}, v1w[4] = {vv1.x, vv1.y, vv1.z, vv1.w};
#pragma unroll
        for (int e = 0; e < 4; ++e) {
            const int d0 = c8 + 2 * e, d1 = d0 + 1;
            const float bl0 = bs[tl * 128 + d0], bl1 = bs[tl * 128 + d1];
            *(LAS unsigned*)(KdT + d0 * P64 + t0) = pk2(bflo(k0w[e]) * __expf(bl0 - bs[t0 * 128 + d0]), bflo(k1w[e]) * __expf(bl0 - bs[t1 * 128 + d0]));
            *(LAS unsigned*)(KdT + d1 * P64 + t0) = pk2(bfhi(k0w[e]) * __expf(bl1 - bs[t0 * 128 + d1]), bfhi(k1w[e]) * __expf(bl1 - bs[t1 * 128 + d1]));
            *(LAS unsigned*)(VT + d0 * P64 + t0) = (v0w[e] & 0xffffu) | (v1w[e] << 16);
            *(LAS unsigned*)(VT + d1 * P64 + t0) = (v0w[e] >> 16) | (v1w[e] & 0xffff0000u);
        }
    }
    LBAR();
    const size_t item = (size_t)chain * 132 + n;
    float* GS = (float*)(F.ws + WS_GS) + item * 16384;
#pragma unroll
    for (int t8 = 0; t8 < 8; ++t8) {
        const int mv = w, na = t8;
        const f32x4 d = mma16<64>(VT + 16 * mv * P64, P64, KdT + 16 * na * P64, P64, (f32x4){0.f, 0.f, 0.f, 0.f}, lane);
#pragma unroll
        for (int jj = 0; jj < 4; ++jj) GS[(16 * mv + 4 * q + jj) * 128 + 16 * na + r] = d[jj];
    }
    if (tid < 128) ((float*)(F.ws + WS_GD))[item * 128 + tid] = __expf(bs[tl * 128 + tid]);
    LBAR();
}
__device__ __forceinline__ void gla_scan_item(Frame& F, int it) {
    const int chain = it >> 3, e4 = (it & 7) * 512 + F.tid, v = e4 >> 5, a4 = (e4 & 31) * 4;
    float* p = (float*)(F.ws + WS_GS) + (size_t)chain * 132 * 16384 + v * 128 + a4;
    const float* gd = (const float*)(F.ws + WS_GD) + (size_t)chain * 132 * 128 + a4;
    f32x4 S = {0.f, 0.f, 0.f, 0.f};
    for (int n = 0; n < 132; n += 12) {
        f32x4 x[12]; f32x4 d[12];
#pragma unroll
        for (int k = 0; k < 12; ++k) { x[k] = *(const f32x4*)(p + (size_t)(n + k) * 16384); d[k] = *(const f32x4*)(gd + (n + k) * 128); }
#pragma unroll
        for (int k = 0; k < 12; ++k) { *(f32x4*)(p + (size_t)(n + k) * 16384) = S; S = S * d[k] + x[k]; }
    }
}
__device__ __forceinline__ void gla_out_item(Frame& F, const Args& A, int l, int c, int h) {
    const int tid = F.tid, lane = F.lane, w = F.wave, r = lane & 15, q = lane >> 4;
    const bf16* Z = (const bf16*)(F.ws + WS_Z);
    const int row0 = 64 * c;
    LAS float* bs = (LAS float*)F.lds;
    LAS bf16* Qt = (LAS bf16*)(F.lds + 32768);
    LAS bf16* Kt = (LAS bf16*)(F.lds + 50176);
    LAS bf16* VT = (LAS bf16*)(F.lds + 67584);
    LAS bf16* ST = (LAS bf16*)(F.lds + 86016);
    LAS bf16* ATT = (LAS bf16*)(F.lds + 120832);
    LAS float* OS = (LAS float*)F.lds;
    const int mi = w >> 1, nvb = 4 * (w & 1);
    f32x4 oacc[4];
#pragma unroll
    for (int k = 0; k < 4; ++k) oacc[k] = (f32x4){0.f, 0.f, 0.f, 0.f};
    for (int dir = 0; dir < 2; ++dir) {
        const int chain = dir * 4 + h, n = chunk_scan_index(dir, c);
        const float* Sg = (const float*)(F.ws + WS_GS) + ((size_t)chain * 132 + n) * 16384;
        const float* bsg = (const float*)(F.ws + WS_BS) + ((size_t)chain * 132 + n) * 8192;
        {
            v4u qv[2], kv[2]; f32x4 bA[2], bB[2], sv[8]; v4u vv0 = {0u, 0u, 0u, 0u}, vv1 = {0u, 0u, 0u, 0u};
#pragma unroll
            for (int i2 = 0; i2 < 2; ++i2) { const int p = tid + 512 * i2, t = p >> 4, c8 = (p & 15) * 8; const bf16* zr = Z + (size_t)(row0 + t) * ZP + h * 128 + c8;
                qv[i2] = *(const v4u*)(zr + C_GQ); kv[i2] = *(const v4u*)(zr + C_GK); bA[i2] = *(const f32x4*)(bsg + t * 128 + c8); bB[i2] = *(const f32x4*)(bsg + t * 128 + c8 + 4); }
#pragma unroll
            for (int i8 = 0; i8 < 8; ++i8) { const int p = tid + 512 * i8; sv[i8] = *(const f32x4*)(Sg + (p >> 5) * 128 + (p & 31) * 4); }
            const int ipv = tid & 31, c8v = (tid >> 5) * 8, t0v = 2 * ipv;
            if (dir == 0) { const bf16* z0 = Z + (size_t)(row0 + t0v) * ZP + h * 128 + c8v + C_GV; vv0 = *(const v4u*)z0; vv1 = *(const v4u*)(z0 + ZP); }
#pragma unroll
            for (int i2 = 0; i2 < 2; ++i2) { const int p = tid + 512 * i2, t = p >> 4, c8 = (p & 15) * 8;
                const unsigned qw[4] = {qv[i2].x, qv[i2].y, qv[i2].z, qv[i2].w}, kw[4] = {kv[i2].x, kv[i2].y, kv[i2].z, kv[i2].w};
                const float bb[8] = {bA[i2].x, bA[i2].y, bA[i2].z, bA[i2].w, bB[i2].x, bB[i2].y, bB[i2].z, bB[i2].w};
                unsigned qo[4], ko[4];
#pragma unroll
                for (int e = 0; e < 4; ++e) { const float b0 = bb[2 * e], b1 = bb[2 * e + 1];
                    qo[e] = pk2(bflo(qw[e]) * __expf(b0), bfhi(qw[e]) * __expf(b1)); ko[e] = pk2(bflo(kw[e]) * __expf(-b0), bfhi(kw[e]) * __expf(-b1)); }
                *(LAS v4u*)(Qt + t * P128 + c8) = (v4u){qo[0], qo[1], qo[2], qo[3]}; *(LAS v4u*)(Kt + t * P128 + c8) = (v4u){ko[0], ko[1], ko[2], ko[3]}; }
            if (dir == 0) {
                const unsigned v0w[4] = {vv0.x, vv0.y, vv0.z, vv0.w}, v1w[4] = {vv1.x, vv1.y, vv1.z, vv1.w};
#pragma unroll
                for (int e = 0; e < 4; ++e) {
                    *(LAS unsigned*)(VT + (c8v + 2 * e) * P64 + t0v) = (v0w[e] & 0xffffu) | (v1w[e] << 16);
                    *(LAS unsigned*)(VT + (c8v + 2 * e + 1) * P64 + t0v) = (v0w[e] >> 16) | (v1w[e] & 0xffff0000u); }
            }
#pragma unroll
            for (int i8 = 0; i8 < 8; ++i8) { const int p = tid + 512 * i8; v2u o; o.x = pk2(sv[i8].x, sv[i8].y); o.y = pk2(sv[i8].z, sv[i8].w);
                *(LAS v2u*)(ST + (p >> 5) * P128 + (p & 31) * 4) = o; }
        }
        LBAR();
#pragma unroll
        for (int t2 = 0; t2 < 2; ++t2) {
            const int t = w * 2 + t2, ai = t >> 2, nj = t & 3;
            const f32x4 acc = mma16<128>(Qt + 16 * ai * P128, P128, Kt + 16 * nj * P128, P128, (f32x4){0.f, 0.f, 0.f, 0.f}, lane);
            const int tj = 16 * nj + r;
#pragma unroll
            for (int jj = 0; jj < 4; ++jj) { const int ti = 16 * ai + 4 * q + jj; const bool ok = dir ? (tj >= ti) : (tj <= ti);
                ATT[ti * P64 + tj] = (bf16)f2bf(ok ? acc[jj] : 0.f); }
        }
        LBAR();
#pragma unroll
        for (int k = 0; k < 4; ++k) {
            const int nv = nvb + k;
            oacc[k] = mma16<64>(ATT + 16 * mi * P64, P64, VT + 16 * nv * P64, P64, oacc[k], lane);
            oacc[k] = mma16<128>(Qt + 16 * mi * P128, P128, ST + 16 * nv * P128, P128, oacc[k], lane);
        }
        LBAR();
    }
#pragma unroll
    for (int k = 0; k < 4; ++k)
#pragma unroll
        for (int jj = 0; jj < 4; ++jj) OS[(16 * mi + 4 * q + jj) * 132 + 16 * (nvb + k) + r] = oacc[k][jj] * 0.08838834764831845f;
    LBAR();
    {   const float* gnw = A.in[13] + l * 128 + lane * 2; const float gw0 = gnw[0], gw1 = gnw[1];
        bf16* A_ = (bf16*)(F.ws + WS_A);
        unsigned gz[8];
#pragma unroll
        for (int t8 = 0; t8 < 8; ++t8) gz[t8] = *(const unsigned*)(Z + (size_t)(row0 + w * 8 + t8) * ZP + C_GG + h * 128 + lane * 2);
#pragma unroll
        for (int t8 = 0; t8 < 8; ++t8) { const int t = w * 8 + t8;
            const float x0 = OS[t * 132 + lane * 2], x1 = OS[t * 132 + lane * 2 + 1];
            const float rs = __builtin_amdgcn_rsqf(wave_sum(x0 * x0 + x1 * x1) * (1.0f / 128.f) + 1e-6f);
            const size_t row = row0 + t; const unsigned g = gz[t8];
            *(unsigned*)(A_ + row * 512 + h * 128 + lane * 2) = pk2(x0 * rs * gw0 * siluf_(bflo(g)), x1 * rs * gw1 * siluf_(bfhi(g)));
        }
    }
    LBAR();
}
__device__ __forceinline__ void diff_out_rows(Frame& F, const Args& A, int l) {
    const int gw = F.bid * 8 + F.wave, NGW = F.G * 8, lane = F.lane;
    const bf16* AO = (const bf16*)(F.ws + WS_AO); bf16* D_ = (bf16*)(F.ws + WS_D);
    const float lam_init = l == 0 ? 0.2f : 0.35550906759096924f;
    const float* lp = A.in[14] + l * 256;
    const float lam = expf(wave_sum(lp[lane] * lp[64 + lane])) - expf(wave_sum(lp[128 + lane] * lp[192 + lane])) + lam_init;
    const float* dnw = A.in[15] + l * 128 + lane * 2; const float dw0 = dnw[0], dw1 = dnw[1];
    for (int r = gw; r < MROWS; r += NGW) {
        unsigned wa[4], wb_[4];
#pragma unroll
        for (int h = 0; h < 4; ++h) { wa[h] = *(const unsigned*)(AO + (size_t)r * 1024 + (h * 2) * 128 + lane * 2); wb_[h] = *(const unsigned*)(AO + (size_t)r * 1024 + (h * 2 + 1) * 128 + lane * 2); }
#pragma unroll
        for (int h = 0; h < 4; ++h) {
            const int c = h * 128 + lane * 2;
            const unsigned w1 = wa[h], w2 = wb_[h];
            const float x0 = bflo(w1) - lam * bflo(w2), x1 = bfhi(w1) - lam * bfhi(w2);
            const float rs = __builtin_amdgcn_rsqf(wave_sum(x0 * x0 + x1 * x1) * (1.0f / 128.f) + 1e-6f) * (1.0f - lam_init);
            *(unsigned*)(D_ + (size_t)r * 512 + c) = pk2(x0 * rs * dw0, x1 * rs * dw1);
        }
    }
}
#ifndef MK_SINGLE
#define MK_SINGLE 1
#endif
template <int l> __device__ __forceinline__ void layer_phases(Frame& F, const Args& args, unsigned char* lds, const int lo, const int hi, const XcdBarrier& bar) {
    unsigned char* ws = args.ws;
#define IN(k) (lo <= (k) && (k) < hi)
#define SEAM(k) do { if (IN(k) && IN((k) + 1)) { xcd_barrier(bar); if (REP_SYNC > 1) xcd_barrier(bar); } } while (0)
    const int pb = 2 + 11 * l;
    unsigned char* wb = ws + WS_W0;
    if (IN(pb + 0) && !SKIP_G1) {
        pg8::Gemm g{(const bf16*)(ws + WS_H), (const bf16*)(wb + WO_IN), MROWS, NIN_MAIN, DM_}; pg8::StaticOrder S; S.init(MROWS, NIN_MAIN, F.G, F.bid); S.rep = REP_G1;
        pg8::EpiZ E{(bf16*)(ws + WS_Z), ZP, (float*)(ws + WS_ZG)};
        pg8::gemm_phase<pg8::EpiZ, pg8::StaticOrder, true, true>(F.lds, g, S, E);
    } SEAM(pb + 0);
    if (IN(pb + 1)) { if (F.bid < 132) g1_tail_item(F, F.bid); prep_phase(F, args, l); } SEAM(pb + 1);
    if (IN(pb + 2)) {
        for (int it = F.bid; it < 2112 * REP_C1; it += F.G) delta_prep2_item(F, (it % 2112) / 132, it % 132);
        for (int it = F.G - 1 - F.bid; it < 1056 * REP_C2; it += F.G) gla_prep2_item(F, args, l, (it % 1056) / 132, it % 132);
    } SEAM(pb + 2);
    if (IN(pb + 3)) {
        if (F.bid < 16) delta_chain(F, F.bid);
        else if (F.bid - 16 < 64) gla_scan_item(F, F.bid - 16);
        {
            const attn_body::bf16* AQ = (const attn_body::bf16*)(ws + WS_AQ); const attn_body::bf16* AK = (const attn_body::bf16*)(ws + WS_AK);
            const attn_body::bf16* AV = (const attn_body::bf16*)(ws + WS_AV); attn_body::bf16* AO = (attn_body::bf16*)(ws + WS_AO);
            unsigned* cnt = (unsigned*)(ws + WS_CNT) + 64 * l;
            volatile LAS unsigned* slot = (volatile LAS unsigned*)(F.lds + MISC_OFF) + 16;
            for (;;) {
                if (F.tid == 0) slot[0] = __hip_atomic_fetch_add(cnt, 1u, __ATOMIC_RELAXED, __HIP_MEMORY_SCOPE_AGENT);
                __syncthreads();
                const int ui = (int)slot[0];
                __syncthreads();
                if (ui >= 528 * REP_ATTN) break;
                const int uj = ui % 528; const int qb = 32 - uj / 16, rem = uj % 16, hm = rem >> 1, half = rem & 1;
                attn_body::attn_unit<8>(AQ + (size_t)qb * 256 * 512 + hm * 64, AK + hm * 64, AV + (hm >> 1) * 128 + half * 64,
                                        AO + (size_t)qb * 256 * 1024 + hm * 128 + half * 64, qb == 0 ? 4 : 132, (char*)lds);
            }
        }
        if (l == 0) p0_dynamic(F, args, 0, (unsigned*)(ws + WS_CNT) + 128, I_IN, PER_L);
        else p0_dynamic(F, args, 1, (unsigned*)(ws + WS_CNT) + 256, I_IN, PER_L - I_2);
    } SEAM(pb + 3);
    if (IN(pb + 4)) {
        for (int it = F.bid; it < 1056 * REP_C3; it += F.G) delta_out_item(F, args, l, (it % 1056) >> 3, it & 7);
        for (int it = F.G - 1 - F.bid; it < 528 * REP_C4; it += F.G) gla_out_item(F, args, l, (it % 528) >> 2, it & 3);
        diff_out_rows(F, args, l);
    } SEAM(pb + 4);
    if (IN(pb + 5) && !SKIP_G2) {
        const bf16* Zm = (const bf16*)(ws + WS_Z) + C_MG; float* YF = (float*)(ws + WS_R2); bf16* YB = (bf16*)(ws + WS_YB);
        pg8::StaticOrder S; S.init(MROWS - CTXL, DM_, F.G, F.bid); S.pmoff = 1;
        { pg8::Gemm g{(const bf16*)(ws + WS_A), (const bf16*)(wb + WO_UA), MROWS, DM_, 512}; pg8::EpiGate<0> E{Zm, ZP, YF, YB, DM_};
          pg8::gemm_phase<pg8::EpiGate<0>, pg8::StaticOrder, true, true>(F.lds, g, S, E); }
        { pg8::Gemm g{(const bf16*)(ws + WS_D), (const bf16*)(wb + WO_UD), MROWS, DM_, 512}; pg8::EpiGate<1> E{Zm + DM_, ZP, YF, YB, DM_};
          pg8::gemm_phase<pg8::EpiGate<1>, pg8::StaticOrder, true, true>(F.lds, g, S, E); }
        { pg8::Gemm g{(const bf16*)(ws + WS_E), (const bf16*)(wb + WO_UE), MROWS, DM_, 1024}; pg8::EpiGate<2> E{Zm + 2 * DM_, ZP, YF, YB, DM_};
          pg8::gemm_phase<pg8::EpiGate<2>, pg8::StaticOrder, true, true>(F.lds, g, S, E); }
        if (l == 0) for (int it = F.bid; it < 256; it += F.G) ctx_g2_item(F, it);
    } SEAM(pb + 5);
    if (IN(pb + 6) && !SKIP_G3) {
        pg8::Gemm g{(const bf16*)(ws + WS_YB), (const bf16*)(wb + WO_O), MROWS, DM_, DM_}; pg8::StaticOrder S; S.init(MROWS - CTXL, DM_, F.G, F.bid); S.pmoff = 1; S.rep = REP_G3;
        pg8::EpiF32 E{(float*)(ws + WS_R2), DM_};
        pg8::gemm_phase<pg8::EpiF32, pg8::StaticOrder, true, true>(F.lds, g, S, E);
        if (l == 0) for (int it = F.bid; it < 256; it += F.G) ctx_f32_item(F, it, (const bf16*)(ws + WS_YB), DM_, (const bf16*)(wb + WO_O), (float*)(ws + WS_R2));
    } SEAM(pb + 6);
    if (IN(pb + 7)) { row_phase<1>(F, args, l); } SEAM(pb + 7);
    if (IN(pb + 8) && !SKIP_G4) {
        pg8::Gemm g{(const bf16*)(ws + WS_H), (const bf16*)(wb + WO_13), MROWS, 2 * DFF, DM_}; pg8::StaticOrder S; S.init(MROWS - CTXL * l, 2 * DFF, F.G, F.bid); S.pmoff = l; S.rep = REP_G4;
        pg8::EpiSwiglu E{(bf16*)(ws + WS_HFF), DFF};
        pg8::gemm_phase<pg8::EpiSwiglu, pg8::StaticOrder, true, true>(F.lds, g, S, E);
        if (l == 0) p0_dynamic(F, args, 1, (unsigned*)(ws + WS_CNT) + 192, 0, I_IN);
        else p0_dynamic(F, args, 1, (unsigned*)(ws + WS_CNT) + 320, PER_L - I_2, PER_L);
    } SEAM(pb + 8);
    if (IN(pb + 9) && !SKIP_G5) {
        pg8::Gemm g{(const bf16*)(ws + WS_HFF), (const bf16*)(wb + WO_2), MROWS, DM_, DFF}; pg8::StaticOrder S; S.init(MROWS - CTXL, DM_, F.G, F.bid); S.pmoff = 1; S.rep = REP_G5;
        pg8::EpiF32 E{(float*)(ws + WS_R2), DM_};
        pg8::gemm_phase<pg8::EpiF32, pg8::StaticOrder, true, true>(F.lds, g, S, E);
        if (l == 0) { for (int it = F.bid; it < 256; it += F.G) ctx_f32_item(F, it, (const bf16*)(ws + WS_HFF), DFF, (const bf16*)(wb + WO_2), (float*)(ws + WS_R2));
                    }
    } SEAM(pb + 9);
    if (IN(pb + 10)) { row_phase<2>(F, args, l); } SEAM(pb + 10);
#undef IN
#undef SEAM
}
__global__ void __launch_bounds__(512, 2) mega_fwd(Args args) {
    extern __shared__ __attribute__((aligned(16))) unsigned char lds[];
    Frame F;
    F.lds = (LAS unsigned char*)lds; F.tid = threadIdx.x; F.lane = F.tid & 63; F.wave = __builtin_amdgcn_readfirstlane(F.tid >> 6);
    F.G = gridDim.x; F.bid = blockIdx.x; F.ws = args.ws; F.out = args.out;
    const int lo = args.ph_lo, hi = args.ph_hi;
    if (lo < 0) cg::this_grid().sync();
    for (int u = F.tid; u < 64; u += 512) ((LAS unsigned*)(F.lds + MISC_OFF))[u] = 0u;
    __syncthreads();
    XcdBarrier bar; bar.bar = (unsigned*)(args.ws + WS_BAR); bar.x = 0; bar.st = nullptr;
    if (hi - lo > 1) bar = xcd_barrier_post((unsigned*)(args.ws + WS_BAR), (volatile LAS unsigned*)(F.lds + MISC_OFF) + 8);
#define IN(k) (lo <= (k) && (k) < hi)
#define SEAM(k) do { if (IN(k) && IN((k) + 1)) { xcd_barrier(bar); if (REP_SYNC > 1) xcd_barrier(bar); } } while (0)
    unsigned char* ws = args.ws;
    if (IN(0)) { p0_phase(F, args, 0, true, 0, I_IN); } SEAM(0);
    if (IN(1)) { row_phase<0>(F, args, 0); } SEAM(1);
    layer_phases<0>(F, args, lds, lo, hi, bar);
    layer_phases<1>(F, args, lds, lo, hi, bar);
#undef IN
#undef SEAM
}

extern "C" void kernel_launch(void* const* d_in, const int* in_sizes, int n_in, void* d_out, int out_size, void* d_ws, size_t ws_size, hipStream_t stream) {
    static int grid = 0;
    if (grid == 0) {
        if (n_in != 27 || out_size != SEQ_ * DM_ || ws_size < WS_END2) { fprintf(stderr, "kernel_launch: unexpected shapes (n_in %d, out %d, ws %zu < %zu)\n", n_in, out_size, ws_size, (size_t)WS_END2); grid = -1; return; }
        if (hipFuncSetAttribute((const void*)mega_fwd, hipFuncAttributeMaxDynamicSharedMemorySize, LDS_BYTES) != hipSuccess) { fprintf(stderr, "kernel_launch: hipFuncSetAttribute failed\n"); grid = -1; return; }
        int dev = 0, cus = 0, per_cu = 0;
        hipGetDevice(&dev); hipDeviceGetAttribute(&cus, hipDeviceAttributeMultiprocessorCount, dev);
        hipOccupancyMaxActiveBlocksPerMultiprocessor(&per_cu, (const void*)mega_fwd, 512, LDS_BYTES);
        if (per_cu < 1) { fprintf(stderr, "kernel_launch: occupancy query says %d blocks per CU\n", per_cu); per_cu = 1; }
        (void)hipGetLastError();
        grid = cus;
    }
    if (grid < 0) return;
    Args a{};
    for (int i = 0; i < 27; ++i) a.in[i] = (const float*)d_in[i];
    a.out = (float*)d_out; a.ws = (unsigned char*)d_ws;
#if MK_SINGLE
    if (hipMemsetAsync((char*)d_ws + WS_BAR, 0, BAR_BYTES, stream) != hipSuccess) { fprintf(stderr, "kernel_launch: memset failed\n"); return; }
    a.ph_lo = 0; a.ph_hi = NPH;
    void* kargs[] = {&a};
    hipError_t e = hipLaunchCooperativeKernel((const void*)mega_fwd, dim3(grid), dim3(512), kargs, LDS_BYTES, stream);
    if (e != hipSuccess) fprintf(stderr, "cooperative launch failed: %s (grid %d)\n", hipGetErrorString(e), grid);
#else
    for (int p = 0; p < NPH; ++p) { a.ph_lo = p; a.ph_hi = p + 1; hipLaunchKernelGGL(mega_fwd, dim3(grid), dim3(512), LDS_BYTES, stream, a); }
#endif
}
```

```cpp
#include <hip/hip_runtime.h>
#include <hip/hip_cooperative_groups.h>
#include <hip/hip_bf16.h>
#include <cstdio>
#include <cstdint>
#include <cmath>
namespace cg = cooperative_groups;
#ifndef SKIP_G1
#define SKIP_G1 0
#endif
#ifndef SKIP_G2
#define SKIP_G2 0
#endif
#ifndef SKIP_G3
#define SKIP_G3 0
#endif
#ifndef SKIP_G4
#define SKIP_G4 0
#endif
#ifndef SKIP_G5
#define SKIP_G5 0
#endif
#ifndef REP_G1
#define REP_G1 1
#endif
#ifndef REP_G3
#define REP_G3 1
#endif
#ifndef REP_G4
#define REP_G4 1
#endif
#ifndef REP_G5
#define REP_G5 1
#endif
#ifndef REP_C1
#define REP_C1 1
#endif
#ifndef REP_C2
#define REP_C2 1
#endif
#ifndef REP_C3
#define REP_C3 1
#endif
#ifndef REP_C4
#define REP_C4 1
#endif
#ifndef REP_GEMM
#define REP_GEMM 1
#endif
#ifndef REP_CHUNK
#define REP_CHUNK 1
#endif
#ifndef REP_ATTN
#define REP_ATTN 1
#endif
#ifndef REP_ROWS
#define REP_ROWS 1
#endif
#ifndef REP_P0
#define REP_P0 1
#endif
#ifndef REP_SYNC
#define REP_SYNC 1
#endif
namespace pg8 {
#define PG8_LAS __attribute__((address_space(3)))
typedef unsigned short bf16_t;
typedef short bf16x8 __attribute__((ext_vector_type(8)));
typedef float f32x4 __attribute__((ext_vector_type(4)));
typedef unsigned u32x4 __attribute__((ext_vector_type(4)));
constexpr int BM = 256, BK = 64, HALF = 128, HTB = HALF * BK * 2  , STAGE_BYTES = 8 * HTB, NXCD = 8, WGM = 8;

__host__ __device__ __forceinline__ int lds_byte(int r, int c) { const int st = (r >> 4) * 2 + (c >> 5), rr = r & 15, cc = c & 31, ob = rr * 64 + cc * 2; return st * 1024 + (ob ^ (((ob >> 9) & 1) << 5)); }
__host__ __device__ __forceinline__ void stage_rc(int b, int& R, int& C) { const int st = b / 1024, sb = b % 1024, swz = sb ^ (((sb >> 9) & 1) << 5); R = (st >> 1) * 16 + swz / 64; C = (st & 1) * 32 + (swz % 64) / 2; }
__host__ __device__ __forceinline__ int perm32(int rho) { const int n = rho >> 4, i = rho & 15; return 8 * (i >> 2) + 4 * n + (i & 3); }

struct Unit { int pm, pn; };
struct Gemm { const bf16_t* A; const bf16_t* Bt; int M, N, K; };

struct StaticOrder {
    int nM, nN, nwg, G, c, rep = 1, pmoff = 0;
    __host__ __device__ void init(int M, int N, int G_, int c_) { nM = M / BM; nN = N / BM; nwg = nM * nN; G = G_; c = c_; }
    __host__ __device__ bool next(int i, Unit& u) const {
        const long L = (long)(i / rep) * G + c; if (L >= nwg) return false;
        int wgid = (int)L; { const int q = nwg / NXCD, r = nwg % NXCD, xcd = wgid % NXCD, off = wgid / NXCD; wgid = (xcd < r ? xcd * (q + 1) : r * (q + 1) + (xcd - r) * q) + off; }
        const int nig = WGM * nN, gid = wgid / nig, fm = gid * WGM, gsz = (nM - fm) < WGM ? (nM - fm) : WGM;
        u.pm = pmoff + fm + ((wgid % nig) % gsz); u.pn = (wgid % nig) / gsz; return true;
    }
    __device__ __forceinline__ void a_ready(const Unit&) const {}
    __device__ __forceinline__ void done(const Unit&) const {}
};

__device__ __forceinline__ unsigned cvt_pk_bf16(float lo, float hi) { unsigned r; asm volatile("v_cvt_pk_bf16_f32 %0, %1, %2" : "=v"(r) : "v"(lo), "v"(hi)); return r; }
typedef float f32x2 __attribute__((ext_vector_type(2)));
typedef unsigned u32x2 __attribute__((ext_vector_type(2)));
__device__ __forceinline__ float ep_sigmoid(float x) { return __builtin_amdgcn_rcpf(1.0f + __expf(-x)); }
struct EpiZ {
    static constexpr bool PERM = true, AFTER_DRAIN = false;
    bf16_t* Z; int ldz; float* ZG;
    __device__ __forceinline__ void operator()(const f32x4 (&acc)[2][2][4][2], const Unit& u, int wr, int wc, int fr, int fq) const {
        const int row0 = u.pm * BM + wr * 64 + fr, col0 = u.pn * BM + wc * 32 + 8 * fq;
#pragma unroll
        for (int ai = 0; ai < 2; ++ai)
#pragma unroll
            for (int m = 0; m < 4; ++m) { const int row = row0 + ai * HALF + m * 16;
#pragma unroll
                for (int bj = 0; bj < 2; ++bj) { const int c = col0 + bj * HALF; const f32x4 v0 = acc[ai][bj][m][0], v1 = acc[ai][bj][m][1];
                    u32x4 w; w.x = cvt_pk_bf16(v0[0], v0[1]); w.y = cvt_pk_bf16(v0[2], v0[3]); w.z = cvt_pk_bf16(v1[0], v1[1]); w.w = cvt_pk_bf16(v1[2], v1[3]);
                    *(u32x4*)(Z + (size_t)row * ldz + c) = w;
                    int gc = -1; if (c >= 1536 && c < 1568) gc = c - 1536; else if (c >= 6688 && c < 6720) gc = 32 + c - 6688;
                    if (gc >= 0) { float* g = ZG + (size_t)row * 64 + gc; *(f32x4*)g = v0; *(f32x4*)(g + 4) = v1; } } }
    }
};
template <int MODE> struct EpiGate {
    static constexpr bool PERM = true, AFTER_DRAIN = false;
    const bf16_t* Zg; int ldz; float* YF; bf16_t* YB; int ldc;
    __device__ __forceinline__ void operator()(const f32x4 (&acc)[2][2][4][2], const Unit& u, int wr, int wc, int fr, int fq) const {
        const int row0 = u.pm * BM + wr * 64 + fr, col0 = u.pn * BM + wc * 32 + 8 * fq;
#pragma unroll
        for (int ai = 0; ai < 2; ++ai)
#pragma unroll
            for (int m = 0; m < 4; ++m) { const int row = row0 + ai * HALF + m * 16;
#pragma unroll
                for (int bj = 0; bj < 2; ++bj) { const int c = col0 + bj * HALF;
                    const u32x4 gz = *(const u32x4*)(Zg + (size_t)row * ldz + c);
                    f32x4 g0, g1;
                    g0[0] = ep_sigmoid(__builtin_bit_cast(float, gz.x << 16)); g0[1] = ep_sigmoid(__builtin_bit_cast(float, gz.x & 0xffff0000u));
                    g0[2] = ep_sigmoid(__builtin_bit_cast(float, gz.y << 16)); g0[3] = ep_sigmoid(__builtin_bit_cast(float, gz.y & 0xffff0000u));
                    g1[0] = ep_sigmoid(__builtin_bit_cast(float, gz.z << 16)); g1[1] = ep_sigmoid(__builtin_bit_cast(float, gz.z & 0xffff0000u));
                    g1[2] = ep_sigmoid(__builtin_bit_cast(float, gz.w << 16)); g1[3] = ep_sigmoid(__builtin_bit_cast(float, gz.w & 0xffff0000u));
                    f32x4 v0 = acc[ai][bj][m][0] * g0, v1 = acc[ai][bj][m][1] * g1;
                    float* y = YF + (size_t)row * ldc + c;
                    if (MODE >= 1) { v0 += *(const f32x4*)y; v1 += *(const f32x4*)(y + 4); }
                    if (MODE <= 1) { *(f32x4*)y = v0; *(f32x4*)(y + 4) = v1; }
                    else { u32x4 w; w.x = cvt_pk_bf16(v0[0], v0[1]); w.y = cvt_pk_bf16(v0[2], v0[3]); w.z = cvt_pk_bf16(v1[0], v1[1]); w.w = cvt_pk_bf16(v1[2], v1[3]);
                        *(u32x4*)(YB + (size_t)row * ldc + c) = w; } } }
    }
};
struct EpiF32 {
    static constexpr bool PERM = true, AFTER_DRAIN = false;
    float* Y; int ldc;
    __device__ __forceinline__ void operator()(const f32x4 (&acc)[2][2][4][2], const Unit& u, int wr, int wc, int fr, int fq) const {
        const int row0 = u.pm * BM + wr * 64 + fr, col0 = u.pn * BM + wc * 32 + 8 * fq;
#pragma unroll
        for (int ai = 0; ai < 2; ++ai)
#pragma unroll
            for (int m = 0; m < 4; ++m) { const int row = row0 + ai * HALF + m * 16;
#pragma unroll
                for (int bj = 0; bj < 2; ++bj) { float* y = Y + (size_t)row * ldc + col0 + bj * HALF; *(f32x4*)y = acc[ai][bj][m][0]; *(f32x4*)(y + 4) = acc[ai][bj][m][1]; } }
    }
};
struct EpiSwiglu {
    static constexpr bool PERM = true, AFTER_DRAIN = false;
    bf16_t* Hf; int ldc;
    __device__ __forceinline__ void operator()(const f32x4 (&acc)[2][2][4][2], const Unit& u, int wr, int wc, int fr, int fq) const {
        const int row0 = u.pm * BM + wr * 64 + fr, col0 = u.pn * HALF + wc * 32 + 8 * fq;
#pragma unroll
        for (int ai = 0; ai < 2; ++ai)
#pragma unroll
            for (int m = 0; m < 4; ++m) { const int row = row0 + ai * HALF + m * 16; float o[8];
#pragma unroll
                for (int n = 0; n < 2; ++n)
#pragma unroll
                    for (int j = 0; j < 4; ++j) { const float a = acc[ai][0][m][n][j], b = acc[ai][1][m][n][j]; o[n * 4 + j] = a * __builtin_amdgcn_rcpf(1.0f + __expf(-a)) * b; }
                u32x4 w; w.x = cvt_pk_bf16(o[0], o[1]); w.y = cvt_pk_bf16(o[2], o[3]); w.z = cvt_pk_bf16(o[4], o[5]); w.w = cvt_pk_bf16(o[6], o[7]);
                *(u32x4*)(Hf + (size_t)row * ldc + col0) = w; }
    }
};
template <class Epi, class Sched, bool ALIGN_EPI = false, bool SP2 = false>
__device__ __forceinline__ void gemm_phase(PG8_LAS unsigned char* lds, const Gemm g, const Sched& S, const Epi& E) {
    const int tid = threadIdx.x, wid = __builtin_amdgcn_readfirstlane(tid >> 6), lane = tid & 63, wr = wid >> 2, wc = wid & 3, fr = lane & 15, fq = lane >> 4;
    const int K = g.K, nt = K / BK;
    unsigned voffA[2], voffB[2];
#pragma unroll
    for (int i = 0; i < 2; ++i) { int R, C; stage_rc(tid * 16 + i * 8192, R, C); const int Rb = Epi::PERM ? ((R & ~31) + perm32(R & 31)) : R;
        voffA[i] = (unsigned)(R * K + C) * 2u; voffB[i] = (unsigned)(Rb * K + C) * 2u; }
    const size_t kstep = (size_t)(BK * 2);
    const size_t hstep = (size_t)HALF * K * 2;
    const size_t tstep = 2 * hstep;
    const unsigned ldsw = (unsigned)wid * 1024u;
    const int aoff = lds_byte(wr * 64 + fr, fq * 8), boff = lds_byte(wc * 32 + fr, fq * 8);
#define PG8_SA(b, h) (((b) * 2 + (h)) * HTB)
#define PG8_SB(b, h) ((4 + (b) * 2 + (h)) * HTB)
#define PG8_STAGE(bufoff, gbase, voff) do { _Pragma("unroll") for (int _i = 0; _i < 2; ++_i) \
        __builtin_amdgcn_global_load_lds((const unsigned*)((const char*)(gbase) + (voff)[_i]), (PG8_LAS unsigned*)(lds + (bufoff) + ldsw + _i * 8192), 16, 0, 0); } while (0)
#define PG8_LDA(dst, b, h) do { _Pragma("unroll") for (int m = 0; m < 4; ++m) _Pragma("unroll") for (int k = 0; k < 2; ++k) dst[m][k] = *(const PG8_LAS bf16x8*)(lds + PG8_SA(b, h) + aoff + m * 2048 + k * 1024); } while (0)
#define PG8_LDB(dst, b, h) do { _Pragma("unroll") for (int n = 0; n < 2; ++n) _Pragma("unroll") for (int k = 0; k < 2; ++k) dst[n][k] = *(const PG8_LAS bf16x8*)(lds + PG8_SB(b, h) + boff + n * 2048 + k * 1024); } while (0)
#define PG8_MMA(ai, bj, At, Bt) do { __builtin_amdgcn_s_setprio(1); _Pragma("unroll") for (int m = 0; m < 4; ++m) _Pragma("unroll") for (int n = 0; n < 2; ++n) _Pragma("unroll") for (int k = 0; k < 2; ++k) \
        acc[ai][bj][m][n] = __builtin_amdgcn_mfma_f32_16x16x32_bf16(Bt[n][k], At[m][k], acc[ai][bj][m][n], 0, 0, 0); __builtin_amdgcn_s_setprio(0); } while (0)
#define PG8_WAIT_V(n) asm volatile("s_waitcnt vmcnt(" #n ")" ::: "memory")
#define PG8_WAIT_L(n) asm volatile("s_waitcnt lgkmcnt(" #n ")" ::: "memory")
#define PG8_BAR __builtin_amdgcn_s_barrier()
#define PG8_SCHED __builtin_amdgcn_sched_barrier(0)
    Unit cur, nxt; int ui = 0;
    if (!S.next(0, cur)) return;
    f32x4 acc[2][2][4][2];
#pragma unroll
    for (int a = 0; a < 2; ++a)
#pragma unroll
        for (int b = 0; b < 2; ++b)
#pragma unroll
            for (int m = 0; m < 4; ++m)
#pragma unroll
                for (int n = 0; n < 2; ++n) acc[a][b][m][n] = (f32x4){0.f, 0.f, 0.f, 0.f};
    bf16x8 At[4][2], B0[2][2], B1[2][2];
    const char* cA = (const char*)g.A + (size_t)cur.pm * tstep; const char* cB = (const char*)g.Bt + (size_t)cur.pn * tstep;
    S.a_ready(cur);
    if constexpr (SP2) {
        PG8_STAGE(PG8_SB(0, 0), cB, voffB); PG8_STAGE(PG8_SB(0, 1), cB + hstep, voffB); PG8_STAGE(PG8_SA(0, 0), cA, voffA); PG8_STAGE(PG8_SA(0, 1), cA + hstep, voffA);
        if (wr == 1) PG8_BAR;
        PG8_WAIT_V(2); PG8_BAR;
        PG8_STAGE(PG8_SB(1, 0), cB + kstep, voffB); PG8_STAGE(PG8_SA(1, 0), cA + kstep, voffA); PG8_STAGE(PG8_SB(1, 1), cB + hstep + kstep, voffB);
        PG8_WAIT_V(6); PG8_BAR;
    } else {
        PG8_STAGE(PG8_SB(0, 0), cB, voffB); PG8_STAGE(PG8_SA(0, 0), cA, voffA); PG8_STAGE(PG8_SB(0, 1), cB + hstep, voffB); PG8_STAGE(PG8_SA(0, 1), cA + hstep, voffA);
        if (wr == 1) PG8_BAR;
        PG8_WAIT_V(4); PG8_BAR;
        PG8_STAGE(PG8_SB(1, 0), cB + kstep, voffB); PG8_STAGE(PG8_SA(1, 0), cA + kstep, voffA); PG8_STAGE(PG8_SB(1, 1), cB + hstep + kstep, voffB);
        PG8_WAIT_V(6); PG8_BAR;
    }
    for (;;) {
        const bool has_next = S.next(ui + 1, nxt);
        const char* nA = has_next ? (const char*)g.A + (size_t)nxt.pm * tstep : cA; const char* nB = has_next ? (const char*)g.Bt + (size_t)nxt.pn * tstep : cB;
        for (int t = 0; t < nt; t += 2) {
            const bool last = (t == nt - 2);
            const char* a1 = cA + (size_t)(t + 1) * kstep;
            const char* a2 = last ? nA : cA + (size_t)(t + 2) * kstep; const char* b2 = last ? nB : cB + (size_t)(t + 2) * kstep;
            const char* a3 = a2 + kstep; const char* b3 = b2 + kstep;
            if (last && has_next) S.a_ready(nxt);
            if constexpr (SP2) {
            PG8_LDB(B0, 0, 0); PG8_LDB(B1, 0, 1); PG8_SCHED; PG8_LDA(At, 0, 0); PG8_STAGE(PG8_SA(1, 1), a1 + hstep, voffA);
            PG8_WAIT_V(8); PG8_WAIT_L(0); PG8_BAR; PG8_MMA(0, 0, At, B0); PG8_MMA(0, 1, At, B1); PG8_BAR; PG8_SCHED;
            PG8_LDA(At, 0, 1); PG8_STAGE(PG8_SB(0, 0), b2, voffB); PG8_STAGE(PG8_SB(0, 1), b2 + hstep, voffB); PG8_STAGE(PG8_SA(0, 0), a2, voffA);
            PG8_WAIT_V(8); PG8_WAIT_L(0); PG8_BAR; PG8_MMA(1, 0, At, B0); PG8_MMA(1, 1, At, B1); PG8_BAR; PG8_SCHED;
            PG8_LDB(B0, 1, 0); PG8_LDB(B1, 1, 1); PG8_SCHED; PG8_LDA(At, 1, 0); PG8_STAGE(PG8_SA(0, 1), a2 + hstep, voffA);
            PG8_WAIT_V(8); PG8_WAIT_L(0); PG8_BAR; PG8_MMA(0, 0, At, B0); PG8_MMA(0, 1, At, B1); PG8_BAR; PG8_SCHED;
            PG8_LDA(At, 1, 1); PG8_STAGE(PG8_SB(1, 0), b3, voffB); PG8_STAGE(PG8_SB(1, 1), b3 + hstep, voffB); PG8_STAGE(PG8_SA(1, 0), a3, voffA);
            PG8_WAIT_V(8); PG8_WAIT_L(0); PG8_BAR; PG8_MMA(1, 0, At, B0); PG8_MMA(1, 1, At, B1); PG8_BAR; PG8_SCHED;
            } else {
            PG8_LDB(B0, 0, 0); PG8_SCHED; PG8_LDA(At, 0, 0); PG8_STAGE(PG8_SA(1, 1), a1 + hstep, voffA);
            PG8_WAIT_L(8); PG8_BAR; PG8_WAIT_L(0); PG8_MMA(0, 0, At, B0); PG8_BAR; PG8_SCHED;
            PG8_LDB(B1, 0, 1); PG8_STAGE(PG8_SB(0, 0), b2, voffB);
            PG8_BAR; PG8_WAIT_L(0); PG8_MMA(0, 1, At, B1); PG8_BAR;
            PG8_LDA(At, 0, 1); PG8_STAGE(PG8_SA(0, 0), a2, voffA);
            PG8_BAR; PG8_WAIT_L(0); PG8_MMA(1, 0, At, B0); PG8_BAR; PG8_SCHED;
            PG8_STAGE(PG8_SB(0, 1), b2 + hstep, voffB);
            PG8_WAIT_V(6); PG8_BAR; PG8_MMA(1, 1, At, B1); PG8_BAR;
            PG8_LDB(B0, 1, 0); PG8_SCHED; PG8_LDA(At, 1, 0); PG8_STAGE(PG8_SA(0, 1), a2 + hstep, voffA);
            PG8_WAIT_L(8); PG8_BAR; PG8_WAIT_L(0); PG8_MMA(0, 0, At, B0); PG8_BAR; PG8_SCHED;
            PG8_LDB(B1, 1, 1); PG8_STAGE(PG8_SB(1, 0), b3, voffB);
            PG8_BAR; PG8_WAIT_L(0); PG8_MMA(0, 1, At, B1); PG8_BAR;
            PG8_LDA(At, 1, 1); PG8_STAGE(PG8_SA(1, 0), a3, voffA);
            PG8_BAR; PG8_WAIT_L(0); PG8_MMA(1, 0, At, B0); PG8_BAR; PG8_SCHED;
            PG8_STAGE(PG8_SB(1, 1), b3 + hstep, voffB);
            PG8_WAIT_V(6); PG8_BAR; PG8_MMA(1, 1, At, B1); PG8_BAR;
            }
        }
        if constexpr (ALIGN_EPI) { if (wr == 0) PG8_BAR; }
        if constexpr (!Epi::AFTER_DRAIN) { E(acc, cur, wr, wc, fr, fq); S.done(cur); }
        if (!has_next) break;
#pragma unroll
        for (int a = 0; a < 2; ++a)
#pragma unroll
            for (int b = 0; b < 2; ++b)
#pragma unroll
                for (int m = 0; m < 4; ++m)
#pragma unroll
                    for (int n = 0; n < 2; ++n) acc[a][b][m][n] = (f32x4){0.f, 0.f, 0.f, 0.f};
        cur = nxt; cA = nA; cB = nB; ++ui;
        if constexpr (ALIGN_EPI) { if (wr == 1) PG8_BAR; }
    }
    PG8_WAIT_V(0);
    if constexpr (!ALIGN_EPI) { if (wr == 0) PG8_BAR; }
    PG8_BAR;
    if constexpr (Epi::AFTER_DRAIN) { E.fused(acc, cur, wr, wc, fr, fq, lds, wid, lane); S.done(cur); }
#undef PG8_SA
#undef PG8_SB
#undef PG8_STAGE
#undef PG8_LDA
#undef PG8_LDB
#undef PG8_MMA
#undef PG8_WAIT_V
#undef PG8_WAIT_L
#undef PG8_BAR
#undef PG8_SCHED
}
}
#include <hip/hip_bf16.h>
#include <cmath>
namespace attn_body {
using bf16=__hip_bfloat16;
using bf16x8=__attribute__((ext_vector_type(8)))short;
using s16x4=__attribute__((ext_vector_type(4)))short;
using f32x16=__attribute__((ext_vector_type(16)))float;
using u32x4=__attribute__((ext_vector_type(4)))unsigned;
constexpr int D=64,DM=512,OPITCH=1024;
constexpr int NW=8,QBLK=32,QB=QBLK*NW,KVBLK=64;
constexpr int ATTN_PITCH=DM, ATTN_UNIT_ROWS=QB;
__device__ __forceinline__ int crow(int r,int hi){return (r&3)+8*(r>>2)+4*hi;}
#define SBAR() __builtin_amdgcn_sched_barrier(0)
__device__ __forceinline__ void cmask(f32x16&p0,f32x16&p1,int jb,int qrel,int hi){
  const float NEG=-INFINITY; int kb=64*jb+4*hi;
  #pragma unroll
  for(int r=0;r<16;++r){int kv=kb+(r&3)+8*(r>>2); if(kv>qrel)p0[r]=NEG; if(kv+32>qrel)p1[r]=NEG;}
}

constexpr int NSLOT=3, SLOTB=8192;
constexpr int LDS_K=0, LDS_V=NSLOT*SLOTB, LDS_WS=2*NSLOT*SLOTB, LDS_OST=LDS_WS+NW*64*4, LDS_BYTES=LDS_OST+NW*4096;
constexpr float C2=0.125f*1.4426950408889634f;
__device__ __forceinline__ void glds16(const void*gsrc,unsigned lds_dst){unsigned keep;
  asm volatile("s_mov_b32 %0, m0\n\ts_mov_b32 m0, %2\n\ts_nop 0\n\tglobal_load_lds_dwordx4 %1, off\n\ts_mov_b32 m0, %0":"=&s"(keep):"v"(gsrc),"s"(lds_dst):"memory");}
__device__ __forceinline__ float max3f(float a,float b,float c){float r;asm("v_max3_f32 %0, %1, %2, %3":"=v"(r):"v"(a),"v"(b),"v"(c));return r;}
__device__ __forceinline__ float max2f(float a,float b){float r;asm("v_max_f32_e32 %0, %1, %2":"=v"(r):"v"(a),"v"(b));return r;}
__device__ __forceinline__ float fadd_s(float a,float b){float r;asm("v_add_f32_e32 %0, %1, %2":"=v"(r):"v"(a),"v"(b));return r;}
__device__ __forceinline__ float fsub_s(float a,float b){float r;asm("v_sub_f32_e32 %0, %1, %2":"=v"(r):"v"(a),"v"(b));return r;}
typedef float f32x2_t __attribute__((ext_vector_type(2))); typedef __bf16 bf16x2_t __attribute__((ext_vector_type(2)));
__device__ __forceinline__ unsigned cvtpk_s(float lo,float hi){f32x2_t v={lo,hi};bf16x2_t b=__builtin_convertvector(v,bf16x2_t);return __builtin_bit_cast(unsigned,b);}
#define WAIT_BAR(N) asm volatile("s_waitcnt vmcnt(" #N ") lgkmcnt(0)\n\ts_barrier":::"memory")

__device__ __forceinline__ void qkt(f32x16&p0,f32x16&p1,const char*Kslot,const bf16x8*qr,const f32x16&negm,int r32,int hi){
  const char*kb=Kslot+hi*1024+r32*16;
  #pragma unroll
  for(int d0=0;d0<4;++d0){
    const bf16x8 b0=*reinterpret_cast<const bf16x8*>(kb+d0*2048);
    const bf16x8 b1=*reinterpret_cast<const bf16x8*>(kb+d0*2048+512);
    if(d0==0){p0=__builtin_amdgcn_mfma_f32_32x32x16_bf16(b0,qr[0],negm,0,0,0);p1=__builtin_amdgcn_mfma_f32_32x32x16_bf16(b1,qr[0],negm,0,0,0);}
    else{p0=__builtin_amdgcn_mfma_f32_32x32x16_bf16(b0,qr[d0],p0,0,0,0);p1=__builtin_amdgcn_mfma_f32_32x32x16_bf16(b1,qr[d0],p1,0,0,0);}}
}
typedef __attribute__((address_space(3))) const char* lds_cptr;
typedef short v4i16_t __attribute__((ext_vector_type(4)));
__device__ __forceinline__ void kload8(bf16x8*kf,lds_cptr kp){
  kf[0]=*(const __attribute__((address_space(3))) bf16x8*)(kp);      kf[1]=*(const __attribute__((address_space(3))) bf16x8*)(kp+512);
  kf[2]=*(const __attribute__((address_space(3))) bf16x8*)(kp+2048); kf[3]=*(const __attribute__((address_space(3))) bf16x8*)(kp+2560);
  kf[4]=*(const __attribute__((address_space(3))) bf16x8*)(kp+4096); kf[5]=*(const __attribute__((address_space(3))) bf16x8*)(kp+4608);
  kf[6]=*(const __attribute__((address_space(3))) bf16x8*)(kp+6144); kf[7]=*(const __attribute__((address_space(3))) bf16x8*)(kp+6656);
}
__device__ __forceinline__ void kload2(bf16x8*kf,lds_cptr kp,int j){ kf[2*j]=*(const __attribute__((address_space(3))) bf16x8*)(kp+j*2048); kf[2*j+1]=*(const __attribute__((address_space(3))) bf16x8*)(kp+j*2048+512); }
__device__ __forceinline__ s16x4 vtr(lds_cptr p){ return __builtin_bit_cast(s16x4,__builtin_amdgcn_ds_read_tr16_b64_v4i16((__attribute__((address_space(3))) v4i16_t*)p)); }
__device__ __forceinline__ float rowmax(const f32x16&p0,const f32x16&p1){
  float a=max3f(p0[0],p0[1],p1[0]),b=max3f(p0[2],p0[3],p1[1]);a=max3f(a,p1[2],p1[3]);
  #pragma unroll
  for(int r=4;r<16;r+=4){a=max3f(a,p0[r],p0[r+1]);b=max3f(b,p0[r+2],p0[r+3]);a=max3f(a,p1[r],p1[r+1]);b=max3f(b,p1[r+2],p1[r+3]);}
  const float m=max2f(a,b);
  auto rr=__builtin_amdgcn_permlane32_swap(__float_as_uint(m),__float_as_uint(m),false,false);
  return max2f(__uint_as_float(rr[0]),__uint_as_float(rr[1]));
}
__device__ __forceinline__ void pv(f32x16*o,int vb,bf16x8 pa0,bf16x8 pa1,bf16x8 pa2,bf16x8 pa3){
  #pragma unroll
  for(int d0=0;d0<2;++d0){s16x4 lo[4],hi[4];
    #pragma unroll
    for(int ks=0;ks<4;++ks){
      asm volatile("ds_read_b64_tr_b16 %0,%1 offset:%c2":"=&v"(lo[ks]):"v"(vb),"i"(d0*4096+ks*1024):"memory");
      asm volatile("ds_read_b64_tr_b16 %0,%1 offset:%c2":"=&v"(hi[ks]):"v"(vb),"i"(d0*4096+ks*1024+512):"memory");}
    asm volatile("s_waitcnt lgkmcnt(0)":::"memory");SBAR();
    #define PK(k) (bf16x8){lo[k][0],lo[k][1],lo[k][2],lo[k][3],hi[k][0],hi[k][1],hi[k][2],hi[k][3]}
    o[d0]=__builtin_amdgcn_mfma_f32_32x32x16_bf16(pa0,PK(0),o[d0],0,0,0);
    o[d0]=__builtin_amdgcn_mfma_f32_32x32x16_bf16(pa1,PK(1),o[d0],0,0,0);
    o[d0]=__builtin_amdgcn_mfma_f32_32x32x16_bf16(pa2,PK(2),o[d0],0,0,0);
    o[d0]=__builtin_amdgcn_mfma_f32_32x32x16_bf16(pa3,PK(3),o[d0],0,0,0);
    #undef PK
  }
}

#ifndef ATTN_STORE16
#define ATTN_STORE16(p,v) (*(u32x4*)(p)=(v))
#endif
template<int THRL> __device__ __forceinline__ void attn_unit(const bf16*Qu,const bf16*__restrict__ Kh,const bf16*__restrict__ Vh,bf16*Ou,const int NT,char*shm){
  const int tid=threadIdx.x,lane=tid&63,r32=lane&31,hi=lane>>5; const int wid=__builtin_amdgcn_readfirstlane(tid>>6);
  const bf16*Qw=Qu+(long)(wid*QBLK)*DM;
  const unsigned lds0=(unsigned)(uintptr_t)shm;
  float*wsf=(float*)(shm+LDS_WS)+wid*64;
  const bf16*ksrc=Kh+(long)lane*DM+wid*8;
  const bf16*vsrc=Vh+(long)(16*(wid&3)+(lane>>2))*DM+(wid>>2)*32+(lane&3)*8;
  const unsigned kdst=lds0+LDS_K+wid*1024, vdst=lds0+LDS_V+wid*1024;
  #define DMA_K(t,slot) glds16(ksrc+(long)(t)*KVBLK*DM,(unsigned)__builtin_amdgcn_readfirstlane(kdst+(slot)))
  #define DMA_V(t,slot) glds16(vsrc+(long)(t)*KVBLK*DM,(unsigned)__builtin_amdgcn_readfirstlane(vdst+(slot)))
  const int vb0=(int)(lds0+LDS_V)+((lane>>4)&1)*32+(lane&3)*8+(4*hi+((lane&15)>>2))*64;
  const char*Kbase=shm+LDS_K; bf16x8 kf[8];
  const lds_cptr shm3=(lds_cptr)shm; const lds_cptr kp0=shm3+LDS_K+hi*1024+r32*16; const lds_cptr vp0=shm3+LDS_V+((lane>>4)&1)*32+(lane&3)*8+(4*hi+((lane&15)>>2))*64;
  DMA_K(0,0);DMA_V(0,0);DMA_K(1,SLOTB);
  bf16x8 qr[4];
  #pragma unroll
  for(int d0=0;d0<4;++d0)qr[d0]=*reinterpret_cast<const bf16x8*>(&Qw[(long)r32*DM+d0*16+hi*8]);
  float mhat=0.f,l_reg=0.f;f32x16 o[2];o[0]=f32x16{};o[1]=f32x16{};f32x16 negm=f32x16{};asm volatile("":"+v"(negm));
  #define CMASK(P0,P1,t) do{}while(0)
  bool resc=false;
  #define START(P0,P1) do{ const float rm=rowmax(P0,P1); resc=false; \
    { const float dl=rm; mhat=fadd_s(mhat,dl); \
      _Pragma("unroll") for(int r=0;r<16;++r){P0[r]=fsub_s(P0[r],dl);P1[r]=fsub_s(P1[r],dl);} \
      _Pragma("unroll") for(int r=0;r<16;++r)negm[r]=-mhat; asm volatile("":"+v"(negm)); } \
    _Pragma("unroll") for(int r=0;r<16;++r)P0[r]=__builtin_amdgcn_exp2f(P0[r]); }while(0)
  #define RESC() do{ if(resc){ asm volatile("s_waitcnt lgkmcnt(0)":::"memory"); \
      _Pragma("unroll") for(int d_=0;d_<2;++d_) _Pragma("unroll") for(int r=0;r<16;++r)o[d_][r]*=wsf[crow(r,hi)]; } }while(0)
  f32x16 pA0,pA1,pB0,pB1;
  int sl_prev=0,sl_cur=0,sl_next=SLOTB;
  #define ROT() do{sl_prev=sl_cur;sl_cur=sl_next;sl_next=(sl_next==(NSLOT-1)*SLOTB)?0:sl_next+SLOTB;}while(0)
  DMA_K(2,2*SLOTB);
  WAIT_BAR(3);
  qkt(pA0,pA1,Kbase,qr,negm,r32,hi);asm volatile("s_nop 15\n\ts_nop 7":"+v"(pA0),"+v"(pA1));CMASK(pA0,pA1,0);
  START(pA0,pA1);
  _Pragma("unroll") for(int r=0;r<16;++r)pA1[r]=__builtin_amdgcn_exp2f(pA1[r]);
  WAIT_BAR(0);
  DMA_K(3,0);DMA_V(1,SLOTB);
  ROT();
  kload8(kf,kp0+sl_cur);
  WAIT_BAR(2);
  s16x4 vlo[8],vhi[8]; u32x4 pw0,pw1,pw2,pw3;
  #define PKW(P,B) cvtpk_s(P[B],P[B+1])
  #define PAF(k) __builtin_bit_cast(bf16x8,pw##k)
  #define VFR(i) (bf16x8){vlo[i][0],vlo[i][1],vlo[i][2],vlo[i][3],vhi[i][0],vhi[i][1],vhi[i][2],vhi[i][3]}
  #define PIN(x) asm volatile("":"+v"(x))
  #define MX3(a,b,c) __builtin_fmaxf(__builtin_fmaxf((a),(b)),(c))
  #define GAPA(MF,A0,A1,A2,A3,W0,W1,PW) do{ MF; sacc+=A0; sacc+=A1; sacc+=A2; sacc+=A3; PIN(sacc); W0; W1; PIN(PW); SBAR(); }while(0)
  #define EX(v) __builtin_amdgcn_exp2f(v)
  #define GAPB(MF,X,B) do{ MF; X[B]=EX(X[B]); X[B+1]=EX(X[B+1]); X[B+2]=EX(X[B+2]); X[B+3]=EX(X[B+3]); PIN(X); SBAR(); }while(0)
  #define VRD(i) do{ vlo[i]=vtr(vp_+(((i)>>2)*4096+((i)&3)*1024)); vhi[i]=vtr(vp_+(((i)>>2)*4096+((i)&3)*1024+512)); }while(0)
  #define KRD(G,j) do{ if(G){ kload2(kf,kp0+sl_next,j); SBAR(); } }while(0)
  #define STEP(C0,C1,P0,P1,t,GK,GV,GL) do{ SBAR(); \
    const lds_cptr vp_=vp0+sl_prev; \
    VRD(0); SBAR(); float sacc=(P0[0]+P0[1]); \
    GAPA(C0=__builtin_amdgcn_mfma_f32_32x32x16_bf16(kf[0],qr[0],negm,0,0,0), P0[2],P0[3],P0[4],P0[5],     pw0[0]=PKW(P0,0), pw0[1]=PKW(P0,2), pw0); \
    VRD(4); SBAR(); GAPA(C1=__builtin_amdgcn_mfma_f32_32x32x16_bf16(kf[1],qr[0],negm,0,0,0), P0[6],P0[7],P0[8],P0[9],     pw0[2]=PKW(P0,4), pw0[3]=PKW(P0,6), pw0); \
    VRD(1); SBAR(); GAPA(C0=__builtin_amdgcn_mfma_f32_32x32x16_bf16(kf[2],qr[1],C0,0,0,0),   P0[10],P0[11],P0[12],P0[13], pw1[0]=PKW(P0,8), pw1[1]=PKW(P0,10), pw1); \
    VRD(5); SBAR(); GAPA(C1=__builtin_amdgcn_mfma_f32_32x32x16_bf16(kf[3],qr[1],C1,0,0,0),   P0[14],P0[15],P1[0],P1[1],   pw1[2]=PKW(P0,12),pw1[3]=PKW(P0,14), pw1); \
    VRD(2); SBAR(); GAPA(C0=__builtin_amdgcn_mfma_f32_32x32x16_bf16(kf[4],qr[2],C0,0,0,0),   P1[2],P1[3],P1[4],P1[5],     pw2[0]=PKW(P1,0), pw2[1]=PKW(P1,2), pw2); \
    VRD(6); SBAR(); GAPA(C1=__builtin_amdgcn_mfma_f32_32x32x16_bf16(kf[5],qr[2],C1,0,0,0),   P1[6],P1[7],P1[8],P1[9],     pw2[2]=PKW(P1,4), pw2[3]=PKW(P1,6), pw2); \
    VRD(3); SBAR(); GAPA(C0=__builtin_amdgcn_mfma_f32_32x32x16_bf16(kf[6],qr[3],C0,0,0,0),   P1[10],P1[11],P1[12],P1[13], pw3[0]=PKW(P1,8), pw3[1]=PKW(P1,10), pw3); \
    VRD(7); SBAR(); GAPA(C1=__builtin_amdgcn_mfma_f32_32x32x16_bf16(kf[7],qr[3],C1,0,0,0),   P1[14],P1[15],0.f,0.f,       pw3[2]=PKW(P1,12),pw3[3]=PKW(P1,14), pw3); \
    l_reg+=sacc; \
    if(GK){DMA_K((t)+3,sl_cur);} if(GV){DMA_V((t)+1,sl_next);} \
    CMASK(C0,C1,t); \
    { float a=MX3(C0[0],C0[1],C1[0]),b=MX3(C0[2],C0[3],C1[1]); a=MX3(a,C1[2],C1[3]); \
      _Pragma("unroll") for(int r=4;r<16;r+=4){a=MX3(a,C0[r],C0[r+1]);b=MX3(b,C0[r+2],C0[r+3]);a=MX3(a,C1[r],C1[r+1]);b=MX3(b,C1[r+2],C1[r+3]);} \
      float rm=__builtin_fmaxf(a,b); { auto rr=__builtin_amdgcn_permlane32_swap(__float_as_uint(rm),__float_as_uint(rm),false,false); rm=__builtin_fmaxf(__uint_as_float(rr[0]),__uint_as_float(rr[1])); } \
      resc=false; \
      if(__builtin_expect(__any(rm>(float)THRL),0)){ const float dl=__builtin_fmaxf(rm,0.f); mhat+=dl; \
        _Pragma("unroll") for(int r=0;r<16;++r){C0[r]-=dl;C1[r]-=dl;} \
        _Pragma("unroll") for(int r=0;r<16;++r)negm[r]=-mhat; asm volatile("":"+v"(negm)); \
        const float f=__builtin_amdgcn_exp2f(-dl); l_reg*=f; if(hi==0)wsf[r32]=f; resc=true; } } \
    SBAR(); \
    GAPB(o[0]=__builtin_amdgcn_mfma_f32_32x32x16_bf16(PAF(0),VFR(0),o[0],0,0,0), C0,0); \
    GAPB(o[1]=__builtin_amdgcn_mfma_f32_32x32x16_bf16(PAF(0),VFR(4),o[1],0,0,0), C0,4); \
    KRD(GL,0); GAPB(o[0]=__builtin_amdgcn_mfma_f32_32x32x16_bf16(PAF(1),VFR(1),o[0],0,0,0), C0,8); \
    KRD(GL,1); GAPB(o[1]=__builtin_amdgcn_mfma_f32_32x32x16_bf16(PAF(1),VFR(5),o[1],0,0,0), C0,12); \
    KRD(GL,2); GAPB(o[0]=__builtin_amdgcn_mfma_f32_32x32x16_bf16(PAF(2),VFR(2),o[0],0,0,0), C1,0); \
    KRD(GL,3); GAPB(o[1]=__builtin_amdgcn_mfma_f32_32x32x16_bf16(PAF(2),VFR(6),o[1],0,0,0), C1,4); \
    GAPB(o[0]=__builtin_amdgcn_mfma_f32_32x32x16_bf16(PAF(3),VFR(3),o[0],0,0,0), C1,8); \
    GAPB(o[1]=__builtin_amdgcn_mfma_f32_32x32x16_bf16(PAF(3),VFR(7),o[1],0,0,0), C1,12); \
    }while(0)
  int t=1;
  #undef CMASK
  #define CMASK(P0,P1,t) do{}while(0)
  for(;t+5<NT;t+=2){
    STEP(pB0,pB1,pA0,pA1,t,true,true,true);     WAIT_BAR(2); RESC(); ROT();
    STEP(pA0,pA1,pB0,pB1,t+1,true,true,true);   WAIT_BAR(2); RESC(); ROT();
  }
  #undef CMASK
  #define CMASK(P0,P1,t) do{}while(0)
  #define ENDW(tt) do{ if((tt)+3<NT){WAIT_BAR(2);} else if((tt)+2<NT){WAIT_BAR(1);} else {WAIT_BAR(0);} }while(0)
  for(;t+1<NT;t+=2){
    STEP(pB0,pB1,pA0,pA1,t,(t+3<NT),(t+1<NT),(t+1<NT));       ENDW(t);   RESC(); ROT();
    STEP(pA0,pA1,pB0,pB1,t+1,(t+4<NT),(t+2<NT),(t+2<NT));     ENDW(t+1); RESC(); ROT();
  }
  STEP(pB0,pB1,pA0,pA1,NT-1,false,false,false); RESC();
  { float sacc=pB0[0]+pB0[1]; _Pragma("unroll") for(int r=2;r<16;++r)sacc+=pB0[r]; _Pragma("unroll") for(int r=0;r<16;++r)sacc+=pB1[r]; l_reg+=sacc;
    pw0=(u32x4){PKW(pB0,0),PKW(pB0,2),PKW(pB0,4),PKW(pB0,6)};pw1=(u32x4){PKW(pB0,8),PKW(pB0,10),PKW(pB0,12),PKW(pB0,14)};pw2=(u32x4){PKW(pB1,0),PKW(pB1,2),PKW(pB1,4),PKW(pB1,6)};pw3=(u32x4){PKW(pB1,8),PKW(pB1,10),PKW(pB1,12),PKW(pB1,14)};
    SBAR(); pv(o,vb0+sl_cur,PAF(0),PAF(1),PAF(2),PAF(3)); }
  #undef PKW
  #undef PAF
  #undef VFR
  #undef PIN
  #undef MX3
  #undef GAPA
  #undef GAPB
  #undef EX
  #undef VRD
  #undef KRD
  #undef STEP
  #undef ENDW
  {auto rr=__builtin_amdgcn_permlane32_swap(__float_as_uint(l_reg),__float_as_uint(l_reg),false,false);l_reg=__uint_as_float(rr[0])+__uint_as_float(rr[1]);}
  if(hi==0)wsf[32+r32]=l_reg;asm volatile("s_waitcnt lgkmcnt(0)":::"memory");
  float rli[16];
  #pragma unroll
  for(int r=0;r<16;++r)rli[r]=__builtin_amdgcn_rcpf(wsf[32+crow(r,hi)]);
  bf16*Ow=Ou+(long)(wid*QBLK)*OPITCH;
  { bf16*stg=(bf16*)(shm+LDS_OST)+wid*2048;
    #pragma unroll
    for(int r=0;r<16;++r){const int orow=crow(r,hi);
      #pragma unroll
      for(int d0=0;d0<2;++d0)stg[orow*64+d0*32+r32]=__float2bfloat16(o[d0][r]*rli[r]);}
    asm volatile("s_waitcnt lgkmcnt(0)":::"memory");
    #pragma unroll
    for(int i=0;i<4;++i){const int row=i*8+(lane>>3),ch=lane&7; const u32x4 v=*(const u32x4*)(stg+row*64+ch*8); ATTN_STORE16(Ow+(long)row*OPITCH+ch*8,v);} }
  asm volatile("s_waitcnt lgkmcnt(0)\n\ts_barrier":::"memory");
  #undef DMA_K
  #undef DMA_V
  #undef CMASK
  #undef START
  #undef RESC
  #undef ROT
}
constexpr int ATTN_LDS_BYTES=LDS_BYTES;
#undef SBAR
#undef WAIT_BAR
}
#define GAS __attribute__((address_space(1)))
#define LAS __attribute__((address_space(3)))
typedef unsigned short bf16;
typedef unsigned v4u __attribute__((ext_vector_type(4)));
typedef unsigned v2u __attribute__((ext_vector_type(2)));
typedef float f32x4 __attribute__((ext_vector_type(4)));
#define LDS_WAIT() asm volatile("s_waitcnt lgkmcnt(0)" ::: "memory")

constexpr int DM_ = 2048, SEQ_ = 8192, CTXL = 256, MROWS = SEQ_ + CTXL;
constexpr int NIN = 13888, NINP = 14080, DFF = 5632;
constexpr int ZP = NINP;
constexpr int C_GQ = 0, C_GK = 512, C_GV = 1024, C_GLR = 1536, C_GG = 1568, C_DQ = 2080, C_DK = 2592, C_DV = 3104,
              C_EQ = 3616, C_EA = 6688, C_EB = 6704, C_EG = 6720, C_MG = 7744;
constexpr size_t MiB = 1u << 20;
constexpr size_t WS_MOD = 0;
constexpr size_t WS_BAR = 512 * 1024, BAR_BYTES = 16384;
constexpr int MISC_OFF = 147456 - 256;
constexpr size_t WS_CNT = WS_BAR + 14336;
constexpr size_t WS_W0 = 1 * MiB, W_LAYER = 137 * MiB;
constexpr size_t WO_IN = 0, WO_UA = 55 * MiB, WO_UD = 57 * MiB, WO_UE = 59 * MiB, WO_O = 63 * MiB, WO_13 = 71 * MiB, WO_2 = 115 * MiB;
constexpr size_t WS_X = WS_W0 + 2 * W_LAYER;
constexpr size_t WS_H = WS_X + 66 * MiB;
constexpr size_t WS_Z = WS_H + 33 * MiB;
constexpr size_t WS_ZG = WS_Z + 227 * MiB;
constexpr size_t WS_AQ = WS_ZG + 3 * MiB, WS_AK = WS_AQ + 9 * MiB, WS_AV = WS_AK + 9 * MiB, WS_AO = WS_AV + 9 * MiB;
constexpr size_t WS_DQ = WS_AO + 17 * MiB, WS_DK = WS_DQ + 17 * MiB, WS_DV = WS_DK + 17 * MiB, WS_DGB = WS_DV + 17 * MiB;
constexpr size_t WS_A = WS_DGB + 2 * MiB, WS_D = WS_A + 9 * MiB, WS_E = WS_D + 9 * MiB;
constexpr size_t WS_R2 = WS_E + 17 * MiB;
constexpr size_t WS_YB = WS_R2 + 66 * MiB;
constexpr size_t WS_END = WS_YB + 33 * MiB;
constexpr size_t WS_HFF = WS_Z;

constexpr int LDS_BYTES = 147456;
constexpr int NPH = 24;

typedef float pk_f32x2 __attribute__((ext_vector_type(2))); typedef __bf16 pk_bf16x2 __attribute__((ext_vector_type(2)));
__device__ __forceinline__ unsigned pk2(float lo, float hi) { const pk_f32x2 v = {lo, hi}; const pk_bf16x2 b = __builtin_convertvector(v, pk_bf16x2); return __builtin_bit_cast(unsigned, b); }
__device__ __forceinline__ unsigned f2bf(float f) { return pk2(f, 0.f) & 0xffffu; }
__device__ __forceinline__ float bf2f(unsigned short b) { return __builtin_bit_cast(float, (unsigned)b << 16); }
__device__ __forceinline__ float bflo(unsigned w) { return __builtin_bit_cast(float, w << 16); }
__device__ __forceinline__ float bfhi(unsigned w) { return __builtin_bit_cast(float, w & 0xffff0000u); }
__device__ __forceinline__ float wave_sum(float v) {
#pragma unroll
    for (int o = 1; o < 64; o <<= 1) v += __shfl_xor(v, o);
    return v;
}
__device__ __forceinline__ float sigmoidf_(float x) { return __builtin_amdgcn_rcpf(1.0f + __expf(-x)); }
__device__ __forceinline__ float siluf_(float x) { return x * __builtin_amdgcn_rcpf(1.0f + __expf(-x)); }

struct Args { const float* in[27]; float* out; unsigned char* ws; int ph_lo, ph_hi; };

struct Frame {
    LAS unsigned char* lds;
    int tid, lane, wave, G, bid;
    unsigned char* ws; float* out;
};

#define XB_TMO      128
#define XB_XCNT(j)  (256  + 64 * (j))
#define XB_XSUB(j)  (1280 + 64 * (j))
#define XB_XGEN(j)  (2304 + 64 * (j))
#define XB_TOP      3328
#define XB_TOPGEN   3392
#define XCD_BAR_WORDS 3456
#define XB_SPIN_CAP (1u << 18)

__device__ __forceinline__ unsigned xb_ld(unsigned* p)              { return __hip_atomic_load(p, __ATOMIC_RELAXED, __HIP_MEMORY_SCOPE_AGENT); }
__device__ __forceinline__ unsigned xb_add(unsigned* p, unsigned v) { return __hip_atomic_fetch_add(p, v, __ATOMIC_RELAXED, __HIP_MEMORY_SCOPE_AGENT); }
__device__ __forceinline__ unsigned xb_xcc_id() { return (unsigned)__builtin_amdgcn_s_getreg((3 << 11) | 20) & 0xFu; }
#define XB_SPIN(cond, bar) do { unsigned _sp = 0; while (cond) { __builtin_amdgcn_s_sleep(1); \
    if ((++_sp & 255u) == 0u) { if (xb_ld(&(bar)[XB_TMO])) break; if (_sp > XB_SPIN_CAP) { atomicAdd(&(bar)[XB_TMO], 1u); break; } } } } while (0)

struct XcdBarrier {
    unsigned* bar; unsigned x;
    volatile LAS unsigned* st;
};

__device__ __forceinline__ XcdBarrier xcd_barrier_post(unsigned* bar, volatile LAS unsigned* st) {
    XcdBarrier b; b.bar = bar; b.x = xb_xcc_id(); b.st = st;
    if (threadIdx.x == 0) (void)xb_add(&bar[XB_XCNT(b.x)], 1u);
    return b;
}
__device__ __forceinline__ void xcd_barrier_complete(unsigned* bar, unsigned x, unsigned& nloc, unsigned& nx) {
    const unsigned G = gridDim.x * gridDim.y * gridDim.z;
    unsigned sum, cnt, mine, sp = 0u;
    for (;;) {
        sum = 0u; cnt = 0u; mine = 0u;
#pragma unroll
        for (unsigned j = 0; j < 16; ++j) { const unsigned c = xb_ld(&bar[XB_XCNT(j)]); sum += c; cnt += (c > 0u) ? 1u : 0u; mine = (j == x) ? c : mine; }
        if (sum == G) break;
        __builtin_amdgcn_s_sleep(1);
        if ((++sp & 255u) == 0u) { if (xb_ld(&bar[XB_TMO])) break; if (sp > XB_SPIN_CAP) { atomicAdd(&bar[XB_TMO], 1u); break; } }
    }
    nloc = mine > 0u ? mine : 1u; nx = cnt > 0u ? cnt : 1u;
}

__device__ __forceinline__ void xcd_barrier(const XcdBarrier& b) {
    asm volatile("s_waitcnt vmcnt(0)" ::: "memory");
    __syncthreads();
    if (threadIdx.x == 0) {
        unsigned* bar = b.bar;
        __builtin_amdgcn_s_waitcnt(0);
        unsigned nloc = b.st[0], nx = b.st[1];
        if (nloc == 0u) { xcd_barrier_complete(bar, b.x, nloc, nx); b.st[0] = nloc; b.st[1] = nx; }
        const unsigned old = xb_add(&bar[XB_XSUB(b.x)], 1u);
        const unsigned gen = old / nloc;
        if (old + 1u == (gen + 1u) * nloc) {
            __builtin_amdgcn_fence(__ATOMIC_RELEASE, "agent");
            asm volatile("s_waitcnt vmcnt(0)" ::: "memory");
            const unsigned og = xb_add(&bar[XB_TOP], 1u);
            const unsigned tg = og / nx;
            if (og + 1u == (tg + 1u) * nx) xb_add(&bar[XB_TOPGEN], 1u);
            else XB_SPIN(xb_ld(&bar[XB_TOPGEN]) == tg, bar);
            __builtin_amdgcn_fence(__ATOMIC_ACQUIRE, "agent");
            xb_add(&bar[XB_XGEN(b.x)], 1u);
            asm volatile("s_waitcnt vmcnt(0)" ::: "memory");
        } else {
            XB_SPIN(xb_ld(&bar[XB_XGEN(b.x)]) == gen, bar);
            __builtin_amdgcn_fence(__ATOMIC_ACQUIRE, "agent");
            asm volatile("s_waitcnt vmcnt(0)" ::: "memory");
        }
    }
    __syncthreads();
}

__device__ __forceinline__ void p0_transpose_item(const float* W, int K, int N, bf16* WT, int k0, int n0, int drow, LAS float* scr, int lane) {
#pragma unroll 8
    for (int i = 0; i < 32; ++i) { const int kk = 2 * i + (lane >> 5); scr[kk * 33 + (lane & 31)] = __builtin_nontemporal_load(W + (size_t)(k0 + kk) * N + n0 + (lane & 31)); }
    LDS_WAIT(); asm volatile("" ::: "memory");
    const int c = lane & 7;
#pragma unroll
    for (int j = 0; j < 4; ++j) { const int n = (lane >> 3) + 8 * j; const LAS float* s = scr + (8 * c) * 33 + n;
        v4u o; o.x = pk2(s[0 * 33], s[1 * 33]); o.y = pk2(s[2 * 33], s[3 * 33]); o.z = pk2(s[4 * 33], s[5 * 33]); o.w = pk2(s[6 * 33], s[7 * 33]);
        *(v4u*)(WT + (size_t)(drow + n) * K + k0 + 8 * c) = o; }
    LDS_WAIT(); asm volatile("" ::: "memory");
}
__device__ __forceinline__ void tr_plain(const float* W, int K, int N, bf16* WT, int item, LAS float* scr, int lane) {
    const int nblk = N / 32, kb = item / nblk, nb = item % nblk;
    p0_transpose_item(W, K, N, WT, 64 * kb, 32 * nb, 32 * nb, scr, lane);
}
__device__ __forceinline__ void tr_ffn13(const float* W, bf16* WT, int item, int which, LAS float* scr, int lane) {
    const int nblk = DFF / 32, kb = item / nblk, nb = item % nblk, n0 = 32 * nb;
    p0_transpose_item(W, DM_, DFF, WT, 64 * kb, n0, 256 * (n0 >> 7) + (n0 & 127) + 128 * which, scr, lane);
}
constexpr int I_IN = 32 * (NIN / 32), I_UA = 8 * 64, I_UE = 16 * 64, I_O = 32 * 64, I_F = 32 * (DFF / 32), I_2 = (DFF / 64) * 64;
constexpr int PER_L = I_IN + 2 * I_UA + I_UE + I_O + 2 * I_F + I_2;
__device__ __forceinline__ void p0_item(Frame& F, const Args& A, const int l, int r, LAS float* scr) {
    unsigned char* wb = F.ws + WS_W0;
    if (r < I_IN) { tr_plain(A.in[10] + (size_t)l * DM_ * NIN, DM_, NIN, (bf16*)(wb + WO_IN), r, scr, F.lane); return; } r -= I_IN;
    if (r < I_UA) { tr_plain(A.in[20] + (size_t)l * 512 * DM_, 512, DM_, (bf16*)(wb + WO_UA), r, scr, F.lane); return; } r -= I_UA;
    if (r < I_UA) { tr_plain(A.in[21] + (size_t)l * 512 * DM_, 512, DM_, (bf16*)(wb + WO_UD), r, scr, F.lane); return; } r -= I_UA;
    if (r < I_UE) { tr_plain(A.in[22] + (size_t)l * 1024 * DM_, 1024, DM_, (bf16*)(wb + WO_UE), r, scr, F.lane); return; } r -= I_UE;
    if (r < I_O) { tr_plain(A.in[23] + (size_t)l * DM_ * DM_, DM_, DM_, (bf16*)(wb + WO_O), r, scr, F.lane); return; } r -= I_O;
    if (r < I_F) { tr_ffn13(A.in[24] + (size_t)l * DM_ * DFF, (bf16*)(wb + WO_13), r, 0, scr, F.lane); return; } r -= I_F;
    if (r < I_F) { tr_ffn13(A.in[25] + (size_t)l * DM_ * DFF, (bf16*)(wb + WO_13), r, 1, scr, F.lane); return; } r -= I_F;
    tr_plain(A.in[26] + (size_t)l * DFF * DM_, DFF, DM_, (bf16*)(wb + WO_2), r, scr, F.lane);
}
__device__ __forceinline__ void p0_dynamic(Frame& F, const Args& A, const int l, unsigned* cnt, const int lo_, const int hi) {
    LAS float* scr = (LAS float*)(F.lds + F.wave * 16384);
    volatile LAS unsigned* slot = (volatile LAS unsigned*)(F.lds + MISC_OFF) + 16;
    for (;;) {
        if (F.tid == 0) slot[0] = __hip_atomic_fetch_add(cnt, 64u, __ATOMIC_RELAXED, __HIP_MEMORY_SCOPE_AGENT);
        __syncthreads();
        const int base = lo_ + (int)slot[0];
        __syncthreads();
        if (base >= hi) break;
        for (int k = 0; k < 8; ++k) { const int it = base + F.wave * 8 + k; if (it < hi) p0_item(F, A, l, it, scr); }
    }
}
__device__ __forceinline__ void p0_phase(Frame& F, const Args& A, const int l, const bool gemv, const int ilo, const int ihi) {
    LAS float* scr = (LAS float*)(F.lds + F.wave * 16384);
    const int gw = F.bid * 8 + F.wave, NGW = F.G * 8;
    for (int it = ilo + gw; it < ilo + (ihi - ilo) * REP_P0; it += NGW) p0_item(F, A, l, ilo + (it - ilo) % (ihi - ilo), scr);
    __syncthreads();
    if (!gemv) return;
    LAS float* red = (LAS float*)F.lds;
    const float* cl = A.in[1]; const float* cc = A.in[3];
    for (int it = F.bid; it < 2 * 192; it += F.G) {
        const int lg = it / 192, jb = it % 192, kg = F.tid >> 4, jl = F.tid & 15;
        const float* wp = A.in[4] + ((size_t)lg * DM_ + kg * 64) * 12288 + jb * 64 + jl * 4;
        f32x4 al = {0.f, 0.f, 0.f, 0.f}, ac = {0.f, 0.f, 0.f, 0.f};
#pragma unroll 8
        for (int kk = 0; kk < 64; ++kk) {
            const f32x4 w = __builtin_nontemporal_load((const f32x4*)(wp + (size_t)kk * 12288));
            const float sl = siluf_(cl[kg * 64 + kk]), sc = siluf_(cc[kg * 64 + kk]);
            al += w * sl; ac += w * sc;
        }
        LAS float* rp = red + (kg * 16 + jl) * 8;
        rp[0] = al.x; rp[1] = al.y; rp[2] = al.z; rp[3] = al.w; rp[4] = ac.x; rp[5] = ac.y; rp[6] = ac.z; rp[7] = ac.w;
        __syncthreads();
        if (F.tid < 128) {
            const int j2 = F.tid & 15, comp = F.tid >> 4; float s = 0.f;
            for (int g = 0; g < 32; ++g) s += red[(g * 16 + j2) * 8 + comp];
            const int sidx = comp >> 2, col = jb * 64 + j2 * 4 + (comp & 3);
            ((float*)(F.ws + WS_MOD))[(size_t)(lg * 2 + sidx) * 12288 + col] = s + A.in[5][(size_t)lg * 12288 + col];
        }
        __syncthreads();
    }
}

template <int MODE> __device__ __forceinline__ void row_phase(Frame& F, const Args& A, int l) {
    const int gw = F.bid * 8 + F.wave, NGW = F.G * 8;
    float* X = (float*)(F.ws + WS_X); const float* Y2 = (const float*)(F.ws + WS_R2); bf16* H = (bf16*)(F.ws + WS_H);
    const float* MOD = (const float*)(F.ws + WS_MOD);
    for (int r = gw + ((MODE >= 1 && l == 1) ? CTXL : 0); r < MROWS; r += NGW) {
        const int s = r < CTXL ? 1 : 0;
        const float* mod = MOD + (size_t)(l * 2 + s) * 12288;
        f32x4 v[8];
        if (MODE == 0) {
            const float* src = s ? A.in[2] + (size_t)r * DM_ : A.in[0] + (size_t)(r - CTXL) * DM_;
#pragma unroll
            for (int j = 0; j < 8; ++j) v[j] = *(const f32x4*)(src + (F.lane + 64 * j) * 4);
        } else {
            const float* y = Y2 + (size_t)r * DM_; float ss = 0.f;
            const float* w = (MODE == 1 ? A.in[7] : A.in[9]) + (size_t)l * DM_;
            const float* gate = mod + (MODE == 1 ? 2 : 5) * DM_;
            f32x4 xv[8], wv[8], gv[8];
#pragma unroll
            for (int j = 0; j < 8; ++j) { const int c = (F.lane + 64 * j) * 4; v[j] = *(const f32x4*)(y + c); xv[j] = *(const f32x4*)(X + (size_t)r * DM_ + c); wv[j] = *(const f32x4*)(w + c); gv[j] = *(const f32x4*)(gate + c); }
#pragma unroll
            for (int j = 0; j < 8; ++j) ss += v[j].x * v[j].x + v[j].y * v[j].y + v[j].z * v[j].z + v[j].w * v[j].w;
            const float rs = __builtin_amdgcn_rsqf(wave_sum(ss) * (1.0f / DM_) + 1e-6f);
#pragma unroll
            for (int j = 0; j < 8; ++j) v[j] = xv[j] + gv[j] * (v[j] * rs * wv[j]);
        }
        if (MODE == 2 && l == 1) {
            if (!s) {
#pragma unroll
                for (int j = 0; j < 8; ++j) *(f32x4*)(F.out + (size_t)(r - CTXL) * DM_ + (F.lane + 64 * j) * 4) = v[j];
            }
            continue;
        }
        float ss = 0.f;
        const float* wn = (MODE == 0 ? A.in[6] : MODE == 1 ? A.in[8] + (size_t)l * DM_ : A.in[6] + (size_t)(l + 1) * DM_);
        const float* modn = (MODE == 2) ? MOD + (size_t)((l + 1) * 2 + s) * 12288 : mod;
        const float* sh = modn + (MODE == 1 ? 3 : 0) * DM_; const float* sc = sh + DM_;
#pragma unroll
        for (int j = 0; j < 8; ++j) { *(f32x4*)(X + (size_t)r * DM_ + (F.lane + 64 * j) * 4) = v[j]; ss += v[j].x * v[j].x + v[j].y * v[j].y + v[j].z * v[j].z + v[j].w * v[j].w; }
        const float rs2 = __builtin_amdgcn_rsqf(wave_sum(ss) * (1.0f / DM_) + 1e-6f);
#pragma unroll
        for (int j = 0; j < 8; ++j) { const int c = (F.lane + 64 * j) * 4;
            const f32x4 wv = *(const f32x4*)(wn + c), shv = *(const f32x4*)(sh + c), scv = *(const f32x4*)(sc + c);
            const f32x4 h = (v[j] * rs2 * wv) * (1.0f + scv) + shv;
            v2u o; o.x = pk2(h.x, h.y); o.y = pk2(h.z, h.w);
            *(v2u*)(H + (size_t)r * DM_ + c) = o; }
    }
}
__device__ __forceinline__ void prep_phase(Frame& F, const Args& A, int l) {
    const int gw = F.bid * 8 + F.wave, NGW = F.G * 8, lane = F.lane;
    const bf16* Z = (const bf16*)(F.ws + WS_Z); const float* ZG = (const float*)(F.ws + WS_ZG);
    bf16* AQ = (bf16*)(F.ws + WS_AQ); bf16* AK = (bf16*)(F.ws + WS_AK); bf16* AV = (bf16*)(F.ws + WS_AV);
    bf16* DQ = (bf16*)(F.ws + WS_DQ); bf16* DK = (bf16*)(F.ws + WS_DK); bf16* DV = (bf16*)(F.ws + WS_DV);
    float* DG = (float*)(F.ws + WS_DGB); float* DB = DG + 16 * MROWS;
    const float* conv_w = A.in[16] + (size_t)l * 5 * 3072;
    const float* a_log = A.in[17] + l * 16; const float* dt_bias = A.in[18] + l * 16;
    constexpr float C2 = 0.125f * 1.4426950408889634f;
    for (int g_ = gw; g_ < (MROWS / 4) * REP_ROWS; g_ += NGW) {
        const int r0 = (g_ % (MROWS / 4)) * 4;
        const bool lat = r0 >= CTXL; const int lo = lat ? CTXL : 0, hi = lat ? MROWS : CTXL;
        for (int it = 0; it < 6; ++it) {
            const int ch0 = it * 512 + lane * 8, p = it >> 1;
            v4u xr[8];
#pragma unroll
            for (int j = 0; j < 8; ++j) { const int rr = r0 + j - 2; xr[j] = (rr >= lo && rr < hi) ? *(const v4u*)(Z + (size_t)rr * ZP + C_EQ + ch0) : (v4u){0u, 0u, 0u, 0u}; }
            float acc[4][8];
#pragma unroll
            for (int j = 0; j < 4; ++j)
#pragma unroll
                for (int e = 0; e < 8; ++e) acc[j][e] = 0.f;
#pragma unroll
            for (int i = 0; i < 5; ++i) {
                const f32x4 c0 = *(const f32x4*)(conv_w + i * 3072 + ch0), c1 = *(const f32x4*)(conv_w + i * 3072 + ch0 + 4);
#pragma unroll
                for (int j = 0; j < 4; ++j) { const v4u x = xr[j + i];
                    acc[j][0] += bflo(x.x) * c0.x; acc[j][1] += bfhi(x.x) * c0.y; acc[j][2] += bflo(x.y) * c0.z; acc[j][3] += bfhi(x.y) * c0.w;
                    acc[j][4] += bflo(x.z) * c1.x; acc[j][5] += bfhi(x.z) * c1.y; acc[j][6] += bflo(x.w) * c1.z; acc[j][7] += bfhi(x.w) * c1.w; }
            }
            bf16* dstb = (p == 0 ? DQ : p == 1 ? DK : DV) + (ch0 & 1023);
#pragma unroll
            for (int j = 0; j < 4; ++j) {
                float sv[8]; float ss = 0.f;
#pragma unroll
                for (int e = 0; e < 8; ++e) { sv[e] = siluf_(acc[j][e]); ss += sv[e] * sv[e]; }
                if (p < 2) {
                    ss += __shfl_xor(ss, 1); ss += __shfl_xor(ss, 2); ss += __shfl_xor(ss, 4); ss += __shfl_xor(ss, 8);
                    const float sc = __builtin_amdgcn_rsqf(ss + 1e-6f) * (p == 0 ? 0.08838834764831845f : 1.0f);
#pragma unroll
                    for (int e = 0; e < 8; ++e) sv[e] *= sc;
                }
                v4u o; o.x = pk2(sv[0], sv[1]); o.y = pk2(sv[2], sv[3]); o.z = pk2(sv[4], sv[5]); o.w = pk2(sv[6], sv[7]);
                *(v4u*)(dstb + (size_t)(r0 + j) * 1024) = o;
            }
        }
        {
            const int r = r0 + (lane >> 4), gi = lane & 15;
            const float a = ZG[(size_t)r * 64 + 32 + gi], bt = ZG[(size_t)r * 64 + 48 + gi];
            const float xs = a + dt_bias[gi];
            const float sp = xs > 20.f ? xs : log1pf(expf(xs));
            DG[(size_t)gi * MROWS + r] = -expf(a_log[gi]) * sp;
            DB[(size_t)gi * MROWS + r] = 1.0f / (1.0f + expf(-bt));
        }
        for (int j = 0; j < 4; ++j) {
            const int r = r0 + j, t = r - CTXL; const bf16* zr = Z + (size_t)r * ZP;
            const v4u qv = *(const v4u*)(zr + C_DQ + lane * 8), kv = *(const v4u*)(zr + C_DK + lane * 8), vv = *(const v4u*)(zr + C_DV + lane * 8);
            *(v4u*)(AV + (size_t)r * 512 + lane * 8) = vv;
            float q[8], k[8];
            q[0] = bflo(qv.x); q[1] = bfhi(qv.x); q[2] = bflo(qv.y); q[3] = bfhi(qv.y); q[4] = bflo(qv.z); q[5] = bfhi(qv.z); q[6] = bflo(qv.w); q[7] = bfhi(qv.w);
            k[0] = bflo(kv.x); k[1] = bfhi(kv.x); k[2] = bflo(kv.y); k[3] = bfhi(kv.y); k[4] = bflo(kv.z); k[5] = bfhi(kv.z); k[6] = bflo(kv.w); k[7] = bfhi(kv.w);
            if (lat) {
                const int sub = lane & 3, part = (lane >> 2) & 1; const float pos = (float)(part ? (t & 63) : (t >> 6));
                const float sgn = (sub & 2) ? 1.0f : -1.0f;
#pragma unroll
                for (int e = 0; e < 8; ++e) {
                    const float qp = __shfl_xor(q[e], 2), kp = __shfl_xor(k[e], 2);
                    const int i = (sub & 1) * 8 + e;
                    const float inv = __builtin_amdgcn_exp2f(-(float)i * 0.8304820237218406f);
                    const float rev = (pos * inv) * 0.15915494309189535f;
                    const float cs = __builtin_amdgcn_cosf(rev), sn = __builtin_amdgcn_sinf(rev);
                    q[e] = q[e] * cs + sgn * qp * sn; k[e] = k[e] * cs + sgn * kp * sn;
                }
            }
            v4u qo, ko;
            qo.x = pk2(q[0] * C2, q[1] * C2); qo.y = pk2(q[2] * C2, q[3] * C2); qo.z = pk2(q[4] * C2, q[5] * C2); qo.w = pk2(q[6] * C2, q[7] * C2);
            ko.x = pk2(k[0], k[1]); ko.y = pk2(k[2], k[3]); ko.z = pk2(k[4], k[5]); ko.w = pk2(k[6], k[7]);
            *(v4u*)(AQ + (size_t)r * 512 + lane * 8) = qo; *(v4u*)(AK + (size_t)r * 512 + lane * 8) = ko;
        }
    }
}

__device__ __forceinline__ int scan_row(int dir, int n, int i) {
    if (dir == 0) return 64 * n + i;
    return (n < 4 ? 64 * (3 - n) : CTXL + 64 * (127 - (n - 4))) + 63 - i;
}

__device__ __forceinline__ void gla_chain_naive(Frame& F, const Args& A, int l, int chain) {
    const int dir = chain >> 2, h = chain & 3, tid = F.tid, lane = F.lane;
    const bf16* Z = (const bf16*)(F.ws + WS_Z); const float* ZG = (const float*)(F.ws + WS_ZG);
    float* OA = (float*)(F.ws + WS_YB) + (size_t)dir * MROWS * 512;
    const float* w2 = A.in[11] + ((size_t)(l * 2 + dir) * 16) * 512 + h * 128; const float* gb = A.in[12] + (size_t)(l * 2 + dir) * 512 + h * 128;
    LAS bf16* qs = (LAS bf16*)F.lds; LAS bf16* ks = qs + 64 * 128; LAS bf16* vs = ks + 64 * 128; LAS float* eg = (LAS float*)(F.lds + 49152);
    float S[64];
#pragma unroll
    for (int d = 0; d < 64; ++d) S[d] = 0.f;
    const int col = (tid >> 6) * 32 + (lane & 31), half = lane >> 5;
    for (int n = 0; n < 132; ++n) {
        for (int p = tid; p < 1024; p += 512) { const int i = p >> 4, c8 = (p & 15) * 8; const bf16* zr = Z + (size_t)scan_row(dir, n, i) * ZP + h * 128 + c8;
            *(LAS v4u*)(qs + i * 128 + c8) = *(const v4u*)(zr + C_GQ); *(LAS v4u*)(ks + i * 128 + c8) = *(const v4u*)(zr + C_GK); *(LAS v4u*)(vs + i * 128 + c8) = *(const v4u*)(zr + C_GV); }
        {   const int i = tid >> 3, dg = (tid & 7) * 16; const float* lr = ZG + (size_t)scan_row(dir, n, i) * 64 + dir * 16;
            float x[16];
#pragma unroll
            for (int jj = 0; jj < 16; ++jj) x[jj] = gb[dg + jj];
            for (int j = 0; j < 16; ++j) { const float lv = lr[j];
#pragma unroll
                for (int jj = 0; jj < 16; ++jj) x[jj] += lv * w2[j * 512 + dg + jj]; }
#pragma unroll
            for (int jj = 0; jj < 16; ++jj) { const float ls = fminf(x[jj], 0.f) - log1pf(expf(-fabsf(x[jj]))); eg[i * 128 + dg + jj] = expf(ls * 0.0625f); }
        }
        __syncthreads();
        if (tid < 256) {
            for (int i = 0; i < 64; ++i) {
                const float vv = bf2f(vs[i * 128 + col]); float o = 0.f;
#pragma unroll
                for (int d4 = 0; d4 < 16; ++d4) {
                    const f32x4 e4 = *(const LAS f32x4*)(eg + i * 128 + half * 64 + d4 * 4);
                    const v2u k2 = *(const LAS v2u*)(ks + i * 128 + half * 64 + d4 * 4), q2 = *(const LAS v2u*)(qs + i * 128 + half * 64 + d4 * 4);
                    S[d4 * 4 + 0] = S[d4 * 4 + 0] * e4.x + bflo(k2.x) * vv; o += S[d4 * 4 + 0] * bflo(q2.x);
                    S[d4 * 4 + 1] = S[d4 * 4 + 1] * e4.y + bfhi(k2.x) * vv; o += S[d4 * 4 + 1] * bfhi(q2.x);
                    S[d4 * 4 + 2] = S[d4 * 4 + 2] * e4.z + bflo(k2.y) * vv; o += S[d4 * 4 + 2] * bflo(q2.y);
                    S[d4 * 4 + 3] = S[d4 * 4 + 3] * e4.w + bfhi(k2.y) * vv; o += S[d4 * 4 + 3] * bfhi(q2.y);
                }
                o += __shfl_xor(o, 32);
                if (half == 0) OA[(size_t)scan_row(dir, n, i) * 512 + h * 128 + col] = o * 0.08838834764831845f;
            }
        }
        __syncthreads();
    }
}
__device__ __forceinline__ void delta_chain_naive(Frame& F, const Args& A, int chain) {
    const int dir = chain >> 3, h = chain & 7, tid = F.tid, lane = F.lane;
    const bf16* DQ = (const bf16*)(F.ws + WS_DQ); const bf16* DK = (const bf16*)(F.ws + WS_DK); const bf16* DV = (const bf16*)(F.ws + WS_DV);
    const float* DG = (const float*)(F.ws + WS_DGB) + (size_t)chain * MROWS; const float* DB = (const float*)(F.ws + WS_DGB) + (size_t)(16 + chain) * MROWS;
    float* OE = (float*)(F.ws + WS_R2) + (size_t)dir * MROWS * 1024;
    LAS bf16* qs = (LAS bf16*)F.lds; LAS bf16* ks = qs + 64 * 128; LAS bf16* vs = ks + 64 * 128; LAS float* gs = (LAS float*)(F.lds + 49152);
    float S[64];
#pragma unroll
    for (int d = 0; d < 64; ++d) S[d] = 0.f;
    const int col = (tid >> 6) * 32 + (lane & 31), half = lane >> 5;
    for (int n = 0; n < 132; ++n) {
        for (int p = tid; p < 1024; p += 512) { const int i = p >> 4, c8 = (p & 15) * 8; const size_t off = (size_t)scan_row(dir, n, i) * 1024 + h * 128 + c8;
            *(LAS v4u*)(qs + i * 128 + c8) = *(const v4u*)(DQ + off); *(LAS v4u*)(ks + i * 128 + c8) = *(const v4u*)(DK + off); *(LAS v4u*)(vs + i * 128 + c8) = *(const v4u*)(DV + off); }
        if (tid < 64) { const int r = scan_row(dir, n, tid); gs[tid] = expf(DG[r]); gs[64 + tid] = DB[r]; }
        __syncthreads();
        if (tid < 256) {
            for (int i = 0; i < 64; ++i) {
                const float vv = bf2f(vs[i * 128 + col]), egv = gs[i], beta = gs[64 + i];
                float kf[64]; float kS = 0.f;
#pragma unroll
                for (int d4 = 0; d4 < 16; ++d4) { const v2u k2 = *(const LAS v2u*)(ks + i * 128 + half * 64 + d4 * 4);
                    kf[d4 * 4 + 0] = bflo(k2.x); kf[d4 * 4 + 1] = bfhi(k2.x); kf[d4 * 4 + 2] = bflo(k2.y); kf[d4 * 4 + 3] = bfhi(k2.y);
                    kS += kf[d4 * 4 + 0] * S[d4 * 4 + 0] + kf[d4 * 4 + 1] * S[d4 * 4 + 1] + kf[d4 * 4 + 2] * S[d4 * 4 + 2] + kf[d4 * 4 + 3] * S[d4 * 4 + 3]; }
                kS += __shfl_xor(kS, 32);
                const float u = beta * (vv - egv * kS); float o = 0.f;
#pragma unroll
                for (int d4 = 0; d4 < 16; ++d4) { const v2u q2 = *(const LAS v2u*)(qs + i * 128 + half * 64 + d4 * 4);
                    S[d4 * 4 + 0] = S[d4 * 4 + 0] * egv + kf[d4 * 4 + 0] * u; o += S[d4 * 4 + 0] * bflo(q2.x);
                    S[d4 * 4 + 1] = S[d4 * 4 + 1] * egv + kf[d4 * 4 + 1] * u; o += S[d4 * 4 + 1] * bfhi(q2.x);
                    S[d4 * 4 + 2] = S[d4 * 4 + 2] * egv + kf[d4 * 4 + 2] * u; o += S[d4 * 4 + 2] * bflo(q2.y);
                    S[d4 * 4 + 3] = S[d4 * 4 + 3] * egv + kf[d4 * 4 + 3] * u; o += S[d4 * 4 + 3] * bfhi(q2.y); }
                o += __shfl_xor(o, 32);
                if (half == 0) OE[(size_t)scan_row(dir, n, i) * 1024 + h * 128 + col] = o;
            }
        }
        __syncthreads();
    }
}

__device__ __forceinline__ void out_phase(Frame& F, const Args& A, int l) {
    const int gw = F.bid * 8 + F.wave, NGW = F.G * 8, lane = F.lane;
    const bf16* Z = (const bf16*)(F.ws + WS_Z); const bf16* AO = (const bf16*)(F.ws + WS_AO);
    const float* OA = (const float*)(F.ws + WS_YB); const float* OE = (const float*)(F.ws + WS_R2);
    bf16* A_ = (bf16*)(F.ws + WS_A); bf16* D_ = (bf16*)(F.ws + WS_D); bf16* E_ = (bf16*)(F.ws + WS_E);
    const float lam_init = l == 0 ? 0.2f : 0.35550906759096924f;
    const float* lp = A.in[14] + l * 256;
    const float lam = expf(wave_sum(lp[lane] * lp[64 + lane])) - expf(wave_sum(lp[128 + lane] * lp[192 + lane])) + lam_init;
    const float* gnw = A.in[13] + l * 128 + lane * 2; const float* dnw = A.in[15] + l * 128 + lane * 2; const float* enw = A.in[19] + l * 128 + lane * 2;
    const float gw0 = gnw[0], gw1 = gnw[1], dw0 = dnw[0], dw1 = dnw[1], ew0 = enw[0], ew1 = enw[1];
    for (int r = gw; r < MROWS; r += NGW) {
        const bf16* zr = Z + (size_t)r * ZP;
        for (int h = 0; h < 4; ++h) {
            const int c = h * 128 + lane * 2;
            {   const float* o0 = OA + (size_t)r * 512 + c; const float* o1 = o0 + (size_t)MROWS * 512;
                const float x0 = o0[0] + o1[0], x1 = o0[1] + o1[1];
                const float rs = __builtin_amdgcn_rsqf(wave_sum(x0 * x0 + x1 * x1) * (1.0f / 128.f) + 1e-6f);
                const unsigned g = *(const unsigned*)(zr + C_GG + c);
                *(unsigned*)(A_ + (size_t)r * 512 + c) = pk2(x0 * rs * gw0 * siluf_(bflo(g)), x1 * rs * gw1 * siluf_(bfhi(g))); }
            {   const unsigned w1 = *(const unsigned*)(AO + (size_t)r * 1024 + (h * 2) * 128 + lane * 2), w2 = *(const unsigned*)(AO + (size_t)r * 1024 + (h * 2 + 1) * 128 + lane * 2);
                const float x0 = bflo(w1) - lam * bflo(w2), x1 = bfhi(w1) - lam * bfhi(w2);
                const float rs = __builtin_amdgcn_rsqf(wave_sum(x0 * x0 + x1 * x1) * (1.0f / 128.f) + 1e-6f) * (1.0f - lam_init);
                *(unsigned*)(D_ + (size_t)r * 512 + c) = pk2(x0 * rs * dw0, x1 * rs * dw1); }
        }
        for (int h = 0; h < 8; ++h) {
            const int c = h * 128 + lane * 2;
            const float* o0 = OE + (size_t)r * 1024 + c; const float* o1 = o0 + (size_t)MROWS * 1024;
            const float x0 = o0[0] + o1[0], x1 = o0[1] + o1[1];
            const float rs = __builtin_amdgcn_rsqf(wave_sum(x0 * x0 + x1 * x1) * (1.0f / 128.f) + 1e-6f);
            const unsigned g = *(const unsigned*)(zr + C_EG + c);
            *(unsigned*)(E_ + (size_t)r * 1024 + c) = pk2(x0 * rs * ew0 * siluf_(bflo(g)), x1 * rs * ew1 * siluf_(bfhi(g)));
        }
    }
}
typedef short bf16x8_t __attribute__((ext_vector_type(8)));
#define LBAR() do { asm volatile("s_waitcnt lgkmcnt(0)" ::: "memory"); __builtin_amdgcn_s_barrier(); asm volatile("" ::: "memory"); } while (0)
constexpr int P128 = 136, P64 = 72;
template <int K> __device__ __forceinline__ f32x4 mma16(const LAS bf16* A, int lda, const LAS bf16* Bt, int ldb, f32x4 acc, int lane) {
    const int r = lane & 15, q = lane >> 4;
    const LAS bf16* ap = A + r * lda + q * 8; const LAS bf16* bp = Bt + r * ldb + q * 8;
#pragma unroll
    for (int k0 = 0; k0 < K; k0 += 32) {
        const bf16x8_t a = *(const LAS bf16x8_t*)(ap + k0), b = *(const LAS bf16x8_t*)(bp + k0);
        acc = __builtin_amdgcn_mfma_f32_16x16x32_bf16(a, b, acc, 0, 0, 0);
    }
    return acc;
}
__device__ __forceinline__ int chunk_scan_index(int dir, int c) { return dir == 0 ? c : (c < 4 ? 3 - c : 135 - c); }
__device__ __forceinline__ float wave_incl_scan(float x, int lane) {
#pragma unroll
    for (int o = 1; o < 64; o <<= 1) { const float t = __shfl_up(x, o); if (lane >= o) x += t; }
    return x;
}
constexpr size_t WS_DS = WS_W0 + W_LAYER;
constexpr size_t WS_PP = WS_DS, WS_NT = WS_DS + 66 * MiB, WS_GL = WS_DS + 132 * MiB, WS_GD = WS_GL + 1 * MiB;
constexpr size_t WS_UG = WS_H, WS_WG = WS_END, WS_GS = WS_R2, WS_BS = WS_YB;
constexpr size_t WS_END2 = WS_END + 33 * MiB;

__device__ __forceinline__ void delta_prep2_item(Frame& F, int chain, int n) {
    const int dir = chain >> 3, h = chain & 7, tid = F.tid, lane = F.lane, w = F.wave;
    const bf16* DK = (const bf16*)(F.ws + WS_DK); const bf16* DV = (const bf16*)(F.ws + WS_DV);
    const float* DG = (const float*)(F.ws + WS_DGB) + (size_t)chain * MROWS; const float* DB = (const float*)(F.ws + WS_DGB) + (size_t)(16 + chain) * MROWS;
    const size_t item = (size_t)chain * 132 + n;
    bf16* Pp = (bf16*)(F.ws + WS_PP) + item * 16384; bf16* NT = (bf16*)(F.ws + WS_NT) + item * 16384;
    bf16* Ug = (bf16*)(F.ws + WS_UG) + item * 8192; bf16* Wg = (bf16*)(F.ws + WS_WG) + item * 8192;
    LAS bf16* Ks = (LAS bf16*)(F.lds);
    LAS float* AM = (LAS float*)(F.lds + 18432);
    LAS bf16* UT = (LAS bf16*)(F.lds);
    LAS bf16* KbT = (LAS bf16*)(F.lds + 35840);
    LAS bf16* KdT = (LAS bf16*)(F.lds + 54272);
    LAS bf16* VbT = (LAS bf16*)(F.lds + 72704);
    LAS bf16* TB = (LAS bf16*)(F.lds + 91136);
    LAS bf16* WT = (LAS bf16*)(F.lds + 100352);
    LAS float* gcs = (LAS float*)(F.lds + 118784); LAS float* bts = gcs + 64;
    const int ip = tid & 31, c8 = (tid >> 5) * 8, i0 = 2 * ip, i1 = i0 + 1;
    const size_t off0 = (size_t)scan_row(dir, n, i0) * 1024 + h * 128 + c8, off1 = (size_t)scan_row(dir, n, i1) * 1024 + h * 128 + c8;
    const v4u kv0 = *(const v4u*)(DK + off0), kv1 = *(const v4u*)(DK + off1), vv0 = *(const v4u*)(DV + off0), vv1 = *(const v4u*)(DV + off1);
    if (w == 0) { const int r = scan_row(dir, n, lane); gcs[lane] = wave_incl_scan(DG[r], lane); bts[lane] = DB[r]; }
    LBAR();
    const float gclast = gcs[63];
    {
        *(LAS v4u*)(Ks + i0 * P128 + c8) = kv0; *(LAS v4u*)(Ks + i1 * P128 + c8) = kv1;
        const float bt0 = bts[i0], bt1 = bts[i1], fb0 = bt0 * __expf(gcs[i0]), fb1 = bt1 * __expf(gcs[i1]), fd0 = __expf(gclast - gcs[i0]), fd1 = __expf(gclast - gcs[i1]);
        const unsigned k0w[4] = {kv0.x, kv0.y, kv0.z, kv0.w}, k1w[4] = {kv1.x, kv1.y, kv1.z, kv1.w}, v0w[4] = {vv0.x, vv0.y, vv0.z, vv0.w}, v1w[4] = {vv1.x, vv1.y, vv1.z, vv1.w};
#pragma unroll
        for (int e = 0; e < 4; ++e) {
            const float ka0 = bflo(k0w[e]), kb0 = bfhi(k0w[e]), ka1 = bflo(k1w[e]), kb1 = bfhi(k1w[e]);
            const float va0 = bflo(v0w[e]), vb0 = bfhi(v0w[e]), va1 = bflo(v1w[e]), vb1 = bfhi(v1w[e]);
            const int ca = (c8 + 2 * e) * P64 + i0, cb = (c8 + 2 * e + 1) * P64 + i0;
            *(LAS unsigned*)(KbT + ca) = pk2(ka0 * fb0, ka1 * fb1); *(LAS unsigned*)(KbT + cb) = pk2(kb0 * fb0, kb1 * fb1);
            *(LAS unsigned*)(KdT + ca) = pk2(ka0 * fd0, ka1 * fd1); *(LAS unsigned*)(KdT + cb) = pk2(kb0 * fd0, kb1 * fd1);
            *(LAS unsigned*)(VbT + ca) = pk2(va0 * bt0, va1 * bt1); *(LAS unsigned*)(VbT + cb) = pk2(vb0 * bt0, vb1 * bt1);
        }
    }
    LBAR();
    const int r = lane & 15, q = lane >> 4;
#pragma unroll
    for (int t2 = 0; t2 < 2; ++t2) {
        const int t = w * 2 + t2, mi = t >> 2, nj = t & 3;
        const f32x4 acc = mma16<128>(Ks + 16 * mi * P128, P128, Ks + 16 * nj * P128, P128, (f32x4){0.f, 0.f, 0.f, 0.f}, lane);
        const int j = 16 * nj + r; const float gj = gcs[j];
#pragma unroll
        for (int jj = 0; jj < 4; ++jj) { const int i = 16 * mi + 4 * q + jj;
            AM[i * 68 + j] = (j < i) ? bts[i] * acc[jj] * __expf(gcs[i] - gj) : 0.f; }
    }
    LBAR();
    {
        LAS float* TM = (LAS float*)(F.lds + 119296);
        LAS float* XM = (LAS float*)(F.lds + 136704);
        if (w == 0) {
            const int b16 = 16 * (lane >> 4), c = lane & 15;
            float t[16];
#pragma unroll
            for (int i = 0; i < 16; ++i) {
                float s_ = (i == c) ? 1.f : 0.f;
#pragma unroll
                for (int j4 = 0; j4 < (i + 3) / 4; ++j4) {
                    const f32x4 a = *(const LAS f32x4*)(AM + (b16 + i) * 68 + b16 + j4 * 4);
                    if (j4 * 4 + 0 < i) s_ -= a.x * t[j4 * 4 + 0];
                    if (j4 * 4 + 1 < i) s_ -= a.y * t[j4 * 4 + 1];
                    if (j4 * 4 + 2 < i) s_ -= a.z * t[j4 * 4 + 2];
                    if (j4 * 4 + 3 < i) s_ -= a.w * t[j4 * 4 + 3];
                }
                t[i] = s_;
                TM[(b16 + i) * 68 + b16 + c] = s_;
            }
        }
        LBAR();
        const int rr = (tid >> 4) & 15, cc = tid & 15;
#pragma unroll
        for (int d = 1; d < 4; ++d) {
            for (int blk = tid >> 8; blk < 4 - d; blk += 2) {
                const int bj = blk, bi = blk + d; float x = 0.f;
                for (int k = bj; k < bi; ++k)
#pragma unroll
                    for (int m = 0; m < 16; ++m) x += AM[(16 * bi + rr) * 68 + 16 * k + m] * TM[(16 * k + m) * 68 + 16 * bj + cc];
                XM[(blk * 16 + rr) * 17 + cc] = x;
            }
            LBAR();
            for (int blk = tid >> 8; blk < 4 - d; blk += 2) {
                const int bj = blk, bi = blk + d; float x = 0.f;
#pragma unroll
                for (int m = 0; m < 16; ++m) x -= TM[(16 * bi + rr) * 68 + 16 * bi + m] * XM[(blk * 16 + m) * 17 + cc];
                TM[(16 * bi + rr) * 68 + 16 * bj + cc] = x;
            }
            LBAR();
        }
        {   const int i = tid >> 3, j0 = (tid & 7) * 8; float v[8];
#pragma unroll
            for (int e = 0; e < 8; ++e) v[e] = ((j0 + e) >> 4) > (i >> 4) ? 0.f : TM[i * 68 + j0 + e];
            v4u o; o.x = pk2(v[0], v[1]); o.y = pk2(v[2], v[3]); o.z = pk2(v[4], v[5]); o.w = pk2(v[6], v[7]);
            *(LAS v4u*)(TB + i * P64 + j0) = o; }
    }
    LBAR();
#pragma unroll
    for (int t4 = 0; t4 < 4; ++t4) {
        const int t = w * 4 + t4, mi = t >> 3, nv = t & 7;
        const f32x4 u = mma16<64>(TB + 16 * mi * P64, P64, VbT + 16 * nv * P64, P64, (f32x4){0.f, 0.f, 0.f, 0.f}, lane);
        const f32x4 ww = mma16<64>(TB + 16 * mi * P64, P64, KbT + 16 * nv * P64, P64, (f32x4){0.f, 0.f, 0.f, 0.f}, lane);
        const int c = 16 * nv + r, i0 = 16 * mi + 4 * q;
        v2u up; up.x = pk2(u[0], u[1]); up.y = pk2(u[2], u[3]);
        v2u wp; wp.x = pk2(ww[0], ww[1]); wp.y = pk2(ww[2], ww[3]);
        *(LAS v2u*)(UT + c * P64 + i0) = up; *(LAS v2u*)(WT + c * P64 + i0) = wp;
        *(v2u*)(Ug + c * 64 + i0) = up;
#pragma unroll
        for (int jj = 0; jj < 4; ++jj) Wg[(i0 + jj) * 128 + c] = (bf16)f2bf(ww[jj]);
    }
    LBAR();
#pragma unroll
    for (int t8 = 0; t8 < 8; ++t8) {
        const int mb = w, na = t8;
        const f32x4 pt = mma16<64>(WT + 16 * mb * P64, P64, KdT + 16 * na * P64, P64, (f32x4){0.f, 0.f, 0.f, 0.f}, lane);
        v2u pp; pp.x = pk2(-pt[0], -pt[1]); pp.y = pk2(-pt[2], -pt[3]);
        *(v2u*)(Pp + ((size_t)((na * 4 + (mb >> 1)) * 64 + lane)) * 8 + 4 * (mb & 1)) = pp;
        const int ma = w, nv = t8;
        const f32x4 nn = mma16<64>(KdT + 16 * ma * P64, P64, UT + 16 * nv * P64, P64, (f32x4){0.f, 0.f, 0.f, 0.f}, lane);
        v2u np; np.x = pk2(nn[0], nn[1]); np.y = pk2(nn[2], nn[3]);
        *(v2u*)(NT + (size_t)(16 * nv + r) * 128 + 16 * ma + 4 * q) = np;
    }
    if (tid == 0) ((float*)(F.ws + WS_GL))[item] = __expf(gclast);
    LBAR();
}

constexpr int CH_SLOT = 32768 + 128 * P128 * 2;
#define CH_BAR() do { asm volatile("s_waitcnt lgkmcnt(0)" ::: "memory"); __builtin_amdgcn_s_barrier(); asm volatile("" ::: "memory"); } while (0)
__device__ __forceinline__ void delta_chain(Frame& F, int chain) {
    const int tid = F.tid, lane = F.lane, w = F.wave, r = lane & 15, q = lane >> 4;
    const bf16* Pp = (const bf16*)(F.ws + WS_PP) + (size_t)chain * 132 * 16384; bf16* NT = (bf16*)(F.ws + WS_NT) + (size_t)chain * 132 * 16384;
    LAS unsigned char* ring = F.lds; LAS float* gls = (LAS float*)(F.lds + 2 * CH_SLOT);
    if (tid < 132) gls[tid] = ((const float*)(F.ws + WS_GL))[chain * 132 + tid];
    if (w >= 4) {
        const int lt = tid - 256;
        unsigned ndst[8];
#pragma unroll
        for (int k = 0; k < 8; ++k) { const int p = lt + 256 * k; ndst[k] = 32768u + (unsigned)((p >> 4) * P128 + (p & 15) * 8) * 2u; }
        v4u rp[3][8], rn[3][8];
#define CH_LOAD(set, step) do { const v4u* ps_ = (const v4u*)(Pp + (size_t)(step) * 16384) + lt; const v4u* ns_ = (const v4u*)(NT + (size_t)(step) * 16384) + lt; \
        _Pragma("unroll") for (int k = 0; k < 8; ++k) { rp[set][k] = ps_[256 * k]; rn[set][k] = ns_[256 * k]; } } while (0)
#define CH_WRITE(set, slot) do { LAS unsigned char* sb_ = ring + (slot) * CH_SLOT; \
        _Pragma("unroll") for (int k = 0; k < 8; ++k) { *(LAS v4u*)(sb_ + (lt + 256 * k) * 16) = rp[set][k]; *(LAS v4u*)(sb_ + ndst[k]) = rn[set][k]; } } while (0)
        CH_LOAD(0, 0); CH_LOAD(1, 1); CH_LOAD(2, 2);
        CH_WRITE(0, 0);
        CH_BAR();
        for (int n = 0; n < 132; n += 3) {
            if (n + 3 < 132) CH_LOAD(0, n + 3);
            CH_WRITE(1, (n + 1) & 1);
            CH_BAR();
            if (n + 4 < 132) CH_LOAD(1, n + 4);
            CH_WRITE(2, (n + 2) & 1);
            CH_BAR();
            if (n + 5 < 132) CH_LOAD(2, n + 5);
            if (n + 3 < 132) CH_WRITE(0, (n + 3) & 1);
            CH_BAR();
        }
#undef CH_LOAD
#undef CH_WRITE
    } else {
        f32x4 acc[2][8];
#pragma unroll
        for (int nb = 0; nb < 2; ++nb)
#pragma unroll
            for (int m = 0; m < 8; ++m) acc[nb][m] = (f32x4){0.f, 0.f, 0.f, 0.f};
        bf16* srow = NT + (size_t)(32 * w + r) * 128 + 4 * q;
        const unsigned noff = 32768u + (unsigned)((32 * w + r) * P128 + 4 * q) * 2u;
        CH_BAR();
        for (int n = 0; n < 132; ++n) {
            const LAS unsigned char* slot = ring + (n & 1) * CH_SLOT;
            const float gl = gls[n];
            v2u sp[2][8];
#pragma unroll
            for (int nb = 0; nb < 2; ++nb)
#pragma unroll
                for (int m = 0; m < 8; ++m) {
                    sp[nb][m].x = pk2(acc[nb][m][0], acc[nb][m][1]); sp[nb][m].y = pk2(acc[nb][m][2], acc[nb][m][3]);
                    *(v2u*)(srow + (size_t)n * 16384 + nb * 2048 + 16 * m) = sp[nb][m];
                    const v2u nv = *(const LAS v2u*)(slot + noff + nb * (16 * P128 * 2) + m * 32);
                    acc[nb][m][0] = gl * acc[nb][m][0] + bflo(nv.x); acc[nb][m][1] = gl * acc[nb][m][1] + bfhi(nv.x);
                    acc[nb][m][2] = gl * acc[nb][m][2] + bflo(nv.y); acc[nb][m][3] = gl * acc[nb][m][3] + bfhi(nv.y);
                }
#pragma unroll
            for (int kb = 0; kb < 4; ++kb) {
                const v4u bu0 = {sp[0][2 * kb].x, sp[0][2 * kb].y, sp[0][2 * kb + 1].x, sp[0][2 * kb + 1].y};
                const v4u bu1 = {sp[1][2 * kb].x, sp[1][2 * kb].y, sp[1][2 * kb + 1].x, sp[1][2 * kb + 1].y};
                const bf16x8_t b0 = __builtin_bit_cast(bf16x8_t, bu0), b1 = __builtin_bit_cast(bf16x8_t, bu1);
#pragma unroll
                for (int m = 0; m < 8; ++m) {
                    const bf16x8_t a = *(const LAS bf16x8_t*)(slot + (m * 4 + kb) * 1024 + lane * 16);
                    acc[0][m] = __builtin_amdgcn_mfma_f32_16x16x32_bf16(a, b0, acc[0][m], 0, 0, 0);
                    acc[1][m] = __builtin_amdgcn_mfma_f32_16x16x32_bf16(a, b1, acc[1][m], 0, 0, 0);
                }
            }
            CH_BAR();
        }
    }
    asm volatile("s_waitcnt vmcnt(0)" ::: "memory");
    __syncthreads();
}

__device__ __forceinline__ void delta_out_item(Frame& F, const Args& A, int l, int c, int h) {
    const int tid = F.tid, lane = F.lane, w = F.wave, r = lane & 15, q = lane >> 4;
    const bf16* DQ = (const bf16*)(F.ws + WS_DQ); const bf16* DK = (const bf16*)(F.ws + WS_DK);
    const int row0 = 64 * c;
    LAS bf16* Qs = (LAS bf16*)(F.lds);
    LAS bf16* Ks = (LAS bf16*)(F.lds + 17408);
    LAS bf16* ST = (LAS bf16*)(F.lds + 35840);
    LAS bf16* Ws = (LAS bf16*)(F.lds + 70656);
    LAS bf16* ATT = (LAS bf16*)(F.lds + 88064);
    LAS float* gcs = (LAS float*)(F.lds + 97280);
    LAS bf16* VNT = (LAS bf16*)(F.lds + 97792);
    LAS float* OS = (LAS float*)(F.lds);
    const int mi = w >> 1, nvb = 4 * (w & 1);
    f32x4 oacc[4];
#pragma unroll
    for (int k = 0; k < 4; ++k) oacc[k] = (f32x4){0.f, 0.f, 0.f, 0.f};
    for (int dir = 0; dir < 2; ++dir) {
        const int chain = dir * 8 + h, n = chunk_scan_index(dir, c);
        const size_t item = (size_t)chain * 132 + n;
        const bf16* Sg = (const bf16*)(F.ws + WS_NT) + item * 16384; const bf16* Ug = (const bf16*)(F.ws + WS_UG) + item * 8192; const bf16* Wg = (const bf16*)(F.ws + WS_WG) + item * 8192;
        const float g_in = (w == 0) ? ((const float*)(F.ws + WS_DGB))[(size_t)chain * MROWS + row0 + (dir ? 63 - lane : lane)] : 0.f;
        v2u uu[4];
#pragma unroll
        for (int k = 0; k < 4; ++k) uu[k] = *(const v2u*)(Ug + (16 * (nvb + k) + r) * 64 + (dir ? 60 - (16 * mi + 4 * q) : (16 * mi + 4 * q)));
        {   v4u rq[2], rk[2], rw[2], rs[4];
#pragma unroll
            for (int i2 = 0; i2 < 2; ++i2) { const int p = tid + 512 * i2, t = p >> 4, c8 = (p & 15) * 8; const size_t off = (size_t)(row0 + t) * 1024 + h * 128 + c8;
                if (dir == 0) { rq[i2] = *(const v4u*)(DQ + off); rk[i2] = *(const v4u*)(DK + off); }
                rw[i2] = *(const v4u*)(Wg + (size_t)(dir ? 63 - t : t) * 128 + c8); }
#pragma unroll
            for (int i4 = 0; i4 < 4; ++i4) { const int p = tid + 512 * i4; rs[i4] = *(const v4u*)(Sg + (p >> 4) * 128 + (p & 15) * 8); }
#pragma unroll
            for (int i2 = 0; i2 < 2; ++i2) { const int p = tid + 512 * i2, t = p >> 4, c8 = (p & 15) * 8;
                if (dir == 0) { *(LAS v4u*)(Qs + t * P128 + c8) = rq[i2]; *(LAS v4u*)(Ks + t * P128 + c8) = rk[i2]; }
                *(LAS v4u*)(Ws + t * P128 + c8) = rw[i2]; }
#pragma unroll
            for (int i4 = 0; i4 < 4; ++i4) { const int p = tid + 512 * i4; *(LAS v4u*)(ST + (p >> 4) * P128 + (p & 15) * 8) = rs[i4]; }
        }
        if (w == 0) { const float s_ = wave_incl_scan(g_in, lane); gcs[dir ? 63 - lane : lane] = s_; }
        LBAR();
#pragma unroll
        for (int t2 = 0; t2 < 2; ++t2) {
            const int t = w * 2 + t2, ai = t >> 2, nj = t & 3;
            const f32x4 acc = mma16<128>(Qs + 16 * ai * P128, P128, Ks + 16 * nj * P128, P128, (f32x4){0.f, 0.f, 0.f, 0.f}, lane);
            const int tj = 16 * nj + r; const float gj = gcs[tj];
#pragma unroll
            for (int jj = 0; jj < 4; ++jj) { const int ti = 16 * ai + 4 * q + jj; const bool ok = dir ? (tj >= ti) : (tj <= ti);
                ATT[ti * P64 + tj] = (bf16)f2bf(ok ? acc[jj] * __expf(gcs[ti] - gj) : 0.f); }
        }
#pragma unroll
        for (int k = 0; k < 4; ++k) {
            const int nv = nvb + k;
            const f32x4 ws = mma16<128>(Ws + 16 * mi * P128, P128, ST + 16 * nv * P128, P128, (f32x4){0.f, 0.f, 0.f, 0.f}, lane);
            const int v = 16 * nv + r, t0 = 16 * mi + 4 * q;
            float u[4];
            if (dir == 0) { u[0] = bflo(uu[k].x); u[1] = bfhi(uu[k].x); u[2] = bflo(uu[k].y); u[3] = bfhi(uu[k].y); }
            else { u[3] = bflo(uu[k].x); u[2] = bfhi(uu[k].x); u[1] = bflo(uu[k].y); u[0] = bfhi(uu[k].y); }
            v2u o; o.x = pk2(u[0] - ws[0], u[1] - ws[1]); o.y = pk2(u[2] - ws[2], u[3] - ws[3]);
            *(LAS v2u*)(VNT + v * P64 + t0) = o;
        }
        LBAR();
#pragma unroll
        for (int k = 0; k < 4; ++k) {
            const int nv = nvb + k;
            f32x4 a = mma16<128>(Qs + 16 * mi * P128, P128, ST + 16 * nv * P128, P128, (f32x4){0.f, 0.f, 0.f, 0.f}, lane);
#pragma unroll
            for (int jj = 0; jj < 4; ++jj) a[jj] *= __expf(gcs[16 * mi + 4 * q + jj]);
            a = mma16<64>(ATT + 16 * mi * P64, P64, VNT + 16 * nv * P64, P64, a, lane);
            oacc[k] += a;
        }
        LBAR();
    }
#pragma unroll
    for (int k = 0; k < 4; ++k)
#pragma unroll
        for (int jj = 0; jj < 4; ++jj) OS[(16 * mi + 4 * q + jj) * 132 + 16 * (nvb + k) + r] = oacc[k][jj];
    LBAR();
    {   const float* enw = A.in[19] + l * 128 + lane * 2; const float ew0 = enw[0], ew1 = enw[1];
        const bf16* Z = (const bf16*)(F.ws + WS_Z); bf16* E_ = (bf16*)(F.ws + WS_E);
        unsigned gz[8];
#pragma unroll
        for (int t8 = 0; t8 < 8; ++t8) gz[t8] = *(const unsigned*)(Z + (size_t)(row0 + w * 8 + t8) * ZP + C_EG + h * 128 + lane * 2);
#pragma unroll
        for (int t8 = 0; t8 < 8; ++t8) { const int t = w * 8 + t8;
            const float x0 = OS[t * 132 + lane * 2], x1 = OS[t * 132 + lane * 2 + 1];
            const float rs = __builtin_amdgcn_rsqf(wave_sum(x0 * x0 + x1 * x1) * (1.0f / 128.f) + 1e-6f);
            const size_t row = row0 + t; const unsigned g = gz[t8];
            *(unsigned*)(E_ + row * 1024 + h * 128 + lane * 2) = pk2(x0 * rs * ew0 * siluf_(bflo(g)), x1 * rs * ew1 * siluf_(bfhi(g)));
        }
    }
    LBAR();
}
constexpr int NIN_MAIN = 13824;
__device__ __forceinline__ void g1_tail_item(Frame& F, int it) {
    const int tid = F.tid, lane = F.lane, w = F.wave, r = lane & 15, q = lane >> 4;
    const bf16* Hm = (const bf16*)(F.ws + WS_H) + (size_t)(64 * it) * DM_;
    const bf16* Wt = (const bf16*)(F.ws + WS_W0 + WO_IN) + (size_t)NIN_MAIN * DM_;
    LAS bf16* As = (LAS bf16*)F.lds; LAS bf16* Bs = As + 64 * 264;
    f32x4 acc[2] = {(f32x4){0.f, 0.f, 0.f, 0.f}, (f32x4){0.f, 0.f, 0.f, 0.f}};
    v4u pa[4], pb[4];
#pragma unroll
    for (int k = 0; k < 4; ++k) { const int p = tid + 512 * k, row = p >> 5, c8 = (p & 31) * 8; pa[k] = *(const v4u*)(Hm + (size_t)row * DM_ + c8); pb[k] = *(const v4u*)(Wt + (size_t)row * DM_ + c8); }
    for (int kc = 0; kc < 8; ++kc) {
#pragma unroll
        for (int k = 0; k < 4; ++k) { const int p = tid + 512 * k, row = p >> 5, c8 = (p & 31) * 8; *(LAS v4u*)(As + row * 264 + c8) = pa[k]; *(LAS v4u*)(Bs + row * 264 + c8) = pb[k]; }
        __syncthreads();
        if (kc + 1 < 8) {
#pragma unroll
            for (int k = 0; k < 4; ++k) { const int p = tid + 512 * k, row = p >> 5, c8 = (p & 31) * 8 + (kc + 1) * 256; pa[k] = *(const v4u*)(Hm + (size_t)row * DM_ + c8); pb[k] = *(const v4u*)(Wt + (size_t)row * DM_ + c8); }
        }
#pragma unroll
        for (int t2 = 0; t2 < 2; ++t2) { const int t = w * 2 + t2, mi = t >> 2, nj = t & 3;
            acc[t2] = mma16<256>(As + 16 * mi * 264, 264, Bs + 16 * nj * 264, 264, acc[t2], lane); }
        __syncthreads();
    }
    bf16* Z = (bf16*)(F.ws + WS_Z);
#pragma unroll
    for (int t2 = 0; t2 < 2; ++t2) { const int t = w * 2 + t2, mi = t >> 2, nj = t & 3;
#pragma unroll
        for (int jj = 0; jj < 4; ++jj) Z[(size_t)(64 * it + 16 * mi + 4 * q + jj) * ZP + NIN_MAIN + 16 * nj + r] = (bf16)f2bf(acc[t2][jj]); }
}

__device__ __forceinline__ f32x4 small_mm_acc(Frame& F, const bf16* Ap, int lda, const bf16* Bp, int ldb, int K, f32x4 acc) {
    const int tid = F.tid, lane = F.lane, w = F.wave;
    LAS bf16* As = (LAS bf16*)F.lds; LAS bf16* Bs = As + 32 * 264;
    v4u pa[2][2], pb[2][4];
#define SM_LOAD(set, kc_) do { \
    _Pragma("unroll") for (int k = 0; k < 2; ++k) { const int p = tid + 512 * k, row = p >> 5, c8 = (p & 31) * 8 + (kc_) * 256; pa[set][k] = *(const v4u*)(Ap + (size_t)row * lda + c8); } \
    _Pragma("unroll") for (int k = 0; k < 4; ++k) { const int p = tid + 512 * k, row = p >> 5, c8 = (p & 31) * 8 + (kc_) * 256; pb[set][k] = *(const v4u*)(Bp + (size_t)row * ldb + c8); } } while (0)
#define SM_STEP(set, kc_) do { \
    _Pragma("unroll") for (int k = 0; k < 2; ++k) { const int p = tid + 512 * k, row = p >> 5, c8 = (p & 31) * 8; *(LAS v4u*)(As + row * 264 + c8) = pa[set][k]; } \
    _Pragma("unroll") for (int k = 0; k < 4; ++k) { const int p = tid + 512 * k, row = p >> 5, c8 = (p & 31) * 8; *(LAS v4u*)(Bs + row * 264 + c8) = pb[set][k]; } \
    LBAR(); \
    if ((kc_) + 2 < nk) SM_LOAD(set, (kc_) + 2); \
    acc = mma16<256>(As + 16 * (w >> 2) * 264, 264, Bs + 16 * (w & 3) * 264, 264, acc, lane); \
    LBAR(); } while (0)
    const int nk = K >> 8;
    SM_LOAD(0, 0); SM_LOAD(1, 1);
    for (int kc = 0; kc < nk; kc += 2) { SM_STEP(0, kc); SM_STEP(1, kc + 1); }
#undef SM_LOAD
#undef SM_STEP
    return acc;
}
__device__ __forceinline__ void ctx_f32_item(Frame& F, int it, const bf16* A, int K, const bf16* Bt, float* Y) {
    const int rt = it >> 5, ct = it & 31, lane = F.lane, w = F.wave, r = lane & 15, q = lane >> 4;
    const f32x4 acc = small_mm_acc(F, A + (size_t)(32 * rt) * K, K, Bt + (size_t)(64 * ct) * K, K, K, (f32x4){0.f, 0.f, 0.f, 0.f});
#pragma unroll
    for (int jj = 0; jj < 4; ++jj) Y[(size_t)(32 * rt + 16 * (w >> 2) + 4 * q + jj) * DM_ + 64 * ct + 16 * (w & 3) + r] = acc[jj];
}
__device__ __forceinline__ void ctx_g2_item(Frame& F, int it) {
    const int rt = it >> 5, ct = it & 31, lane = F.lane, w = F.wave, r = lane & 15, q = lane >> 4;
    unsigned char* ws = F.ws; unsigned char* wb = ws + WS_W0;
    const bf16* Zm = (const bf16*)(ws + WS_Z) + C_MG;
    const int col = 64 * ct + 16 * (w & 3) + r, rowb = 32 * rt + 16 * (w >> 2) + 4 * q;
    f32x4 tot = {0.f, 0.f, 0.f, 0.f};
    {   const f32x4 a = small_mm_acc(F, (const bf16*)(ws + WS_A) + (size_t)(32 * rt) * 512, 512, (const bf16*)(wb + WO_UA) + (size_t)(64 * ct) * 512, 512, 512, (f32x4){0.f, 0.f, 0.f, 0.f});
#pragma unroll
        for (int jj = 0; jj < 4; ++jj) tot[jj] += a[jj] * sigmoidf_(bf2f(Zm[(size_t)(rowb + jj) * ZP + col])); }
    {   const f32x4 a = small_mm_acc(F, (const bf16*)(ws + WS_D) + (size_t)(32 * rt) * 512, 512, (const bf16*)(wb + WO_UD) + (size_t)(64 * ct) * 512, 512, 512, (f32x4){0.f, 0.f, 0.f, 0.f});
#pragma unroll
        for (int jj = 0; jj < 4; ++jj) tot[jj] += a[jj] * sigmoidf_(bf2f(Zm[(size_t)(rowb + jj) * ZP + DM_ + col])); }
    {   const f32x4 a = small_mm_acc(F, (const bf16*)(ws + WS_E) + (size_t)(32 * rt) * 1024, 1024, (const bf16*)(wb + WO_UE) + (size_t)(64 * ct) * 1024, 1024, 1024, (f32x4){0.f, 0.f, 0.f, 0.f});
#pragma unroll
        for (int jj = 0; jj < 4; ++jj) tot[jj] += a[jj] * sigmoidf_(bf2f(Zm[(size_t)(rowb + jj) * ZP + 2 * DM_ + col])); }
    bf16* YB = (bf16*)(ws + WS_YB);
#pragma unroll
    for (int jj = 0; jj < 4; ++jj) YB[(size_t)(rowb + jj) * DM_ + col] = (bf16)f2bf(tot[jj]);
}

__device__ __forceinline__ void gla_cum_decay(Frame& F, const Args& A, int l, int dir, int h, int row0, LAS float* bs, LAS float* part, float* bsg) {
    const int tg = F.wave >> 1, d = (F.wave & 1) * 64 + F.lane;
    const float* ZG = (const float*)(F.ws + WS_ZG);
    const float* w2 = A.in[11] + ((size_t)(l * 2 + dir) * 16) * 512 + h * 128 + d; const float bd = A.in[12][(size_t)(l * 2 + dir) * 512 + h * 128 + d];
    float wc[16], g[16];
#pragma unroll
    for (int j = 0; j < 16; ++j) wc[j] = w2[j * 512];
    LAS float* lrs = part + 512;
    {   const int t = F.tid >> 3, j2 = (F.tid & 7) * 2; const float* src = ZG + (size_t)(row0 + t) * 64 + dir * 16 + j2; lrs[t * 16 + j2] = src[0]; lrs[t * 16 + j2 + 1] = src[1]; }
    LBAR();
#pragma unroll
    for (int k = 0; k < 16; ++k) {
        const LAS float* lr = lrs + (tg * 16 + k) * 16;
        float x = bd;
#pragma unroll
        for (int j = 0; j < 16; ++j) x += lr[j] * wc[j];
        g[k] = (fminf(x, 0.f) - __logf(1.0f + __expf(-fabsf(x)))) * 0.0625f;
    }
    float run = 0.f;
    if (dir == 0) {
#pragma unroll
        for (int k = 0; k < 16; ++k) { run += g[k]; g[k] = run; }
    } else {
#pragma unroll
        for (int k = 15; k >= 0; --k) { run += g[k]; g[k] = run; }
    }
    part[tg * 128 + d] = run;
    LBAR();
    float off = 0.f;
#pragma unroll
    for (int t2 = 0; t2 < 4; ++t2) { const float pv = part[t2 * 128 + d]; if (dir == 0 ? (t2 < tg) : (t2 > tg)) off += pv; }
#pragma unroll
    for (int k = 0; k < 16; ++k) { bs[(tg * 16 + k) * 128 + d] = g[k] + off; bsg[(tg * 16 + k) * 128 + d] = g[k] + off; }
    LBAR();
}
__device__ __forceinline__ void gla_prep2_item(Frame& F, const Args& A, int l, int chain, int c) {
    const int dir = chain >> 2, h = chain & 3, tid = F.tid, lane = F.lane, w = F.wave, r = lane & 15, q = lane >> 4;
    const bf16* Z = (const bf16*)(F.ws + WS_Z);
    const int row0 = 64 * c, n = chunk_scan_index(dir, c);
    LAS float* bs = (LAS float*)F.lds;
    LAS bf16* KdT = (LAS bf16*)(F.lds + 32768);
    LAS bf16* VT = (LAS bf16*)(F.lds + 51200);
    gla_cum_decay(F, A, l, dir, h, row0, bs, (LAS float*)(F.lds + 69632), (float*)(F.ws + WS_BS) + ((size_t)chain * 132 + chunk_scan_index(dir, c)) * 8192);
    const int tl = dir ? 0 : 63;
    {   const int ip = tid & 31, c8 = (tid >> 5) * 8, t0 = 2 * ip, t1 = t0 + 1;
        const bf16* z0 = Z + (size_t)(row0 + t0) * ZP + h * 128 + c8; const bf16* z1 = z0 + ZP;
        const v4u kv0 = *(const v4u*)(z0 + C_GK), kv1 = *(const v4u*)(z1 + C_GK), vv0 = *(const v4u*)(z0 + C_GV), vv1 = *(const v4u*)(z1 + C_GV);
        const unsigned k0w[4] = {kv0.x, kv0.y, kv0.z, kv0.w}, k1w[4] = {kv1.x, kv1.y, kv1.z, kv1.w}, v0w[4] = {vv0.x, vv0.y, vv0.z, vv0.w}, v1w[4] = {vv1.x, vv1.y, vv1.z, vv1.w};
#pragma unroll
        for (int e = 0; e < 4; ++e) {
            const int d0 = c8 + 2 * e, d1 = d0 + 1;
            const float bl0 = bs[tl * 128 + d0], bl1 = bs[tl * 128 + d1];
            *(LAS unsigned*)(KdT + d0 * P64 + t0) = pk2(bflo(k0w[e]) * __expf(bl0 - bs[t0 * 128 + d0]), bflo(k1w[e]) * __expf(bl0 - bs[t1 * 128 + d0]));
            *(LAS unsigned*)(KdT + d1 * P64 + t0) = pk2(bfhi(k0w[e]) * __expf(bl1 - bs[t0 * 128 + d1]), bfhi(k1w[e]) * __expf(bl1 - bs[t1 * 128 + d1]));
            *(LAS unsigned*)(VT + d0 * P64 + t0) = (v0w[e] & 0xffffu) | (v1w[e] << 16);
            *(LAS unsigned*)(VT + d1 * P64 + t0) = (v0w[e] >> 16) | (v1w[e] & 0xffff0000u);
        }
    }
    LBAR();
    const size_t item = (size_t)chain * 132 + n;
    float* GS = (float*)(F.ws + WS_GS) + item * 16384;
#pragma unroll
    for (int t8 = 0; t8 < 8; ++t8) {
        const int mv = w, na = t8;
        const f32x4 d = mma16<64>(VT + 16 * mv * P64, P64, KdT + 16 * na * P64, P64, (f32x4){0.f, 0.f, 0.f, 0.f}, lane);
#pragma unroll
        for (int jj = 0; jj < 4; ++jj) GS[(16 * mv + 4 * q + jj) * 128 + 16 * na + r] = d[jj];
    }
    if (tid < 128) ((float*)(F.ws + WS_GD))[item * 128 + tid] = __expf(bs[tl * 128 + tid]);
    LBAR();
}
__device__ __forceinline__ void gla_scan_item(Frame& F, int it) {
    const int chain = it >> 3, e4 = (it & 7) * 512 + F.tid, v = e4 >> 5, a4 = (e4 & 31) * 4;
    float* p = (float*)(F.ws + WS_GS) + (size_t)chain * 132 * 16384 + v * 128 + a4;
    const float* gd = (const float*)(F.ws + WS_GD) + (size_t)chain * 132 * 128 + a4;
    f32x4 S = {0.f, 0.f, 0.f, 0.f};
    for (int n = 0; n < 132; n += 12) {
        f32x4 x[12]; f32x4 d[12];
#pragma unroll
        for (int k = 0; k < 12; ++k) { x[k] = *(const f32x4*)(p + (size_t)(n + k) * 16384); d[k] = *(const f32x4*)(gd + (n + k) * 128); }
#pragma unroll
        for (int k = 0; k < 12; ++k) { *(f32x4*)(p + (size_t)(n + k) * 16384) = S; S = S * d[k] + x[k]; }
    }
}
__device__ __forceinline__ void gla_out_item(Frame& F, const Args& A, int l, int c, int h) {
    const int tid = F.tid, lane = F.lane, w = F.wave, r = lane & 15, q = lane >> 4;
    const bf16* Z = (const bf16*)(F.ws + WS_Z);
    const int row0 = 64 * c;
    LAS float* bs = (LAS float*)F.lds;
    LAS bf16* Qt = (LAS bf16*)(F.lds + 32768);
    LAS bf16* Kt = (LAS bf16*)(F.lds + 50176);
    LAS bf16* VT = (LAS bf16*)(F.lds + 67584);
    LAS bf16* ST = (LAS bf16*)(F.lds + 86016);
    LAS bf16* ATT = (LAS bf16*)(F.lds + 120832);
    LAS float* OS = (LAS float*)F.lds;
    const int mi = w >> 1, nvb = 4 * (w & 1);
    f32x4 oacc[4];
#pragma unroll
    for (int k = 0; k < 4; ++k) oacc[k] = (f32x4){0.f, 0.f, 0.f, 0.f};
    for (int dir = 0; dir < 2; ++dir) {
        const int chain = dir * 4 + h, n = chunk_scan_index(dir, c);
        const float* Sg = (const float*)(F.ws + WS_GS) + ((size_t)chain * 132 + n) * 16384;
        const float* bsg = (const float*)(F.ws + WS_BS) + ((size_t)chain * 132 + n) * 8192;
        {
            v4u qv[2], kv[2]; f32x4 bA[2], bB[2], sv[8]; v4u vv0 = {0u, 0u, 0u, 0u}, vv1 = {0u, 0u, 0u, 0u};
#pragma unroll
            for (int i2 = 0; i2 < 2; ++i2) { const int p = tid + 512 * i2, t = p >> 4, c8 = (p & 15) * 8; const bf16* zr = Z + (size_t)(row0 + t) * ZP + h * 128 + c8;
                qv[i2] = *(const v4u*)(zr + C_GQ); kv[i2] = *(const v4u*)(zr + C_GK); bA[i2] = *(const f32x4*)(bsg + t * 128 + c8); bB[i2] = *(const f32x4*)(bsg + t * 128 + c8 + 4); }
#pragma unroll
            for (int i8 = 0; i8 < 8; ++i8) { const int p = tid + 512 * i8; sv[i8] = *(const f32x4*)(Sg + (p >> 5) * 128 + (p & 31) * 4); }
            const int ipv = tid & 31, c8v = (tid >> 5) * 8, t0v = 2 * ipv;
            if (dir == 0) { const bf16* z0 = Z + (size_t)(row0 + t0v) * ZP + h * 128 + c8v + C_GV; vv0 = *(const v4u*)z0; vv1 = *(const v4u*)(z0 + ZP); }
#pragma unroll
            for (int i2 = 0; i2 < 2; ++i2) { const int p = tid + 512 * i2, t = p >> 4, c8 = (p & 15) * 8;
                const unsigned qw[4] = {qv[i2].x, qv[i2].y, qv[i2].z, qv[i2].w}, kw[4] = {kv[i2].x, kv[i2].y, kv[i2].z, kv[i2].w};
                const float bb[8] = {bA[i2].x, bA[i2].y, bA[i2].z, bA[i2].w, bB[i2].x, bB[i2].y, bB[i2].z, bB[i2].w};
                unsigned qo[4], ko[4];
#pragma unroll
                for (int e = 0; e < 4; ++e) { const float b0 = bb[2 * e], b1 = bb[2 * e + 1];
                    qo[e] = pk2(bflo(qw[e]) * __expf(b0), bfhi(qw[e]) * __expf(b1)); ko[e] = pk2(bflo(kw[e]) * __expf(-b0), bfhi(kw[e]) * __expf(-b1)); }
                *(LAS v4u*)(Qt + t * P128 + c8) = (v4u){qo[0], qo[1], qo[2], qo[3]}; *(LAS v4u*)(Kt + t * P128 + c8) = (v4u){ko[0], ko[1], ko[2], ko[3]}; }
            if (dir == 0) {
                const unsigned v0w[4] = {vv0.x, vv0.y, vv0.z, vv0.w}, v1w[4] = {vv1.x, vv1.y, vv1.z, vv1.w};
#pragma unroll
                for (int e = 0; e < 4; ++e) {
                    *(LAS unsigned*)(VT + (c8v + 2 * e) * P64 + t0v) = (v0w[e] & 0xffffu) | (v1w[e] << 16);
                    *(LAS unsigned*)(VT + (c8v + 2 * e + 1) * P64 + t0v) = (v0w[e] >> 16) | (v1w[e] & 0xffff0000u); }
            }
#pragma unroll
            for (int i8 = 0; i8 < 8; ++i8) { const int p = tid + 512 * i8; v2u o; o.x = pk2(sv[i8].x, sv[i8].y); o.y = pk2(sv[i8].z, sv[i8].w);
                *(LAS v2u*)(ST + (p >> 5) * P128 + (p & 31) * 4) = o; }
        }
        LBAR();
#pragma unroll
        for (int t2 = 0; t2 < 2; ++t2) {
            const int t = w * 2 + t2, ai = t >> 2, nj = t & 3;
            const f32x4 acc = mma16<128>(Qt + 16 * ai * P128, P128, Kt + 16 * nj * P128, P128, (f32x4){0.f, 0.f, 0.f, 0.f}, lane);
            const int tj = 16 * nj + r;
#pragma unroll
            for (int jj = 0; jj < 4; ++jj) { const int ti = 16 * ai + 4 * q + jj; const bool ok = dir ? (tj >= ti) : (tj <= ti);
                ATT[ti * P64 + tj] = (bf16)f2bf(ok ? acc[jj] : 0.f); }
        }
        LBAR();
#pragma unroll
        for (int k = 0; k < 4; ++k) {
            const int nv = nvb + k;
            oacc[k] = mma16<64>(ATT + 16 * mi * P64, P64, VT + 16 * nv * P64, P64, oacc[k], lane);
            oacc[k] = mma16<128>(Qt + 16 * mi * P128, P128, ST + 16 * nv * P128, P128, oacc[k], lane);
        }
        LBAR();
    }
#pragma unroll
    for (int k = 0; k < 4; ++k)
#pragma unroll
        for (int jj = 0; jj < 4; ++jj) OS[(16 * mi + 4 * q + jj) * 132 + 16 * (nvb + k) + r] = oacc[k][jj] * 0.08838834764831845f;
    LBAR();
    {   const float* gnw = A.in[13] + l * 128 + lane * 2; const float gw0 = gnw[0], gw1 = gnw[1];
        bf16* A_ = (bf16*)(F.ws + WS_A);
        unsigned gz[8];
#pragma unroll
        for (int t8 = 0; t8 < 8; ++t8) gz[t8] = *(const unsigned*)(Z + (size_t)(row0 + w * 8 + t8) * ZP + C_GG + h * 128 + lane * 2);
#pragma unroll
        for (int t8 = 0; t8 < 8; ++t8) { const int t = w * 8 + t8;
            const float x0 = OS[t * 132 + lane * 2], x1 = OS[t * 132 + lane * 2 + 1];
            const float rs = __builtin_amdgcn_rsqf(wave_sum(x0 * x0 + x1 * x1) * (1.0f / 128.f) + 1e-6f);
            const size_t row = row0 + t; const unsigned g = gz[t8];
            *(unsigned*)(A_ + row * 512 + h * 128 + lane * 2) = pk2(x0 * rs * gw0 * siluf_(bflo(g)), x1 * rs * gw1 * siluf_(bfhi(g)));
        }
    }
    LBAR();
}
__device__ __forceinline__ void diff_out_rows(Frame& F, const Args& A, int l) {
    const int gw = F.bid * 8 + F.wave, NGW = F.G * 8, lane = F.lane;
    const bf16* AO = (const bf16*)(F.ws + WS_AO); bf16* D_ = (bf16*)(F.ws + WS_D);
    const float lam_init = l == 0 ? 0.2f : 0.35550906759096924f;
    const float* lp = A.in[14] + l * 256;
    const float lam = expf(wave_sum(lp[lane] * lp[64 + lane])) - expf(wave_sum(lp[128 + lane] * lp[192 + lane])) + lam_init;
    const float* dnw = A.in[15] + l * 128 + lane * 2; const float dw0 = dnw[0], dw1 = dnw[1];
    for (int r = gw + (l == 1 ? CTXL : 0); r < MROWS; r += NGW) {
        unsigned wa[4], wb_[4];
#pragma unroll
        for (int h = 0; h < 4; ++h) { wa[h] = *(const unsigned*)(AO + (size_t)r * 1024 + (h * 2) * 128 + lane * 2); wb_[h] = *(const unsigned*)(AO + (size_t)r * 1024 + (h * 2 + 1) * 128 + lane * 2); }
#pragma unroll
        for (int h = 0; h < 4; ++h) {
            const int c = h * 128 + lane * 2;
            const unsigned w1 = wa[h], w2 = wb_[h];
            const float x0 = bflo(w1) - lam * bflo(w2), x1 = bfhi(w1) - lam * bfhi(w2);
            const float rs = __builtin_amdgcn_rsqf(wave_sum(x0 * x0 + x1 * x1) * (1.0f / 128.f) + 1e-6f) * (1.0f - lam_init);
            *(unsigned*)(D_ + (size_t)r * 512 + c) = pk2(x0 * rs * dw0, x1 * rs * dw1);
        }
    }
}
#ifndef MK_SINGLE
#define MK_SINGLE 1
#endif
template <int l> __device__ __forceinline__ void layer_phases(Frame& F, const Args& args, unsigned char* lds, const int lo, const int hi, const XcdBarrier& bar) {
    unsigned char* ws = args.ws;
#define IN(k) (lo <= (k) && (k) < hi)
#define SEAM(k) do { if (IN(k) && IN((k) + 1)) { xcd_barrier(bar); if (REP_SYNC > 1) xcd_barrier(bar); } } while (0)
    const int pb = 2 + 11 * l;
    unsigned char* wb = ws + WS_W0;
    if (IN(pb + 0) && !SKIP_G1) {
        pg8::Gemm g{(const bf16*)(ws + WS_H), (const bf16*)(wb + WO_IN), MROWS, NIN_MAIN, DM_}; pg8::StaticOrder S; S.init(MROWS, NIN_MAIN, F.G, F.bid); S.rep = REP_G1;
        pg8::EpiZ E{(bf16*)(ws + WS_Z), ZP, (float*)(ws + WS_ZG)};
        pg8::gemm_phase<pg8::EpiZ, pg8::StaticOrder, true, true>(F.lds, g, S, E);
    } SEAM(pb + 0);
    if (IN(pb + 1)) { if (F.bid < 132) g1_tail_item(F, F.bid); prep_phase(F, args, l); } SEAM(pb + 1);
    if (IN(pb + 2)) {
        for (int it = F.bid; it < 2112 * REP_C1; it += F.G) delta_prep2_item(F, (it % 2112) / 132, it % 132);
        for (int it = F.G - 1 - F.bid; it < 1056 * REP_C2; it += F.G) gla_prep2_item(F, args, l, (it % 1056) / 132, it % 132);
    } SEAM(pb + 2);
    if (IN(pb + 3)) {
        if (F.bid < 16) delta_chain(F, F.bid);
        else if (F.bid - 16 < 64) gla_scan_item(F, F.bid - 16);
        {
            const attn_body::bf16* AQ = (const attn_body::bf16*)(ws + WS_AQ); const attn_body::bf16* AK = (const attn_body::bf16*)(ws + WS_AK);
            const attn_body::bf16* AV = (const attn_body::bf16*)(ws + WS_AV); attn_body::bf16* AO = (attn_body::bf16*)(ws + WS_AO);
            unsigned* cnt = (unsigned*)(ws + WS_CNT) + 64 * l;
            volatile LAS unsigned* slot = (volatile LAS unsigned*)(F.lds + MISC_OFF) + 16;
            for (;;) {
                if (F.tid == 0) slot[0] = __hip_atomic_fetch_add(cnt, 1u, __ATOMIC_RELAXED, __HIP_MEMORY_SCOPE_AGENT);
                __syncthreads();
                const int ui = (int)slot[0];
                __syncthreads();
                constexpr int NU = (l == 1) ? 512 : 528;
                if (ui >= NU * REP_ATTN) break;
                const int uj = ui % NU; const int qb = 32 - uj / 16, rem = uj % 16, hm = rem >> 1, half = rem & 1;
                attn_body::attn_unit<8>(AQ + (size_t)qb * 256 * 512 + hm * 64, AK + hm * 64, AV + (hm >> 1) * 128 + half * 64,
                                        AO + (size_t)qb * 256 * 1024 + hm * 128 + half * 64, qb == 0 ? 4 : 132, (char*)lds);
            }
        }
        if (l == 0) p0_dynamic(F, args, 0, (unsigned*)(ws + WS_CNT) + 128, I_IN, PER_L);
        else p0_dynamic(F, args, 1, (unsigned*)(ws + WS_CNT) + 256, I_IN, PER_L - I_2);
    } SEAM(pb + 3);
    if (IN(pb + 4)) {
        for (int it = F.bid; it < 1056 * REP_C3; it += F.G) { if (l == 1 && ((it % 1056) >> 3) < 4) continue; delta_out_item(F, args, l, (it % 1056) >> 3, it & 7); }
        for (int it = F.G - 1 - F.bid; it < 528 * REP_C4; it += F.G) { if (l == 1 && ((it % 528) >> 2) < 4) continue; gla_out_item(F, args, l, (it % 528) >> 2, it & 3); }
        diff_out_rows(F, args, l);
    } SEAM(pb + 4);
    if (IN(pb + 5) && !SKIP_G2) {
        const bf16* Zm = (const bf16*)(ws + WS_Z) + C_MG; float* YF = (float*)(ws + WS_R2); bf16* YB = (bf16*)(ws + WS_YB);
        pg8::StaticOrder S; S.init(MROWS - CTXL, DM_, F.G, F.bid); S.pmoff = 1;
        { pg8::Gemm g{(const bf16*)(ws + WS_A), (const bf16*)(wb + WO_UA), MROWS, DM_, 512}; pg8::EpiGate<0> E{Zm, ZP, YF, YB, DM_};
          pg8::gemm_phase<pg8::EpiGate<0>, pg8::StaticOrder, true, true>(F.lds, g, S, E); }
        { pg8::Gemm g{(const bf16*)(ws + WS_D), (const bf16*)(wb + WO_UD), MROWS, DM_, 512}; pg8::EpiGate<1> E{Zm + DM_, ZP, YF, YB, DM_};
          pg8::gemm_phase<pg8::EpiGate<1>, pg8::StaticOrder, true, true>(F.lds, g, S, E); }
        { pg8::Gemm g{(const bf16*)(ws + WS_E), (const bf16*)(wb + WO_UE), MROWS, DM_, 1024}; pg8::EpiGate<2> E{Zm + 2 * DM_, ZP, YF, YB, DM_};
          pg8::gemm_phase<pg8::EpiGate<2>, pg8::StaticOrder, true, true>(F.lds, g, S, E); }
        if (l == 0) for (int it = F.bid; it < 256; it += F.G) ctx_g2_item(F, it);
    } SEAM(pb + 5);
    if (IN(pb + 6) && !SKIP_G3) {
        pg8::Gemm g{(const bf16*)(ws + WS_YB), (const bf16*)(wb + WO_O), MROWS, DM_, DM_}; pg8::StaticOrder S; S.init(MROWS - CTXL, DM_, F.G, F.bid); S.pmoff = 1; S.rep = REP_G3;
        pg8::EpiF32 E{(float*)(ws + WS_R2), DM_};
        pg8::gemm_phase<pg8::EpiF32, pg8::StaticOrder, true, true>(F.lds, g, S, E);
        if (l == 0) for (int it = F.bid; it < 256; it += F.G) ctx_f32_item(F, it, (const bf16*)(ws + WS_YB), DM_, (const bf16*)(wb + WO_O), (float*)(ws + WS_R2));
    } SEAM(pb + 6);
    if (IN(pb + 7)) { row_phase<1>(F, args, l); } SEAM(pb + 7);
    if (IN(pb + 8) && !SKIP_G4) {
        pg8::Gemm g{(const bf16*)(ws + WS_H), (const bf16*)(wb + WO_13), MROWS, 2 * DFF, DM_}; pg8::StaticOrder S; S.init(MROWS - CTXL * l, 2 * DFF, F.G, F.bid); S.pmoff = l; S.rep = REP_G4;
        pg8::EpiSwiglu E{(bf16*)(ws + WS_HFF), DFF};
        pg8::gemm_phase<pg8::EpiSwiglu, pg8::StaticOrder, true, true>(F.lds, g, S, E);
        if (l == 0) p0_dynamic(F, args, 1, (unsigned*)(ws + WS_CNT) + 192, 0, I_IN);
        else p0_dynamic(F, args, 1, (unsigned*)(ws + WS_CNT) + 320, PER_L - I_2, PER_L);
    } SEAM(pb + 8);
    if (IN(pb + 9) && !SKIP_G5) {
        pg8::Gemm g{(const bf16*)(ws + WS_HFF), (const bf16*)(wb + WO_2), MROWS, DM_, DFF}; pg8::StaticOrder S; S.init(MROWS - CTXL, DM_, F.G, F.bid); S.pmoff = 1; S.rep = REP_G5;
        pg8::EpiF32 E{(float*)(ws + WS_R2), DM_};
        pg8::gemm_phase<pg8::EpiF32, pg8::StaticOrder, true, true>(F.lds, g, S, E);
        if (l == 0) { for (int it = F.bid; it < 256; it += F.G) ctx_f32_item(F, it, (const bf16*)(ws + WS_HFF), DFF, (const bf16*)(wb + WO_2), (float*)(ws + WS_R2));
                    }
    } SEAM(pb + 9);
    if (IN(pb + 10)) { row_phase<2>(F, args, l); } SEAM(pb + 10);
#undef IN
#undef SEAM
}
__global__ void __launch_bounds__(512, 2) mega_fwd(Args args) {
    extern __shared__ __attribute__((aligned(16))) unsigned char lds[];
    Frame F;
    F.lds = (LAS unsigned char*)lds; F.tid = threadIdx.x; F.lane = F.tid & 63; F.wave = __builtin_amdgcn_readfirstlane(F.tid >> 6);
    F.G = gridDim.x; F.bid = blockIdx.x; F.ws = args.ws; F.out = args.out;
    const int lo = args.ph_lo, hi = args.ph_hi;
    if (lo < 0) cg::this_grid().sync();
    for (int u = F.tid; u < 64; u += 512) ((LAS unsigned*)(F.lds + MISC_OFF))[u] = 0u;
    __syncthreads();
    XcdBarrier bar; bar.bar = (unsigned*)(args.ws + WS_BAR); bar.x = 0; bar.st = nullptr;
    if (hi - lo > 1) bar = xcd_barrier_post((unsigned*)(args.ws + WS_BAR), (volatile LAS unsigned*)(F.lds + MISC_OFF) + 8);
#define IN(k) (lo <= (k) && (k) < hi)
#define SEAM(k) do { if (IN(k) && IN((k) + 1)) { xcd_barrier(bar); if (REP_SYNC > 1) xcd_barrier(bar); } } while (0)
    unsigned char* ws = args.ws;
    if (IN(0)) { p0_phase(F, args, 0, true, 0, I_IN); } SEAM(0);
    if (IN(1)) { row_phase<0>(F, args, 0); } SEAM(1);
    layer_phases<0>(F, args, lds, lo, hi, bar);
    layer_phases<1>(F, args, lds, lo, hi, bar);
#undef IN
#undef SEAM
}

extern "C" void kernel_launch(void* const* d_in, const int* in_sizes, int n_in, void* d_out, int out_size, void* d_ws, size_t ws_size, hipStream_t stream) {
    static int grid = 0;
    if (grid == 0) {
        if (n_in != 27 || out_size != SEQ_ * DM_ || ws_size < WS_END2) { fprintf(stderr, "kernel_launch: unexpected shapes (n_in %d, out %d, ws %zu < %zu)\n", n_in, out_size, ws_size, (size_t)WS_END2); grid = -1; return; }
        if (hipFuncSetAttribute((const void*)mega_fwd, hipFuncAttributeMaxDynamicSharedMemorySize, LDS_BYTES) != hipSuccess) { fprintf(stderr, "kernel_launch: hipFuncSetAttribute failed\n"); grid = -1; return; }
        int dev = 0, cus = 0, per_cu = 0;
        hipGetDevice(&dev); hipDeviceGetAttribute(&cus, hipDeviceAttributeMultiprocessorCount, dev);
        hipOccupancyMaxActiveBlocksPerMultiprocessor(&per_cu, (const void*)mega_fwd, 512, LDS_BYTES);
        if (per_cu < 1) { fprintf(stderr, "kernel_launch: occupancy query says %d blocks per CU\n", per_cu); per_cu = 1; }
        (void)hipGetLastError();
        grid = cus;
    }
    if (grid < 0) return;
    Args a{};
    for (int i = 0; i < 27; ++i) a.in[i] = (const float*)d_in[i];
    a.out = (float*)d_out; a.ws = (unsigned char*)d_ws;
#if MK_SINGLE
    if (hipMemsetAsync((char*)d_ws + WS_BAR, 0, BAR_BYTES, stream) != hipSuccess) { fprintf(stderr, "kernel_launch: memset failed\n"); return; }
    a.ph_lo = 0; a.ph_hi = NPH;
    void* kargs[] = {&a};
    hipError_t e = hipLaunchCooperativeKernel((const void*)mega_fwd, dim3(grid), dim3(512), kargs, LDS_BYTES, stream);
    if (e != hipSuccess) fprintf(stderr, "cooperative launch failed: %s (grid %d)\n", hipGetErrorString(e), grid);
#else
    for (int p = 0; p < NPH; ++p) { a.ph_lo = p; a.ph_hi = p + 1; hipLaunchKernelGGL(mega_fwd, dim3(grid), dim3(512), LDS_BYTES, stream, a); }
#endif
}
```

```cpp
#include <hip/hip_runtime.h>
#include <hip/hip_cooperative_groups.h>
#include <hip/hip_bf16.h>
#include <cstdio>
#include <cstdint>
#include <cmath>
namespace cg = cooperative_groups;
#ifndef SKIP_G1
#define SKIP_G1 0
#endif
#ifndef SKIP_G2
#define SKIP_G2 0
#endif
#ifndef SKIP_G3
#define SKIP_G3 0
#endif
#ifndef SKIP_G4
#define SKIP_G4 0
#endif
#ifndef SKIP_G5
#define SKIP_G5 0
#endif
#ifndef REP_G1
#define REP_G1 1
#endif
#ifndef REP_G3
#define REP_G3 1
#endif
#ifndef REP_G4
#define REP_G4 1
#endif
#ifndef REP_G5
#define REP_G5 1
#endif
#ifndef REP_C1
#define REP_C1 1
#endif
#ifndef REP_C2
#define REP_C2 1
#endif
#ifndef REP_C3
#define REP_C3 1
#endif
#ifndef REP_C4
#define REP_C4 1
#endif
#ifndef REP_GEMM
#define REP_GEMM 1
#endif
#ifndef REP_CHUNK
#define REP_CHUNK 1
#endif
#ifndef REP_ATTN
#define REP_ATTN 1
#endif
#ifndef REP_ROWS
#define REP_ROWS 1
#endif
#ifndef REP_P0
#define REP_P0 1
#endif
#ifndef REP_SYNC
#define REP_SYNC 1
#endif
namespace pg8 {
#define PG8_LAS __attribute__((address_space(3)))
typedef unsigned short bf16_t;
typedef short bf16x8 __attribute__((ext_vector_type(8)));
typedef float f32x4 __attribute__((ext_vector_type(4)));
typedef unsigned u32x4 __attribute__((ext_vector_type(4)));
constexpr int BM = 256, BK = 64, HALF = 128, HTB = HALF * BK * 2  , STAGE_BYTES = 8 * HTB, NXCD = 8, WGM = 8;

__host__ __device__ __forceinline__ int lds_byte(int r, int c) { const int st = (r >> 4) * 2 + (c >> 5), rr = r & 15, cc = c & 31, ob = rr * 64 + cc * 2; return st * 1024 + (ob ^ (((ob >> 9) & 1) << 5)); }
__host__ __device__ __forceinline__ void stage_rc(int b, int& R, int& C) { const int st = b / 1024, sb = b % 1024, swz = sb ^ (((sb >> 9) & 1) << 5); R = (st >> 1) * 16 + swz / 64; C = (st & 1) * 32 + (swz % 64) / 2; }
__host__ __device__ __forceinline__ int perm32(int rho) { const int n = rho >> 4, i = rho & 15; return 8 * (i >> 2) + 4 * n + (i & 3); }

struct Unit { int pm, pn; };
struct Gemm { const bf16_t* A; const bf16_t* Bt; int M, N, K; };

struct StaticOrder {
    int nM, nN, nwg, G, c, rep = 1, pmoff = 0;
    __host__ __device__ void init(int M, int N, int G_, int c_) { nM = M / BM; nN = N / BM; nwg = nM * nN; G = G_; c = c_; }
    __host__ __device__ bool next(int i, Unit& u) const {
        const long L = (long)(i / rep) * G + c; if (L >= nwg) return false;
        int wgid = (int)L; { const int q = nwg / NXCD, r = nwg % NXCD, xcd = wgid % NXCD, off = wgid / NXCD; wgid = (xcd < r ? xcd * (q + 1) : r * (q + 1) + (xcd - r) * q) + off; }
        const int nig = WGM * nN, gid = wgid / nig, fm = gid * WGM, gsz = (nM - fm) < WGM ? (nM - fm) : WGM;
        u.pm = pmoff + fm + ((wgid % nig) % gsz); u.pn = (wgid % nig) / gsz; return true;
    }
    __device__ __forceinline__ void a_ready(const Unit&) const {}
    __device__ __forceinline__ void done(const Unit&) const {}
};

__device__ __forceinline__ unsigned cvt_pk_bf16(float lo, float hi) { unsigned r; asm volatile("v_cvt_pk_bf16_f32 %0, %1, %2" : "=v"(r) : "v"(lo), "v"(hi)); return r; }
typedef float f32x2 __attribute__((ext_vector_type(2)));
typedef unsigned u32x2 __attribute__((ext_vector_type(2)));
__device__ __forceinline__ float ep_sigmoid(float x) { return __builtin_amdgcn_rcpf(1.0f + __expf(-x)); }
struct EpiZ {
    static constexpr bool PERM = true, AFTER_DRAIN = false;
    bf16_t* Z; int ldz; float* ZG;
    __device__ __forceinline__ void operator()(const f32x4 (&acc)[2][2][4][2], const Unit& u, int wr, int wc, int fr, int fq) const {
        const int row0 = u.pm * BM + wr * 64 + fr, col0 = u.pn * BM + wc * 32 + 8 * fq;
#pragma unroll
        for (int ai = 0; ai < 2; ++ai)
#pragma unroll
            for (int m = 0; m < 4; ++m) { const int row = row0 + ai * HALF + m * 16;
#pragma unroll
                for (int bj = 0; bj < 2; ++bj) { const int c = col0 + bj * HALF; const f32x4 v0 = acc[ai][bj][m][0], v1 = acc[ai][bj][m][1];
                    u32x4 w; w.x = cvt_pk_bf16(v0[0], v0[1]); w.y = cvt_pk_bf16(v0[2], v0[3]); w.z = cvt_pk_bf16(v1[0], v1[1]); w.w = cvt_pk_bf16(v1[2], v1[3]);
                    *(u32x4*)(Z + (size_t)row * ldz + c) = w;
                    int gc = -1; if (c >= 1536 && c < 1568) gc = c - 1536; else if (c >= 6688 && c < 6720) gc = 32 + c - 6688;
                    if (gc >= 0) { float* g = ZG + (size_t)row * 64 + gc; *(f32x4*)g = v0; *(f32x4*)(g + 4) = v1; } } }
    }
};
template <int MODE> struct EpiGate {
    static constexpr bool PERM = true, AFTER_DRAIN = false;
    const bf16_t* Zg; int ldz; float* YF; bf16_t* YB; int ldc;
    __device__ __forceinline__ void operator()(const f32x4 (&acc)[2][2][4][2], const Unit& u, int wr, int wc, int fr, int fq) const {
        const int row0 = u.pm * BM + wr * 64 + fr, col0 = u.pn * BM + wc * 32 + 8 * fq;
#pragma unroll
        for (int ai = 0; ai < 2; ++ai)
#pragma unroll
            for (int m = 0; m < 4; ++m) { const int row = row0 + ai * HALF + m * 16;
#pragma unroll
                for (int bj = 0; bj < 2; ++bj) { const int c = col0 + bj * HALF;
                    const u32x4 gz = *(const u32x4*)(Zg + (size_t)row * ldz + c);
                    f32x4 g0, g1;
                    g0[0] = ep_sigmoid(__builtin_bit_cast(float, gz.x << 16)); g0[1] = ep_sigmoid(__builtin_bit_cast(float, gz.x & 0xffff0000u));
                    g0[2] = ep_sigmoid(__builtin_bit_cast(float, gz.y << 16)); g0[3] = ep_sigmoid(__builtin_bit_cast(float, gz.y & 0xffff0000u));
                    g1[0] = ep_sigmoid(__builtin_bit_cast(float, gz.z << 16)); g1[1] = ep_sigmoid(__builtin_bit_cast(float, gz.z & 0xffff0000u));
                    g1[2] = ep_sigmoid(__builtin_bit_cast(float, gz.w << 16)); g1[3] = ep_sigmoid(__builtin_bit_cast(float, gz.w & 0xffff0000u));
                    f32x4 v0 = acc[ai][bj][m][0] * g0, v1 = acc[ai][bj][m][1] * g1;
                    bf16_t* y = (bf16_t*)YF + (size_t)row * ldc + c;
                    if (MODE >= 1) { const u32x4 t = *(const u32x4*)y;
                        v0[0] += __builtin_bit_cast(float, t.x << 16); v0[1] += __builtin_bit_cast(float, t.x & 0xffff0000u); v0[2] += __builtin_bit_cast(float, t.y << 16); v0[3] += __builtin_bit_cast(float, t.y & 0xffff0000u);
                        v1[0] += __builtin_bit_cast(float, t.z << 16); v1[1] += __builtin_bit_cast(float, t.z & 0xffff0000u); v1[2] += __builtin_bit_cast(float, t.w << 16); v1[3] += __builtin_bit_cast(float, t.w & 0xffff0000u); }
                    u32x4 w; w.x = cvt_pk_bf16(v0[0], v0[1]); w.y = cvt_pk_bf16(v0[2], v0[3]); w.z = cvt_pk_bf16(v1[0], v1[1]); w.w = cvt_pk_bf16(v1[2], v1[3]);
                    if (MODE <= 1) *(u32x4*)y = w; else *(u32x4*)(YB + (size_t)row * ldc + c) = w; } }
    }
};
struct EpiF32 {
    static constexpr bool PERM = true, AFTER_DRAIN = false;
    float* Y; int ldc;
    __device__ __forceinline__ void operator()(const f32x4 (&acc)[2][2][4][2], const Unit& u, int wr, int wc, int fr, int fq) const {
        const int row0 = u.pm * BM + wr * 64 + fr, col0 = u.pn * BM + wc * 32 + 8 * fq;
#pragma unroll
        for (int ai = 0; ai < 2; ++ai)
#pragma unroll
            for (int m = 0; m < 4; ++m) { const int row = row0 + ai * HALF + m * 16;
#pragma unroll
                for (int bj = 0; bj < 2; ++bj) { float* y = Y + (size_t)row * ldc + col0 + bj * HALF; *(f32x4*)y = acc[ai][bj][m][0]; *(f32x4*)(y + 4) = acc[ai][bj][m][1]; } }
    }
};
struct EpiSwiglu {
    static constexpr bool PERM = true, AFTER_DRAIN = false;
    bf16_t* Hf; int ldc;
    __device__ __forceinline__ void operator()(const f32x4 (&acc)[2][2][4][2], const Unit& u, int wr, int wc, int fr, int fq) const {
        const int row0 = u.pm * BM + wr * 64 + fr, col0 = u.pn * HALF + wc * 32 + 8 * fq;
#pragma unroll
        for (int ai = 0; ai < 2; ++ai)
#pragma unroll
            for (int m = 0; m < 4; ++m) { const int row = row0 + ai * HALF + m * 16; float o[8];
#pragma unroll
                for (int n = 0; n < 2; ++n)
#pragma unroll
                    for (int j = 0; j < 4; ++j) { const float a = acc[ai][0][m][n][j], b = acc[ai][1][m][n][j]; o[n * 4 + j] = a * __builtin_amdgcn_rcpf(1.0f + __expf(-a)) * b; }
                u32x4 w; w.x = cvt_pk_bf16(o[0], o[1]); w.y = cvt_pk_bf16(o[2], o[3]); w.z = cvt_pk_bf16(o[4], o[5]); w.w = cvt_pk_bf16(o[6], o[7]);
                *(u32x4*)(Hf + (size_t)row * ldc + col0) = w; }
    }
};
template <class Epi, class Sched, bool ALIGN_EPI = false, bool SP2 = false>
__device__ __forceinline__ void gemm_phase(PG8_LAS unsigned char* lds, const Gemm g, const Sched& S, const Epi& E) {
    const int tid = threadIdx.x, wid = __builtin_amdgcn_readfirstlane(tid >> 6), lane = tid & 63, wr = wid >> 2, wc = wid & 3, fr = lane & 15, fq = lane >> 4;
    const int K = g.K, nt = K / BK;
    unsigned voffA[2], voffB[2];
#pragma unroll
    for (int i = 0; i < 2; ++i) { int R, C; stage_rc(tid * 16 + i * 8192, R, C); const int Rb = Epi::PERM ? ((R & ~31) + perm32(R & 31)) : R;
        voffA[i] = (unsigned)(R * K + C) * 2u; voffB[i] = (unsigned)(Rb * K + C) * 2u; }
    const size_t kstep = (size_t)(BK * 2);
    const size_t hstep = (size_t)HALF * K * 2;
    const size_t tstep = 2 * hstep;
    const unsigned ldsw = (unsigned)wid * 1024u;
    const int aoff = lds_byte(wr * 64 + fr, fq * 8), boff = lds_byte(wc * 32 + fr, fq * 8);
#define PG8_SA(b, h) (((b) * 2 + (h)) * HTB)
#define PG8_SB(b, h) ((4 + (b) * 2 + (h)) * HTB)
#define PG8_STAGE(bufoff, gbase, voff) do { _Pragma("unroll") for (int _i = 0; _i < 2; ++_i) \
        __builtin_amdgcn_global_load_lds((const unsigned*)((const char*)(gbase) + (voff)[_i]), (PG8_LAS unsigned*)(lds + (bufoff) + ldsw + _i * 8192), 16, 0, 0); } while (0)
#define PG8_LDA(dst, b, h) do { _Pragma("unroll") for (int m = 0; m < 4; ++m) _Pragma("unroll") for (int k = 0; k < 2; ++k) dst[m][k] = *(const PG8_LAS bf16x8*)(lds + PG8_SA(b, h) + aoff + m * 2048 + k * 1024); } while (0)
#define PG8_LDB(dst, b, h) do { _Pragma("unroll") for (int n = 0; n < 2; ++n) _Pragma("unroll") for (int k = 0; k < 2; ++k) dst[n][k] = *(const PG8_LAS bf16x8*)(lds + PG8_SB(b, h) + boff + n * 2048 + k * 1024); } while (0)
#define PG8_MMA(ai, bj, At, Bt) do { __builtin_amdgcn_s_setprio(1); _Pragma("unroll") for (int m = 0; m < 4; ++m) _Pragma("unroll") for (int n = 0; n < 2; ++n) _Pragma("unroll") for (int k = 0; k < 2; ++k) \
        acc[ai][bj][m][n] = __builtin_amdgcn_mfma_f32_16x16x32_bf16(Bt[n][k], At[m][k], acc[ai][bj][m][n], 0, 0, 0); __builtin_amdgcn_s_setprio(0); } while (0)
#define PG8_WAIT_V(n) asm volatile("s_waitcnt vmcnt(" #n ")" ::: "memory")
#define PG8_WAIT_L(n) asm volatile("s_waitcnt lgkmcnt(" #n ")" ::: "memory")
#define PG8_BAR __builtin_amdgcn_s_barrier()
#define PG8_SCHED __builtin_amdgcn_sched_barrier(0)
    Unit cur, nxt; int ui = 0;
    if (!S.next(0, cur)) return;
    f32x4 acc[2][2][4][2];
#pragma unroll
    for (int a = 0; a < 2; ++a)
#pragma unroll
        for (int b = 0; b < 2; ++b)
#pragma unroll
            for (int m = 0; m < 4; ++m)
#pragma unroll
                for (int n = 0; n < 2; ++n) acc[a][b][m][n] = (f32x4){0.f, 0.f, 0.f, 0.f};
    bf16x8 At[4][2], B0[2][2], B1[2][2];
    const char* cA = (const char*)g.A + (size_t)cur.pm * tstep; const char* cB = (const char*)g.Bt + (size_t)cur.pn * tstep;
    S.a_ready(cur);
    if constexpr (SP2) {
        PG8_STAGE(PG8_SB(0, 0), cB, voffB); PG8_STAGE(PG8_SB(0, 1), cB + hstep, voffB); PG8_STAGE(PG8_SA(0, 0), cA, voffA); PG8_STAGE(PG8_SA(0, 1), cA + hstep, voffA);
        if (wr == 1) PG8_BAR;
        PG8_WAIT_V(2); PG8_BAR;
        PG8_STAGE(PG8_SB(1, 0), cB + kstep, voffB); PG8_STAGE(PG8_SA(1, 0), cA + kstep, voffA); PG8_STAGE(PG8_SB(1, 1), cB + hstep + kstep, voffB);
        PG8_WAIT_V(6); PG8_BAR;
    } else {
        PG8_STAGE(PG8_SB(0, 0), cB, voffB); PG8_STAGE(PG8_SA(0, 0), cA, voffA); PG8_STAGE(PG8_SB(0, 1), cB + hstep, voffB); PG8_STAGE(PG8_SA(0, 1), cA + hstep, voffA);
        if (wr == 1) PG8_BAR;
        PG8_WAIT_V(4); PG8_BAR;
        PG8_STAGE(PG8_SB(1, 0), cB + kstep, voffB); PG8_STAGE(PG8_SA(1, 0), cA + kstep, voffA); PG8_STAGE(PG8_SB(1, 1), cB + hstep + kstep, voffB);
        PG8_WAIT_V(6); PG8_BAR;
    }
    for (;;) {
        const bool has_next = S.next(ui + 1, nxt);
        const char* nA = has_next ? (const char*)g.A + (size_t)nxt.pm * tstep : cA; const char* nB = has_next ? (const char*)g.Bt + (size_t)nxt.pn * tstep : cB;
        for (int t = 0; t < nt; t += 2) {
            const bool last = (t == nt - 2);
            const char* a1 = cA + (size_t)(t + 1) * kstep;
            const char* a2 = last ? nA : cA + (size_t)(t + 2) * kstep; const char* b2 = last ? nB : cB + (size_t)(t + 2) * kstep;
            const char* a3 = a2 + kstep; const char* b3 = b2 + kstep;
            if (last && has_next) S.a_ready(nxt);
            if constexpr (SP2) {
            PG8_LDB(B0, 0, 0); PG8_LDB(B1, 0, 1); PG8_SCHED; PG8_LDA(At, 0, 0); PG8_STAGE(PG8_SA(1, 1), a1 + hstep, voffA);
            PG8_WAIT_V(8); PG8_WAIT_L(0); PG8_BAR; PG8_MMA(0, 0, At, B0); PG8_MMA(0, 1, At, B1); PG8_BAR; PG8_SCHED;
            PG8_LDA(At, 0, 1); PG8_STAGE(PG8_SB(0, 0), b2, voffB); PG8_STAGE(PG8_SB(0, 1), b2 + hstep, voffB); PG8_STAGE(PG8_SA(0, 0), a2, voffA);
            PG8_WAIT_V(8); PG8_WAIT_L(0); PG8_BAR; PG8_MMA(1, 0, At, B0); PG8_MMA(1, 1, At, B1); PG8_BAR; PG8_SCHED;
            PG8_LDB(B0, 1, 0); PG8_LDB(B1, 1, 1); PG8_SCHED; PG8_LDA(At, 1, 0); PG8_STAGE(PG8_SA(0, 1), a2 + hstep, voffA);
            PG8_WAIT_V(8); PG8_WAIT_L(0); PG8_BAR; PG8_MMA(0, 0, At, B0); PG8_MMA(0, 1, At, B1); PG8_BAR; PG8_SCHED;
            PG8_LDA(At, 1, 1); PG8_STAGE(PG8_SB(1, 0), b3, voffB); PG8_STAGE(PG8_SB(1, 1), b3 + hstep, voffB); PG8_STAGE(PG8_SA(1, 0), a3, voffA);
            PG8_WAIT_V(8); PG8_WAIT_L(0); PG8_BAR; PG8_MMA(1, 0, At, B0); PG8_MMA(1, 1, At, B1); PG8_BAR; PG8_SCHED;
            } else {
            PG8_LDB(B0, 0, 0); PG8_SCHED; PG8_LDA(At, 0, 0); PG8_STAGE(PG8_SA(1, 1), a1 + hstep, voffA);
            PG8_WAIT_L(8); PG8_BAR; PG8_WAIT_L(0); PG8_MMA(0, 0, At, B0); PG8_BAR; PG8_SCHED;
            PG8_LDB(B1, 0, 1); PG8_STAGE(PG8_SB(0, 0), b2, voffB);
            PG8_BAR; PG8_WAIT_L(0); PG8_MMA(0, 1, At, B1); PG8_BAR;
            PG8_LDA(At, 0, 1); PG8_STAGE(PG8_SA(0, 0), a2, voffA);
            PG8_BAR; PG8_WAIT_L(0); PG8_MMA(1, 0, At, B0); PG8_BAR; PG8_SCHED;
            PG8_STAGE(PG8_SB(0, 1), b2 + hstep, voffB);
            PG8_WAIT_V(6); PG8_BAR; PG8_MMA(1, 1, At, B1); PG8_BAR;
            PG8_LDB(B0, 1, 0); PG8_SCHED; PG8_LDA(At, 1, 0); PG8_STAGE(PG8_SA(0, 1), a2 + hstep, voffA);
            PG8_WAIT_L(8); PG8_BAR; PG8_WAIT_L(0); PG8_MMA(0, 0, At, B0); PG8_BAR; PG8_SCHED;
            PG8_LDB(B1, 1, 1); PG8_STAGE(PG8_SB(1, 0), b3, voffB);
            PG8_BAR; PG8_WAIT_L(0); PG8_MMA(0, 1, At, B1); PG8_BAR;
            PG8_LDA(At, 1, 1); PG8_STAGE(PG8_SA(1, 0), a3, voffA);
            PG8_BAR; PG8_WAIT_L(0); PG8_MMA(1, 0, At, B0); PG8_BAR; PG8_SCHED;
            PG8_STAGE(PG8_SB(1, 1), b3 + hstep, voffB);
            PG8_WAIT_V(6); PG8_BAR; PG8_MMA(1, 1, At, B1); PG8_BAR;
            }
        }
        if constexpr (ALIGN_EPI) { if (wr == 0) PG8_BAR; }
        if constexpr (!Epi::AFTER_DRAIN) { E(acc, cur, wr, wc, fr, fq); S.done(cur); }
        if (!has_next) break;
#pragma unroll
        for (int a = 0; a < 2; ++a)
#pragma unroll
            for (int b = 0; b < 2; ++b)
#pragma unroll
                for (int m = 0; m < 4; ++m)
#pragma unroll
                    for (int n = 0; n < 2; ++n) acc[a][b][m][n] = (f32x4){0.f, 0.f, 0.f, 0.f};
        cur = nxt; cA = nA; cB = nB; ++ui;
        if constexpr (ALIGN_EPI) { if (wr == 1) PG8_BAR; }
    }
    PG8_WAIT_V(0);
    if constexpr (!ALIGN_EPI) { if (wr == 0) PG8_BAR; }
    PG8_BAR;
    if constexpr (Epi::AFTER_DRAIN) { E.fused(acc, cur, wr, wc, fr, fq, lds, wid, lane); S.done(cur); }
#undef PG8_SA
#undef PG8_SB
#undef PG8_STAGE
#undef PG8_LDA
#undef PG8_LDB
#undef PG8_MMA
#undef PG8_WAIT_V
#undef PG8_WAIT_L
#undef PG8_BAR
#undef PG8_SCHED
}
}
#include <hip/hip_bf16.h>
#include <cmath>
namespace attn_body {
using bf16=__hip_bfloat16;
using bf16x8=__attribute__((ext_vector_type(8)))short;
using s16x4=__attribute__((ext_vector_type(4)))short;
using f32x16=__attribute__((ext_vector_type(16)))float;
using u32x4=__attribute__((ext_vector_type(4)))unsigned;
constexpr int D=64,DM=512,OPITCH=1024;
constexpr int NW=8,QBLK=32,QB=QBLK*NW,KVBLK=64;
constexpr int ATTN_PITCH=DM, ATTN_UNIT_ROWS=QB;
__device__ __forceinline__ int crow(int r,int hi){return (r&3)+8*(r>>2)+4*hi;}
#define SBAR() __builtin_amdgcn_sched_barrier(0)
__device__ __forceinline__ void cmask(f32x16&p0,f32x16&p1,int jb,int qrel,int hi){
  const float NEG=-INFINITY; int kb=64*jb+4*hi;
  #pragma unroll
  for(int r=0;r<16;++r){int kv=kb+(r&3)+8*(r>>2); if(kv>qrel)p0[r]=NEG; if(kv+32>qrel)p1[r]=NEG;}
}

constexpr int NSLOT=3, SLOTB=8192;
constexpr int LDS_K=0, LDS_V=NSLOT*SLOTB, LDS_WS=2*NSLOT*SLOTB, LDS_OST=LDS_WS+NW*64*4, LDS_BYTES=LDS_OST+NW*4096;
constexpr float C2=0.125f*1.4426950408889634f;
__device__ __forceinline__ void glds16(const void*gsrc,unsigned lds_dst){unsigned keep;
  asm volatile("s_mov_b32 %0, m0\n\ts_mov_b32 m0, %2\n\ts_nop 0\n\tglobal_load_lds_dwordx4 %1, off\n\ts_mov_b32 m0, %0":"=&s"(keep):"v"(gsrc),"s"(lds_dst):"memory");}
__device__ __forceinline__ float max3f(float a,float b,float c){float r;asm("v_max3_f32 %0, %1, %2, %3":"=v"(r):"v"(a),"v"(b),"v"(c));return r;}
__device__ __forceinline__ float max2f(float a,float b){float r;asm("v_max_f32_e32 %0, %1, %2":"=v"(r):"v"(a),"v"(b));return r;}
__device__ __forceinline__ float fadd_s(float a,float b){float r;asm("v_add_f32_e32 %0, %1, %2":"=v"(r):"v"(a),"v"(b));return r;}
__device__ __forceinline__ float fsub_s(float a,float b){float r;asm("v_sub_f32_e32 %0, %1, %2":"=v"(r):"v"(a),"v"(b));return r;}
typedef float f32x2_t __attribute__((ext_vector_type(2))); typedef __bf16 bf16x2_t __attribute__((ext_vector_type(2)));
__device__ __forceinline__ unsigned cvtpk_s(float lo,float hi){f32x2_t v={lo,hi};bf16x2_t b=__builtin_convertvector(v,bf16x2_t);return __builtin_bit_cast(unsigned,b);}
#define WAIT_BAR(N) asm volatile("s_waitcnt vmcnt(" #N ") lgkmcnt(0)\n\ts_barrier":::"memory")

__device__ __forceinline__ void qkt(f32x16&p0,f32x16&p1,const char*Kslot,const bf16x8*qr,const f32x16&negm,int r32,int hi){
  const char*kb=Kslot+hi*1024+r32*16;
  #pragma unroll
  for(int d0=0;d0<4;++d0){
    const bf16x8 b0=*reinterpret_cast<const bf16x8*>(kb+d0*2048);
    const bf16x8 b1=*reinterpret_cast<const bf16x8*>(kb+d0*2048+512);
    if(d0==0){p0=__builtin_amdgcn_mfma_f32_32x32x16_bf16(b0,qr[0],negm,0,0,0);p1=__builtin_amdgcn_mfma_f32_32x32x16_bf16(b1,qr[0],negm,0,0,0);}
    else{p0=__builtin_amdgcn_mfma_f32_32x32x16_bf16(b0,qr[d0],p0,0,0,0);p1=__builtin_amdgcn_mfma_f32_32x32x16_bf16(b1,qr[d0],p1,0,0,0);}}
}
typedef __attribute__((address_space(3))) const char* lds_cptr;
typedef short v4i16_t __attribute__((ext_vector_type(4)));
__device__ __forceinline__ void kload8(bf16x8*kf,lds_cptr kp){
  kf[0]=*(const __attribute__((address_space(3))) bf16x8*)(kp);      kf[1]=*(const __attribute__((address_space(3))) bf16x8*)(kp+512);
  kf[2]=*(const __attribute__((address_space(3))) bf16x8*)(kp+2048); kf[3]=*(const __attribute__((address_space(3))) bf16x8*)(kp+2560);
  kf[4]=*(const __attribute__((address_space(3))) bf16x8*)(kp+4096); kf[5]=*(const __attribute__((address_space(3))) bf16x8*)(kp+4608);
  kf[6]=*(const __attribute__((address_space(3))) bf16x8*)(kp+6144); kf[7]=*(const __attribute__((address_space(3))) bf16x8*)(kp+6656);
}
__device__ __forceinline__ void kload2(bf16x8*kf,lds_cptr kp,int j){ kf[2*j]=*(const __attribute__((address_space(3))) bf16x8*)(kp+j*2048); kf[2*j+1]=*(const __attribute__((address_space(3))) bf16x8*)(kp+j*2048+512); }
__device__ __forceinline__ s16x4 vtr(lds_cptr p){ return __builtin_bit_cast(s16x4,__builtin_amdgcn_ds_read_tr16_b64_v4i16((__attribute__((address_space(3))) v4i16_t*)p)); }
__device__ __forceinline__ float rowmax(const f32x16&p0,const f32x16&p1){
  float a=max3f(p0[0],p0[1],p1[0]),b=max3f(p0[2],p0[3],p1[1]);a=max3f(a,p1[2],p1[3]);
  #pragma unroll
  for(int r=4;r<16;r+=4){a=max3f(a,p0[r],p0[r+1]);b=max3f(b,p0[r+2],p0[r+3]);a=max3f(a,p1[r],p1[r+1]);b=max3f(b,p1[r+2],p1[r+3]);}
  const float m=max2f(a,b);
  auto rr=__builtin_amdgcn_permlane32_swap(__float_as_uint(m),__float_as_uint(m),false,false);
  return max2f(__uint_as_float(rr[0]),__uint_as_float(rr[1]));
}
__device__ __forceinline__ void pv(f32x16*o,int vb,bf16x8 pa0,bf16x8 pa1,bf16x8 pa2,bf16x8 pa3){
  #pragma unroll
  for(int d0=0;d0<2;++d0){s16x4 lo[4],hi[4];
    #pragma unroll
    for(int ks=0;ks<4;++ks){
      asm volatile("ds_read_b64_tr_b16 %0,%1 offset:%c2":"=&v"(lo[ks]):"v"(vb),"i"(d0*4096+ks*1024):"memory");
      asm volatile("ds_read_b64_tr_b16 %0,%1 offset:%c2":"=&v"(hi[ks]):"v"(vb),"i"(d0*4096+ks*1024+512):"memory");}
    asm volatile("s_waitcnt lgkmcnt(0)":::"memory");SBAR();
    #define PK(k) (bf16x8){lo[k][0],lo[k][1],lo[k][2],lo[k][3],hi[k][0],hi[k][1],hi[k][2],hi[k][3]}
    o[d0]=__builtin_amdgcn_mfma_f32_32x32x16_bf16(pa0,PK(0),o[d0],0,0,0);
    o[d0]=__builtin_amdgcn_mfma_f32_32x32x16_bf16(pa1,PK(1),o[d0],0,0,0);
    o[d0]=__builtin_amdgcn_mfma_f32_32x32x16_bf16(pa2,PK(2),o[d0],0,0,0);
    o[d0]=__builtin_amdgcn_mfma_f32_32x32x16_bf16(pa3,PK(3),o[d0],0,0,0);
    #undef PK
  }
}

#ifndef ATTN_STORE16
#define ATTN_STORE16(p,v) (*(u32x4*)(p)=(v))
#endif
template<int THRL> __device__ __forceinline__ void attn_unit(const bf16*Qu,const bf16*__restrict__ Kh,const bf16*__restrict__ Vh,bf16*Ou,const int NT,char*shm){
  const int tid=threadIdx.x,lane=tid&63,r32=lane&31,hi=lane>>5; const int wid=__builtin_amdgcn_readfirstlane(tid>>6);
  const bf16*Qw=Qu+(long)(wid*QBLK)*DM;
  const unsigned lds0=(unsigned)(uintptr_t)shm;
  float*wsf=(float*)(shm+LDS_WS)+wid*64;
  const bf16*ksrc=Kh+(long)lane*DM+wid*8;
  const bf16*vsrc=Vh+(long)(16*(wid&3)+(lane>>2))*DM+(wid>>2)*32+(lane&3)*8;
  const unsigned kdst=lds0+LDS_K+wid*1024, vdst=lds0+LDS_V+wid*1024;
  #define DMA_K(t,slot) glds16(ksrc+(long)(t)*KVBLK*DM,(unsigned)__builtin_amdgcn_readfirstlane(kdst+(slot)))
  #define DMA_V(t,slot) glds16(vsrc+(long)(t)*KVBLK*DM,(unsigned)__builtin_amdgcn_readfirstlane(vdst+(slot)))
  const int vb0=(int)(lds0+LDS_V)+((lane>>4)&1)*32+(lane&3)*8+(4*hi+((lane&15)>>2))*64;
  const char*Kbase=shm+LDS_K; bf16x8 kf[8];
  const lds_cptr shm3=(lds_cptr)shm; const lds_cptr kp0=shm3+LDS_K+hi*1024+r32*16; const lds_cptr vp0=shm3+LDS_V+((lane>>4)&1)*32+(lane&3)*8+(4*hi+((lane&15)>>2))*64;
  DMA_K(0,0);DMA_V(0,0);DMA_K(1,SLOTB);
  bf16x8 qr[4];
  #pragma unroll
  for(int d0=0;d0<4;++d0)qr[d0]=*reinterpret_cast<const bf16x8*>(&Qw[(long)r32*DM+d0*16+hi*8]);
  float mhat=0.f,l_reg=0.f;f32x16 o[2];o[0]=f32x16{};o[1]=f32x16{};f32x16 negm=f32x16{};asm volatile("":"+v"(negm));
  #define CMASK(P0,P1,t) do{}while(0)
  bool resc=false;
  #define START(P0,P1) do{ const float rm=rowmax(P0,P1); resc=false; \
    { const float dl=rm; mhat=fadd_s(mhat,dl); \
      _Pragma("unroll") for(int r=0;r<16;++r){P0[r]=fsub_s(P0[r],dl);P1[r]=fsub_s(P1[r],dl);} \
      _Pragma("unroll") for(int r=0;r<16;++r)negm[r]=-mhat; asm volatile("":"+v"(negm)); } \
    _Pragma("unroll") for(int r=0;r<16;++r)P0[r]=__builtin_amdgcn_exp2f(P0[r]); }while(0)
  #define RESC() do{ if(resc){ asm volatile("s_waitcnt lgkmcnt(0)":::"memory"); \
      _Pragma("unroll") for(int d_=0;d_<2;++d_) _Pragma("unroll") for(int r=0;r<16;++r)o[d_][r]*=wsf[crow(r,hi)]; } }while(0)
  f32x16 pA0,pA1,pB0,pB1;
  int sl_prev=0,sl_cur=0,sl_next=SLOTB;
  #define ROT() do{sl_prev=sl_cur;sl_cur=sl_next;sl_next=(sl_next==(NSLOT-1)*SLOTB)?0:sl_next+SLOTB;}while(0)
  DMA_K(2,2*SLOTB);
  WAIT_BAR(3);
  qkt(pA0,pA1,Kbase,qr,negm,r32,hi);asm volatile("s_nop 15\n\ts_nop 7":"+v"(pA0),"+v"(pA1));CMASK(pA0,pA1,0);
  START(pA0,pA1);
  _Pragma("unroll") for(int r=0;r<16;++r)pA1[r]=__builtin_amdgcn_exp2f(pA1[r]);
  WAIT_BAR(0);
  DMA_K(3,0);DMA_V(1,SLOTB);
  ROT();
  kload8(kf,kp0+sl_cur);
  WAIT_BAR(2);
  s16x4 vlo[8],vhi[8]; u32x4 pw0,pw1,pw2,pw3;
  #define PKW(P,B) cvtpk_s(P[B],P[B+1])
  #define PAF(k) __builtin_bit_cast(bf16x8,pw##k)
  #define VFR(i) (bf16x8){vlo[i][0],vlo[i][1],vlo[i][2],vlo[i][3],vhi[i][0],vhi[i][1],vhi[i][2],vhi[i][3]}
  #define PIN(x) asm volatile("":"+v"(x))
  #define MX3(a,b,c) __builtin_fmaxf(__builtin_fmaxf((a),(b)),(c))
  #define GAPA(MF,A0,A1,A2,A3,W0,W1,PW) do{ MF; sacc+=A0; sacc+=A1; sacc+=A2; sacc+=A3; PIN(sacc); W0; W1; PIN(PW); SBAR(); }while(0)
  #define EX(v) __builtin_amdgcn_exp2f(v)
  #define GAPB(MF,X,B) do{ MF; X[B]=EX(X[B]); X[B+1]=EX(X[B+1]); X[B+2]=EX(X[B+2]); X[B+3]=EX(X[B+3]); PIN(X); SBAR(); }while(0)
  #define VRD(i) do{ vlo[i]=vtr(vp_+(((i)>>2)*4096+((i)&3)*1024)); vhi[i]=vtr(vp_+(((i)>>2)*4096+((i)&3)*1024+512)); }while(0)
  #define KRD(G,j) do{ if(G){ kload2(kf,kp0+sl_next,j); SBAR(); } }while(0)
  #define STEP(C0,C1,P0,P1,t,GK,GV,GL) do{ SBAR(); \
    const lds_cptr vp_=vp0+sl_prev; \
    VRD(0); SBAR(); float sacc=(P0[0]+P0[1]); \
    GAPA(C0=__builtin_amdgcn_mfma_f32_32x32x16_bf16(kf[0],qr[0],negm,0,0,0), P0[2],P0[3],P0[4],P0[5],     pw0[0]=PKW(P0,0), pw0[1]=PKW(P0,2), pw0); \
    VRD(4); SBAR(); GAPA(C1=__builtin_amdgcn_mfma_f32_32x32x16_bf16(kf[1],qr[0],negm,0,0,0), P0[6],P0[7],P0[8],P0[9],     pw0[2]=PKW(P0,4), pw0[3]=PKW(P0,6), pw0); \
    VRD(1); SBAR(); GAPA(C0=__builtin_amdgcn_mfma_f32_32x32x16_bf16(kf[2],qr[1],C0,0,0,0),   P0[10],P0[11],P0[12],P0[13], pw1[0]=PKW(P0,8), pw1[1]=PKW(P0,10), pw1); \
    VRD(5); SBAR(); GAPA(C1=__builtin_amdgcn_mfma_f32_32x32x16_bf16(kf[3],qr[1],C1,0,0,0),   P0[14],P0[15],P1[0],P1[1],   pw1[2]=PKW(P0,12),pw1[3]=PKW(P0,14), pw1); \
    VRD(2); SBAR(); GAPA(C0=__builtin_amdgcn_mfma_f32_32x32x16_bf16(kf[4],qr[2],C0,0,0,0),   P1[2],P1[3],P1[4],P1[5],     pw2[0]=PKW(P1,0), pw2[1]=PKW(P1,2), pw2); \
    VRD(6); SBAR(); GAPA(C1=__builtin_amdgcn_mfma_f32_32x32x16_bf16(kf[5],qr[2],C1,0,0,0),   P1[6],P1[7],P1[8],P1[9],     pw2[2]=PKW(P1,4), pw2[3]=PKW(P1,6), pw2); \
    VRD(3); SBAR(); GAPA(C0=__builtin_amdgcn_mfma_f32_32x32x16_bf16(kf[6],qr[3],C0,0,0,0),   P1[10],P1[11],P1[12],P1[13], pw3[0]=PKW(P1,8), pw3[1]=PKW(P1,10), pw3); \
    VRD(7); SBAR(); GAPA(C1=__builtin_amdgcn_mfma_f32_32x32x16_bf16(kf[7],qr[3],C1,0,0,0),   P1[14],P1[15],0.f,0.f,       pw3[2]=PKW(P1,12),pw3[3]=PKW(P1,14), pw3); \
    l_reg+=sacc; \
    if(GK){DMA_K((t)+3,sl_cur);} if(GV){DMA_V((t)+1,sl_next);} \
    CMASK(C0,C1,t); \
    { float a=MX3(C0[0],C0[1],C1[0]),b=MX3(C0[2],C0[3],C1[1]); a=MX3(a,C1[2],C1[3]); \
      _Pragma("unroll") for(int r=4;r<16;r+=4){a=MX3(a,C0[r],C0[r+1]);b=MX3(b,C0[r+2],C0[r+3]);a=MX3(a,C1[r],C1[r+1]);b=MX3(b,C1[r+2],C1[r+3]);} \
      float rm=__builtin_fmaxf(a,b); { auto rr=__builtin_amdgcn_permlane32_swap(__float_as_uint(rm),__float_as_uint(rm),false,false); rm=__builtin_fmaxf(__uint_as_float(rr[0]),__uint_as_float(rr[1])); } \
      resc=false; \
      if(__builtin_expect(__any(rm>(float)THRL),0)){ const float dl=__builtin_fmaxf(rm,0.f); mhat+=dl; \
        _Pragma("unroll") for(int r=0;r<16;++r){C0[r]-=dl;C1[r]-=dl;} \
        _Pragma("unroll") for(int r=0;r<16;++r)negm[r]=-mhat; asm volatile("":"+v"(negm)); \
        const float f=__builtin_amdgcn_exp2f(-dl); l_reg*=f; if(hi==0)wsf[r32]=f; resc=true; } } \
    SBAR(); \
    GAPB(o[0]=__builtin_amdgcn_mfma_f32_32x32x16_bf16(PAF(0),VFR(0),o[0],0,0,0), C0,0); \
    GAPB(o[1]=__builtin_amdgcn_mfma_f32_32x32x16_bf16(PAF(0),VFR(4),o[1],0,0,0), C0,4); \
    KRD(GL,0); GAPB(o[0]=__builtin_amdgcn_mfma_f32_32x32x16_bf16(PAF(1),VFR(1),o[0],0,0,0), C0,8); \
    KRD(GL,1); GAPB(o[1]=__builtin_amdgcn_mfma_f32_32x32x16_bf16(PAF(1),VFR(5),o[1],0,0,0), C0,12); \
    KRD(GL,2); GAPB(o[0]=__builtin_amdgcn_mfma_f32_32x32x16_bf16(PAF(2),VFR(2),o[0],0,0,0), C1,0); \
    KRD(GL,3); GAPB(o[1]=__builtin_amdgcn_mfma_f32_32x32x16_bf16(PAF(2),VFR(6),o[1],0,0,0), C1,4); \
    GAPB(o[0]=__builtin_amdgcn_mfma_f32_32x32x16_bf16(PAF(3),VFR(3),o[0],0,0,0), C1,8); \
    GAPB(o[1]=__builtin_amdgcn_mfma_f32_32x32x16_bf16(PAF(3),VFR(7),o[1],0,0,0), C1,12); \
    }while(0)
  int t=1;
  #undef CMASK
  #define CMASK(P0,P1,t) do{}while(0)
  for(;t+5<NT;t+=2){
    STEP(pB0,pB1,pA0,pA1,t,true,true,true);     WAIT_BAR(2); RESC(); ROT();
    STEP(pA0,pA1,pB0,pB1,t+1,true,true,true);   WAIT_BAR(2); RESC(); ROT();
  }
  #undef CMASK
  #define CMASK(P0,P1,t) do{}while(0)
  #define ENDW(tt) do{ if((tt)+3<NT){WAIT_BAR(2);} else if((tt)+2<NT){WAIT_BAR(1);} else {WAIT_BAR(0);} }while(0)
  for(;t+1<NT;t+=2){
    STEP(pB0,pB1,pA0,pA1,t,(t+3<NT),(t+1<NT),(t+1<NT));       ENDW(t);   RESC(); ROT();
    STEP(pA0,pA1,pB0,pB1,t+1,(t+4<NT),(t+2<NT),(t+2<NT));     ENDW(t+1); RESC(); ROT();
  }
  STEP(pB0,pB1,pA0,pA1,NT-1,false,false,false); RESC();
  { float sacc=pB0[0]+pB0[1]; _Pragma("unroll") for(int r=2;r<16;++r)sacc+=pB0[r]; _Pragma("unroll") for(int r=0;r<16;++r)sacc+=pB1[r]; l_reg+=sacc;
    pw0=(u32x4){PKW(pB0,0),PKW(pB0,2),PKW(pB0,4),PKW(pB0,6)};pw1=(u32x4){PKW(pB0,8),PKW(pB0,10),PKW(pB0,12),PKW(pB0,14)};pw2=(u32x4){PKW(pB1,0),PKW(pB1,2),PKW(pB1,4),PKW(pB1,6)};pw3=(u32x4){PKW(pB1,8),PKW(pB1,10),PKW(pB1,12),PKW(pB1,14)};
    SBAR(); pv(o,vb0+sl_cur,PAF(0),PAF(1),PAF(2),PAF(3)); }
  #undef PKW
  #undef PAF
  #undef VFR
  #undef PIN
  #undef MX3
  #undef GAPA
  #undef GAPB
  #undef EX
  #undef VRD
  #undef KRD
  #undef STEP
  #undef ENDW
  {auto rr=__builtin_amdgcn_permlane32_swap(__float_as_uint(l_reg),__float_as_uint(l_reg),false,false);l_reg=__uint_as_float(rr[0])+__uint_as_float(rr[1]);}
  if(hi==0)wsf[32+r32]=l_reg;asm volatile("s_waitcnt lgkmcnt(0)":::"memory");
  float rli[16];
  #pragma unroll
  for(int r=0;r<16;++r)rli[r]=__builtin_amdgcn_rcpf(wsf[32+crow(r,hi)]);
  bf16*Ow=Ou+(long)(wid*QBLK)*OPITCH;
  { bf16*stg=(bf16*)(shm+LDS_OST)+wid*2048;
    #pragma unroll
    for(int r=0;r<16;++r){const int orow=crow(r,hi);
      #pragma unroll
      for(int d0=0;d0<2;++d0)stg[orow*64+d0*32+r32]=__float2bfloat16(o[d0][r]*rli[r]);}
    asm volatile("s_waitcnt lgkmcnt(0)":::"memory");
    #pragma unroll
    for(int i=0;i<4;++i){const int row=i*8+(lane>>3),ch=lane&7; const u32x4 v=*(const u32x4*)(stg+row*64+ch*8); ATTN_STORE16(Ow+(long)row*OPITCH+ch*8,v);} }
  asm volatile("s_waitcnt lgkmcnt(0)\n\ts_barrier":::"memory");
  #undef DMA_K
  #undef DMA_V
  #undef CMASK
  #undef START
  #undef RESC
  #undef ROT
}
constexpr int ATTN_LDS_BYTES=LDS_BYTES;
#undef SBAR
#undef WAIT_BAR
}
#define GAS __attribute__((address_space(1)))
#define LAS __attribute__((address_space(3)))
typedef unsigned short bf16;
typedef unsigned v4u __attribute__((ext_vector_type(4)));
typedef unsigned v2u __attribute__((ext_vector_type(2)));
typedef float f32x4 __attribute__((ext_vector_type(4)));
#define LDS_WAIT() asm volatile("s_waitcnt lgkmcnt(0)" ::: "memory")

constexpr int DM_ = 2048, SEQ_ = 8192, CTXL = 256, MROWS = SEQ_ + CTXL;
constexpr int NIN = 13888, NINP = 14080, DFF = 5632;
constexpr int ZP = NINP;
constexpr int C_GQ = 0, C_GK = 512, C_GV = 1024, C_GLR = 1536, C_GG = 1568, C_DQ = 2080, C_DK = 2592, C_DV = 3104,
              C_EQ = 3616, C_EA = 6688, C_EB = 6704, C_EG = 6720, C_MG = 7744;
constexpr size_t MiB = 1u << 20;
constexpr size_t WS_MOD = 0;
constexpr size_t WS_BAR = 512 * 1024, BAR_BYTES = 16384;
constexpr int MISC_OFF = 147456 - 256;
constexpr size_t WS_CNT = WS_BAR + 14336;
constexpr size_t WS_W0 = 1 * MiB, W_LAYER = 137 * MiB;
constexpr size_t WO_IN = 0, WO_UA = 55 * MiB, WO_UD = 57 * MiB, WO_UE = 59 * MiB, WO_O = 63 * MiB, WO_13 = 71 * MiB, WO_2 = 115 * MiB;
constexpr size_t WS_X = WS_W0 + 2 * W_LAYER;
constexpr size_t WS_H = WS_X + 66 * MiB;
constexpr size_t WS_Z = WS_H + 33 * MiB;
constexpr size_t WS_ZG = WS_Z + 227 * MiB;
constexpr size_t WS_AQ = WS_ZG + 3 * MiB, WS_AK = WS_AQ + 9 * MiB, WS_AV = WS_AK + 9 * MiB, WS_AO = WS_AV + 9 * MiB;
constexpr size_t WS_DQ = WS_AO + 17 * MiB, WS_DK = WS_DQ + 17 * MiB, WS_DV = WS_DK + 17 * MiB, WS_DGB = WS_DV + 17 * MiB;
constexpr size_t WS_A = WS_DGB + 2 * MiB, WS_D = WS_A + 9 * MiB, WS_E = WS_D + 9 * MiB;
constexpr size_t WS_R2 = WS_E + 17 * MiB;
constexpr size_t WS_YB = WS_R2 + 66 * MiB;
constexpr size_t WS_END = WS_YB + 33 * MiB;
constexpr size_t WS_HFF = WS_Z;

constexpr int LDS_BYTES = 147456;
constexpr int NPH = 24;

typedef float pk_f32x2 __attribute__((ext_vector_type(2))); typedef __bf16 pk_bf16x2 __attribute__((ext_vector_type(2)));
__device__ __forceinline__ unsigned pk2(float lo, float hi) { const pk_f32x2 v = {lo, hi}; const pk_bf16x2 b = __builtin_convertvector(v, pk_bf16x2); return __builtin_bit_cast(unsigned, b); }
__device__ __forceinline__ unsigned f2bf(float f) { return pk2(f, 0.f) & 0xffffu; }
__device__ __forceinline__ float bf2f(unsigned short b) { return __builtin_bit_cast(float, (unsigned)b << 16); }
__device__ __forceinline__ float bflo(unsigned w) { return __builtin_bit_cast(float, w << 16); }
__device__ __forceinline__ float bfhi(unsigned w) { return __builtin_bit_cast(float, w & 0xffff0000u); }
__device__ __forceinline__ float wave_sum(float v) {
#pragma unroll
    for (int o = 1; o < 64; o <<= 1) v += __shfl_xor(v, o);
    return v;
}
__device__ __forceinline__ float sigmoidf_(float x) { return __builtin_amdgcn_rcpf(1.0f + __expf(-x)); }
__device__ __forceinline__ float siluf_(float x) { return x * __builtin_amdgcn_rcpf(1.0f + __expf(-x)); }

struct Args { const float* in[27]; float* out; unsigned char* ws; int ph_lo, ph_hi; };

struct Frame {
    LAS unsigned char* lds;
    int tid, lane, wave, G, bid;
    unsigned char* ws; float* out;
};

#define XB_TMO      128
#define XB_XCNT(j)  (256  + 64 * (j))
#define XB_XSUB(j)  (1280 + 64 * (j))
#define XB_XGEN(j)  (2304 + 64 * (j))
#define XB_TOP      3328
#define XB_TOPGEN   3392
#define XCD_BAR_WORDS 3456
#define XB_SPIN_CAP (1u << 18)

__device__ __forceinline__ unsigned xb_ld(unsigned* p)              { return __hip_atomic_load(p, __ATOMIC_RELAXED, __HIP_MEMORY_SCOPE_AGENT); }
__device__ __forceinline__ unsigned xb_add(unsigned* p, unsigned v) { return __hip_atomic_fetch_add(p, v, __ATOMIC_RELAXED, __HIP_MEMORY_SCOPE_AGENT); }
__device__ __forceinline__ unsigned xb_xcc_id() { return (unsigned)__builtin_amdgcn_s_getreg((3 << 11) | 20) & 0xFu; }
#define XB_SPIN(cond, bar) do { unsigned _sp = 0; while (cond) { __builtin_amdgcn_s_sleep(1); \
    if ((++_sp & 255u) == 0u) { if (xb_ld(&(bar)[XB_TMO])) break; if (_sp > XB_SPIN_CAP) { atomicAdd(&(bar)[XB_TMO], 1u); break; } } } } while (0)

struct XcdBarrier {
    unsigned* bar; unsigned x;
    volatile LAS unsigned* st;
};

__device__ __forceinline__ XcdBarrier xcd_barrier_post(unsigned* bar, volatile LAS unsigned* st) {
    XcdBarrier b; b.bar = bar; b.x = xb_xcc_id(); b.st = st;
    if (threadIdx.x == 0) (void)xb_add(&bar[XB_XCNT(b.x)], 1u);
    return b;
}
__device__ __forceinline__ void xcd_barrier_complete(unsigned* bar, unsigned x, unsigned& nloc, unsigned& nx) {
    const unsigned G = gridDim.x * gridDim.y * gridDim.z;
    unsigned sum, cnt, mine, sp = 0u;
    for (;;) {
        sum = 0u; cnt = 0u; mine = 0u;
#pragma unroll
        for (unsigned j = 0; j < 16; ++j) { const unsigned c = xb_ld(&bar[XB_XCNT(j)]); sum += c; cnt += (c > 0u) ? 1u : 0u; mine = (j == x) ? c : mine; }
        if (sum == G) break;
        __builtin_amdgcn_s_sleep(1);
        if ((++sp & 255u) == 0u) { if (xb_ld(&bar[XB_TMO])) break; if (sp > XB_SPIN_CAP) { atomicAdd(&bar[XB_TMO], 1u); break; } }
    }
    nloc = mine > 0u ? mine : 1u; nx = cnt > 0u ? cnt : 1u;
}

__device__ __forceinline__ void xcd_barrier(const XcdBarrier& b) {
    asm volatile("s_waitcnt vmcnt(0)" ::: "memory");
    __syncthreads();
    if (threadIdx.x == 0) {
        unsigned* bar = b.bar;
        __builtin_amdgcn_s_waitcnt(0);
        unsigned nloc = b.st[0], nx = b.st[1];
        if (nloc == 0u) { xcd_barrier_complete(bar, b.x, nloc, nx); b.st[0] = nloc; b.st[1] = nx; }
        const unsigned old = xb_add(&bar[XB_XSUB(b.x)], 1u);
        const unsigned gen = old / nloc;
        if (old + 1u == (gen + 1u) * nloc) {
            __builtin_amdgcn_fence(__ATOMIC_RELEASE, "agent");
            asm volatile("s_waitcnt vmcnt(0)" ::: "memory");
            const unsigned og = xb_add(&bar[XB_TOP], 1u);
            const unsigned tg = og / nx;
            if (og + 1u == (tg + 1u) * nx) xb_add(&bar[XB_TOPGEN], 1u);
            else XB_SPIN(xb_ld(&bar[XB_TOPGEN]) == tg, bar);
            __builtin_amdgcn_fence(__ATOMIC_ACQUIRE, "agent");
            xb_add(&bar[XB_XGEN(b.x)], 1u);
            asm volatile("s_waitcnt vmcnt(0)" ::: "memory");
        } else {
            XB_SPIN(xb_ld(&bar[XB_XGEN(b.x)]) == gen, bar);
            __builtin_amdgcn_fence(__ATOMIC_ACQUIRE, "agent");
            asm volatile("s_waitcnt vmcnt(0)" ::: "memory");
        }
    }
    __syncthreads();
}

__device__ __forceinline__ void p0_transpose_item(const float* W, int K, int N, bf16* WT, int k0, int n0, int drow, LAS float* scr, int lane) {
#pragma unroll 8
    for (int i = 0; i < 32; ++i) { const int kk = 2 * i + (lane >> 5); scr[kk * 33 + (lane & 31)] = __builtin_nontemporal_load(W + (size_t)(k0 + kk) * N + n0 + (lane & 31)); }
    LDS_WAIT(); asm volatile("" ::: "memory");
    const int c = lane & 7;
#pragma unroll
    for (int j = 0; j < 4; ++j) { const int n = (lane >> 3) + 8 * j; const LAS float* s = scr + (8 * c) * 33 + n;
        v4u o; o.x = pk2(s[0 * 33], s[1 * 33]); o.y = pk2(s[2 * 33], s[3 * 33]); o.z = pk2(s[4 * 33], s[5 * 33]); o.w = pk2(s[6 * 33], s[7 * 33]);
        *(v4u*)(WT + (size_t)(drow + n) * K + k0 + 8 * c) = o; }
    LDS_WAIT(); asm volatile("" ::: "memory");
}
__device__ __forceinline__ void tr_plain(const float* W, int K, int N, bf16* WT, int item, LAS float* scr, int lane) {
    const int nblk = N / 32, kb = item / nblk, nb = item % nblk;
    p0_transpose_item(W, K, N, WT, 64 * kb, 32 * nb, 32 * nb, scr, lane);
}
__device__ __forceinline__ void tr_ffn13(const float* W, bf16* WT, int item, int which, LAS float* scr, int lane) {
    const int nblk = DFF / 32, kb = item / nblk, nb = item % nblk, n0 = 32 * nb;
    p0_transpose_item(W, DM_, DFF, WT, 64 * kb, n0, 256 * (n0 >> 7) + (n0 & 127) + 128 * which, scr, lane);
}
constexpr int I_IN = 32 * (NIN / 32), I_UA = 8 * 64, I_UE = 16 * 64, I_O = 32 * 64, I_F = 32 * (DFF / 32), I_2 = (DFF / 64) * 64;
constexpr int PER_L = I_IN + 2 * I_UA + I_UE + I_O + 2 * I_F + I_2;
__device__ __forceinline__ void p0_item(Frame& F, const Args& A, const int l, int r, LAS float* scr) {
    unsigned char* wb = F.ws + WS_W0;
    if (r < I_IN) { tr_plain(A.in[10] + (size_t)l * DM_ * NIN, DM_, NIN, (bf16*)(wb + WO_IN), r, scr, F.lane); return; } r -= I_IN;
    if (r < I_UA) { tr_plain(A.in[20] + (size_t)l * 512 * DM_, 512, DM_, (bf16*)(wb + WO_UA), r, scr, F.lane); return; } r -= I_UA;
    if (r < I_UA) { tr_plain(A.in[21] + (size_t)l * 512 * DM_, 512, DM_, (bf16*)(wb + WO_UD), r, scr, F.lane); return; } r -= I_UA;
    if (r < I_UE) { tr_plain(A.in[22] + (size_t)l * 1024 * DM_, 1024, DM_, (bf16*)(wb + WO_UE), r, scr, F.lane); return; } r -= I_UE;
    if (r < I_O) { tr_plain(A.in[23] + (size_t)l * DM_ * DM_, DM_, DM_, (bf16*)(wb + WO_O), r, scr, F.lane); return; } r -= I_O;
    if (r < I_F) { tr_ffn13(A.in[24] + (size_t)l * DM_ * DFF, (bf16*)(wb + WO_13), r, 0, scr, F.lane); return; } r -= I_F;
    if (r < I_F) { tr_ffn13(A.in[25] + (size_t)l * DM_ * DFF, (bf16*)(wb + WO_13), r, 1, scr, F.lane); return; } r -= I_F;
    tr_plain(A.in[26] + (size_t)l * DFF * DM_, DFF, DM_, (bf16*)(wb + WO_2), r, scr, F.lane);
}
__device__ __forceinline__ void p0_dynamic(Frame& F, const Args& A, const int l, unsigned* cnt, const int lo_, const int hi) {
    LAS float* scr = (LAS float*)(F.lds + F.wave * 16384);
    volatile LAS unsigned* slot = (volatile LAS unsigned*)(F.lds + MISC_OFF) + 16;
    for (;;) {
        if (F.tid == 0) slot[0] = __hip_atomic_fetch_add(cnt, 64u, __ATOMIC_RELAXED, __HIP_MEMORY_SCOPE_AGENT);
        __syncthreads();
        const int base = lo_ + (int)slot[0];
        __syncthreads();
        if (base >= hi) break;
        for (int k = 0; k < 8; ++k) { const int it = base + F.wave * 8 + k; if (it < hi) p0_item(F, A, l, it, scr); }
    }
}
__device__ __forceinline__ void p0_phase(Frame& F, const Args& A, const int l, const bool gemv, const int ilo, const int ihi) {
    LAS float* scr = (LAS float*)(F.lds + F.wave * 16384);
    const int gw = F.bid * 8 + F.wave, NGW = F.G * 8;
    for (int it = ilo + gw; it < ilo + (ihi - ilo) * REP_P0; it += NGW) p0_item(F, A, l, ilo + (it - ilo) % (ihi - ilo), scr);
    __syncthreads();
    if (!gemv) return;
    LAS float* red = (LAS float*)F.lds;
    const float* cl = A.in[1]; const float* cc = A.in[3];
    for (int it = F.bid; it < 2 * 192; it += F.G) {
        const int lg = it / 192, jb = it % 192, kg = F.tid >> 4, jl = F.tid & 15;
        const float* wp = A.in[4] + ((size_t)lg * DM_ + kg * 64) * 12288 + jb * 64 + jl * 4;
        f32x4 al = {0.f, 0.f, 0.f, 0.f}, ac = {0.f, 0.f, 0.f, 0.f};
#pragma unroll 8
        for (int kk = 0; kk < 64; ++kk) {
            const f32x4 w = __builtin_nontemporal_load((const f32x4*)(wp + (size_t)kk * 12288));
            const float sl = siluf_(cl[kg * 64 + kk]), sc = siluf_(cc[kg * 64 + kk]);
            al += w * sl; ac += w * sc;
        }
        LAS float* rp = red + (kg * 16 + jl) * 8;
        rp[0] = al.x; rp[1] = al.y; rp[2] = al.z; rp[3] = al.w; rp[4] = ac.x; rp[5] = ac.y; rp[6] = ac.z; rp[7] = ac.w;
        __syncthreads();
        if (F.tid < 128) {
            const int j2 = F.tid & 15, comp = F.tid >> 4; float s = 0.f;
            for (int g = 0; g < 32; ++g) s += red[(g * 16 + j2) * 8 + comp];
            const int sidx = comp >> 2, col = jb * 64 + j2 * 4 + (comp & 3);
            ((float*)(F.ws + WS_MOD))[(size_t)(lg * 2 + sidx) * 12288 + col] = s + A.in[5][(size_t)lg * 12288 + col];
        }
        __syncthreads();
    }
}

template <int MODE> __device__ __forceinline__ void row_phase(Frame& F, const Args& A, int l) {
    const int gw = F.bid * 8 + F.wave, NGW = F.G * 8;
    float* X = (float*)(F.ws + WS_X); const float* Y2 = (const float*)(F.ws + WS_R2); bf16* H = (bf16*)(F.ws + WS_H);
    const float* MOD = (const float*)(F.ws + WS_MOD);
    for (int r = gw + ((MODE >= 1 && l == 1) ? CTXL : 0); r < MROWS; r += NGW) {
        const int s = r < CTXL ? 1 : 0;
        const float* mod = MOD + (size_t)(l * 2 + s) * 12288;
        f32x4 v[8];
        if (MODE == 0) {
            const float* src = s ? A.in[2] + (size_t)r * DM_ : A.in[0] + (size_t)(r - CTXL) * DM_;
#pragma unroll
            for (int j = 0; j < 8; ++j) v[j] = *(const f32x4*)(src + (F.lane + 64 * j) * 4);
        } else {
            const float* y = Y2 + (size_t)r * DM_; float ss = 0.f;
            const float* w = (MODE == 1 ? A.in[7] : A.in[9]) + (size_t)l * DM_;
            const float* gate = mod + (MODE == 1 ? 2 : 5) * DM_;
            f32x4 xv[8], wv[8], gv[8];
#pragma unroll
            for (int j = 0; j < 8; ++j) { const int c = (F.lane + 64 * j) * 4; v[j] = *(const f32x4*)(y + c); xv[j] = *(const f32x4*)(X + (size_t)r * DM_ + c); wv[j] = *(const f32x4*)(w + c); gv[j] = *(const f32x4*)(gate + c); }
#pragma unroll
            for (int j = 0; j < 8; ++j) ss += v[j].x * v[j].x + v[j].y * v[j].y + v[j].z * v[j].z + v[j].w * v[j].w;
            const float rs = __builtin_amdgcn_rsqf(wave_sum(ss) * (1.0f / DM_) + 1e-6f);
#pragma unroll
            for (int j = 0; j < 8; ++j) v[j] = xv[j] + gv[j] * (v[j] * rs * wv[j]);
        }
        if (MODE == 2 && l == 1) {
            if (!s) {
#pragma unroll
                for (int j = 0; j < 8; ++j) *(f32x4*)(F.out + (size_t)(r - CTXL) * DM_ + (F.lane + 64 * j) * 4) = v[j];
            }
            continue;
        }
        float ss = 0.f;
        const float* wn = (MODE == 0 ? A.in[6] : MODE == 1 ? A.in[8] + (size_t)l * DM_ : A.in[6] + (size_t)(l + 1) * DM_);
        const float* modn = (MODE == 2) ? MOD + (size_t)((l + 1) * 2 + s) * 12288 : mod;
        const float* sh = modn + (MODE == 1 ? 3 : 0) * DM_; const float* sc = sh + DM_;
#pragma unroll
        for (int j = 0; j < 8; ++j) { *(f32x4*)(X + (size_t)r * DM_ + (F.lane + 64 * j) * 4) = v[j]; ss += v[j].x * v[j].x + v[j].y * v[j].y + v[j].z * v[j].z + v[j].w * v[j].w; }
        const float rs2 = __builtin_amdgcn_rsqf(wave_sum(ss) * (1.0f / DM_) + 1e-6f);
#pragma unroll
        for (int j = 0; j < 8; ++j) { const int c = (F.lane + 64 * j) * 4;
            const f32x4 wv = *(const f32x4*)(wn + c), shv = *(const f32x4*)(sh + c), scv = *(const f32x4*)(sc + c);
            const f32x4 h = (v[j] * rs2 * wv) * (1.0f + scv) + shv;
            v2u o; o.x = pk2(h.x, h.y); o.y = pk2(h.z, h.w);
            *(v2u*)(H + (size_t)r * DM_ + c) = o; }
    }
}
__device__ __forceinline__ void prep_phase(Frame& F, const Args& A, int l) {
    const int gw = F.bid * 8 + F.wave, NGW = F.G * 8, lane = F.lane;
    const bf16* Z = (const bf16*)(F.ws + WS_Z); const float* ZG = (const float*)(F.ws + WS_ZG);
    bf16* AQ = (bf16*)(F.ws + WS_AQ); bf16* AK = (bf16*)(F.ws + WS_AK); bf16* AV = (bf16*)(F.ws + WS_AV);
    bf16* DQ = (bf16*)(F.ws + WS_DQ); bf16* DK = (bf16*)(F.ws + WS_DK); bf16* DV = (bf16*)(F.ws + WS_DV);
    float* DG = (float*)(F.ws + WS_DGB); float* DB = DG + 16 * MROWS;
    const float* conv_w = A.in[16] + (size_t)l * 5 * 3072;
    const float* a_log = A.in[17] + l * 16; const float* dt_bias = A.in[18] + l * 16;
    constexpr float C2 = 0.125f * 1.4426950408889634f;
    for (int g_ = gw; g_ < (MROWS / 4) * REP_ROWS; g_ += NGW) {
        const int r0 = (g_ % (MROWS / 4)) * 4;
        const bool lat = r0 >= CTXL; const int lo = lat ? CTXL : 0, hi = lat ? MROWS : CTXL;
        for (int it = 0; it < 6; ++it) {
            const int ch0 = it * 512 + lane * 8, p = it >> 1;
            v4u xr[8];
#pragma unroll
            for (int j = 0; j < 8; ++j) { const int rr = r0 + j - 2; xr[j] = (rr >= lo && rr < hi) ? *(const v4u*)(Z + (size_t)rr * ZP + C_EQ + ch0) : (v4u){0u, 0u, 0u, 0u}; }
            float acc[4][8];
#pragma unroll
            for (int j = 0; j < 4; ++j)
#pragma unroll
                for (int e = 0; e < 8; ++e) acc[j][e] = 0.f;
#pragma unroll
            for (int i = 0; i < 5; ++i) {
                const f32x4 c0 = *(const f32x4*)(conv_w + i * 3072 + ch0), c1 = *(const f32x4*)(conv_w + i * 3072 + ch0 + 4);
#pragma unroll
                for (int j = 0; j < 4; ++j) { const v4u x = xr[j + i];
                    acc[j][0] += bflo(x.x) * c0.x; acc[j][1] += bfhi(x.x) * c0.y; acc[j][2] += bflo(x.y) * c0.z; acc[j][3] += bfhi(x.y) * c0.w;
                    acc[j][4] += bflo(x.z) * c1.x; acc[j][5] += bfhi(x.z) * c1.y; acc[j][6] += bflo(x.w) * c1.z; acc[j][7] += bfhi(x.w) * c1.w; }
            }
            bf16* dstb = (p == 0 ? DQ : p == 1 ? DK : DV) + (ch0 & 1023);
#pragma unroll
            for (int j = 0; j < 4; ++j) {
                float sv[8]; float ss = 0.f;
#pragma unroll
                for (int e = 0; e < 8; ++e) { sv[e] = siluf_(acc[j][e]); ss += sv[e] * sv[e]; }
                if (p < 2) {
                    ss += __shfl_xor(ss, 1); ss += __shfl_xor(ss, 2); ss += __shfl_xor(ss, 4); ss += __shfl_xor(ss, 8);
                    const float sc = __builtin_amdgcn_rsqf(ss + 1e-6f) * (p == 0 ? 0.08838834764831845f : 1.0f);
#pragma unroll
                    for (int e = 0; e < 8; ++e) sv[e] *= sc;
                }
                v4u o; o.x = pk2(sv[0], sv[1]); o.y = pk2(sv[2], sv[3]); o.z = pk2(sv[4], sv[5]); o.w = pk2(sv[6], sv[7]);
                *(v4u*)(dstb + (size_t)(r0 + j) * 1024) = o;
            }
        }
        {
            const int r = r0 + (lane >> 4), gi = lane & 15;
            const float a = ZG[(size_t)r * 64 + 32 + gi], bt = ZG[(size_t)r * 64 + 48 + gi];
            const float xs = a + dt_bias[gi];
            const float sp = xs > 20.f ? xs : log1pf(expf(xs));
            DG[(size_t)gi * MROWS + r] = -expf(a_log[gi]) * sp;
            DB[(size_t)gi * MROWS + r] = 1.0f / (1.0f + expf(-bt));
        }
        for (int j = 0; j < 4; ++j) {
            const int r = r0 + j, t = r - CTXL; const bf16* zr = Z + (size_t)r * ZP;
            const v4u qv = *(const v4u*)(zr + C_DQ + lane * 8), kv = *(const v4u*)(zr + C_DK + lane * 8), vv = *(const v4u*)(zr + C_DV + lane * 8);
            *(v4u*)(AV + (size_t)r * 512 + lane * 8) = vv;
            float q[8], k[8];
            q[0] = bflo(qv.x); q[1] = bfhi(qv.x); q[2] = bflo(qv.y); q[3] = bfhi(qv.y); q[4] = bflo(qv.z); q[5] = bfhi(qv.z); q[6] = bflo(qv.w); q[7] = bfhi(qv.w);
            k[0] = bflo(kv.x); k[1] = bfhi(kv.x); k[2] = bflo(kv.y); k[3] = bfhi(kv.y); k[4] = bflo(kv.z); k[5] = bfhi(kv.z); k[6] = bflo(kv.w); k[7] = bfhi(kv.w);
            if (lat) {
                const int sub = lane & 3, part = (lane >> 2) & 1; const float pos = (float)(part ? (t & 63) : (t >> 6));
                const float sgn = (sub & 2) ? 1.0f : -1.0f;
#pragma unroll
                for (int e = 0; e < 8; ++e) {
                    const float qp = __shfl_xor(q[e], 2), kp = __shfl_xor(k[e], 2);
                    const int i = (sub & 1) * 8 + e;
                    const float inv = __builtin_amdgcn_exp2f(-(float)i * 0.8304820237218406f);
                    const float rev = (pos * inv) * 0.15915494309189535f;
                    const float cs = __builtin_amdgcn_cosf(rev), sn = __builtin_amdgcn_sinf(rev);
                    q[e] = q[e] * cs + sgn * qp * sn; k[e] = k[e] * cs + sgn * kp * sn;
                }
            }
            v4u qo, ko;
            qo.x = pk2(q[0] * C2, q[1] * C2); qo.y = pk2(q[2] * C2, q[3] * C2); qo.z = pk2(q[4] * C2, q[5] * C2); qo.w = pk2(q[6] * C2, q[7] * C2);
            ko.x = pk2(k[0], k[1]); ko.y = pk2(k[2], k[3]); ko.z = pk2(k[4], k[5]); ko.w = pk2(k[6], k[7]);
            *(v4u*)(AQ + (size_t)r * 512 + lane * 8) = qo; *(v4u*)(AK + (size_t)r * 512 + lane * 8) = ko;
        }
    }
}

__device__ __forceinline__ int scan_row(int dir, int n, int i) {
    if (dir == 0) return 64 * n + i;
    return (n < 4 ? 64 * (3 - n) : CTXL + 64 * (127 - (n - 4))) + 63 - i;
}

__device__ __forceinline__ void gla_chain_naive(Frame& F, const Args& A, int l, int chain) {
    const int dir = chain >> 2, h = chain & 3, tid = F.tid, lane = F.lane;
    const bf16* Z = (const bf16*)(F.ws + WS_Z); const float* ZG = (const float*)(F.ws + WS_ZG);
    float* OA = (float*)(F.ws + WS_YB) + (size_t)dir * MROWS * 512;
    const float* w2 = A.in[11] + ((size_t)(l * 2 + dir) * 16) * 512 + h * 128; const float* gb = A.in[12] + (size_t)(l * 2 + dir) * 512 + h * 128;
    LAS bf16* qs = (LAS bf16*)F.lds; LAS bf16* ks = qs + 64 * 128; LAS bf16* vs = ks + 64 * 128; LAS float* eg = (LAS float*)(F.lds + 49152);
    float S[64];
#pragma unroll
    for (int d = 0; d < 64; ++d) S[d] = 0.f;
    const int col = (tid >> 6) * 32 + (lane & 31), half = lane >> 5;
    for (int n = 0; n < 132; ++n) {
        for (int p = tid; p < 1024; p += 512) { const int i = p >> 4, c8 = (p & 15) * 8; const bf16* zr = Z + (size_t)scan_row(dir, n, i) * ZP + h * 128 + c8;
            *(LAS v4u*)(qs + i * 128 + c8) = *(const v4u*)(zr + C_GQ); *(LAS v4u*)(ks + i * 128 + c8) = *(const v4u*)(zr + C_GK); *(LAS v4u*)(vs + i * 128 + c8) = *(const v4u*)(zr + C_GV); }
        {   const int i = tid >> 3, dg = (tid & 7) * 16; const float* lr = ZG + (size_t)scan_row(dir, n, i) * 64 + dir * 16;
            float x[16];
#pragma unroll
            for (int jj = 0; jj < 16; ++jj) x[jj] = gb[dg + jj];
            for (int j = 0; j < 16; ++j) { const float lv = lr[j];
#pragma unroll
                for (int jj = 0; jj < 16; ++jj) x[jj] += lv * w2[j * 512 + dg + jj]; }
#pragma unroll
            for (int jj = 0; jj < 16; ++jj) { const float ls = fminf(x[jj], 0.f) - log1pf(expf(-fabsf(x[jj]))); eg[i * 128 + dg + jj] = expf(ls * 0.0625f); }
        }
        __syncthreads();
        if (tid < 256) {
            for (int i = 0; i < 64; ++i) {
                const float vv = bf2f(vs[i * 128 + col]); float o = 0.f;
#pragma unroll
                for (int d4 = 0; d4 < 16; ++d4) {
                    const f32x4 e4 = *(const LAS f32x4*)(eg + i * 128 + half * 64 + d4 * 4);
                    const v2u k2 = *(const LAS v2u*)(ks + i * 128 + half * 64 + d4 * 4), q2 = *(const LAS v2u*)(qs + i * 128 + half * 64 + d4 * 4);
                    S[d4 * 4 + 0] = S[d4 * 4 + 0] * e4.x + bflo(k2.x) * vv; o += S[d4 * 4 + 0] * bflo(q2.x);
                    S[d4 * 4 + 1] = S[d4 * 4 + 1] * e4.y + bfhi(k2.x) * vv; o += S[d4 * 4 + 1] * bfhi(q2.x);
                    S[d4 * 4 + 2] = S[d4 * 4 + 2] * e4.z + bflo(k2.y) * vv; o += S[d4 * 4 + 2] * bflo(q2.y);
                    S[d4 * 4 + 3] = S[d4 * 4 + 3] * e4.w + bfhi(k2.y) * vv; o += S[d4 * 4 + 3] * bfhi(q2.y);
                }
                o += __shfl_xor(o, 32);
                if (half == 0) OA[(size_t)scan_row(dir, n, i) * 512 + h * 128 + col] = o * 0.08838834764831845f;
            }
        }
        __syncthreads();
    }
}
__device__ __forceinline__ void delta_chain_naive(Frame& F, const Args& A, int chain) {
    const int dir = chain >> 3, h = chain & 7, tid = F.tid, lane = F.lane;
    const bf16* DQ = (const bf16*)(F.ws + WS_DQ); const bf16* DK = (const bf16*)(F.ws + WS_DK); const bf16* DV = (const bf16*)(F.ws + WS_DV);
    const float* DG = (const float*)(F.ws + WS_DGB) + (size_t)chain * MROWS; const float* DB = (const float*)(F.ws + WS_DGB) + (size_t)(16 + chain) * MROWS;
    float* OE = (float*)(F.ws + WS_R2) + (size_t)dir * MROWS * 1024;
    LAS bf16* qs = (LAS bf16*)F.lds; LAS bf16* ks = qs + 64 * 128; LAS bf16* vs = ks + 64 * 128; LAS float* gs = (LAS float*)(F.lds + 49152);
    float S[64];
#pragma unroll
    for (int d = 0; d < 64; ++d) S[d] = 0.f;
    const int col = (tid >> 6) * 32 + (lane & 31), half = lane >> 5;
    for (int n = 0; n < 132; ++n) {
        for (int p = tid; p < 1024; p += 512) { const int i = p >> 4, c8 = (p & 15) * 8; const size_t off = (size_t)scan_row(dir, n, i) * 1024 + h * 128 + c8;
            *(LAS v4u*)(qs + i * 128 + c8) = *(const v4u*)(DQ + off); *(LAS v4u*)(ks + i * 128 + c8) = *(const v4u*)(DK + off); *(LAS v4u*)(vs + i * 128 + c8) = *(const v4u*)(DV + off); }
        if (tid < 64) { const int r = scan_row(dir, n, tid); gs[tid] = expf(DG[r]); gs[64 + tid] = DB[r]; }
        __syncthreads();
        if (tid < 256) {
            for (int i = 0; i < 64; ++i) {
                const float vv = bf2f(vs[i * 128 + col]), egv = gs[i], beta = gs[64 + i];
                float kf[64]; float kS = 0.f;
#pragma unroll
                for (int d4 = 0; d4 < 16; ++d4) { const v2u k2 = *(const LAS v2u*)(ks + i * 128 + half * 64 + d4 * 4);
                    kf[d4 * 4 + 0] = bflo(k2.x); kf[d4 * 4 + 1] = bfhi(k2.x); kf[d4 * 4 + 2] = bflo(k2.y); kf[d4 * 4 + 3] = bfhi(k2.y);
                    kS += kf[d4 * 4 + 0] * S[d4 * 4 + 0] + kf[d4 * 4 + 1] * S[d4 * 4 + 1] + kf[d4 * 4 + 2] * S[d4 * 4 + 2] + kf[d4 * 4 + 3] * S[d4 * 4 + 3]; }
                kS += __shfl_xor(kS, 32);
                const float u = beta * (vv - egv * kS); float o = 0.f;
#pragma unroll
                for (int d4 = 0; d4 < 16; ++d4) { const v2u q2 = *(const LAS v2u*)(qs + i * 128 + half * 64 + d4 * 4);
                    S[d4 * 4 + 0] = S[d4 * 4 + 0] * egv + kf[d4 * 4 + 0] * u; o += S[d4 * 4 + 0] * bflo(q2.x);
                    S[d4 * 4 + 1] = S[d4 * 4 + 1] * egv + kf[d4 * 4 + 1] * u; o += S[d4 * 4 + 1] * bfhi(q2.x);
                    S[d4 * 4 + 2] = S[d4 * 4 + 2] * egv + kf[d4 * 4 + 2] * u; o += S[d4 * 4 + 2] * bflo(q2.y);
                    S[d4 * 4 + 3] = S[d4 * 4 + 3] * egv + kf[d4 * 4 + 3] * u; o += S[d4 * 4 + 3] * bfhi(q2.y); }
                o += __shfl_xor(o, 32);
                if (half == 0) OE[(size_t)scan_row(dir, n, i) * 1024 + h * 128 + col] = o;
            }
        }
        __syncthreads();
    }
}

__device__ __forceinline__ void out_phase(Frame& F, const Args& A, int l) {
    const int gw = F.bid * 8 + F.wave, NGW = F.G * 8, lane = F.lane;
    const bf16* Z = (const bf16*)(F.ws + WS_Z); const bf16* AO = (const bf16*)(F.ws + WS_AO);
    const float* OA = (const float*)(F.ws + WS_YB); const float* OE = (const float*)(F.ws + WS_R2);
    bf16* A_ = (bf16*)(F.ws + WS_A); bf16* D_ = (bf16*)(F.ws + WS_D); bf16* E_ = (bf16*)(F.ws + WS_E);
    const float lam_init = l == 0 ? 0.2f : 0.35550906759096924f;
    const float* lp = A.in[14] + l * 256;
    const float lam = expf(wave_sum(lp[lane] * lp[64 + lane])) - expf(wave_sum(lp[128 + lane] * lp[192 + lane])) + lam_init;
    const float* gnw = A.in[13] + l * 128 + lane * 2; const float* dnw = A.in[15] + l * 128 + lane * 2; const float* enw = A.in[19] + l * 128 + lane * 2;
    const float gw0 = gnw[0], gw1 = gnw[1], dw0 = dnw[0], dw1 = dnw[1], ew0 = enw[0], ew1 = enw[1];
    for (int r = gw; r < MROWS; r += NGW) {
        const bf16* zr = Z + (size_t)r * ZP;
        for (int h = 0; h < 4; ++h) {
            const int c = h * 128 + lane * 2;
            {   const float* o0 = OA + (size_t)r * 512 + c; const float* o1 = o0 + (size_t)MROWS * 512;
                const float x0 = o0[0] + o1[0], x1 = o0[1] + o1[1];
                const float rs = __builtin_amdgcn_rsqf(wave_sum(x0 * x0 + x1 * x1) * (1.0f / 128.f) + 1e-6f);
                const unsigned g = *(const unsigned*)(zr + C_GG + c);
                *(unsigned*)(A_ + (size_t)r * 512 + c) = pk2(x0 * rs * gw0 * siluf_(bflo(g)), x1 * rs * gw1 * siluf_(bfhi(g))); }
            {   const unsigned w1 = *(const unsigned*)(AO + (size_t)r * 1024 + (h * 2) * 128 + lane * 2), w2 = *(const unsigned*)(AO + (size_t)r * 1024 + (h * 2 + 1) * 128 + lane * 2);
                const float x0 = bflo(w1) - lam * bflo(w2), x1 = bfhi(w1) - lam * bfhi(w2);
                const float rs = __builtin_amdgcn_rsqf(wave_sum(x0 * x0 + x1 * x1) * (1.0f / 128.f) + 1e-6f) * (1.0f - lam_init);
                *(unsigned*)(D_ + (size_t)r * 512 + c) = pk2(x0 * rs * dw0, x1 * rs * dw1); }
        }
        for (int h = 0; h < 8; ++h) {
            const int c = h * 128 + lane * 2;
            const float* o0 = OE + (size_t)r * 1024 + c; const float* o1 = o0 + (size_t)MROWS * 1024;
            const float x0 = o0[0] + o1[0], x1 = o0[1] + o1[1];
            const float rs = __builtin_amdgcn_rsqf(wave_sum(x0 * x0 + x1 * x1) * (1.0f / 128.f) + 1e-6f);
            const unsigned g = *(const unsigned*)(zr + C_EG + c);
            *(unsigned*)(E_ + (size_t)r * 1024 + c) = pk2(x0 * rs * ew0 * siluf_(bflo(g)), x1 * rs * ew1 * siluf_(bfhi(g)));
        }
    }
}
typedef short bf16x8_t __attribute__((ext_vector_type(8)));
#define LBAR() do { asm volatile("s_waitcnt lgkmcnt(0)" ::: "memory"); __builtin_amdgcn_s_barrier(); asm volatile("" ::: "memory"); } while (0)
constexpr int P128 = 136, P64 = 72;
template <int K> __device__ __forceinline__ f32x4 mma16(const LAS bf16* A, int lda, const LAS bf16* Bt, int ldb, f32x4 acc, int lane) {
    const int r = lane & 15, q = lane >> 4;
    const LAS bf16* ap = A + r * lda + q * 8; const LAS bf16* bp = Bt + r * ldb + q * 8;
#pragma unroll
    for (int k0 = 0; k0 < K; k0 += 32) {
        const bf16x8_t a = *(const LAS bf16x8_t*)(ap + k0), b = *(const LAS bf16x8_t*)(bp + k0);
        acc = __builtin_amdgcn_mfma_f32_16x16x32_bf16(a, b, acc, 0, 0, 0);
    }
    return acc;
}
__device__ __forceinline__ int chunk_scan_index(int dir, int c) { return dir == 0 ? c : (c < 4 ? 3 - c : 135 - c); }
__device__ __forceinline__ float wave_incl_scan(float x, int lane) {
#pragma unroll
    for (int o = 1; o < 64; o <<= 1) { const float t = __shfl_up(x, o); if (lane >= o) x += t; }
    return x;
}
constexpr size_t WS_DS = WS_W0 + W_LAYER;
constexpr size_t WS_PP = WS_DS, WS_NT = WS_DS + 66 * MiB, WS_GL = WS_DS + 132 * MiB, WS_GD = WS_GL + 1 * MiB;
constexpr size_t WS_UG = WS_H, WS_WG = WS_END, WS_GS = WS_R2, WS_BS = WS_YB;
constexpr size_t WS_END2 = WS_END + 33 * MiB;

__device__ __forceinline__ void delta_prep2_item(Frame& F, int chain, int n) {
    const int dir = chain >> 3, h = chain & 7, tid = F.tid, lane = F.lane, w = F.wave;
    const bf16* DK = (const bf16*)(F.ws + WS_DK); const bf16* DV = (const bf16*)(F.ws + WS_DV);
    const float* DG = (const float*)(F.ws + WS_DGB) + (size_t)chain * MROWS; const float* DB = (const float*)(F.ws + WS_DGB) + (size_t)(16 + chain) * MROWS;
    const size_t item = (size_t)chain * 132 + n;
    bf16* Pp = (bf16*)(F.ws + WS_PP) + item * 16384; bf16* NT = (bf16*)(F.ws + WS_NT) + item * 16384;
    bf16* Ug = (bf16*)(F.ws + WS_UG) + item * 8192; bf16* Wg = (bf16*)(F.ws + WS_WG) + item * 8192;
    LAS bf16* Ks = (LAS bf16*)(F.lds);
    LAS float* AM = (LAS float*)(F.lds + 18432);
    LAS bf16* UT = (LAS bf16*)(F.lds);
    LAS bf16* KbT = (LAS bf16*)(F.lds + 35840);
    LAS bf16* KdT = (LAS bf16*)(F.lds + 54272);
    LAS bf16* VbT = (LAS bf16*)(F.lds + 72704);
    LAS bf16* TB = (LAS bf16*)(F.lds + 91136);
    LAS bf16* WT = (LAS bf16*)(F.lds + 100352);
    LAS float* gcs = (LAS float*)(F.lds + 118784); LAS float* bts = gcs + 64;
    const int ip = tid & 31, c8 = (tid >> 5) * 8, i0 = 2 * ip, i1 = i0 + 1;
    const size_t off0 = (size_t)scan_row(dir, n, i0) * 1024 + h * 128 + c8, off1 = (size_t)scan_row(dir, n, i1) * 1024 + h * 128 + c8;
    const v4u kv0 = *(const v4u*)(DK + off0), kv1 = *(const v4u*)(DK + off1), vv0 = *(const v4u*)(DV + off0), vv1 = *(const v4u*)(DV + off1);
    if (w == 0) { const int r = scan_row(dir, n, lane); gcs[lane] = wave_incl_scan(DG[r], lane); bts[lane] = DB[r]; }
    LBAR();
    const float gclast = gcs[63];
    {
        *(LAS v4u*)(Ks + i0 * P128 + c8) = kv0; *(LAS v4u*)(Ks + i1 * P128 + c8) = kv1;
        const float bt0 = bts[i0], bt1 = bts[i1], fb0 = bt0 * __expf(gcs[i0]), fb1 = bt1 * __expf(gcs[i1]), fd0 = __expf(gclast - gcs[i0]), fd1 = __expf(gclast - gcs[i1]);
        const unsigned k0w[4] = {kv0.x, kv0.y, kv0.z, kv0.w}, k1w[4] = {kv1.x, kv1.y, kv1.z, kv1.w}, v0w[4] = {vv0.x, vv0.y, vv0.z, vv0.w}, v1w[4] = {vv1.x, vv1.y, vv1.z, vv1.w};
#pragma unroll
        for (int e = 0; e < 4; ++e) {
            const float ka0 = bflo(k0w[e]), kb0 = bfhi(k0w[e]), ka1 = bflo(k1w[e]), kb1 = bfhi(k1w[e]);
            const float va0 = bflo(v0w[e]), vb0 = bfhi(v0w[e]), va1 = bflo(v1w[e]), vb1 = bfhi(v1w[e]);
            const int ca = (c8 + 2 * e) * P64 + i0, cb = (c8 + 2 * e + 1) * P64 + i0;
            *(LAS unsigned*)(KbT + ca) = pk2(ka0 * fb0, ka1 * fb1); *(LAS unsigned*)(KbT + cb) = pk2(kb0 * fb0, kb1 * fb1);
            *(LAS unsigned*)(KdT + ca) = pk2(ka0 * fd0, ka1 * fd1); *(LAS unsigned*)(KdT + cb) = pk2(kb0 * fd0, kb1 * fd1);
            *(LAS unsigned*)(VbT + ca) = pk2(va0 * bt0, va1 * bt1); *(LAS unsigned*)(VbT + cb) = pk2(vb0 * bt0, vb1 * bt1);
        }
    }
    LBAR();
    const int r = lane & 15, q = lane >> 4;
#pragma unroll
    for (int t2 = 0; t2 < 2; ++t2) {
        const int t = w * 2 + t2, mi = t >> 2, nj = t & 3;
        const f32x4 acc = mma16<128>(Ks + 16 * mi * P128, P128, Ks + 16 * nj * P128, P128, (f32x4){0.f, 0.f, 0.f, 0.f}, lane);
        const int j = 16 * nj + r; const float gj = gcs[j];
#pragma unroll
        for (int jj = 0; jj < 4; ++jj) { const int i = 16 * mi + 4 * q + jj;
            AM[i * 68 + j] = (j < i) ? bts[i] * acc[jj] * __expf(gcs[i] - gj) : 0.f; }
    }
    LBAR();
    {
        LAS float* TM = (LAS float*)(F.lds + 119296);
        LAS float* XM = (LAS float*)(F.lds + 136704);
        if (w == 0) {
            const int b16 = 16 * (lane >> 4), c = lane & 15;
            float t[16];
#pragma unroll
            for (int i = 0; i < 16; ++i) {
                float s_ = (i == c) ? 1.f : 0.f;
#pragma unroll
                for (int j4 = 0; j4 < (i + 3) / 4; ++j4) {
                    const f32x4 a = *(const LAS f32x4*)(AM + (b16 + i) * 68 + b16 + j4 * 4);
                    if (j4 * 4 + 0 < i) s_ -= a.x * t[j4 * 4 + 0];
                    if (j4 * 4 + 1 < i) s_ -= a.y * t[j4 * 4 + 1];
                    if (j4 * 4 + 2 < i) s_ -= a.z * t[j4 * 4 + 2];
                    if (j4 * 4 + 3 < i) s_ -= a.w * t[j4 * 4 + 3];
                }
                t[i] = s_;
                TM[(b16 + i) * 68 + b16 + c] = s_;
            }
        }
        LBAR();
        const int rr = (tid >> 4) & 15, cc = tid & 15;
#pragma unroll
        for (int d = 1; d < 4; ++d) {
            for (int blk = tid >> 8; blk < 4 - d; blk += 2) {
                const int bj = blk, bi = blk + d; float x = 0.f;
                for (int k = bj; k < bi; ++k)
#pragma unroll
                    for (int m = 0; m < 16; ++m) x += AM[(16 * bi + rr) * 68 + 16 * k + m] * TM[(16 * k + m) * 68 + 16 * bj + cc];
                XM[(blk * 16 + rr) * 17 + cc] = x;
            }
            LBAR();
            for (int blk = tid >> 8; blk < 4 - d; blk += 2) {
                const int bj = blk, bi = blk + d; float x = 0.f;
#pragma unroll
                for (int m = 0; m < 16; ++m) x -= TM[(16 * bi + rr) * 68 + 16 * bi + m] * XM[(blk * 16 + m) * 17 + cc];
                TM[(16 * bi + rr) * 68 + 16 * bj + cc] = x;
            }
            LBAR();
        }
        {   const int i = tid >> 3, j0 = (tid & 7) * 8; float v[8];
#pragma unroll
            for (int e = 0; e < 8; ++e) v[e] = ((j0 + e) >> 4) > (i >> 4) ? 0.f : TM[i * 68 + j0 + e];
            v4u o; o.x = pk2(v[0], v[1]); o.y = pk2(v[2], v[3]); o.z = pk2(v[4], v[5]); o.w = pk2(v[6], v[7]);
            *(LAS v4u*)(TB + i * P64 + j0) = o; }
    }
    LBAR();
#pragma unroll
    for (int t4 = 0; t4 < 4; ++t4) {
        const int t = w * 4 + t4, mi = t >> 3, nv = t & 7;
        const f32x4 u = mma16<64>(TB + 16 * mi * P64, P64, VbT + 16 * nv * P64, P64, (f32x4){0.f, 0.f, 0.f, 0.f}, lane);
        const f32x4 ww = mma16<64>(TB + 16 * mi * P64, P64, KbT + 16 * nv * P64, P64, (f32x4){0.f, 0.f, 0.f, 0.f}, lane);
        const int c = 16 * nv + r, i0 = 16 * mi + 4 * q;
        v2u up; up.x = pk2(u[0], u[1]); up.y = pk2(u[2], u[3]);
        v2u wp; wp.x = pk2(ww[0], ww[1]); wp.y = pk2(ww[2], ww[3]);
        *(LAS v2u*)(UT + c * P64 + i0) = up; *(LAS v2u*)(WT + c * P64 + i0) = wp;
        *(v2u*)(Ug + c * 64 + i0) = up;
#pragma unroll
        for (int jj = 0; jj < 4; ++jj) Wg[(i0 + jj) * 128 + c] = (bf16)f2bf(ww[jj]);
    }
    LBAR();
#pragma unroll
    for (int t8 = 0; t8 < 8; ++t8) {
        const int mb = w, na = t8;
        const f32x4 pt = mma16<64>(WT + 16 * mb * P64, P64, KdT + 16 * na * P64, P64, (f32x4){0.f, 0.f, 0.f, 0.f}, lane);
        v2u pp; pp.x = pk2(-pt[0], -pt[1]); pp.y = pk2(-pt[2], -pt[3]);
        *(v2u*)(Pp + ((size_t)((na * 4 + (mb >> 1)) * 64 + lane)) * 8 + 4 * (mb & 1)) = pp;
        const int ma = w, nv = t8;
        const f32x4 nn = mma16<64>(KdT + 16 * ma * P64, P64, UT + 16 * nv * P64, P64, (f32x4){0.f, 0.f, 0.f, 0.f}, lane);
        v2u np; np.x = pk2(nn[0], nn[1]); np.y = pk2(nn[2], nn[3]);
        *(v2u*)(NT + (size_t)(16 * nv + r) * 128 + 16 * ma + 4 * q) = np;
    }
    if (tid == 0) ((float*)(F.ws + WS_GL))[item] = __expf(gclast);
    LBAR();
}

constexpr int CH_SLOT = 32768 + 128 * P128 * 2;
#define CH_BAR() do { asm volatile("s_waitcnt lgkmcnt(0)" ::: "memory"); __builtin_amdgcn_s_barrier(); asm volatile("" ::: "memory"); } while (0)
__device__ __forceinline__ void delta_chain(Frame& F, int chain) {
    const int tid = F.tid, lane = F.lane, w = F.wave, r = lane & 15, q = lane >> 4;
    const bf16* Pp = (const bf16*)(F.ws + WS_PP) + (size_t)chain * 132 * 16384; bf16* NT = (bf16*)(F.ws + WS_NT) + (size_t)chain * 132 * 16384;
    LAS unsigned char* ring = F.lds; LAS float* gls = (LAS float*)(F.lds + 2 * CH_SLOT);
    if (tid < 132) gls[tid] = ((const float*)(F.ws + WS_GL))[chain * 132 + tid];
    if (w >= 4) {
        const int lt = tid - 256;
        unsigned ndst[8];
#pragma unroll
        for (int k = 0; k < 8; ++k) { const int p = lt + 256 * k; ndst[k] = 32768u + (unsigned)((p >> 4) * P128 + (p & 15) * 8) * 2u; }
        v4u rp[3][8], rn[3][8];
#define CH_LOAD(set, step) do { const v4u* ps_ = (const v4u*)(Pp + (size_t)(step) * 16384) + lt; const v4u* ns_ = (const v4u*)(NT + (size_t)(step) * 16384) + lt; \
        _Pragma("unroll") for (int k = 0; k < 8; ++k) { rp[set][k] = ps_[256 * k]; rn[set][k] = ns_[256 * k]; } } while (0)
#define CH_WRITE(set, slot) do { LAS unsigned char* sb_ = ring + (slot) * CH_SLOT; \
        _Pragma("unroll") for (int k = 0; k < 8; ++k) { *(LAS v4u*)(sb_ + (lt + 256 * k) * 16) = rp[set][k]; *(LAS v4u*)(sb_ + ndst[k]) = rn[set][k]; } } while (0)
        CH_LOAD(0, 0); CH_LOAD(1, 1); CH_LOAD(2, 2);
        CH_WRITE(0, 0);
        CH_BAR();
        for (int n = 0; n < 132; n += 3) {
            if (n + 3 < 132) CH_LOAD(0, n + 3);
            CH_WRITE(1, (n + 1) & 1);
            CH_BAR();
            if (n + 4 < 132) CH_LOAD(1, n + 4);
            CH_WRITE(2, (n + 2) & 1);
            CH_BAR();
            if (n + 5 < 132) CH_LOAD(2, n + 5);
            if (n + 3 < 132) CH_WRITE(0, (n + 3) & 1);
            CH_BAR();
        }
#undef CH_LOAD
#undef CH_WRITE
    } else {
        f32x4 acc[2][8];
#pragma unroll
        for (int nb = 0; nb < 2; ++nb)
#pragma unroll
            for (int m = 0; m < 8; ++m) acc[nb][m] = (f32x4){0.f, 0.f, 0.f, 0.f};
        bf16* srow = NT + (size_t)(32 * w + r) * 128 + 4 * q;
        const unsigned noff = 32768u + (unsigned)((32 * w + r) * P128 + 4 * q) * 2u;
        CH_BAR();
        for (int n = 0; n < 132; ++n) {
            const LAS unsigned char* slot = ring + (n & 1) * CH_SLOT;
            const float gl = gls[n];
            v2u sp[2][8];
#pragma unroll
            for (int nb = 0; nb < 2; ++nb)
#pragma unroll
                for (int m = 0; m < 8; ++m) {
                    sp[nb][m].x = pk2(acc[nb][m][0], acc[nb][m][1]); sp[nb][m].y = pk2(acc[nb][m][2], acc[nb][m][3]);
                    *(v2u*)(srow + (size_t)n * 16384 + nb * 2048 + 16 * m) = sp[nb][m];
                    const v2u nv = *(const LAS v2u*)(slot + noff + nb * (16 * P128 * 2) + m * 32);
                    acc[nb][m][0] = gl * acc[nb][m][0] + bflo(nv.x); acc[nb][m][1] = gl * acc[nb][m][1] + bfhi(nv.x);
                    acc[nb][m][2] = gl * acc[nb][m][2] + bflo(nv.y); acc[nb][m][3] = gl * acc[nb][m][3] + bfhi(nv.y);
                }
#pragma unroll
            for (int kb = 0; kb < 4; ++kb) {
                const v4u bu0 = {sp[0][2 * kb].x, sp[0][2 * kb].y, sp[0][2 * kb + 1].x, sp[0][2 * kb + 1].y};
                const v4u bu1 = {sp[1][2 * kb].x, sp[1][2 * kb].y, sp[1][2 * kb + 1].x, sp[1][2 * kb + 1].y};
                const bf16x8_t b0 = __builtin_bit_cast(bf16x8_t, bu0), b1 = __builtin_bit_cast(bf16x8_t, bu1);
#pragma unroll
                for (int m = 0; m < 8; ++m) {
                    const bf16x8_t a = *(const LAS bf16x8_t*)(slot + (m * 4 + kb) * 1024 + lane * 16);
                    acc[0][m] = __builtin_amdgcn_mfma_f32_16x16x32_bf16(a, b0, acc[0][m], 0, 0, 0);
                    acc[1][m] = __builtin_amdgcn_mfma_f32_16x16x32_bf16(a, b1, acc[1][m], 0, 0, 0);
                }
            }
            CH_BAR();
        }
    }
    asm volatile("s_waitcnt vmcnt(0)" ::: "memory");
    __syncthreads();
}

__device__ __forceinline__ void delta_out_item(Frame& F, const Args& A, int l, int c, int h) {
    const int tid = F.tid, lane = F.lane, w = F.wave, r = lane & 15, q = lane >> 4;
    const bf16* DQ = (const bf16*)(F.ws + WS_DQ); const bf16* DK = (const bf16*)(F.ws + WS_DK);
    const int row0 = 64 * c;
    LAS bf16* Qs = (LAS bf16*)(F.lds);
    LAS bf16* Ks = (LAS bf16*)(F.lds + 17408);
    LAS bf16* ST = (LAS bf16*)(F.lds + 35840);
    LAS bf16* Ws = (LAS bf16*)(F.lds + 70656);
    LAS bf16* ATT = (LAS bf16*)(F.lds + 88064);
    LAS float* gcs = (LAS float*)(F.lds + 97280);
    LAS bf16* VNT = (LAS bf16*)(F.lds + 97792);
    LAS float* OS = (LAS float*)(F.lds);
    const int mi = w >> 1, nvb = 4 * (w & 1);
    f32x4 oacc[4];
#pragma unroll
    for (int k = 0; k < 4; ++k) oacc[k] = (f32x4){0.f, 0.f, 0.f, 0.f};
    for (int dir = 0; dir < 2; ++dir) {
        const int chain = dir * 8 + h, n = chunk_scan_index(dir, c);
        const size_t item = (size_t)chain * 132 + n;
        const bf16* Sg = (const bf16*)(F.ws + WS_NT) + item * 16384; const bf16* Ug = (const bf16*)(F.ws + WS_UG) + item * 8192; const bf16* Wg = (const bf16*)(F.ws + WS_WG) + item * 8192;
        const float g_in = (w == 0) ? ((const float*)(F.ws + WS_DGB))[(size_t)chain * MROWS + row0 + (dir ? 63 - lane : lane)] : 0.f;
        v2u uu[4];
#pragma unroll
        for (int k = 0; k < 4; ++k) uu[k] = *(const v2u*)(Ug + (16 * (nvb + k) + r) * 64 + (dir ? 60 - (16 * mi + 4 * q) : (16 * mi + 4 * q)));
        {   v4u rq[2], rk[2], rw[2], rs[4];
#pragma unroll
            for (int i2 = 0; i2 < 2; ++i2) { const int p = tid + 512 * i2, t = p >> 4, c8 = (p & 15) * 8; const size_t off = (size_t)(row0 + t) * 1024 + h * 128 + c8;
                if (dir == 0) { rq[i2] = *(const v4u*)(DQ + off); rk[i2] = *(const v4u*)(DK + off); }
                rw[i2] = *(const v4u*)(Wg + (size_t)(dir ? 63 - t : t) * 128 + c8); }
#pragma unroll
            for (int i4 = 0; i4 < 4; ++i4) { const int p = tid + 512 * i4; rs[i4] = *(const v4u*)(Sg + (p >> 4) * 128 + (p & 15) * 8); }
#pragma unroll
            for (int i2 = 0; i2 < 2; ++i2) { const int p = tid + 512 * i2, t = p >> 4, c8 = (p & 15) * 8;
                if (dir == 0) { *(LAS v4u*)(Qs + t * P128 + c8) = rq[i2]; *(LAS v4u*)(Ks + t * P128 + c8) = rk[i2]; }
                *(LAS v4u*)(Ws + t * P128 + c8) = rw[i2]; }
#pragma unroll
            for (int i4 = 0; i4 < 4; ++i4) { const int p = tid + 512 * i4; *(LAS v4u*)(ST + (p >> 4) * P128 + (p & 15) * 8) = rs[i4]; }
        }
        if (w == 0) { const float s_ = wave_incl_scan(g_in, lane); gcs[dir ? 63 - lane : lane] = s_; }
        LBAR();
#pragma unroll
        for (int t2 = 0; t2 < 2; ++t2) {
            const int t = w * 2 + t2, ai = t >> 2, nj = t & 3;
            const f32x4 acc = mma16<128>(Qs + 16 * ai * P128, P128, Ks + 16 * nj * P128, P128, (f32x4){0.f, 0.f, 0.f, 0.f}, lane);
            const int tj = 16 * nj + r; const float gj = gcs[tj];
#pragma unroll
            for (int jj = 0; jj < 4; ++jj) { const int ti = 16 * ai + 4 * q + jj; const bool ok = dir ? (tj >= ti) : (tj <= ti);
                ATT[ti * P64 + tj] = (bf16)f2bf(ok ? acc[jj] * __expf(gcs[ti] - gj) : 0.f); }
        }
#pragma unroll
        for (int k = 0; k < 4; ++k) {
            const int nv = nvb + k;
            const f32x4 ws = mma16<128>(Ws + 16 * mi * P128, P128, ST + 16 * nv * P128, P128, (f32x4){0.f, 0.f, 0.f, 0.f}, lane);
            const int v = 16 * nv + r, t0 = 16 * mi + 4 * q;
            float u[4];
            if (dir == 0) { u[0] = bflo(uu[k].x); u[1] = bfhi(uu[k].x); u[2] = bflo(uu[k].y); u[3] = bfhi(uu[k].y); }
            else { u[3] = bflo(uu[k].x); u[2] = bfhi(uu[k].x); u[1] = bflo(uu[k].y); u[0] = bfhi(uu[k].y); }
            v2u o; o.x = pk2(u[0] - ws[0], u[1] - ws[1]); o.y = pk2(u[2] - ws[2], u[3] - ws[3]);
            *(LAS v2u*)(VNT + v * P64 + t0) = o;
        }
        LBAR();
#pragma unroll
        for (int k = 0; k < 4; ++k) {
            const int nv = nvb + k;
            f32x4 a = mma16<128>(Qs + 16 * mi * P128, P128, ST + 16 * nv * P128, P128, (f32x4){0.f, 0.f, 0.f, 0.f}, lane);
#pragma unroll
            for (int jj = 0; jj < 4; ++jj) a[jj] *= __expf(gcs[16 * mi + 4 * q + jj]);
            a = mma16<64>(ATT + 16 * mi * P64, P64, VNT + 16 * nv * P64, P64, a, lane);
            oacc[k] += a;
        }
        LBAR();
    }
#pragma unroll
    for (int k = 0; k < 4; ++k)
#pragma unroll
        for (int jj = 0; jj < 4; ++jj) OS[(16 * mi + 4 * q + jj) * 132 + 16 * (nvb + k) + r] = oacc[k][jj];
    LBAR();
    {   const float* enw = A.in[19] + l * 128 + lane * 2; const float ew0 = enw[0], ew1 = enw[1];
        const bf16* Z = (const bf16*)(F.ws + WS_Z); bf16* E_ = (bf16*)(F.ws + WS_E);
        unsigned gz[8];
#pragma unroll
        for (int t8 = 0; t8 < 8; ++t8) gz[t8] = *(const unsigned*)(Z + (size_t)(row0 + w * 8 + t8) * ZP + C_EG + h * 128 + lane * 2);
#pragma unroll
        for (int t8 = 0; t8 < 8; ++t8) { const int t = w * 8 + t8;
            const float x0 = OS[t * 132 + lane * 2], x1 = OS[t * 132 + lane * 2 + 1];
            const float rs = __builtin_amdgcn_rsqf(wave_sum(x0 * x0 + x1 * x1) * (1.0f / 128.f) + 1e-6f);
            const size_t row = row0 + t; const unsigned g = gz[t8];
            *(unsigned*)(E_ + row * 1024 + h * 128 + lane * 2) = pk2(x0 * rs * ew0 * siluf_(bflo(g)), x1 * rs * ew1 * siluf_(bfhi(g)));
        }
    }
    LBAR();
}
constexpr int NIN_MAIN = 13824;
__device__ __forceinline__ void g1_tail_item(Frame& F, int it) {
    const int tid = F.tid, lane = F.lane, w = F.wave, r = lane & 15, q = lane >> 4;
    const bf16* Hm = (const bf16*)(F.ws + WS_H) + (size_t)(64 * it) * DM_;
    const bf16* Wt = (const bf16*)(F.ws + WS_W0 + WO_IN) + (size_t)NIN_MAIN * DM_;
    LAS bf16* As = (LAS bf16*)F.lds; LAS bf16* Bs = As + 64 * 264;
    f32x4 acc[2] = {(f32x4){0.f, 0.f, 0.f, 0.f}, (f32x4){0.f, 0.f, 0.f, 0.f}};
    v4u pa[4], pb[4];
#pragma unroll
    for (int k = 0; k < 4; ++k) { const int p = tid + 512 * k, row = p >> 5, c8 = (p & 31) * 8; pa[k] = *(const v4u*)(Hm + (size_t)row * DM_ + c8); pb[k] = *(const v4u*)(Wt + (size_t)row * DM_ + c8); }
    for (int kc = 0; kc < 8; ++kc) {
#pragma unroll
        for (int k = 0; k < 4; ++k) { const int p = tid + 512 * k, row = p >> 5, c8 = (p & 31) * 8; *(LAS v4u*)(As + row * 264 + c8) = pa[k]; *(LAS v4u*)(Bs + row * 264 + c8) = pb[k]; }
        __syncthreads();
        if (kc + 1 < 8) {
#pragma unroll
            for (int k = 0; k < 4; ++k) { const int p = tid + 512 * k, row = p >> 5, c8 = (p & 31) * 8 + (kc + 1) * 256; pa[k] = *(const v4u*)(Hm + (size_t)row * DM_ + c8); pb[k] = *(const v4u*)(Wt + (size_t)row * DM_ + c8); }
        }
#pragma unroll
        for (int t2 = 0; t2 < 2; ++t2) { const int t = w * 2 + t2, mi = t >> 2, nj = t & 3;
            acc[t2] = mma16<256>(As + 16 * mi * 264, 264, Bs + 16 * nj * 264, 264, acc[t2], lane); }
        __syncthreads();
    }
    bf16* Z = (bf16*)(F.ws + WS_Z);
#pragma unroll
    for (int t2 = 0; t2 < 2; ++t2) { const int t = w * 2 + t2, mi = t >> 2, nj = t & 3;
#pragma unroll
        for (int jj = 0; jj < 4; ++jj) Z[(size_t)(64 * it + 16 * mi + 4 * q + jj) * ZP + NIN_MAIN + 16 * nj + r] = (bf16)f2bf(acc[t2][jj]); }
}

__device__ __forceinline__ f32x4 small_mm_acc(Frame& F, const bf16* Ap, int lda, const bf16* Bp, int ldb, int K, f32x4 acc) {
    const int tid = F.tid, lane = F.lane, w = F.wave;
    LAS bf16* As = (LAS bf16*)F.lds; LAS bf16* Bs = As + 32 * 264;
    v4u pa[2][2], pb[2][4];
#define SM_LOAD(set, kc_) do { \
    _Pragma("unroll") for (int k = 0; k < 2; ++k) { const int p = tid + 512 * k, row = p >> 5, c8 = (p & 31) * 8 + (kc_) * 256; pa[set][k] = *(const v4u*)(Ap + (size_t)row * lda + c8); } \
    _Pragma("unroll") for (int k = 0; k < 4; ++k) { const int p = tid + 512 * k, row = p >> 5, c8 = (p & 31) * 8 + (kc_) * 256; pb[set][k] = *(const v4u*)(Bp + (size_t)row * ldb + c8); } } while (0)
#define SM_STEP(set, kc_) do { \
    _Pragma("unroll") for (int k = 0; k < 2; ++k) { const int p = tid + 512 * k, row = p >> 5, c8 = (p & 31) * 8; *(LAS v4u*)(As + row * 264 + c8) = pa[set][k]; } \
    _Pragma("unroll") for (int k = 0; k < 4; ++k) { const int p = tid + 512 * k, row = p >> 5, c8 = (p & 31) * 8; *(LAS v4u*)(Bs + row * 264 + c8) = pb[set][k]; } \
    LBAR(); \
    if ((kc_) + 2 < nk) SM_LOAD(set, (kc_) + 2); \
    acc = mma16<256>(As + 16 * (w >> 2) * 264, 264, Bs + 16 * (w & 3) * 264, 264, acc, lane); \
    LBAR(); } while (0)
    const int nk = K >> 8;
    SM_LOAD(0, 0); SM_LOAD(1, 1);
    for (int kc = 0; kc < nk; kc += 2) { SM_STEP(0, kc); SM_STEP(1, kc + 1); }
#undef SM_LOAD
#undef SM_STEP
    return acc;
}
__device__ __forceinline__ void ctx_f32_item(Frame& F, int it, const bf16* A, int K, const bf16* Bt, float* Y) {
    const int rt = it >> 5, ct = it & 31, lane = F.lane, w = F.wave, r = lane & 15, q = lane >> 4;
    const f32x4 acc = small_mm_acc(F, A + (size_t)(32 * rt) * K, K, Bt + (size_t)(64 * ct) * K, K, K, (f32x4){0.f, 0.f, 0.f, 0.f});
#pragma unroll
    for (int jj = 0; jj < 4; ++jj) Y[(size_t)(32 * rt + 16 * (w >> 2) + 4 * q + jj) * DM_ + 64 * ct + 16 * (w & 3) + r] = acc[jj];
}
__device__ __forceinline__ void ctx_g2_item(Frame& F, int it) {
    const int rt = it >> 5, ct = it & 31, lane = F.lane, w = F.wave, r = lane & 15, q = lane >> 4;
    unsigned char* ws = F.ws; unsigned char* wb = ws + WS_W0;
    const bf16* Zm = (const bf16*)(ws + WS_Z) + C_MG;
    const int col = 64 * ct + 16 * (w & 3) + r, rowb = 32 * rt + 16 * (w >> 2) + 4 * q;
    f32x4 tot = {0.f, 0.f, 0.f, 0.f};
    {   const f32x4 a = small_mm_acc(F, (const bf16*)(ws + WS_A) + (size_t)(32 * rt) * 512, 512, (const bf16*)(wb + WO_UA) + (size_t)(64 * ct) * 512, 512, 512, (f32x4){0.f, 0.f, 0.f, 0.f});
#pragma unroll
        for (int jj = 0; jj < 4; ++jj) tot[jj] += a[jj] * sigmoidf_(bf2f(Zm[(size_t)(rowb + jj) * ZP + col])); }
    {   const f32x4 a = small_mm_acc(F, (const bf16*)(ws + WS_D) + (size_t)(32 * rt) * 512, 512, (const bf16*)(wb + WO_UD) + (size_t)(64 * ct) * 512, 512, 512, (f32x4){0.f, 0.f, 0.f, 0.f});
#pragma unroll
        for (int jj = 0; jj < 4; ++jj) tot[jj] += a[jj] * sigmoidf_(bf2f(Zm[(size_t)(rowb + jj) * ZP + DM_ + col])); }
    {   const f32x4 a = small_mm_acc(F, (const bf16*)(ws + WS_E) + (size_t)(32 * rt) * 1024, 1024, (const bf16*)(wb + WO_UE) + (size_t)(64 * ct) * 1024, 1024, 1024, (f32x4){0.f, 0.f, 0.f, 0.f});
#pragma unroll
        for (int jj = 0; jj < 4; ++jj) tot[jj] += a[jj] * sigmoidf_(bf2f(Zm[(size_t)(rowb + jj) * ZP + 2 * DM_ + col])); }
    bf16* YB = (bf16*)(ws + WS_YB);
#pragma unroll
    for (int jj = 0; jj < 4; ++jj) YB[(size_t)(rowb + jj) * DM_ + col] = (bf16)f2bf(tot[jj]);
}

__device__ __forceinline__ void gla_cum_decay(Frame& F, const Args& A, int l, int dir, int h, int row0, LAS float* bs, LAS float* part, float* bsg) {
    const int tg = F.wave >> 1, d = (F.wave & 1) * 64 + F.lane;
    const float* ZG = (const float*)(F.ws + WS_ZG);
    const float* w2 = A.in[11] + ((size_t)(l * 2 + dir) * 16) * 512 + h * 128 + d; const float bd = A.in[12][(size_t)(l * 2 + dir) * 512 + h * 128 + d];
    float wc[16], g[16];
#pragma unroll
    for (int j = 0; j < 16; ++j) wc[j] = w2[j * 512];
    LAS float* lrs = part + 512;
    {   const int t = F.tid >> 3, j2 = (F.tid & 7) * 2; const float* src = ZG + (size_t)(row0 + t) * 64 + dir * 16 + j2; lrs[t * 16 + j2] = src[0]; lrs[t * 16 + j2 + 1] = src[1]; }
    LBAR();
#pragma unroll
    for (int k = 0; k < 16; ++k) {
        const LAS float* lr = lrs + (tg * 16 + k) * 16;
        float x = bd;
#pragma unroll
        for (int j = 0; j < 16; ++j) x += lr[j] * wc[j];
        g[k] = (fminf(x, 0.f) - __logf(1.0f + __expf(-fabsf(x)))) * 0.0625f;
    }
    float run = 0.f;
    if (dir == 0) {
#pragma unroll
        for (int k = 0; k < 16; ++k) { run += g[k]; g[k] = run; }
    } else {
#pragma unroll
        for (int k = 15; k >= 0; --k) { run += g[k]; g[k] = run; }
    }
    part[tg * 128 + d] = run;
    LBAR();
    float off = 0.f;
#pragma unroll
    for (int t2 = 0; t2 < 4; ++t2) { const float pv = part[t2 * 128 + d]; if (dir == 0 ? (t2 < tg) : (t2 > tg)) off += pv; }
#pragma unroll
    for (int k = 0; k < 16; ++k) { bs[(tg * 16 + k) * 128 + d] = g[k] + off; bsg[(tg * 16 + k) * 128 + d] = g[k] + off; }
    LBAR();
}
__device__ __forceinline__ void gla_prep2_item(Frame& F, const Args& A, int l, int chain, int c) {
    const int dir = chain >> 2, h = chain & 3, tid = F.tid, lane = F.lane, w = F.wave, r = lane & 15, q = lane >> 4;
    const bf16* Z = (const bf16*)(F.ws + WS_Z);
    const int row0 = 64 * c, n = chunk_scan_index(dir, c);
    LAS float* bs = (LAS float*)F.lds;
    LAS bf16* KdT = (LAS bf16*)(F.lds + 32768);
    LAS bf16* VT = (LAS bf16*)(F.lds + 51200);
    gla_cum_decay(F, A, l, dir, h, row0, bs, (LAS float*)(F.lds + 69632), (float*)(F.ws + WS_BS) + ((size_t)chain * 132 + chunk_scan_index(dir, c)) * 8192);
    const int tl = dir ? 0 : 63;
    {   const int ip = tid & 31, c8 = (tid >> 5) * 8, t0 = 2 * ip, t1 = t0 + 1;
        const bf16* z0 = Z + (size_t)(row0 + t0) * ZP + h * 128 + c8; const bf16* z1 = z0 + ZP;
        const v4u kv0 = *(const v4u*)(z0 + C_GK), kv1 = *(const v4u*)(z1 + C_GK), vv0 = *(const v4u*)(z0 + C_GV), vv1 = *(const v4u*)(z1 + C_GV);
        const unsigned k0w[4] = {kv0.x, kv0.y, kv0.z, kv0.w}, k1w[4] = {kv1.x, kv1.y, kv1.z, kv1.w}, v0w[4] = {vv0.x, vv0.y, vv0.z, vv0.w}, v1w[4] = {vv1.x, vv1.y, vv1.z, vv1.w};
#pragma unroll
        for (int e = 0; e < 4; ++e) {
            const int d0 = c8 + 2 * e, d1 = d0 + 1;
            const float bl0 = bs[tl * 128 + d0], bl1 = bs[tl * 128 + d1];
            *(LAS unsigned*)(KdT + d0 * P64 + t0) = pk2(bflo(k0w[e]) * __expf(bl0 - bs[t0 * 128 + d0]), bflo(k1w[e]) * __expf(bl0 - bs[t1 * 128 + d0]));
            *(LAS unsigned*)(KdT + d1 * P64 + t0) = pk2(bfhi(k0w[e]) * __expf(bl1 - bs[t0 * 128 + d1]), bfhi(k1w[e]) * __expf(bl1 - bs[t1 * 128 + d1]));
            *(LAS unsigned*)(VT + d0 * P64 + t0) = (v0w[e] & 0xffffu) | (v1w[e] << 16);
            *(LAS unsigned*)(VT + d1 * P64 + t0) = (v0w[e] >> 16) | (v1w[e] & 0xffff0000u);
        }
    }
    LBAR();
    const size_t item = (size_t)chain * 132 + n;
    float* GS = (float*)(F.ws + WS_GS) + item * 16384;
#pragma unroll
    for (int t8 = 0; t8 < 8; ++t8) {
        const int mv = w, na = t8;
        const f32x4 d = mma16<64>(VT + 16 * mv * P64, P64, KdT + 16 * na * P64, P64, (f32x4){0.f, 0.f, 0.f, 0.f}, lane);
#pragma unroll
        for (int jj = 0; jj < 4; ++jj) GS[(16 * mv + 4 * q + jj) * 128 + 16 * na + r] = d[jj];
    }
    if (tid < 128) ((float*)(F.ws + WS_GD))[item * 128 + tid] = __expf(bs[tl * 128 + tid]);
    LBAR();
}
__device__ __forceinline__ void gla_scan_item(Frame& F, int it) {
    const int chain = it >> 3, e4 = (it & 7) * 512 + F.tid, v = e4 >> 5, a4 = (e4 & 31) * 4;
    float* p = (float*)(F.ws + WS_GS) + (size_t)chain * 132 * 16384 + v * 128 + a4;
    const float* gd = (const float*)(F.ws + WS_GD) + (size_t)chain * 132 * 128 + a4;
    f32x4 S = {0.f, 0.f, 0.f, 0.f};
    for (int n = 0; n < 132; n += 12) {
        f32x4 x[12]; f32x4 d[12];
#pragma unroll
        for (int k = 0; k < 12; ++k) { x[k] = *(const f32x4*)(p + (size_t)(n + k) * 16384); d[k] = *(const f32x4*)(gd + (n + k) * 128); }
#pragma unroll
        for (int k = 0; k < 12; ++k) { *(f32x4*)(p + (size_t)(n + k) * 16384) = S; S = S * d[k] + x[k]; }
    }
}
__device__ __forceinline__ void gla_out_item(Frame& F, const Args& A, int l, int c, int h) {
    const int tid = F.tid, lane = F.lane, w = F.wave, r = lane & 15, q = lane >> 4;
    const bf16* Z = (const bf16*)(F.ws + WS_Z);
    const int row0 = 64 * c;
    LAS float* bs = (LAS float*)F.lds;
    LAS bf16* Qt = (LAS bf16*)(F.lds + 32768);
    LAS bf16* Kt = (LAS bf16*)(F.lds + 50176);
    LAS bf16* VT = (LAS bf16*)(F.lds + 67584);
    LAS bf16* ST = (LAS bf16*)(F.lds + 86016);
    LAS bf16* ATT = (LAS bf16*)(F.lds + 120832);
    LAS float* OS = (LAS float*)F.lds;
    const int mi = w >> 1, nvb = 4 * (w & 1);
    f32x4 oacc[4];
#pragma unroll
    for (int k = 0; k < 4; ++k) oacc[k] = (f32x4){0.f, 0.f, 0.f, 0.f};
    for (int dir = 0; dir < 2; ++dir) {
        const int chain = dir * 4 + h, n = chunk_scan_index(dir, c);
        const float* Sg = (const float*)(F.ws + WS_GS) + ((size_t)chain * 132 + n) * 16384;
        const float* bsg = (const float*)(F.ws + WS_BS) + ((size_t)chain * 132 + n) * 8192;
        {
            v4u qv[2], kv[2]; f32x4 bA[2], bB[2], sv[8]; v4u vv0 = {0u, 0u, 0u, 0u}, vv1 = {0u, 0u, 0u, 0u};
#pragma unroll
            for (int i2 = 0; i2 < 2; ++i2) { const int p = tid + 512 * i2, t = p >> 4, c8 = (p & 15) * 8; const bf16* zr = Z + (size_t)(row0 + t) * ZP + h * 128 + c8;
                qv[i2] = *(const v4u*)(zr + C_GQ); kv[i2] = *(const v4u*)(zr + C_GK); bA[i2] = *(const f32x4*)(bsg + t * 128 + c8); bB[i2] = *(const f32x4*)(bsg + t * 128 + c8 + 4); }
#pragma unroll
            for (int i8 = 0; i8 < 8; ++i8) { const int p = tid + 512 * i8; sv[i8] = *(const f32x4*)(Sg + (p >> 5) * 128 + (p & 31) * 4); }
            const int ipv = tid & 31, c8v = (tid >> 5) * 8, t0v = 2 * ipv;
            if (dir == 0) { const bf16* z0 = Z + (size_t)(row0 + t0v) * ZP + h * 128 + c8v + C_GV; vv0 = *(const v4u*)z0; vv1 = *(const v4u*)(z0 + ZP); }
#pragma unroll
            for (int i2 = 0; i2 < 2; ++i2) { const int p = tid + 512 * i2, t = p >> 4, c8 = (p & 15) * 8;
                const unsigned qw[4] = {qv[i2].x, qv[i2].y, qv[i2].z, qv[i2].w}, kw[4] = {kv[i2].x, kv[i2].y, kv[i2].z, kv[i2].w};
                const float bb[8] = {bA[i2].x, bA[i2].y, bA[i2].z, bA[i2].w, bB[i2].x, bB[i2].y, bB[i2].z, bB[i2].w};
                unsigned qo[4], ko[4];
#pragma unroll
                for (int e = 0; e < 4; ++e) { const float b0 = bb[2 * e], b1 = bb[2 * e + 1];
                    qo[e] = pk2(bflo(qw[e]) * __expf(b0), bfhi(qw[e]) * __expf(b1)); ko[e] = pk2(bflo(kw[e]) * __expf(-b0), bfhi(kw[e]) * __expf(-b1)); }
                *(LAS v4u*)(Qt + t * P128 + c8) = (v4u){qo[0], qo[1], qo[2], qo[3]}; *(LAS v4u*)(Kt + t * P128 + c8) = (v4u){ko[0], ko[1], ko[2], ko[3]}; }
            if (dir == 0) {
                const unsigned v0w[4] = {vv0.x, vv0.y, vv0.z, vv0.w}, v1w[4] = {vv1.x, vv1.y, vv1.z, vv1.w};
#pragma unroll
                for (int e = 0; e < 4; ++e) {
                    *(LAS unsigned*)(VT + (c8v + 2 * e) * P64 + t0v) = (v0w[e] & 0xffffu) | (v1w[e] << 16);
                    *(LAS unsigned*)(VT + (c8v + 2 * e + 1) * P64 + t0v) = (v0w[e] >> 16) | (v1w[e] & 0xffff0000u); }
            }
#pragma unroll
            for (int i8 = 0; i8 < 8; ++i8) { const int p = tid + 512 * i8; v2u o; o.x = pk2(sv[i8].x, sv[i8].y); o.y = pk2(sv[i8].z, sv[i8].w);
                *(LAS v2u*)(ST + (p >> 5) * P128 + (p & 31) * 4) = o; }
        }
        LBAR();
#pragma unroll
        for (int t2 = 0; t2 < 2; ++t2) {
            const int t = w * 2 + t2, ai = t >> 2, nj = t & 3;
            const f32x4 acc = mma16<128>(Qt + 16 * ai * P128, P128, Kt + 16 * nj * P128, P128, (f32x4){0.f, 0.f, 0.f, 0.f}, lane);
            const int tj = 16 * nj + r;
#pragma unroll
            for (int jj = 0; jj < 4; ++jj) { const int ti = 16 * ai + 4 * q + jj; const bool ok = dir ? (tj >= ti) : (tj <= ti);
                ATT[ti * P64 + tj] = (bf16)f2bf(ok ? acc[jj] : 0.f); }
        }
        LBAR();
#pragma unroll
        for (int k = 0; k < 4; ++k) {
            const int nv = nvb + k;
            oacc[k] = mma16<64>(ATT + 16 * mi * P64, P64, VT + 16 * nv * P64, P64, oacc[k], lane);
            oacc[k] = mma16<128>(Qt + 16 * mi * P128, P128, ST + 16 * nv * P128, P128, oacc[k], lane);
        }
        LBAR();
    }
#pragma unroll
    for (int k = 0; k < 4; ++k)
#pragma unroll
        for (int jj = 0; jj < 4; ++jj) OS[(16 * mi + 4 * q + jj) * 132 + 16 * (nvb + k) + r] = oacc[k][jj] * 0.08838834764831845f;
    LBAR();
    {   const float* gnw = A.in[13] + l * 128 + lane * 2; const float gw0 = gnw[0], gw1 = gnw[1];
        bf16* A_ = (bf16*)(F.ws + WS_A);
        unsigned gz[8];
#pragma unroll
        for (int t8 = 0; t8 < 8; ++t8) gz[t8] = *(const unsigned*)(Z + (size_t)(row0 + w * 8 + t8) * ZP + C_GG + h * 128 + lane * 2);
#pragma unroll
        for (int t8 = 0; t8 < 8; ++t8) { const int t = w * 8 + t8;
            const float x0 = OS[t * 132 + lane * 2], x1 = OS[t * 132 + lane * 2 + 1];
            const float rs = __builtin_amdgcn_rsqf(wave_sum(x0 * x0 + x1 * x1) * (1.0f / 128.f) + 1e-6f);
            const size_t row = row0 + t; const unsigned g = gz[t8];
            *(unsigned*)(A_ + row * 512 + h * 128 + lane * 2) = pk2(x0 * rs * gw0 * siluf_(bflo(g)), x1 * rs * gw1 * siluf_(bfhi(g)));
        }
    }
    LBAR();
}
__device__ __forceinline__ void diff_out_rows(Frame& F, const Args& A, int l) {
    const int gw = F.bid * 8 + F.wave, NGW = F.G * 8, lane = F.lane;
    const bf16* AO = (const bf16*)(F.ws + WS_AO); bf16* D_ = (bf16*)(F.ws + WS_D);
    const float lam_init = l == 0 ? 0.2f : 0.35550906759096924f;
    const float* lp = A.in[14] + l * 256;
    const float lam = expf(wave_sum(lp[lane] * lp[64 + lane])) - expf(wave_sum(lp[128 + lane] * lp[192 + lane])) + lam_init;
    const float* dnw = A.in[15] + l * 128 + lane * 2; const float dw0 = dnw[0], dw1 = dnw[1];
    for (int r = gw + (l == 1 ? CTXL : 0); r < MROWS; r += NGW) {
        unsigned wa[4], wb_[4];
#pragma unroll
        for (int h = 0; h < 4; ++h) { wa[h] = *(const unsigned*)(AO + (size_t)r * 1024 + (h * 2) * 128 + lane * 2); wb_[h] = *(const unsigned*)(AO + (size_t)r * 1024 + (h * 2 + 1) * 128 + lane * 2); }
#pragma unroll
        for (int h = 0; h < 4; ++h) {
            const int c = h * 128 + lane * 2;
            const unsigned w1 = wa[h], w2 = wb_[h];
            const float x0 = bflo(w1) - lam * bflo(w2), x1 = bfhi(w1) - lam * bfhi(w2);
            const float rs = __builtin_amdgcn_rsqf(wave_sum(x0 * x0 + x1 * x1) * (1.0f / 128.f) + 1e-6f) * (1.0f - lam_init);
            *(unsigned*)(D_ + (size_t)r * 512 + c) = pk2(x0 * rs * dw0, x1 * rs * dw1);
        }
    }
}
#ifndef MK_SINGLE
#define MK_SINGLE 1
#endif
template <int l> __device__ __forceinline__ void layer_phases(Frame& F, const Args& args, unsigned char* lds, const int lo, const int hi, const XcdBarrier& bar) {
    unsigned char* ws = args.ws;
#define IN(k) (lo <= (k) && (k) < hi)
#define SEAM(k) do { if (IN(k) && IN((k) + 1)) { xcd_barrier(bar); if (REP_SYNC > 1) xcd_barrier(bar); } } while (0)
    const int pb = 2 + 11 * l;
    unsigned char* wb = ws + WS_W0;
    if (IN(pb + 0) && !SKIP_G1) {
        pg8::Gemm g{(const bf16*)(ws + WS_H), (const bf16*)(wb + WO_IN), MROWS, NIN_MAIN, DM_}; pg8::StaticOrder S; S.init(MROWS, NIN_MAIN, F.G, F.bid); S.rep = REP_G1;
        pg8::EpiZ E{(bf16*)(ws + WS_Z), ZP, (float*)(ws + WS_ZG)};
        pg8::gemm_phase<pg8::EpiZ, pg8::StaticOrder, true, true>(F.lds, g, S, E);
    } SEAM(pb + 0);
    if (IN(pb + 1)) { if (F.bid < 132) g1_tail_item(F, F.bid); prep_phase(F, args, l); } SEAM(pb + 1);
    if (IN(pb + 2)) {
        for (int it = F.bid; it < 2112 * REP_C1; it += F.G) delta_prep2_item(F, (it % 2112) / 132, it % 132);
        for (int it = F.G - 1 - F.bid; it < 1056 * REP_C2; it += F.G) gla_prep2_item(F, args, l, (it % 1056) / 132, it % 132);
    } SEAM(pb + 2);
    if (IN(pb + 3)) {
        if (F.bid < 16) delta_chain(F, F.bid);
        else if (F.bid - 16 < 64) gla_scan_item(F, F.bid - 16);
        {
            const attn_body::bf16* AQ = (const attn_body::bf16*)(ws + WS_AQ); const attn_body::bf16* AK = (const attn_body::bf16*)(ws + WS_AK);
            const attn_body::bf16* AV = (const attn_body::bf16*)(ws + WS_AV); attn_body::bf16* AO = (attn_body::bf16*)(ws + WS_AO);
            unsigned* cnt = (unsigned*)(ws + WS_CNT) + 64 * l;
            volatile LAS unsigned* slot = (volatile LAS unsigned*)(F.lds + MISC_OFF) + 16;
            for (;;) {
                if (F.tid == 0) slot[0] = __hip_atomic_fetch_add(cnt, 1u, __ATOMIC_RELAXED, __HIP_MEMORY_SCOPE_AGENT);
                __syncthreads();
                const int ui = (int)slot[0];
                __syncthreads();
                constexpr int NU = (l == 1) ? 512 : 528;
                if (ui >= NU * REP_ATTN) break;
                const int uj = ui % NU; const int qb = 32 - uj / 16, rem = uj % 16, hm = rem >> 1, half = rem & 1;
                attn_body::attn_unit<8>(AQ + (size_t)qb * 256 * 512 + hm * 64, AK + hm * 64, AV + (hm >> 1) * 128 + half * 64,
                                        AO + (size_t)qb * 256 * 1024 + hm * 128 + half * 64, qb == 0 ? 4 : 132, (char*)lds);
            }
        }
        if (l == 0) p0_dynamic(F, args, 0, (unsigned*)(ws + WS_CNT) + 128, I_IN, PER_L);
        else p0_dynamic(F, args, 1, (unsigned*)(ws + WS_CNT) + 256, I_IN, PER_L - I_2);
    } SEAM(pb + 3);
    if (IN(pb + 4)) {
        for (int it = F.bid; it < 1056 * REP_C3; it += F.G) { if (l == 1 && ((it % 1056) >> 3) < 4) continue; delta_out_item(F, args, l, (it % 1056) >> 3, it & 7); }
        for (int it = F.G - 1 - F.bid; it < 528 * REP_C4; it += F.G) { if (l == 1 && ((it % 528) >> 2) < 4) continue; gla_out_item(F, args, l, (it % 528) >> 2, it & 3); }
        diff_out_rows(F, args, l);
    } SEAM(pb + 4);
    if (IN(pb + 5) && !SKIP_G2) {
        const bf16* Zm = (const bf16*)(ws + WS_Z) + C_MG; float* YF = (float*)(ws + WS_R2); bf16* YB = (bf16*)(ws + WS_YB);
        pg8::StaticOrder S; S.init(MROWS - CTXL, DM_, F.G, F.bid); S.pmoff = 1;
        { pg8::Gemm g{(const bf16*)(ws + WS_A), (const bf16*)(wb + WO_UA), MROWS, DM_, 512}; pg8::EpiGate<0> E{Zm, ZP, YF, YB, DM_};
          pg8::gemm_phase<pg8::EpiGate<0>, pg8::StaticOrder, true, true>(F.lds, g, S, E); }
        { pg8::Gemm g{(const bf16*)(ws + WS_D), (const bf16*)(wb + WO_UD), MROWS, DM_, 512}; pg8::EpiGate<1> E{Zm + DM_, ZP, YF, YB, DM_};
          pg8::gemm_phase<pg8::EpiGate<1>, pg8::StaticOrder, true, true>(F.lds, g, S, E); }
        { pg8::Gemm g{(const bf16*)(ws + WS_E), (const bf16*)(wb + WO_UE), MROWS, DM_, 1024}; pg8::EpiGate<2> E{Zm + 2 * DM_, ZP, YF, YB, DM_};
          pg8::gemm_phase<pg8::EpiGate<2>, pg8::StaticOrder, true, true>(F.lds, g, S, E); }
        if (l == 0) for (int it = F.bid; it < 256; it += F.G) ctx_g2_item(F, it);
    } SEAM(pb + 5);
    if (IN(pb + 6) && !SKIP_G3) {
        pg8::Gemm g{(const bf16*)(ws + WS_YB), (const bf16*)(wb + WO_O), MROWS, DM_, DM_}; pg8::StaticOrder S; S.init(MROWS - CTXL, DM_, F.G, F.bid); S.pmoff = 1; S.rep = REP_G3;
        pg8::EpiF32 E{(float*)(ws + WS_R2), DM_};
        pg8::gemm_phase<pg8::EpiF32, pg8::StaticOrder, true, true>(F.lds, g, S, E);
        if (l == 0) for (int it = F.bid; it < 256; it += F.G) ctx_f32_item(F, it, (const bf16*)(ws + WS_YB), DM_, (const bf16*)(wb + WO_O), (float*)(ws + WS_R2));
    } SEAM(pb + 6);
    if (IN(pb + 7)) { row_phase<1>(F, args, l); } SEAM(pb + 7);
    if (IN(pb + 8) && !SKIP_G4) {
        pg8::Gemm g{(const bf16*)(ws + WS_H), (const bf16*)(wb + WO_13), MROWS, 2 * DFF, DM_}; pg8::StaticOrder S; S.init(MROWS - CTXL * l, 2 * DFF, F.G, F.bid); S.pmoff = l; S.rep = REP_G4;
        pg8::EpiSwiglu E{(bf16*)(ws + WS_HFF), DFF};
        pg8::gemm_phase<pg8::EpiSwiglu, pg8::StaticOrder, true, true>(F.lds, g, S, E);
        if (l == 0) p0_dynamic(F, args, 1, (unsigned*)(ws + WS_CNT) + 192, 0, I_IN);
        else p0_dynamic(F, args, 1, (unsigned*)(ws + WS_CNT) + 320, PER_L - I_2, PER_L);
    } SEAM(pb + 8);
    if (IN(pb + 9) && !SKIP_G5) {
        pg8::Gemm g{(const bf16*)(ws + WS_HFF), (const bf16*)(wb + WO_2), MROWS, DM_, DFF}; pg8::StaticOrder S; S.init(MROWS - CTXL, DM_, F.G, F.bid); S.pmoff = 1; S.rep = REP_G5;
        pg8::EpiF32 E{(float*)(ws + WS_R2), DM_};
        pg8::gemm_phase<pg8::EpiF32, pg8::StaticOrder, true, true>(F.lds, g, S, E);
        if (l == 0) { for (int it = F.bid; it < 256; it += F.G) ctx_f32_item(F, it, (const bf16*)(ws + WS_HFF), DFF, (const bf16*)(wb + WO_2), (float*)(ws + WS_R2));
                    }
    } SEAM(pb + 9);
    if (IN(pb + 10)) { row_phase<2>(F, args, l); } SEAM(pb + 10);
#undef IN
#undef SEAM
}
__global__ void __launch_bounds__(512, 2) mega_fwd(Args args) {
    extern __shared__ __attribute__((aligned(16))) unsigned char lds[];
    Frame F;
    F.lds = (LAS unsigned char*)lds; F.tid = threadIdx.x; F.lane = F.tid & 63; F.wave = __builtin_amdgcn_readfirstlane(F.tid >> 6);
    F.G = gridDim.x; F.bid = blockIdx.x; F.ws = args.ws; F.out = args.out;
    const int lo = args.ph_lo, hi = args.ph_hi;
    if (lo < 0) cg::this_grid().sync();
    for (int u = F.tid; u < 64; u += 512) ((LAS unsigned*)(F.lds + MISC_OFF))[u] = 0u;
    __syncthreads();
    XcdBarrier bar; bar.bar = (unsigned*)(args.ws + WS_BAR); bar.x = 0; bar.st = nullptr;
    if (hi - lo > 1) bar = xcd_barrier_post((unsigned*)(args.ws + WS_BAR), (volatile LAS unsigned*)(F.lds + MISC_OFF) + 8);
#define IN(k) (lo <= (k) && (k) < hi)
#define SEAM(k) do { if (IN(k) && IN((k) + 1)) { xcd_barrier(bar); if (REP_SYNC > 1) xcd_barrier(bar); } } while (0)
    unsigned char* ws = args.ws;
    if (IN(0)) { p0_phase(F, args, 0, true, 0, I_IN); } SEAM(0);
    if (IN(1)) { row_phase<0>(F, args, 0); } SEAM(1);
    layer_phases<0>(F, args, lds, lo, hi, bar);
    layer_phases<1>(F, args, lds, lo, hi, bar);
#undef IN
#undef SEAM
}

extern "C" void kernel_launch(void* const* d_in, const int* in_sizes, int n_in, void* d_out, int out_size, void* d_ws, size_t ws_size, hipStream_t stream) {
    static int grid = 0;
    if (grid == 0) {
        if (n_in != 27 || out_size != SEQ_ * DM_ || ws_size < WS_END2) { fprintf(stderr, "kernel_launch: unexpected shapes (n_in %d, out %d, ws %zu < %zu)\n", n_in, out_size, ws_size, (size_t)WS_END2); grid = -1; return; }
        if (hipFuncSetAttribute((const void*)mega_fwd, hipFuncAttributeMaxDynamicSharedMemorySize, LDS_BYTES) != hipSuccess) { fprintf(stderr, "kernel_launch: hipFuncSetAttribute failed\n"); grid = -1; return; }
        int dev = 0, cus = 0, per_cu = 0;
        hipGetDevice(&dev); hipDeviceGetAttribute(&cus, hipDeviceAttributeMultiprocessorCount, dev);
        hipOccupancyMaxActiveBlocksPerMultiprocessor(&per_cu, (const void*)mega_fwd, 512, LDS_BYTES);
        if (per_cu < 1) { fprintf(stderr, "kernel_launch: occupancy query says %d blocks per CU\n", per_cu); per_cu = 1; }
        (void)hipGetLastError();
        grid = cus;
    }
    if (grid < 0) return;
    Args a{};
    for (int i = 0; i < 27; ++i) a.in[i] = (const float*)d_in[i];
    a.out = (float*)d_out; a.ws = (unsigned char*)d_ws;
#if MK_SINGLE
    if (hipMemsetAsync((char*)d_ws + WS_BAR, 0, BAR_BYTES, stream) != hipSuccess) { fprintf(stderr, "kernel_launch: memset failed\n"); return; }
    a.ph_lo = 0; a.ph_hi = NPH;
    void* kargs[] = {&a};
    hipError_t e = hipLaunchCooperativeKernel((const void*)mega_fwd, dim3(grid), dim3(512), kargs, LDS_BYTES, stream);
    if (e != hipSuccess) fprintf(stderr, "cooperative launch failed: %s (grid %d)\n", hipGetErrorString(e), grid);
#else
    for (int p = 0; p < NPH; ++p) { a.ph_lo = p; a.ph_hi = p + 1; hipLaunchKernelGGL(mega_fwd, dim3(grid), dim3(512), LDS_BYTES, stream, a); }
#endif
}
```

```cpp
#include <hip/hip_runtime.h>
#include <hip/hip_cooperative_groups.h>
#include <hip/hip_bf16.h>
#include <cstdio>
#include <cstdint>
#include <cmath>
namespace cg = cooperative_groups;
#ifndef SKIP_G1
#define SKIP_G1 0
#endif
#ifndef SKIP_G2
#define SKIP_G2 0
#endif
#ifndef SKIP_G3
#define SKIP_G3 0
#endif
#ifndef SKIP_G4
#define SKIP_G4 0
#endif
#ifndef SKIP_G5
#define SKIP_G5 0
#endif
#ifndef REP_G1
#define REP_G1 1
#endif
#ifndef REP_G3
#define REP_G3 1
#endif
#ifndef REP_G4
#define REP_G4 1
#endif
#ifndef REP_G5
#define REP_G5 1
#endif
#ifndef REP_C1
#define REP_C1 1
#endif
#ifndef REP_C2
#define REP_C2 1
#endif
#ifndef REP_C3
#define REP_C3 1
#endif
#ifndef REP_C4
#define REP_C4 1
#endif
#ifndef REP_GEMM
#define REP_GEMM 1
#endif
#ifndef REP_CHUNK
#define REP_CHUNK 1
#endif
#ifndef REP_ATTN
#define REP_ATTN 1
#endif
#ifndef REP_ROWS
#define REP_ROWS 1
#endif
#ifndef REP_P0
#define REP_P0 1
#endif
#ifndef REP_SYNC
#define REP_SYNC 1
#endif
namespace pg8 {
#define PG8_LAS __attribute__((address_space(3)))
typedef unsigned short bf16_t;
typedef short bf16x8 __attribute__((ext_vector_type(8)));
typedef float f32x4 __attribute__((ext_vector_type(4)));
typedef unsigned u32x4 __attribute__((ext_vector_type(4)));
constexpr int BM = 256, BK = 64, HALF = 128, HTB = HALF * BK * 2  , STAGE_BYTES = 8 * HTB, NXCD = 8, WGM = 8;

__host__ __device__ __forceinline__ int lds_byte(int r, int c) { const int st = (r >> 4) * 2 + (c >> 5), rr = r & 15, cc = c & 31, ob = rr * 64 + cc * 2; return st * 1024 + (ob ^ (((ob >> 9) & 1) << 5)); }
__host__ __device__ __forceinline__ void stage_rc(int b, int& R, int& C) { const int st = b / 1024, sb = b % 1024, swz = sb ^ (((sb >> 9) & 1) << 5); R = (st >> 1) * 16 + swz / 64; C = (st & 1) * 32 + (swz % 64) / 2; }
__host__ __device__ __forceinline__ int perm32(int rho) { const int n = rho >> 4, i = rho & 15; return 8 * (i >> 2) + 4 * n + (i & 3); }

struct Unit { int pm, pn; };
struct Gemm { const bf16_t* A; const bf16_t* Bt; int M, N, K; };

struct StaticOrder {
    int nM, nN, nwg, G, c, rep = 1, pmoff = 0;
    __host__ __device__ void init(int M, int N, int G_, int c_) { nM = M / BM; nN = N / BM; nwg = nM * nN; G = G_; c = c_; }
    __host__ __device__ bool next(int i, Unit& u) const {
        const long L = (long)(i / rep) * G + c; if (L >= nwg) return false;
        int wgid = (int)L; { const int q = nwg / NXCD, r = nwg % NXCD, xcd = wgid % NXCD, off = wgid / NXCD; wgid = (xcd < r ? xcd * (q + 1) : r * (q + 1) + (xcd - r) * q) + off; }
        const int nig = WGM * nN, gid = wgid / nig, fm = gid * WGM, gsz = (nM - fm) < WGM ? (nM - fm) : WGM;
        u.pm = pmoff + fm + ((wgid % nig) % gsz); u.pn = (wgid % nig) / gsz; return true;
    }
    __device__ __forceinline__ void a_ready(const Unit&) const {}
    __device__ __forceinline__ void done(const Unit&) const {}
};

__device__ __forceinline__ unsigned cvt_pk_bf16(float lo, float hi) { unsigned r; asm volatile("v_cvt_pk_bf16_f32 %0, %1, %2" : "=v"(r) : "v"(lo), "v"(hi)); return r; }
typedef float f32x2 __attribute__((ext_vector_type(2)));
typedef unsigned u32x2 __attribute__((ext_vector_type(2)));
__device__ __forceinline__ float ep_sigmoid(float x) { return __builtin_amdgcn_rcpf(1.0f + __expf(-x)); }
struct EpiZ {
    static constexpr bool PERM = true, AFTER_DRAIN = false;
    bf16_t* Z; int ldz; float* ZG;
    __device__ __forceinline__ void operator()(const f32x4 (&acc)[2][2][4][2], const Unit& u, int wr, int wc, int fr, int fq) const {
        const int row0 = u.pm * BM + wr * 64 + fr, col0 = u.pn * BM + wc * 32 + 8 * fq;
#pragma unroll
        for (int ai = 0; ai < 2; ++ai)
#pragma unroll
            for (int m = 0; m < 4; ++m) { const int row = row0 + ai * HALF + m * 16;
#pragma unroll
                for (int bj = 0; bj < 2; ++bj) { const int c = col0 + bj * HALF; const f32x4 v0 = acc[ai][bj][m][0], v1 = acc[ai][bj][m][1];
                    u32x4 w; w.x = cvt_pk_bf16(v0[0], v0[1]); w.y = cvt_pk_bf16(v0[2], v0[3]); w.z = cvt_pk_bf16(v1[0], v1[1]); w.w = cvt_pk_bf16(v1[2], v1[3]);
                    *(u32x4*)(Z + (size_t)row * ldz + c) = w;
                    int gc = -1; if (c >= 1536 && c < 1568) gc = c - 1536; else if (c >= 6688 && c < 6720) gc = 32 + c - 6688;
                    if (gc >= 0) { float* g = ZG + (size_t)row * 64 + gc; *(f32x4*)g = v0; *(f32x4*)(g + 4) = v1; } } }
    }
};
template <int MODE> struct EpiGate {
    static constexpr bool PERM = true, AFTER_DRAIN = false;
    const bf16_t* Zg; int ldz; float* YF; bf16_t* YB; int ldc;
    __device__ __forceinline__ void operator()(const f32x4 (&acc)[2][2][4][2], const Unit& u, int wr, int wc, int fr, int fq) const {
        const int row0 = u.pm * BM + wr * 64 + fr, col0 = u.pn * BM + wc * 32 + 8 * fq;
#pragma unroll
        for (int ai = 0; ai < 2; ++ai)
#pragma unroll
            for (int m = 0; m < 4; ++m) { const int row = row0 + ai * HALF + m * 16;
#pragma unroll
                for (int bj = 0; bj < 2; ++bj) { const int c = col0 + bj * HALF;
                    const u32x4 gz = *(const u32x4*)(Zg + (size_t)row * ldz + c);
                    f32x4 g0, g1;
                    g0[0] = ep_sigmoid(__builtin_bit_cast(float, gz.x << 16)); g0[1] = ep_sigmoid(__builtin_bit_cast(float, gz.x & 0xffff0000u));
                    g0[2] = ep_sigmoid(__builtin_bit_cast(float, gz.y << 16)); g0[3] = ep_sigmoid(__builtin_bit_cast(float, gz.y & 0xffff0000u));
                    g1[0] = ep_sigmoid(__builtin_bit_cast(float, gz.z << 16)); g1[1] = ep_sigmoid(__builtin_bit_cast(float, gz.z & 0xffff0000u));
                    g1[2] = ep_sigmoid(__builtin_bit_cast(float, gz.w << 16)); g1[3] = ep_sigmoid(__builtin_bit_cast(float, gz.w & 0xffff0000u));
                    f32x4 v0 = acc[ai][bj][m][0] * g0, v1 = acc[ai][bj][m][1] * g1;
                    bf16_t* y = (bf16_t*)YF + (size_t)row * ldc + c;
                    if (MODE >= 1) { const u32x4 t = *(const u32x4*)y;
                        v0[0] += __builtin_bit_cast(float, t.x << 16); v0[1] += __builtin_bit_cast(float, t.x & 0xffff0000u); v0[2] += __builtin_bit_cast(float, t.y << 16); v0[3] += __builtin_bit_cast(float, t.y & 0xffff0000u);
                        v1[0] += __builtin_bit_cast(float, t.z << 16); v1[1] += __builtin_bit_cast(float, t.z & 0xffff0000u); v1[2] += __builtin_bit_cast(float, t.w << 16); v1[3] += __builtin_bit_cast(float, t.w & 0xffff0000u); }
                    u32x4 w; w.x = cvt_pk_bf16(v0[0], v0[1]); w.y = cvt_pk_bf16(v0[2], v0[3]); w.z = cvt_pk_bf16(v1[0], v1[1]); w.w = cvt_pk_bf16(v1[2], v1[3]);
                    if (MODE <= 1) *(u32x4*)y = w; else *(u32x4*)(YB + (size_t)row * ldc + c) = w; } }
    }
};
struct EpiF32 {
    static constexpr bool PERM = true, AFTER_DRAIN = false;
    bf16_t* Y; int ldc;
    __device__ __forceinline__ void operator()(const f32x4 (&acc)[2][2][4][2], const Unit& u, int wr, int wc, int fr, int fq) const {
        const int row0 = u.pm * BM + wr * 64 + fr, col0 = u.pn * BM + wc * 32 + 8 * fq;
#pragma unroll
        for (int ai = 0; ai < 2; ++ai)
#pragma unroll
            for (int m = 0; m < 4; ++m) { const int row = row0 + ai * HALF + m * 16;
#pragma unroll
                for (int bj = 0; bj < 2; ++bj) { const f32x4 v0 = acc[ai][bj][m][0], v1 = acc[ai][bj][m][1];
                    u32x4 w; w.x = cvt_pk_bf16(v0[0], v0[1]); w.y = cvt_pk_bf16(v0[2], v0[3]); w.z = cvt_pk_bf16(v1[0], v1[1]); w.w = cvt_pk_bf16(v1[2], v1[3]);
                    *(u32x4*)(Y + (size_t)row * ldc + col0 + bj * HALF) = w; } }
    }
};
struct EpiSwiglu {
    static constexpr bool PERM = true, AFTER_DRAIN = false;
    bf16_t* Hf; int ldc;
    __device__ __forceinline__ void operator()(const f32x4 (&acc)[2][2][4][2], const Unit& u, int wr, int wc, int fr, int fq) const {
        const int row0 = u.pm * BM + wr * 64 + fr, col0 = u.pn * HALF + wc * 32 + 8 * fq;
#pragma unroll
        for (int ai = 0; ai < 2; ++ai)
#pragma unroll
            for (int m = 0; m < 4; ++m) { const int row = row0 + ai * HALF + m * 16; float o[8];
#pragma unroll
                for (int n = 0; n < 2; ++n)
#pragma unroll
                    for (int j = 0; j < 4; ++j) { const float a = acc[ai][0][m][n][j], b = acc[ai][1][m][n][j]; o[n * 4 + j] = a * __builtin_amdgcn_rcpf(1.0f + __expf(-a)) * b; }
                u32x4 w; w.x = cvt_pk_bf16(o[0], o[1]); w.y = cvt_pk_bf16(o[2], o[3]); w.z = cvt_pk_bf16(o[4], o[5]); w.w = cvt_pk_bf16(o[6], o[7]);
                *(u32x4*)(Hf + (size_t)row * ldc + col0) = w; }
    }
};
template <class Epi, class Sched, bool ALIGN_EPI = false, bool SP2 = false>
__device__ __forceinline__ void gemm_phase(PG8_LAS unsigned char* lds, const Gemm g, const Sched& S, const Epi& E) {
    const int tid = threadIdx.x, wid = __builtin_amdgcn_readfirstlane(tid >> 6), lane = tid & 63, wr = wid >> 2, wc = wid & 3, fr = lane & 15, fq = lane >> 4;
    const int K = g.K, nt = K / BK;
    unsigned voffA[2], voffB[2];
#pragma unroll
    for (int i = 0; i < 2; ++i) { int R, C; stage_rc(tid * 16 + i * 8192, R, C); const int Rb = Epi::PERM ? ((R & ~31) + perm32(R & 31)) : R;
        voffA[i] = (unsigned)(R * K + C) * 2u; voffB[i] = (unsigned)(Rb * K + C) * 2u; }
    const size_t kstep = (size_t)(BK * 2);
    const size_t hstep = (size_t)HALF * K * 2;
    const size_t tstep = 2 * hstep;
    const unsigned ldsw = (unsigned)wid * 1024u;
    const int aoff = lds_byte(wr * 64 + fr, fq * 8), boff = lds_byte(wc * 32 + fr, fq * 8);
#define PG8_SA(b, h) (((b) * 2 + (h)) * HTB)
#define PG8_SB(b, h) ((4 + (b) * 2 + (h)) * HTB)
#define PG8_STAGE(bufoff, gbase, voff) do { _Pragma("unroll") for (int _i = 0; _i < 2; ++_i) \
        __builtin_amdgcn_global_load_lds((const unsigned*)((const char*)(gbase) + (voff)[_i]), (PG8_LAS unsigned*)(lds + (bufoff) + ldsw + _i * 8192), 16, 0, 0); } while (0)
#define PG8_LDA(dst, b, h) do { _Pragma("unroll") for (int m = 0; m < 4; ++m) _Pragma("unroll") for (int k = 0; k < 2; ++k) dst[m][k] = *(const PG8_LAS bf16x8*)(lds + PG8_SA(b, h) + aoff + m * 2048 + k * 1024); } while (0)
#define PG8_LDB(dst, b, h) do { _Pragma("unroll") for (int n = 0; n < 2; ++n) _Pragma("unroll") for (int k = 0; k < 2; ++k) dst[n][k] = *(const PG8_LAS bf16x8*)(lds + PG8_SB(b, h) + boff + n * 2048 + k * 1024); } while (0)
#define PG8_MMA(ai, bj, At, Bt) do { __builtin_amdgcn_s_setprio(1); _Pragma("unroll") for (int m = 0; m < 4; ++m) _Pragma("unroll") for (int n = 0; n < 2; ++n) _Pragma("unroll") for (int k = 0; k < 2; ++k) \
        acc[ai][bj][m][n] = __builtin_amdgcn_mfma_f32_16x16x32_bf16(Bt[n][k], At[m][k], acc[ai][bj][m][n], 0, 0, 0); __builtin_amdgcn_s_setprio(0); } while (0)
#define PG8_WAIT_V(n) asm volatile("s_waitcnt vmcnt(" #n ")" ::: "memory")
#define PG8_WAIT_L(n) asm volatile("s_waitcnt lgkmcnt(" #n ")" ::: "memory")
#define PG8_BAR __builtin_amdgcn_s_barrier()
#define PG8_SCHED __builtin_amdgcn_sched_barrier(0)
    Unit cur, nxt; int ui = 0;
    if (!S.next(0, cur)) return;
    f32x4 acc[2][2][4][2];
#pragma unroll
    for (int a = 0; a < 2; ++a)
#pragma unroll
        for (int b = 0; b < 2; ++b)
#pragma unroll
            for (int m = 0; m < 4; ++m)
#pragma unroll
                for (int n = 0; n < 2; ++n) acc[a][b][m][n] = (f32x4){0.f, 0.f, 0.f, 0.f};
    bf16x8 At[4][2], B0[2][2], B1[2][2];
    const char* cA = (const char*)g.A + (size_t)cur.pm * tstep; const char* cB = (const char*)g.Bt + (size_t)cur.pn * tstep;
    S.a_ready(cur);
    if constexpr (SP2) {
        PG8_STAGE(PG8_SB(0, 0), cB, voffB); PG8_STAGE(PG8_SB(0, 1), cB + hstep, voffB); PG8_STAGE(PG8_SA(0, 0), cA, voffA); PG8_STAGE(PG8_SA(0, 1), cA + hstep, voffA);
        if (wr == 1) PG8_BAR;
        PG8_WAIT_V(2); PG8_BAR;
        PG8_STAGE(PG8_SB(1, 0), cB + kstep, voffB); PG8_STAGE(PG8_SA(1, 0), cA + kstep, voffA); PG8_STAGE(PG8_SB(1, 1), cB + hstep + kstep, voffB);
        PG8_WAIT_V(6); PG8_BAR;
    } else {
        PG8_STAGE(PG8_SB(0, 0), cB, voffB); PG8_STAGE(PG8_SA(0, 0), cA, voffA); PG8_STAGE(PG8_SB(0, 1), cB + hstep, voffB); PG8_STAGE(PG8_SA(0, 1), cA + hstep, voffA);
        if (wr == 1) PG8_BAR;
        PG8_WAIT_V(4); PG8_BAR;
        PG8_STAGE(PG8_SB(1, 0), cB + kstep, voffB); PG8_STAGE(PG8_SA(1, 0), cA + kstep, voffA); PG8_STAGE(PG8_SB(1, 1), cB + hstep + kstep, voffB);
        PG8_WAIT_V(6); PG8_BAR;
    }
    for (;;) {
        const bool has_next = S.next(ui + 1, nxt);
        const char* nA = has_next ? (const char*)g.A + (size_t)nxt.pm * tstep : cA; const char* nB = has_next ? (const char*)g.Bt + (size_t)nxt.pn * tstep : cB;
        for (int t = 0; t < nt; t += 2) {
            const bool last = (t == nt - 2);
            const char* a1 = cA + (size_t)(t + 1) * kstep;
            const char* a2 = last ? nA : cA + (size_t)(t + 2) * kstep; const char* b2 = last ? nB : cB + (size_t)(t + 2) * kstep;
            const char* a3 = a2 + kstep; const char* b3 = b2 + kstep;
            if (last && has_next) S.a_ready(nxt);
            if constexpr (SP2) {
            PG8_LDB(B0, 0, 0); PG8_LDB(B1, 0, 1); PG8_SCHED; PG8_LDA(At, 0, 0); PG8_STAGE(PG8_SA(1, 1), a1 + hstep, voffA);
            PG8_WAIT_V(8); PG8_WAIT_L(0); PG8_BAR; PG8_MMA(0, 0, At, B0); PG8_MMA(0, 1, At, B1); PG8_BAR; PG8_SCHED;
            PG8_LDA(At, 0, 1); PG8_STAGE(PG8_SB(0, 0), b2, voffB); PG8_STAGE(PG8_SB(0, 1), b2 + hstep, voffB); PG8_STAGE(PG8_SA(0, 0), a2, voffA);
            PG8_WAIT_V(8); PG8_WAIT_L(0); PG8_BAR; PG8_MMA(1, 0, At, B0); PG8_MMA(1, 1, At, B1); PG8_BAR; PG8_SCHED;
            PG8_LDB(B0, 1, 0); PG8_LDB(B1, 1, 1); PG8_SCHED; PG8_LDA(At, 1, 0); PG8_STAGE(PG8_SA(0, 1), a2 + hstep, voffA);
            PG8_WAIT_V(8); PG8_WAIT_L(0); PG8_BAR; PG8_MMA(0, 0, At, B0); PG8_MMA(0, 1, At, B1); PG8_BAR; PG8_SCHED;
            PG8_LDA(At, 1, 1); PG8_STAGE(PG8_SB(1, 0), b3, voffB); PG8_STAGE(PG8_SB(1, 1), b3 + hstep, voffB); PG8_STAGE(PG8_SA(1, 0), a3, voffA);
            PG8_WAIT_V(8); PG8_WAIT_L(0); PG8_BAR; PG8_MMA(1, 0, At, B0); PG8_MMA(1, 1, At, B1); PG8_BAR; PG8_SCHED;
            } else {
            PG8_LDB(B0, 0, 0); PG8_SCHED; PG8_LDA(At, 0, 0); PG8_STAGE(PG8_SA(1, 1), a1 + hstep, voffA);
            PG8_WAIT_L(8); PG8_BAR; PG8_WAIT_L(0); PG8_MMA(0, 0, At, B0); PG8_BAR; PG8_SCHED;
            PG8_LDB(B1, 0, 1); PG8_STAGE(PG8_SB(0, 0), b2, voffB);
            PG8_BAR; PG8_WAIT_L(0); PG8_MMA(0, 1, At, B1); PG8_BAR;
            PG8_LDA(At, 0, 1); PG8_STAGE(PG8_SA(0, 0), a2, voffA);
            PG8_BAR; PG8_WAIT_L(0); PG8_MMA(1, 0, At, B0); PG8_BAR; PG8_SCHED;
            PG8_STAGE(PG8_SB(0, 1), b2 + hstep, voffB);
            PG8_WAIT_V(6); PG8_BAR; PG8_MMA(1, 1, At, B1); PG8_BAR;
            PG8_LDB(B0, 1, 0); PG8_SCHED; PG8_LDA(At, 1, 0); PG8_STAGE(PG8_SA(0, 1), a2 + hstep, voffA);
            PG8_WAIT_L(8); PG8_BAR; PG8_WAIT_L(0); PG8_MMA(0, 0, At, B0); PG8_BAR; PG8_SCHED;
            PG8_LDB(B1, 1, 1); PG8_STAGE(PG8_SB(1, 0), b3, voffB);
            PG8_BAR; PG8_WAIT_L(0); PG8_MMA(0, 1, At, B1); PG8_BAR;
            PG8_LDA(At, 1, 1); PG8_STAGE(PG8_SA(1, 0), a3, voffA);
            PG8_BAR; PG8_WAIT_L(0); PG8_MMA(1, 0, At, B0); PG8_BAR; PG8_SCHED;
            PG8_STAGE(PG8_SB(1, 1), b3 + hstep, voffB);
            PG8_WAIT_V(6); PG8_BAR; PG8_MMA(1, 1, At, B1); PG8_BAR;
            }
        }
        if constexpr (ALIGN_EPI) { if (wr == 0) PG8_BAR; }
        if constexpr (!Epi::AFTER_DRAIN) { E(acc, cur, wr, wc, fr, fq); S.done(cur); }
        if (!has_next) break;
#pragma unroll
        for (int a = 0; a < 2; ++a)
#pragma unroll
            for (int b = 0; b < 2; ++b)
#pragma unroll
                for (int m = 0; m < 4; ++m)
#pragma unroll
                    for (int n = 0; n < 2; ++n) acc[a][b][m][n] = (f32x4){0.f, 0.f, 0.f, 0.f};
        cur = nxt; cA = nA; cB = nB; ++ui;
        if constexpr (ALIGN_EPI) { if (wr == 1) PG8_BAR; }
    }
    PG8_WAIT_V(0);
    if constexpr (!ALIGN_EPI) { if (wr == 0) PG8_BAR; }
    PG8_BAR;
    if constexpr (Epi::AFTER_DRAIN) { E.fused(acc, cur, wr, wc, fr, fq, lds, wid, lane); S.done(cur); }
#undef PG8_SA
#undef PG8_SB
#undef PG8_STAGE
#undef PG8_LDA
#undef PG8_LDB
#undef PG8_MMA
#undef PG8_WAIT_V
#undef PG8_WAIT_L
#undef PG8_BAR
#undef PG8_SCHED
}
}
#include <hip/hip_bf16.h>
#include <cmath>
namespace attn_body {
using bf16=__hip_bfloat16;
using bf16x8=__attribute__((ext_vector_type(8)))short;
using s16x4=__attribute__((ext_vector_type(4)))short;
using f32x16=__attribute__((ext_vector_type(16)))float;
using u32x4=__attribute__((ext_vector_type(4)))unsigned;
constexpr int D=64,DM=512,OPITCH=1024;
constexpr int NW=8,QBLK=32,QB=QBLK*NW,KVBLK=64;
constexpr int ATTN_PITCH=DM, ATTN_UNIT_ROWS=QB;
__device__ __forceinline__ int crow(int r,int hi){return (r&3)+8*(r>>2)+4*hi;}
#define SBAR() __builtin_amdgcn_sched_barrier(0)
__device__ __forceinline__ void cmask(f32x16&p0,f32x16&p1,int jb,int qrel,int hi){
  const float NEG=-INFINITY; int kb=64*jb+4*hi;
  #pragma unroll
  for(int r=0;r<16;++r){int kv=kb+(r&3)+8*(r>>2); if(kv>qrel)p0[r]=NEG; if(kv+32>qrel)p1[r]=NEG;}
}

constexpr int NSLOT=3, SLOTB=8192;
constexpr int LDS_K=0, LDS_V=NSLOT*SLOTB, LDS_WS=2*NSLOT*SLOTB, LDS_OST=LDS_WS+NW*64*4, LDS_BYTES=LDS_OST+NW*4096;
constexpr float C2=0.125f*1.4426950408889634f;
__device__ __forceinline__ void glds16(const void*gsrc,unsigned lds_dst){unsigned keep;
  asm volatile("s_mov_b32 %0, m0\n\ts_mov_b32 m0, %2\n\ts_nop 0\n\tglobal_load_lds_dwordx4 %1, off\n\ts_mov_b32 m0, %0":"=&s"(keep):"v"(gsrc),"s"(lds_dst):"memory");}
__device__ __forceinline__ float max3f(float a,float b,float c){float r;asm("v_max3_f32 %0, %1, %2, %3":"=v"(r):"v"(a),"v"(b),"v"(c));return r;}
__device__ __forceinline__ float max2f(float a,float b){float r;asm("v_max_f32_e32 %0, %1, %2":"=v"(r):"v"(a),"v"(b));return r;}
__device__ __forceinline__ float fadd_s(float a,float b){float r;asm("v_add_f32_e32 %0, %1, %2":"=v"(r):"v"(a),"v"(b));return r;}
__device__ __forceinline__ float fsub_s(float a,float b){float r;asm("v_sub_f32_e32 %0, %1, %2":"=v"(r):"v"(a),"v"(b));return r;}
typedef float f32x2_t __attribute__((ext_vector_type(2))); typedef __bf16 bf16x2_t __attribute__((ext_vector_type(2)));
__device__ __forceinline__ unsigned cvtpk_s(float lo,float hi){f32x2_t v={lo,hi};bf16x2_t b=__builtin_convertvector(v,bf16x2_t);return __builtin_bit_cast(unsigned,b);}
#define WAIT_BAR(N) asm volatile("s_waitcnt vmcnt(" #N ") lgkmcnt(0)\n\ts_barrier":::"memory")

__device__ __forceinline__ void qkt(f32x16&p0,f32x16&p1,const char*Kslot,const bf16x8*qr,const f32x16&negm,int r32,int hi){
  const char*kb=Kslot+hi*1024+r32*16;
  #pragma unroll
  for(int d0=0;d0<4;++d0){
    const bf16x8 b0=*reinterpret_cast<const bf16x8*>(kb+d0*2048);
    const bf16x8 b1=*reinterpret_cast<const bf16x8*>(kb+d0*2048+512);
    if(d0==0){p0=__builtin_amdgcn_mfma_f32_32x32x16_bf16(b0,qr[0],negm,0,0,0);p1=__builtin_amdgcn_mfma_f32_32x32x16_bf16(b1,qr[0],negm,0,0,0);}
    else{p0=__builtin_amdgcn_mfma_f32_32x32x16_bf16(b0,qr[d0],p0,0,0,0);p1=__builtin_amdgcn_mfma_f32_32x32x16_bf16(b1,qr[d0],p1,0,0,0);}}
}
typedef __attribute__((address_space(3))) const char* lds_cptr;
typedef short v4i16_t __attribute__((ext_vector_type(4)));
__device__ __forceinline__ void kload8(bf16x8*kf,lds_cptr kp){
  kf[0]=*(const __attribute__((address_space(3))) bf16x8*)(kp);      kf[1]=*(const __attribute__((address_space(3))) bf16x8*)(kp+512);
  kf[2]=*(const __attribute__((address_space(3))) bf16x8*)(kp+2048); kf[3]=*(const __attribute__((address_space(3))) bf16x8*)(kp+2560);
  kf[4]=*(const __attribute__((address_space(3))) bf16x8*)(kp+4096); kf[5]=*(const __attribute__((address_space(3))) bf16x8*)(kp+4608);
  kf[6]=*(const __attribute__((address_space(3))) bf16x8*)(kp+6144); kf[7]=*(const __attribute__((address_space(3))) bf16x8*)(kp+6656);
}
__device__ __forceinline__ void kload2(bf16x8*kf,lds_cptr kp,int j){ kf[2*j]=*(const __attribute__((address_space(3))) bf16x8*)(kp+j*2048); kf[2*j+1]=*(const __attribute__((address_space(3))) bf16x8*)(kp+j*2048+512); }
__device__ __forceinline__ s16x4 vtr(lds_cptr p){ return __builtin_bit_cast(s16x4,__builtin_amdgcn_ds_read_tr16_b64_v4i16((__attribute__((address_space(3))) v4i16_t*)p)); }
__device__ __forceinline__ float rowmax(const f32x16&p0,const f32x16&p1){
  float a=max3f(p0[0],p0[1],p1[0]),b=max3f(p0[2],p0[3],p1[1]);a=max3f(a,p1[2],p1[3]);
  #pragma unroll
  for(int r=4;r<16;r+=4){a=max3f(a,p0[r],p0[r+1]);b=max3f(b,p0[r+2],p0[r+3]);a=max3f(a,p1[r],p1[r+1]);b=max3f(b,p1[r+2],p1[r+3]);}
  const float m=max2f(a,b);
  auto rr=__builtin_amdgcn_permlane32_swap(__float_as_uint(m),__float_as_uint(m),false,false);
  return max2f(__uint_as_float(rr[0]),__uint_as_float(rr[1]));
}
__device__ __forceinline__ void pv(f32x16*o,int vb,bf16x8 pa0,bf16x8 pa1,bf16x8 pa2,bf16x8 pa3){
  #pragma unroll
  for(int d0=0;d0<2;++d0){s16x4 lo[4],hi[4];
    #pragma unroll
    for(int ks=0;ks<4;++ks){
      asm volatile("ds_read_b64_tr_b16 %0,%1 offset:%c2":"=&v"(lo[ks]):"v"(vb),"i"(d0*4096+ks*1024):"memory");
      asm volatile("ds_read_b64_tr_b16 %0,%1 offset:%c2":"=&v"(hi[ks]):"v"(vb),"i"(d0*4096+ks*1024+512):"memory");}
    asm volatile("s_waitcnt lgkmcnt(0)":::"memory");SBAR();
    #define PK(k) (bf16x8){lo[k][0],lo[k][1],lo[k][2],lo[k][3],hi[k][0],hi[k][1],hi[k][2],hi[k][3]}
    o[d0]=__builtin_amdgcn_mfma_f32_32x32x16_bf16(pa0,PK(0),o[d0],0,0,0);
    o[d0]=__builtin_amdgcn_mfma_f32_32x32x16_bf16(pa1,PK(1),o[d0],0,0,0);
    o[d0]=__builtin_amdgcn_mfma_f32_32x32x16_bf16(pa2,PK(2),o[d0],0,0,0);
    o[d0]=__builtin_amdgcn_mfma_f32_32x32x16_bf16(pa3,PK(3),o[d0],0,0,0);
    #undef PK
  }
}

#ifndef ATTN_STORE16
#define ATTN_STORE16(p,v) (*(u32x4*)(p)=(v))
#endif
template<int THRL> __device__ __forceinline__ void attn_unit(const bf16*Qu,const bf16*__restrict__ Kh,const bf16*__restrict__ Vh,bf16*Ou,const int NT,char*shm){
  const int tid=threadIdx.x,lane=tid&63,r32=lane&31,hi=lane>>5; const int wid=__builtin_amdgcn_readfirstlane(tid>>6);
  const bf16*Qw=Qu+(long)(wid*QBLK)*DM;
  const unsigned lds0=(unsigned)(uintptr_t)shm;
  float*wsf=(float*)(shm+LDS_WS)+wid*64;
  const bf16*ksrc=Kh+(long)lane*DM+wid*8;
  const bf16*vsrc=Vh+(long)(16*(wid&3)+(lane>>2))*DM+(wid>>2)*32+(lane&3)*8;
  const unsigned kdst=lds0+LDS_K+wid*1024, vdst=lds0+LDS_V+wid*1024;
  #define DMA_K(t,slot) glds16(ksrc+(long)(t)*KVBLK*DM,(unsigned)__builtin_amdgcn_readfirstlane(kdst+(slot)))
  #define DMA_V(t,slot) glds16(vsrc+(long)(t)*KVBLK*DM,(unsigned)__builtin_amdgcn_readfirstlane(vdst+(slot)))
  const int vb0=(int)(lds0+LDS_V)+((lane>>4)&1)*32+(lane&3)*8+(4*hi+((lane&15)>>2))*64;
  const char*Kbase=shm+LDS_K; bf16x8 kf[8];
  const lds_cptr shm3=(lds_cptr)shm; const lds_cptr kp0=shm3+LDS_K+hi*1024+r32*16; const lds_cptr vp0=shm3+LDS_V+((lane>>4)&1)*32+(lane&3)*8+(4*hi+((lane&15)>>2))*64;
  DMA_K(0,0);DMA_V(0,0);DMA_K(1,SLOTB);
  bf16x8 qr[4];
  #pragma unroll
  for(int d0=0;d0<4;++d0)qr[d0]=*reinterpret_cast<const bf16x8*>(&Qw[(long)r32*DM+d0*16+hi*8]);
  float mhat=0.f,l_reg=0.f;f32x16 o[2];o[0]=f32x16{};o[1]=f32x16{};f32x16 negm=f32x16{};asm volatile("":"+v"(negm));
  #define CMASK(P0,P1,t) do{}while(0)
  bool resc=false;
  #define START(P0,P1) do{ const float rm=rowmax(P0,P1); resc=false; \
    { const float dl=rm; mhat=fadd_s(mhat,dl); \
      _Pragma("unroll") for(int r=0;r<16;++r){P0[r]=fsub_s(P0[r],dl);P1[r]=fsub_s(P1[r],dl);} \
      _Pragma("unroll") for(int r=0;r<16;++r)negm[r]=-mhat; asm volatile("":"+v"(negm)); } \
    _Pragma("unroll") for(int r=0;r<16;++r)P0[r]=__builtin_amdgcn_exp2f(P0[r]); }while(0)
  #define RESC() do{ if(resc){ asm volatile("s_waitcnt lgkmcnt(0)":::"memory"); \
      _Pragma("unroll") for(int d_=0;d_<2;++d_) _Pragma("unroll") for(int r=0;r<16;++r)o[d_][r]*=wsf[crow(r,hi)]; } }while(0)
  f32x16 pA0,pA1,pB0,pB1;
  int sl_prev=0,sl_cur=0,sl_next=SLOTB;
  #define ROT() do{sl_prev=sl_cur;sl_cur=sl_next;sl_next=(sl_next==(NSLOT-1)*SLOTB)?0:sl_next+SLOTB;}while(0)
  DMA_K(2,2*SLOTB);
  WAIT_BAR(3);
  qkt(pA0,pA1,Kbase,qr,negm,r32,hi);asm volatile("s_nop 15\n\ts_nop 7":"+v"(pA0),"+v"(pA1));CMASK(pA0,pA1,0);
  START(pA0,pA1);
  _Pragma("unroll") for(int r=0;r<16;++r)pA1[r]=__builtin_amdgcn_exp2f(pA1[r]);
  WAIT_BAR(0);
  DMA_K(3,0);DMA_V(1,SLOTB);
  ROT();
  kload8(kf,kp0+sl_cur);
  WAIT_BAR(2);
  s16x4 vlo[8],vhi[8]; u32x4 pw0,pw1,pw2,pw3;
  #define PKW(P,B) cvtpk_s(P[B],P[B+1])
  #define PAF(k) __builtin_bit_cast(bf16x8,pw##k)
  #define VFR(i) (bf16x8){vlo[i][0],vlo[i][1],vlo[i][2],vlo[i][3],vhi[i][0],vhi[i][1],vhi[i][2],vhi[i][3]}
  #define PIN(x) asm volatile("":"+v"(x))
  #define MX3(a,b,c) __builtin_fmaxf(__builtin_fmaxf((a),(b)),(c))
  #define GAPA(MF,A0,A1,A2,A3,W0,W1,PW) do{ MF; sacc+=A0; sacc+=A1; sacc+=A2; sacc+=A3; PIN(sacc); W0; W1; PIN(PW); SBAR(); }while(0)
  #define EX(v) __builtin_amdgcn_exp2f(v)
  #define GAPB(MF,X,B) do{ MF; X[B]=EX(X[B]); X[B+1]=EX(X[B+1]); X[B+2]=EX(X[B+2]); X[B+3]=EX(X[B+3]); PIN(X); SBAR(); }while(0)
  #define VRD(i) do{ vlo[i]=vtr(vp_+(((i)>>2)*4096+((i)&3)*1024)); vhi[i]=vtr(vp_+(((i)>>2)*4096+((i)&3)*1024+512)); }while(0)
  #define KRD(G,j) do{ if(G){ kload2(kf,kp0+sl_next,j); SBAR(); } }while(0)
  #define STEP(C0,C1,P0,P1,t,GK,GV,GL) do{ SBAR(); \
    const lds_cptr vp_=vp0+sl_prev; \
    VRD(0); SBAR(); float sacc=(P0[0]+P0[1]); \
    GAPA(C0=__builtin_amdgcn_mfma_f32_32x32x16_bf16(kf[0],qr[0],negm,0,0,0), P0[2],P0[3],P0[4],P0[5],     pw0[0]=PKW(P0,0), pw0[1]=PKW(P0,2), pw0); \
    VRD(4); SBAR(); GAPA(C1=__builtin_amdgcn_mfma_f32_32x32x16_bf16(kf[1],qr[0],negm,0,0,0), P0[6],P0[7],P0[8],P0[9],     pw0[2]=PKW(P0,4), pw0[3]=PKW(P0,6), pw0); \
    VRD(1); SBAR(); GAPA(C0=__builtin_amdgcn_mfma_f32_32x32x16_bf16(kf[2],qr[1],C0,0,0,0),   P0[10],P0[11],P0[12],P0[13], pw1[0]=PKW(P0,8), pw1[1]=PKW(P0,10), pw1); \
    VRD(5); SBAR(); GAPA(C1=__builtin_amdgcn_mfma_f32_32x32x16_bf16(kf[3],qr[1],C1,0,0,0),   P0[14],P0[15],P1[0],P1[1],   pw1[2]=PKW(P0,12),pw1[3]=PKW(P0,14), pw1); \
    VRD(2); SBAR(); GAPA(C0=__builtin_amdgcn_mfma_f32_32x32x16_bf16(kf[4],qr[2],C0,0,0,0),   P1[2],P1[3],P1[4],P1[5],     pw2[0]=PKW(P1,0), pw2[1]=PKW(P1,2), pw2); \
    VRD(6); SBAR(); GAPA(C1=__builtin_amdgcn_mfma_f32_32x32x16_bf16(kf[5],qr[2],C1,0,0,0),   P1[6],P1[7],P1[8],P1[9],     pw2[2]=PKW(P1,4), pw2[3]=PKW(P1,6), pw2); \
    VRD(3); SBAR(); GAPA(C0=__builtin_amdgcn_mfma_f32_32x32x16_bf16(kf[6],qr[3],C0,0,0,0),   P1[10],P1[11],P1[12],P1[13], pw3[0]=PKW(P1,8), pw3[1]=PKW(P1,10), pw3); \
    VRD(7); SBAR(); GAPA(C1=__builtin_amdgcn_mfma_f32_32x32x16_bf16(kf[7],qr[3],C1,0,0,0),   P1[14],P1[15],0.f,0.f,       pw3[2]=PKW(P1,12),pw3[3]=PKW(P1,14), pw3); \
    l_reg+=sacc; \
    if(GK){DMA_K((t)+3,sl_cur);} if(GV){DMA_V((t)+1,sl_next);} \
    CMASK(C0,C1,t); \
    { float a=MX3(C0[0],C0[1],C1[0]),b=MX3(C0[2],C0[3],C1[1]); a=MX3(a,C1[2],C1[3]); \
      _Pragma("unroll") for(int r=4;r<16;r+=4){a=MX3(a,C0[r],C0[r+1]);b=MX3(b,C0[r+2],C0[r+3]);a=MX3(a,C1[r],C1[r+1]);b=MX3(b,C1[r+2],C1[r+3]);} \
      float rm=__builtin_fmaxf(a,b); { auto rr=__builtin_amdgcn_permlane32_swap(__float_as_uint(rm),__float_as_uint(rm),false,false); rm=__builtin_fmaxf(__uint_as_float(rr[0]),__uint_as_float(rr[1])); } \
      resc=false; \
      if(__builtin_expect(__any(rm>(float)THRL),0)){ const float dl=__builtin_fmaxf(rm,0.f); mhat+=dl; \
        _Pragma("unroll") for(int r=0;r<16;++r){C0[r]-=dl;C1[r]-=dl;} \
        _Pragma("unroll") for(int r=0;r<16;++r)negm[r]=-mhat; asm volatile("":"+v"(negm)); \
        const float f=__builtin_amdgcn_exp2f(-dl); l_reg*=f; if(hi==0)wsf[r32]=f; resc=true; } } \
    SBAR(); \
    GAPB(o[0]=__builtin_amdgcn_mfma_f32_32x32x16_bf16(PAF(0),VFR(0),o[0],0,0,0), C0,0); \
    GAPB(o[1]=__builtin_amdgcn_mfma_f32_32x32x16_bf16(PAF(0),VFR(4),o[1],0,0,0), C0,4); \
    KRD(GL,0); GAPB(o[0]=__builtin_amdgcn_mfma_f32_32x32x16_bf16(PAF(1),VFR(1),o[0],0,0,0), C0,8); \
    KRD(GL,1); GAPB(o[1]=__builtin_amdgcn_mfma_f32_32x32x16_bf16(PAF(1),VFR(5),o[1],0,0,0), C0,12); \
    KRD(GL,2); GAPB(o[0]=__builtin_amdgcn_mfma_f32_32x32x16_bf16(PAF(2),VFR(2),o[0],0,0,0), C1,0); \
    KRD(GL,3); GAPB(o[1]=__builtin_amdgcn_mfma_f32_32x32x16_bf16(PAF(2),VFR(6),o[1],0,0,0), C1,4); \
    GAPB(o[0]=__builtin_amdgcn_mfma_f32_32x32x16_bf16(PAF(3),VFR(3),o[0],0,0,0), C1,8); \
    GAPB(o[1]=__builtin_amdgcn_mfma_f32_32x32x16_bf16(PAF(3),VFR(7),o[1],0,0,0), C1,12); \
    }while(0)
  int t=1;
  #undef CMASK
  #define CMASK(P0,P1,t) do{}while(0)
  for(;t+5<NT;t+=2){
    STEP(pB0,pB1,pA0,pA1,t,true,true,true);     WAIT_BAR(2); RESC(); ROT();
    STEP(pA0,pA1,pB0,pB1,t+1,true,true,true);   WAIT_BAR(2); RESC(); ROT();
  }
  #undef CMASK
  #define CMASK(P0,P1,t) do{}while(0)
  #define ENDW(tt) do{ if((tt)+3<NT){WAIT_BAR(2);} else if((tt)+2<NT){WAIT_BAR(1);} else {WAIT_BAR(0);} }while(0)
  for(;t+1<NT;t+=2){
    STEP(pB0,pB1,pA0,pA1,t,(t+3<NT),(t+1<NT),(t+1<NT));       ENDW(t);   RESC(); ROT();
    STEP(pA0,pA1,pB0,pB1,t+1,(t+4<NT),(t+2<NT),(t+2<NT));     ENDW(t+1); RESC(); ROT();
  }
  STEP(pB0,pB1,pA0,pA1,NT-1,false,false,false); RESC();
  { float sacc=pB0[0]+pB0[1]; _Pragma("unroll") for(int r=2;r<16;++r)sacc+=pB0[r]; _Pragma("unroll") for(int r=0;r<16;++r)sacc+=pB1[r]; l_reg+=sacc;
    pw0=(u32x4){PKW(pB0,0),PKW(pB0,2),PKW(pB0,4),PKW(pB0,6)};pw1=(u32x4){PKW(pB0,8),PKW(pB0,10),PKW(pB0,12),PKW(pB0,14)};pw2=(u32x4){PKW(pB1,0),PKW(pB1,2),PKW(pB1,4),PKW(pB1,6)};pw3=(u32x4){PKW(pB1,8),PKW(pB1,10),PKW(pB1,12),PKW(pB1,14)};
    SBAR(); pv(o,vb0+sl_cur,PAF(0),PAF(1),PAF(2),PAF(3)); }
  #undef PKW
  #undef PAF
  #undef VFR
  #undef PIN
  #undef MX3
  #undef GAPA
  #undef GAPB
  #undef EX
  #undef VRD
  #undef KRD
  #undef STEP
  #undef ENDW
  {auto rr=__builtin_amdgcn_permlane32_swap(__float_as_uint(l_reg),__float_as_uint(l_reg),false,false);l_reg=__uint_as_float(rr[0])+__uint_as_float(rr[1]);}
  if(hi==0)wsf[32+r32]=l_reg;asm volatile("s_waitcnt lgkmcnt(0)":::"memory");
  float rli[16];
  #pragma unroll
  for(int r=0;r<16;++r)rli[r]=__builtin_amdgcn_rcpf(wsf[32+crow(r,hi)]);
  bf16*Ow=Ou+(long)(wid*QBLK)*OPITCH;
  { bf16*stg=(bf16*)(shm+LDS_OST)+wid*2048;
    #pragma unroll
    for(int r=0;r<16;++r){const int orow=crow(r,hi);
      #pragma unroll
      for(int d0=0;d0<2;++d0)stg[orow*64+d0*32+r32]=__float2bfloat16(o[d0][r]*rli[r]);}
    asm volatile("s_waitcnt lgkmcnt(0)":::"memory");
    #pragma unroll
    for(int i=0;i<4;++i){const int row=i*8+(lane>>3),ch=lane&7; const u32x4 v=*(const u32x4*)(stg+row*64+ch*8); ATTN_STORE16(Ow+(long)row*OPITCH+ch*8,v);} }
  asm volatile("s_waitcnt lgkmcnt(0)\n\ts_barrier":::"memory");
  #undef DMA_K
  #undef DMA_V
  #undef CMASK
  #undef START
  #undef RESC
  #undef ROT
}
constexpr int ATTN_LDS_BYTES=LDS_BYTES;
#undef SBAR
#undef WAIT_BAR
}
#define GAS __attribute__((address_space(1)))
#define LAS __attribute__((address_space(3)))
typedef unsigned short bf16;
typedef unsigned v4u __attribute__((ext_vector_type(4)));
typedef unsigned v2u __attribute__((ext_vector_type(2)));
typedef float f32x4 __attribute__((ext_vector_type(4)));
#define LDS_WAIT() asm volatile("s_waitcnt lgkmcnt(0)" ::: "memory")

constexpr int DM_ = 2048, SEQ_ = 8192, CTXL = 256, MROWS = SEQ_ + CTXL;
constexpr int NIN = 13888, NINP = 14080, DFF = 5632;
constexpr int ZP = NINP;
constexpr int C_GQ = 0, C_GK = 512, C_GV = 1024, C_GLR = 1536, C_GG = 1568, C_DQ = 2080, C_DK = 2592, C_DV = 3104,
              C_EQ = 3616, C_EA = 6688, C_EB = 6704, C_EG = 6720, C_MG = 7744;
constexpr size_t MiB = 1u << 20;
constexpr size_t WS_MOD = 0;
constexpr size_t WS_BAR = 512 * 1024, BAR_BYTES = 16384;
constexpr int MISC_OFF = 147456 - 256;
constexpr size_t WS_CNT = WS_BAR + 14336;
constexpr size_t WS_W0 = 1 * MiB, W_LAYER = 137 * MiB;
constexpr size_t WO_IN = 0, WO_UA = 55 * MiB, WO_UD = 57 * MiB, WO_UE = 59 * MiB, WO_O = 63 * MiB, WO_13 = 71 * MiB, WO_2 = 115 * MiB;
constexpr size_t WS_X = WS_W0 + 2 * W_LAYER;
constexpr size_t WS_H = WS_X + 66 * MiB;
constexpr size_t WS_Z = WS_H + 33 * MiB;
constexpr size_t WS_ZG = WS_Z + 227 * MiB;
constexpr size_t WS_AQ = WS_ZG + 3 * MiB, WS_AK = WS_AQ + 9 * MiB, WS_AV = WS_AK + 9 * MiB, WS_AO = WS_AV + 9 * MiB;
constexpr size_t WS_DQ = WS_AO + 17 * MiB, WS_DK = WS_DQ + 17 * MiB, WS_DV = WS_DK + 17 * MiB, WS_DGB = WS_DV + 17 * MiB;
constexpr size_t WS_A = WS_DGB + 2 * MiB, WS_D = WS_A + 9 * MiB, WS_E = WS_D + 9 * MiB;
constexpr size_t WS_R2 = WS_E + 17 * MiB;
constexpr size_t WS_YB = WS_R2 + 66 * MiB;
constexpr size_t WS_END = WS_YB + 33 * MiB;
constexpr size_t WS_HFF = WS_Z;

constexpr int LDS_BYTES = 147456;
constexpr int NPH = 24;

typedef float pk_f32x2 __attribute__((ext_vector_type(2))); typedef __bf16 pk_bf16x2 __attribute__((ext_vector_type(2)));
__device__ __forceinline__ unsigned pk2(float lo, float hi) { const pk_f32x2 v = {lo, hi}; const pk_bf16x2 b = __builtin_convertvector(v, pk_bf16x2); return __builtin_bit_cast(unsigned, b); }
__device__ __forceinline__ unsigned f2bf(float f) { return pk2(f, 0.f) & 0xffffu; }
__device__ __forceinline__ float bf2f(unsigned short b) { return __builtin_bit_cast(float, (unsigned)b << 16); }
__device__ __forceinline__ float bflo(unsigned w) { return __builtin_bit_cast(float, w << 16); }
__device__ __forceinline__ float bfhi(unsigned w) { return __builtin_bit_cast(float, w & 0xffff0000u); }
__device__ __forceinline__ float wave_sum(float v) {
#pragma unroll
    for (int o = 1; o < 64; o <<= 1) v += __shfl_xor(v, o);
    return v;
}
__device__ __forceinline__ float sigmoidf_(float x) { return __builtin_amdgcn_rcpf(1.0f + __expf(-x)); }
__device__ __forceinline__ float siluf_(float x) { return x * __builtin_amdgcn_rcpf(1.0f + __expf(-x)); }

struct Args { const float* in[27]; float* out; unsigned char* ws; int ph_lo, ph_hi; };

struct Frame {
    LAS unsigned char* lds;
    int tid, lane, wave, G, bid;
    unsigned char* ws; float* out;
};

#define XB_TMO      128
#define XB_XCNT(j)  (256  + 64 * (j))
#define XB_XSUB(j)  (1280 + 64 * (j))
#define XB_XGEN(j)  (2304 + 64 * (j))
#define XB_TOP      3328
#define XB_TOPGEN   3392
#define XCD_BAR_WORDS 3456
#define XB_SPIN_CAP (1u << 18)

__device__ __forceinline__ unsigned xb_ld(unsigned* p)              { return __hip_atomic_load(p, __ATOMIC_RELAXED, __HIP_MEMORY_SCOPE_AGENT); }
__device__ __forceinline__ unsigned xb_add(unsigned* p, unsigned v) { return __hip_atomic_fetch_add(p, v, __ATOMIC_RELAXED, __HIP_MEMORY_SCOPE_AGENT); }
__device__ __forceinline__ unsigned xb_xcc_id() { return (unsigned)__builtin_amdgcn_s_getreg((3 << 11) | 20) & 0xFu; }
#define XB_SPIN(cond, bar) do { unsigned _sp = 0; while (cond) { __builtin_amdgcn_s_sleep(1); \
    if ((++_sp & 255u) == 0u) { if (xb_ld(&(bar)[XB_TMO])) break; if (_sp > XB_SPIN_CAP) { atomicAdd(&(bar)[XB_TMO], 1u); break; } } } } while (0)

struct XcdBarrier {
    unsigned* bar; unsigned x;
    volatile LAS unsigned* st;
};

__device__ __forceinline__ XcdBarrier xcd_barrier_post(unsigned* bar, volatile LAS unsigned* st) {
    XcdBarrier b; b.bar = bar; b.x = xb_xcc_id(); b.st = st;
    if (threadIdx.x == 0) (void)xb_add(&bar[XB_XCNT(b.x)], 1u);
    return b;
}
__device__ __forceinline__ void xcd_barrier_complete(unsigned* bar, unsigned x, unsigned& nloc, unsigned& nx) {
    const unsigned G = gridDim.x * gridDim.y * gridDim.z;
    unsigned sum, cnt, mine, sp = 0u;
    for (;;) {
        sum = 0u; cnt = 0u; mine = 0u;
#pragma unroll
        for (unsigned j = 0; j < 16; ++j) { const unsigned c = xb_ld(&bar[XB_XCNT(j)]); sum += c; cnt += (c > 0u) ? 1u : 0u; mine = (j == x) ? c : mine; }
        if (sum == G) break;
        __builtin_amdgcn_s_sleep(1);
        if ((++sp & 255u) == 0u) { if (xb_ld(&bar[XB_TMO])) break; if (sp > XB_SPIN_CAP) { atomicAdd(&bar[XB_TMO], 1u); break; } }
    }
    nloc = mine > 0u ? mine : 1u; nx = cnt > 0u ? cnt : 1u;
}

__device__ __forceinline__ void xcd_barrier(const XcdBarrier& b) {
    asm volatile("s_waitcnt vmcnt(0)" ::: "memory");
    __syncthreads();
    if (threadIdx.x == 0) {
        unsigned* bar = b.bar;
        __builtin_amdgcn_s_waitcnt(0);
        unsigned nloc = b.st[0], nx = b.st[1];
        if (nloc == 0u) { xcd_barrier_complete(bar, b.x, nloc, nx); b.st[0] = nloc; b.st[1] = nx; }
        const unsigned old = xb_add(&bar[XB_XSUB(b.x)], 1u);
        const unsigned gen = old / nloc;
        if (old + 1u == (gen + 1u) * nloc) {
            __builtin_amdgcn_fence(__ATOMIC_RELEASE, "agent");
            asm volatile("s_waitcnt vmcnt(0)" ::: "memory");
            const unsigned og = xb_add(&bar[XB_TOP], 1u);
            const unsigned tg = og / nx;
            if (og + 1u == (tg + 1u) * nx) xb_add(&bar[XB_TOPGEN], 1u);
            else XB_SPIN(xb_ld(&bar[XB_TOPGEN]) == tg, bar);
            __builtin_amdgcn_fence(__ATOMIC_ACQUIRE, "agent");
            xb_add(&bar[XB_XGEN(b.x)], 1u);
            asm volatile("s_waitcnt vmcnt(0)" ::: "memory");
        } else {
            XB_SPIN(xb_ld(&bar[XB_XGEN(b.x)]) == gen, bar);
            __builtin_amdgcn_fence(__ATOMIC_ACQUIRE, "agent");
            asm volatile("s_waitcnt vmcnt(0)" ::: "memory");
        }
    }
    __syncthreads();
}

__device__ __forceinline__ void p0_transpose_item(const float* W, int K, int N, bf16* WT, int k0, int n0, int drow, LAS float* scr, int lane) {
#pragma unroll 8
    for (int i = 0; i < 32; ++i) { const int kk = 2 * i + (lane >> 5); scr[kk * 33 + (lane & 31)] = __builtin_nontemporal_load(W + (size_t)(k0 + kk) * N + n0 + (lane & 31)); }
    LDS_WAIT(); asm volatile("" ::: "memory");
    const int c = lane & 7;
#pragma unroll
    for (int j = 0; j < 4; ++j) { const int n = (lane >> 3) + 8 * j; const LAS float* s = scr + (8 * c) * 33 + n;
        v4u o; o.x = pk2(s[0 * 33], s[1 * 33]); o.y = pk2(s[2 * 33], s[3 * 33]); o.z = pk2(s[4 * 33], s[5 * 33]); o.w = pk2(s[6 * 33], s[7 * 33]);
        *(v4u*)(WT + (size_t)(drow + n) * K + k0 + 8 * c) = o; }
    LDS_WAIT(); asm volatile("" ::: "memory");
}
__device__ __forceinline__ void tr_plain(const float* W, int K, int N, bf16* WT, int item, LAS float* scr, int lane) {
    const int nblk = N / 32, kb = item / nblk, nb = item % nblk;
    p0_transpose_item(W, K, N, WT, 64 * kb, 32 * nb, 32 * nb, scr, lane);
}
__device__ __forceinline__ void tr_ffn13(const float* W, bf16* WT, int item, int which, LAS float* scr, int lane) {
    const int nblk = DFF / 32, kb = item / nblk, nb = item % nblk, n0 = 32 * nb;
    p0_transpose_item(W, DM_, DFF, WT, 64 * kb, n0, 256 * (n0 >> 7) + (n0 & 127) + 128 * which, scr, lane);
}
constexpr int I_IN = 32 * (NIN / 32), I_UA = 8 * 64, I_UE = 16 * 64, I_O = 32 * 64, I_F = 32 * (DFF / 32), I_2 = (DFF / 64) * 64;
constexpr int PER_L = I_IN + 2 * I_UA + I_UE + I_O + 2 * I_F + I_2;
__device__ __forceinline__ void p0_item(Frame& F, const Args& A, const int l, int r, LAS float* scr) {
    unsigned char* wb = F.ws + WS_W0;
    if (r < I_IN) { tr_plain(A.in[10] + (size_t)l * DM_ * NIN, DM_, NIN, (bf16*)(wb + WO_IN), r, scr, F.lane); return; } r -= I_IN;
    if (r < I_UA) { tr_plain(A.in[20] + (size_t)l * 512 * DM_, 512, DM_, (bf16*)(wb + WO_UA), r, scr, F.lane); return; } r -= I_UA;
    if (r < I_UA) { tr_plain(A.in[21] + (size_t)l * 512 * DM_, 512, DM_, (bf16*)(wb + WO_UD), r, scr, F.lane); return; } r -= I_UA;
    if (r < I_UE) { tr_plain(A.in[22] + (size_t)l * 1024 * DM_, 1024, DM_, (bf16*)(wb + WO_UE), r, scr, F.lane); return; } r -= I_UE;
    if (r < I_O) { tr_plain(A.in[23] + (size_t)l * DM_ * DM_, DM_, DM_, (bf16*)(wb + WO_O), r, scr, F.lane); return; } r -= I_O;
    if (r < I_F) { tr_ffn13(A.in[24] + (size_t)l * DM_ * DFF, (bf16*)(wb + WO_13), r, 0, scr, F.lane); return; } r -= I_F;
    if (r < I_F) { tr_ffn13(A.in[25] + (size_t)l * DM_ * DFF, (bf16*)(wb + WO_13), r, 1, scr, F.lane); return; } r -= I_F;
    tr_plain(A.in[26] + (size_t)l * DFF * DM_, DFF, DM_, (bf16*)(wb + WO_2), r, scr, F.lane);
}
__device__ __forceinline__ void p0_dynamic(Frame& F, const Args& A, const int l, unsigned* cnt, const int lo_, const int hi) {
    LAS float* scr = (LAS float*)(F.lds + F.wave * 16384);
    volatile LAS unsigned* slot = (volatile LAS unsigned*)(F.lds + MISC_OFF) + 16;
    for (;;) {
        if (F.tid == 0) slot[0] = __hip_atomic_fetch_add(cnt, 64u, __ATOMIC_RELAXED, __HIP_MEMORY_SCOPE_AGENT);
        __syncthreads();
        const int base = lo_ + (int)slot[0];
        __syncthreads();
        if (base >= hi) break;
        for (int k = 0; k < 8; ++k) { const int it = base + F.wave * 8 + k; if (it < hi) p0_item(F, A, l, it, scr); }
    }
}
__device__ __forceinline__ void p0_phase(Frame& F, const Args& A, const int l, const bool gemv, const int ilo, const int ihi) {
    LAS float* scr = (LAS float*)(F.lds + F.wave * 16384);
    const int gw = F.bid * 8 + F.wave, NGW = F.G * 8;
    for (int it = ilo + gw; it < ilo + (ihi - ilo) * REP_P0; it += NGW) p0_item(F, A, l, ilo + (it - ilo) % (ihi - ilo), scr);
    __syncthreads();
    if (!gemv) return;
    LAS float* red = (LAS float*)F.lds;
    const float* cl = A.in[1]; const float* cc = A.in[3];
    for (int it = F.bid; it < 2 * 192; it += F.G) {
        const int lg = it / 192, jb = it % 192, kg = F.tid >> 4, jl = F.tid & 15;
        const float* wp = A.in[4] + ((size_t)lg * DM_ + kg * 64) * 12288 + jb * 64 + jl * 4;
        f32x4 al = {0.f, 0.f, 0.f, 0.f}, ac = {0.f, 0.f, 0.f, 0.f};
#pragma unroll 8
        for (int kk = 0; kk < 64; ++kk) {
            const f32x4 w = __builtin_nontemporal_load((const f32x4*)(wp + (size_t)kk * 12288));
            const float sl = siluf_(cl[kg * 64 + kk]), sc = siluf_(cc[kg * 64 + kk]);
            al += w * sl; ac += w * sc;
        }
        LAS float* rp = red + (kg * 16 + jl) * 8;
        rp[0] = al.x; rp[1] = al.y; rp[2] = al.z; rp[3] = al.w; rp[4] = ac.x; rp[5] = ac.y; rp[6] = ac.z; rp[7] = ac.w;
        __syncthreads();
        if (F.tid < 128) {
            const int j2 = F.tid & 15, comp = F.tid >> 4; float s = 0.f;
            for (int g = 0; g < 32; ++g) s += red[(g * 16 + j2) * 8 + comp];
            const int sidx = comp >> 2, col = jb * 64 + j2 * 4 + (comp & 3);
            ((float*)(F.ws + WS_MOD))[(size_t)(lg * 2 + sidx) * 12288 + col] = s + A.in[5][(size_t)lg * 12288 + col];
        }
        __syncthreads();
    }
}

template <int MODE> __device__ __forceinline__ void row_phase(Frame& F, const Args& A, int l) {
    const int gw = F.bid * 8 + F.wave, NGW = F.G * 8;
    float* X = (float*)(F.ws + WS_X); const bf16* Y2 = (const bf16*)(F.ws + WS_R2); bf16* H = (bf16*)(F.ws + WS_H);
    const float* MOD = (const float*)(F.ws + WS_MOD);
    for (int r = gw + ((MODE >= 1 && l == 1) ? CTXL : 0); r < MROWS; r += NGW) {
        const int s = r < CTXL ? 1 : 0;
        const float* mod = MOD + (size_t)(l * 2 + s) * 12288;
        f32x4 v[8];
        if (MODE == 0) {
            const float* src = s ? A.in[2] + (size_t)r * DM_ : A.in[0] + (size_t)(r - CTXL) * DM_;
#pragma unroll
            for (int j = 0; j < 8; ++j) v[j] = *(const f32x4*)(src + (F.lane + 64 * j) * 4);
        } else {
            const bf16* y = Y2 + (size_t)r * DM_; float ss = 0.f;
            const float* w = (MODE == 1 ? A.in[7] : A.in[9]) + (size_t)l * DM_;
            const float* gate = mod + (MODE == 1 ? 2 : 5) * DM_;
            f32x4 xv[8], wv[8], gv[8];
#pragma unroll
            for (int j = 0; j < 8; ++j) { const int c = (F.lane + 64 * j) * 4; { const v2u yy = *(const v2u*)(y + c); v[j] = (f32x4){bflo(yy.x), bfhi(yy.x), bflo(yy.y), bfhi(yy.y)}; } xv[j] = *(const f32x4*)(X + (size_t)r * DM_ + c); wv[j] = *(const f32x4*)(w + c); gv[j] = *(const f32x4*)(gate + c); }
#pragma unroll
            for (int j = 0; j < 8; ++j) ss += v[j].x * v[j].x + v[j].y * v[j].y + v[j].z * v[j].z + v[j].w * v[j].w;
            const float rs = __builtin_amdgcn_rsqf(wave_sum(ss) * (1.0f / DM_) + 1e-6f);
#pragma unroll
            for (int j = 0; j < 8; ++j) v[j] = xv[j] + gv[j] * (v[j] * rs * wv[j]);
        }
        if (MODE == 2 && l == 1) {
            if (!s) {
#pragma unroll
                for (int j = 0; j < 8; ++j) *(f32x4*)(F.out + (size_t)(r - CTXL) * DM_ + (F.lane + 64 * j) * 4) = v[j];
            }
            continue;
        }
        float ss = 0.f;
        const float* wn = (MODE == 0 ? A.in[6] : MODE == 1 ? A.in[8] + (size_t)l * DM_ : A.in[6] + (size_t)(l + 1) * DM_);
        const float* modn = (MODE == 2) ? MOD + (size_t)((l + 1) * 2 + s) * 12288 : mod;
        const float* sh = modn + (MODE == 1 ? 3 : 0) * DM_; const float* sc = sh + DM_;
#pragma unroll
        for (int j = 0; j < 8; ++j) { *(f32x4*)(X + (size_t)r * DM_ + (F.lane + 64 * j) * 4) = v[j]; ss += v[j].x * v[j].x + v[j].y * v[j].y + v[j].z * v[j].z + v[j].w * v[j].w; }
        const float rs2 = __builtin_amdgcn_rsqf(wave_sum(ss) * (1.0f / DM_) + 1e-6f);
#pragma unroll
        for (int j = 0; j < 8; ++j) { const int c = (F.lane + 64 * j) * 4;
            const f32x4 wv = *(const f32x4*)(wn + c), shv = *(const f32x4*)(sh + c), scv = *(const f32x4*)(sc + c);
            const f32x4 h = (v[j] * rs2 * wv) * (1.0f + scv) + shv;
            v2u o; o.x = pk2(h.x, h.y); o.y = pk2(h.z, h.w);
            *(v2u*)(H + (size_t)r * DM_ + c) = o; }
    }
}
__device__ __forceinline__ void prep_phase(Frame& F, const Args& A, int l) {
    const int gw = F.bid * 8 + F.wave, NGW = F.G * 8, lane = F.lane;
    const bf16* Z = (const bf16*)(F.ws + WS_Z); const float* ZG = (const float*)(F.ws + WS_ZG);
    bf16* AQ = (bf16*)(F.ws + WS_AQ); bf16* AK = (bf16*)(F.ws + WS_AK); bf16* AV = (bf16*)(F.ws + WS_AV);
    bf16* DQ = (bf16*)(F.ws + WS_DQ); bf16* DK = (bf16*)(F.ws + WS_DK); bf16* DV = (bf16*)(F.ws + WS_DV);
    float* DG = (float*)(F.ws + WS_DGB); float* DB = DG + 16 * MROWS;
    const float* conv_w = A.in[16] + (size_t)l * 5 * 3072;
    const float* a_log = A.in[17] + l * 16; const float* dt_bias = A.in[18] + l * 16;
    constexpr float C2 = 0.125f * 1.4426950408889634f;
    for (int g_ = gw; g_ < (MROWS / 4) * REP_ROWS; g_ += NGW) {
        const int r0 = (g_ % (MROWS / 4)) * 4;
        const bool lat = r0 >= CTXL; const int lo = lat ? CTXL : 0, hi = lat ? MROWS : CTXL;
        for (int it = 0; it < 6; ++it) {
            const int ch0 = it * 512 + lane * 8, p = it >> 1;
            v4u xr[8];
#pragma unroll
            for (int j = 0; j < 8; ++j) { const int rr = r0 + j - 2; xr[j] = (rr >= lo && rr < hi) ? *(const v4u*)(Z + (size_t)rr * ZP + C_EQ + ch0) : (v4u){0u, 0u, 0u, 0u}; }
            float acc[4][8];
#pragma unroll
            for (int j = 0; j < 4; ++j)
#pragma unroll
                for (int e = 0; e < 8; ++e) acc[j][e] = 0.f;
#pragma unroll
            for (int i = 0; i < 5; ++i) {
                const f32x4 c0 = *(const f32x4*)(conv_w + i * 3072 + ch0), c1 = *(const f32x4*)(conv_w + i * 3072 + ch0 + 4);
#pragma unroll
                for (int j = 0; j < 4; ++j) { const v4u x = xr[j + i];
                    acc[j][0] += bflo(x.x) * c0.x; acc[j][1] += bfhi(x.x) * c0.y; acc[j][2] += bflo(x.y) * c0.z; acc[j][3] += bfhi(x.y) * c0.w;
                    acc[j][4] += bflo(x.z) * c1.x; acc[j][5] += bfhi(x.z) * c1.y; acc[j][6] += bflo(x.w) * c1.z; acc[j][7] += bfhi(x.w) * c1.w; }
            }
            bf16* dstb = (p == 0 ? DQ : p == 1 ? DK : DV) + (ch0 & 1023);
#pragma unroll
            for (int j = 0; j < 4; ++j) {
                float sv[8]; float ss = 0.f;
#pragma unroll
                for (int e = 0; e < 8; ++e) { sv[e] = siluf_(acc[j][e]); ss += sv[e] * sv[e]; }
                if (p < 2) {
                    ss += __shfl_xor(ss, 1); ss += __shfl_xor(ss, 2); ss += __shfl_xor(ss, 4); ss += __shfl_xor(ss, 8);
                    const float sc = __builtin_amdgcn_rsqf(ss + 1e-6f) * (p == 0 ? 0.08838834764831845f : 1.0f);
#pragma unroll
                    for (int e = 0; e < 8; ++e) sv[e] *= sc;
                }
                v4u o; o.x = pk2(sv[0], sv[1]); o.y = pk2(sv[2], sv[3]); o.z = pk2(sv[4], sv[5]); o.w = pk2(sv[6], sv[7]);
                *(v4u*)(dstb + (size_t)(r0 + j) * 1024) = o;
            }
        }
        {
            const int r = r0 + (lane >> 4), gi = lane & 15;
            const float a = ZG[(size_t)r * 64 + 32 + gi], bt = ZG[(size_t)r * 64 + 48 + gi];
            const float xs = a + dt_bias[gi];
            const float sp = xs > 20.f ? xs : log1pf(expf(xs));
            DG[(size_t)gi * MROWS + r] = -expf(a_log[gi]) * sp;
            DB[(size_t)gi * MROWS + r] = 1.0f / (1.0f + expf(-bt));
        }
        for (int j = 0; j < 4; ++j) {
            const int r = r0 + j, t = r - CTXL; const bf16* zr = Z + (size_t)r * ZP;
            const v4u qv = *(const v4u*)(zr + C_DQ + lane * 8), kv = *(const v4u*)(zr + C_DK + lane * 8), vv = *(const v4u*)(zr + C_DV + lane * 8);
            *(v4u*)(AV + (size_t)r * 512 + lane * 8) = vv;
            float q[8], k[8];
            q[0] = bflo(qv.x); q[1] = bfhi(qv.x); q[2] = bflo(qv.y); q[3] = bfhi(qv.y); q[4] = bflo(qv.z); q[5] = bfhi(qv.z); q[6] = bflo(qv.w); q[7] = bfhi(qv.w);
            k[0] = bflo(kv.x); k[1] = bfhi(kv.x); k[2] = bflo(kv.y); k[3] = bfhi(kv.y); k[4] = bflo(kv.z); k[5] = bfhi(kv.z); k[6] = bflo(kv.w); k[7] = bfhi(kv.w);
            if (lat) {
                const int sub = lane & 3, part = (lane >> 2) & 1; const float pos = (float)(part ? (t & 63) : (t >> 6));
                const float sgn = (sub & 2) ? 1.0f : -1.0f;
#pragma unroll
                for (int e = 0; e < 8; ++e) {
                    const float qp = __shfl_xor(q[e], 2), kp = __shfl_xor(k[e], 2);
                    const int i = (sub & 1) * 8 + e;
                    const float inv = __builtin_amdgcn_exp2f(-(float)i * 0.8304820237218406f);
                    const float rev = (pos * inv) * 0.15915494309189535f;
                    const float cs = __builtin_amdgcn_cosf(rev), sn = __builtin_amdgcn_sinf(rev);
                    q[e] = q[e] * cs + sgn * qp * sn; k[e] = k[e] * cs + sgn * kp * sn;
                }
            }
            v4u qo, ko;
            qo.x = pk2(q[0] * C2, q[1] * C2); qo.y = pk2(q[2] * C2, q[3] * C2); qo.z = pk2(q[4] * C2, q[5] * C2); qo.w = pk2(q[6] * C2, q[7] * C2);
            ko.x = pk2(k[0], k[1]); ko.y = pk2(k[2], k[3]); ko.z = pk2(k[4], k[5]); ko.w = pk2(k[6], k[7]);
            *(v4u*)(AQ + (size_t)r * 512 + lane * 8) = qo; *(v4u*)(AK + (size_t)r * 512 + lane * 8) = ko;
        }
    }
}

__device__ __forceinline__ int scan_row(int dir, int n, int i) {
    if (dir == 0) return 64 * n + i;
    return (n < 4 ? 64 * (3 - n) : CTXL + 64 * (127 - (n - 4))) + 63 - i;
}

__device__ __forceinline__ void gla_chain_naive(Frame& F, const Args& A, int l, int chain) {
    const int dir = chain >> 2, h = chain & 3, tid = F.tid, lane = F.lane;
    const bf16* Z = (const bf16*)(F.ws + WS_Z); const float* ZG = (const float*)(F.ws + WS_ZG);
    float* OA = (float*)(F.ws + WS_YB) + (size_t)dir * MROWS * 512;
    const float* w2 = A.in[11] + ((size_t)(l * 2 + dir) * 16) * 512 + h * 128; const float* gb = A.in[12] + (size_t)(l * 2 + dir) * 512 + h * 128;
    LAS bf16* qs = (LAS bf16*)F.lds; LAS bf16* ks = qs + 64 * 128; LAS bf16* vs = ks + 64 * 128; LAS float* eg = (LAS float*)(F.lds + 49152);
    float S[64];
#pragma unroll
    for (int d = 0; d < 64; ++d) S[d] = 0.f;
    const int col = (tid >> 6) * 32 + (lane & 31), half = lane >> 5;
    for (int n = 0; n < 132; ++n) {
        for (int p = tid; p < 1024; p += 512) { const int i = p >> 4, c8 = (p & 15) * 8; const bf16* zr = Z + (size_t)scan_row(dir, n, i) * ZP + h * 128 + c8;
            *(LAS v4u*)(qs + i * 128 + c8) = *(const v4u*)(zr + C_GQ); *(LAS v4u*)(ks + i * 128 + c8) = *(const v4u*)(zr + C_GK); *(LAS v4u*)(vs + i * 128 + c8) = *(const v4u*)(zr + C_GV); }
        {   const int i = tid >> 3, dg = (tid & 7) * 16; const float* lr = ZG + (size_t)scan_row(dir, n, i) * 64 + dir * 16;
            float x[16];
#pragma unroll
            for (int jj = 0; jj < 16; ++jj) x[jj] = gb[dg + jj];
            for (int j = 0; j < 16; ++j) { const float lv = lr[j];
#pragma unroll
                for (int jj = 0; jj < 16; ++jj) x[jj] += lv * w2[j * 512 + dg + jj]; }
#pragma unroll
            for (int jj = 0; jj < 16; ++jj) { const float ls = fminf(x[jj], 0.f) - log1pf(expf(-fabsf(x[jj]))); eg[i * 128 + dg + jj] = expf(ls * 0.0625f); }
        }
        __syncthreads();
        if (tid < 256) {
            for (int i = 0; i < 64; ++i) {
                const float vv = bf2f(vs[i * 128 + col]); float o = 0.f;
#pragma unroll
                for (int d4 = 0; d4 < 16; ++d4) {
                    const f32x4 e4 = *(const LAS f32x4*)(eg + i * 128 + half * 64 + d4 * 4);
                    const v2u k2 = *(const LAS v2u*)(ks + i * 128 + half * 64 + d4 * 4), q2 = *(const LAS v2u*)(qs + i * 128 + half * 64 + d4 * 4);
                    S[d4 * 4 + 0] = S[d4 * 4 + 0] * e4.x + bflo(k2.x) * vv; o += S[d4 * 4 + 0] * bflo(q2.x);
                    S[d4 * 4 + 1] = S[d4 * 4 + 1] * e4.y + bfhi(k2.x) * vv; o += S[d4 * 4 + 1] * bfhi(q2.x);
                    S[d4 * 4 + 2] = S[d4 * 4 + 2] * e4.z + bflo(k2.y) * vv; o += S[d4 * 4 + 2] * bflo(q2.y);
                    S[d4 * 4 + 3] = S[d4 * 4 + 3] * e4.w + bfhi(k2.y) * vv; o += S[d4 * 4 + 3] * bfhi(q2.y);
                }
                o += __shfl_xor(o, 32);
                if (half == 0) OA[(size_t)scan_row(dir, n, i) * 512 + h * 128 + col] = o * 0.08838834764831845f;
            }
        }
        __syncthreads();
    }
}
__device__ __forceinline__ void delta_chain_naive(Frame& F, const Args& A, int chain) {
    const int dir = chain >> 3, h = chain & 7, tid = F.tid, lane = F.lane;
    const bf16* DQ = (const bf16*)(F.ws + WS_DQ); const bf16* DK = (const bf16*)(F.ws + WS_DK); const bf16* DV = (const bf16*)(F.ws + WS_DV);
    const float* DG = (const float*)(F.ws + WS_DGB) + (size_t)chain * MROWS; const float* DB = (const float*)(F.ws + WS_DGB) + (size_t)(16 + chain) * MROWS;
    float* OE = (float*)(F.ws + WS_R2) + (size_t)dir * MROWS * 1024;
    LAS bf16* qs = (LAS bf16*)F.lds; LAS bf16* ks = qs + 64 * 128; LAS bf16* vs = ks + 64 * 128; LAS float* gs = (LAS float*)(F.lds + 49152);
    float S[64];
#pragma unroll
    for (int d = 0; d < 64; ++d) S[d] = 0.f;
    const int col = (tid >> 6) * 32 + (lane & 31), half = lane >> 5;
    for (int n = 0; n < 132; ++n) {
        for (int p = tid; p < 1024; p += 512) { const int i = p >> 4, c8 = (p & 15) * 8; const size_t off = (size_t)scan_row(dir, n, i) * 1024 + h * 128 + c8;
            *(LAS v4u*)(qs + i * 128 + c8) = *(const v4u*)(DQ + off); *(LAS v4u*)(ks + i * 128 + c8) = *(const v4u*)(DK + off); *(LAS v4u*)(vs + i * 128 + c8) = *(const v4u*)(DV + off); }
        if (tid < 64) { const int r = scan_row(dir, n, tid); gs[tid] = expf(DG[r]); gs[64 + tid] = DB[r]; }
        __syncthreads();
        if (tid < 256) {
            for (int i = 0; i < 64; ++i) {
                const float vv = bf2f(vs[i * 128 + col]), egv = gs[i], beta = gs[64 + i];
                float kf[64]; float kS = 0.f;
#pragma unroll
                for (int d4 = 0; d4 < 16; ++d4) { const v2u k2 = *(const LAS v2u*)(ks + i * 128 + half * 64 + d4 * 4);
                    kf[d4 * 4 + 0] = bflo(k2.x); kf[d4 * 4 + 1] = bfhi(k2.x); kf[d4 * 4 + 2] = bflo(k2.y); kf[d4 * 4 + 3] = bfhi(k2.y);
                    kS += kf[d4 * 4 + 0] * S[d4 * 4 + 0] + kf[d4 * 4 + 1] * S[d4 * 4 + 1] + kf[d4 * 4 + 2] * S[d4 * 4 + 2] + kf[d4 * 4 + 3] * S[d4 * 4 + 3]; }
                kS += __shfl_xor(kS, 32);
                const float u = beta * (vv - egv * kS); float o = 0.f;
#pragma unroll
                for (int d4 = 0; d4 < 16; ++d4) { const v2u q2 = *(const LAS v2u*)(qs + i * 128 + half * 64 + d4 * 4);
                    S[d4 * 4 + 0] = S[d4 * 4 + 0] * egv + kf[d4 * 4 + 0] * u; o += S[d4 * 4 + 0] * bflo(q2.x);
                    S[d4 * 4 + 1] = S[d4 * 4 + 1] * egv + kf[d4 * 4 + 1] * u; o += S[d4 * 4 + 1] * bfhi(q2.x);
                    S[d4 * 4 + 2] = S[d4 * 4 + 2] * egv + kf[d4 * 4 + 2] * u; o += S[d4 * 4 + 2] * bflo(q2.y);
                    S[d4 * 4 + 3] = S[d4 * 4 + 3] * egv + kf[d4 * 4 + 3] * u; o += S[d4 * 4 + 3] * bfhi(q2.y); }
                o += __shfl_xor(o, 32);
                if (half == 0) OE[(size_t)scan_row(dir, n, i) * 1024 + h * 128 + col] = o;
            }
        }
        __syncthreads();
    }
}

__device__ __forceinline__ void out_phase(Frame& F, const Args& A, int l) {
    const int gw = F.bid * 8 + F.wave, NGW = F.G * 8, lane = F.lane;
    const bf16* Z = (const bf16*)(F.ws + WS_Z); const bf16* AO = (const bf16*)(F.ws + WS_AO);
    const float* OA = (const float*)(F.ws + WS_YB); const float* OE = (const float*)(F.ws + WS_R2);
    bf16* A_ = (bf16*)(F.ws + WS_A); bf16* D_ = (bf16*)(F.ws + WS_D); bf16* E_ = (bf16*)(F.ws + WS_E);
    const float lam_init = l == 0 ? 0.2f : 0.35550906759096924f;
    const float* lp = A.in[14] + l * 256;
    const float lam = expf(wave_sum(lp[lane] * lp[64 + lane])) - expf(wave_sum(lp[128 + lane] * lp[192 + lane])) + lam_init;
    const float* gnw = A.in[13] + l * 128 + lane * 2; const float* dnw = A.in[15] + l * 128 + lane * 2; const float* enw = A.in[19] + l * 128 + lane * 2;
    const float gw0 = gnw[0], gw1 = gnw[1], dw0 = dnw[0], dw1 = dnw[1], ew0 = enw[0], ew1 = enw[1];
    for (int r = gw; r < MROWS; r += NGW) {
        const bf16* zr = Z + (size_t)r * ZP;
        for (int h = 0; h < 4; ++h) {
            const int c = h * 128 + lane * 2;
            {   const float* o0 = OA + (size_t)r * 512 + c; const float* o1 = o0 + (size_t)MROWS * 512;
                const float x0 = o0[0] + o1[0], x1 = o0[1] + o1[1];
                const float rs = __builtin_amdgcn_rsqf(wave_sum(x0 * x0 + x1 * x1) * (1.0f / 128.f) + 1e-6f);
                const unsigned g = *(const unsigned*)(zr + C_GG + c);
                *(unsigned*)(A_ + (size_t)r * 512 + c) = pk2(x0 * rs * gw0 * siluf_(bflo(g)), x1 * rs * gw1 * siluf_(bfhi(g))); }
            {   const unsigned w1 = *(const unsigned*)(AO + (size_t)r * 1024 + (h * 2) * 128 + lane * 2), w2 = *(const unsigned*)(AO + (size_t)r * 1024 + (h * 2 + 1) * 128 + lane * 2);
                const float x0 = bflo(w1) - lam * bflo(w2), x1 = bfhi(w1) - lam * bfhi(w2);
                const float rs = __builtin_amdgcn_rsqf(wave_sum(x0 * x0 + x1 * x1) * (1.0f / 128.f) + 1e-6f) * (1.0f - lam_init);
                *(unsigned*)(D_ + (size_t)r * 512 + c) = pk2(x0 * rs * dw0, x1 * rs * dw1); }
        }
        for (int h = 0; h < 8; ++h) {
            const int c = h * 128 + lane * 2;
            const float* o0 = OE + (size_t)r * 1024 + c; const float* o1 = o0 + (size_t)MROWS * 1024;
            const float x0 = o0[0] + o1[0], x1 = o0[1] + o1[1];
            const float rs = __builtin_amdgcn_rsqf(wave_sum(x0 * x0 + x1 * x1) * (1.0f / 128.f) + 1e-6f);
            const unsigned g = *(const unsigned*)(zr + C_EG + c);
            *(unsigned*)(E_ + (size_t)r * 1024 + c) = pk2(x0 * rs * ew0 * siluf_(bflo(g)), x1 * rs * ew1 * siluf_(bfhi(g)));
        }
    }
}
typedef short bf16x8_t __attribute__((ext_vector_type(8)));
#define LBAR() do { asm volatile("s_waitcnt lgkmcnt(0)" ::: "memory"); __builtin_amdgcn_s_barrier(); asm volatile("" ::: "memory"); } while (0)
constexpr int P128 = 136, P64 = 72;
template <int K> __device__ __forceinline__ f32x4 mma16(const LAS bf16* A, int lda, const LAS bf16* Bt, int ldb, f32x4 acc, int lane) {
    const int r = lane & 15, q = lane >> 4;
    const LAS bf16* ap = A + r * lda + q * 8; const LAS bf16* bp = Bt + r * ldb + q * 8;
#pragma unroll
    for (int k0 = 0; k0 < K; k0 += 32) {
        const bf16x8_t a = *(const LAS bf16x8_t*)(ap + k0), b = *(const LAS bf16x8_t*)(bp + k0);
        acc = __builtin_amdgcn_mfma_f32_16x16x32_bf16(a, b, acc, 0, 0, 0);
    }
    return acc;
}
__device__ __forceinline__ int chunk_scan_index(int dir, int c) { return dir == 0 ? c : (c < 4 ? 3 - c : 135 - c); }
__device__ __forceinline__ float wave_incl_scan(float x, int lane) {
#pragma unroll
    for (int o = 1; o < 64; o <<= 1) { const float t = __shfl_up(x, o); if (lane >= o) x += t; }
    return x;
}
constexpr size_t WS_DS = WS_W0 + W_LAYER;
constexpr size_t WS_PP = WS_DS, WS_NT = WS_DS + 66 * MiB, WS_GL = WS_DS + 132 * MiB, WS_GD = WS_GL + 1 * MiB;
constexpr size_t WS_UG = WS_H, WS_WG = WS_END, WS_GS = WS_R2, WS_BS = WS_YB;
constexpr size_t WS_END2 = WS_END + 33 * MiB;

__device__ __forceinline__ void delta_prep2_item(Frame& F, int chain, int n) {
    const int dir = chain >> 3, h = chain & 7, tid = F.tid, lane = F.lane, w = F.wave;
    const bf16* DK = (const bf16*)(F.ws + WS_DK); const bf16* DV = (const bf16*)(F.ws + WS_DV);
    const float* DG = (const float*)(F.ws + WS_DGB) + (size_t)chain * MROWS; const float* DB = (const float*)(F.ws + WS_DGB) + (size_t)(16 + chain) * MROWS;
    const size_t item = (size_t)chain * 132 + n;
    bf16* Pp = (bf16*)(F.ws + WS_PP) + item * 16384; bf16* NT = (bf16*)(F.ws + WS_NT) + item * 16384;
    bf16* Ug = (bf16*)(F.ws + WS_UG) + item * 8192; bf16* Wg = (bf16*)(F.ws + WS_WG) + item * 8192;
    LAS bf16* Ks = (LAS bf16*)(F.lds);
    LAS float* AM = (LAS float*)(F.lds + 18432);
    LAS bf16* UT = (LAS bf16*)(F.lds);
    LAS bf16* KbT = (LAS bf16*)(F.lds + 35840);
    LAS bf16* KdT = (LAS bf16*)(F.lds + 54272);
    LAS bf16* VbT = (LAS bf16*)(F.lds + 72704);
    LAS bf16* TB = (LAS bf16*)(F.lds + 91136);
    LAS bf16* WT = (LAS bf16*)(F.lds + 100352);
    LAS float* gcs = (LAS float*)(F.lds + 118784); LAS float* bts = gcs + 64;
    const int ip = tid & 31, c8 = (tid >> 5) * 8, i0 = 2 * ip, i1 = i0 + 1;
    const size_t off0 = (size_t)scan_row(dir, n, i0) * 1024 + h * 128 + c8, off1 = (size_t)scan_row(dir, n, i1) * 1024 + h * 128 + c8;
    const v4u kv0 = *(const v4u*)(DK + off0), kv1 = *(const v4u*)(DK + off1), vv0 = *(const v4u*)(DV + off0), vv1 = *(const v4u*)(DV + off1);
    if (w == 0) { const int r = scan_row(dir, n, lane); gcs[lane] = wave_incl_scan(DG[r], lane); bts[lane] = DB[r]; }
    LBAR();
    const float gclast = gcs[63];
    {
        *(LAS v4u*)(Ks + i0 * P128 + c8) = kv0; *(LAS v4u*)(Ks + i1 * P128 + c8) = kv1;
        const float bt0 = bts[i0], bt1 = bts[i1], fb0 = bt0 * __expf(gcs[i0]), fb1 = bt1 * __expf(gcs[i1]), fd0 = __expf(gclast - gcs[i0]), fd1 = __expf(gclast - gcs[i1]);
        const unsigned k0w[4] = {kv0.x, kv0.y, kv0.z, kv0.w}, k1w[4] = {kv1.x, kv1.y, kv1.z, kv1.w}, v0w[4] = {vv0.x, vv0.y, vv0.z, vv0.w}, v1w[4] = {vv1.x, vv1.y, vv1.z, vv1.w};
#pragma unroll
        for (int e = 0; e < 4; ++e) {
            const float ka0 = bflo(k0w[e]), kb0 = bfhi(k0w[e]), ka1 = bflo(k1w[e]), kb1 = bfhi(k1w[e]);
            const float va0 = bflo(v0w[e]), vb0 = bfhi(v0w[e]), va1 = bflo(v1w[e]), vb1 = bfhi(v1w[e]);
            const int ca = (c8 + 2 * e) * P64 + i0, cb = (c8 + 2 * e + 1) * P64 + i0;
            *(LAS unsigned*)(KbT + ca) = pk2(ka0 * fb0, ka1 * fb1); *(LAS unsigned*)(KbT + cb) = pk2(kb0 * fb0, kb1 * fb1);
            *(LAS unsigned*)(KdT + ca) = pk2(ka0 * fd0, ka1 * fd1); *(LAS unsigned*)(KdT + cb) = pk2(kb0 * fd0, kb1 * fd1);
            *(LAS unsigned*)(VbT + ca) = pk2(va0 * bt0, va1 * bt1); *(LAS unsigned*)(VbT + cb) = pk2(vb0 * bt0, vb1 * bt1);
        }
    }
    LBAR();
    const int r = lane & 15, q = lane >> 4;
#pragma unroll
    for (int t2 = 0; t2 < 2; ++t2) {
        const int t = w * 2 + t2, mi = t >> 2, nj = t & 3;
        const f32x4 acc = mma16<128>(Ks + 16 * mi * P128, P128, Ks + 16 * nj * P128, P128, (f32x4){0.f, 0.f, 0.f, 0.f}, lane);
        const int j = 16 * nj + r; const float gj = gcs[j];
#pragma unroll
        for (int jj = 0; jj < 4; ++jj) { const int i = 16 * mi + 4 * q + jj;
            AM[i * 68 + j] = (j < i) ? bts[i] * acc[jj] * __expf(gcs[i] - gj) : 0.f; }
    }
    LBAR();
    {
        LAS float* TM = (LAS float*)(F.lds + 119296);
        LAS float* XM = (LAS float*)(F.lds + 136704);
        if (w == 0) {
            const int b16 = 16 * (lane >> 4), c = lane & 15;
            float t[16];
#pragma unroll
            for (int i = 0; i < 16; ++i) {
                float s_ = (i == c) ? 1.f : 0.f;
#pragma unroll
                for (int j4 = 0; j4 < (i + 3) / 4; ++j4) {
                    const f32x4 a = *(const LAS f32x4*)(AM + (b16 + i) * 68 + b16 + j4 * 4);
                    if (j4 * 4 + 0 < i) s_ -= a.x * t[j4 * 4 + 0];
                    if (j4 * 4 + 1 < i) s_ -= a.y * t[j4 * 4 + 1];
                    if (j4 * 4 + 2 < i) s_ -= a.z * t[j4 * 4 + 2];
                    if (j4 * 4 + 3 < i) s_ -= a.w * t[j4 * 4 + 3];
                }
                t[i] = s_;
                TM[(b16 + i) * 68 + b16 + c] = s_;
            }
        }
        LBAR();
        const int rr = (tid >> 4) & 15, cc = tid & 15;
#pragma unroll
        for (int d = 1; d < 4; ++d) {
            for (int blk = tid >> 8; blk < 4 - d; blk += 2) {
                const int bj = blk, bi = blk + d; float x = 0.f;
                for (int k = bj; k < bi; ++k)
#pragma unroll
                    for (int m = 0; m < 16; ++m) x += AM[(16 * bi + rr) * 68 + 16 * k + m] * TM[(16 * k + m) * 68 + 16 * bj + cc];
                XM[(blk * 16 + rr) * 17 + cc] = x;
            }
            LBAR();
            for (int blk = tid >> 8; blk < 4 - d; blk += 2) {
                const int bj = blk, bi = blk + d; float x = 0.f;
#pragma unroll
                for (int m = 0; m < 16; ++m) x -= TM[(16 * bi + rr) * 68 + 16 * bi + m] * XM[(blk * 16 + m) * 17 + cc];
                TM[(16 * bi + rr) * 68 + 16 * bj + cc] = x;
            }
            LBAR();
        }
        {   const int i = tid >> 3, j0 = (tid & 7) * 8; float v[8];
#pragma unroll
            for (int e = 0; e < 8; ++e) v[e] = ((j0 + e) >> 4) > (i >> 4) ? 0.f : TM[i * 68 + j0 + e];
            v4u o; o.x = pk2(v[0], v[1]); o.y = pk2(v[2], v[3]); o.z = pk2(v[4], v[5]); o.w = pk2(v[6], v[7]);
            *(LAS v4u*)(TB + i * P64 + j0) = o; }
    }
    LBAR();
#pragma unroll
    for (int t4 = 0; t4 < 4; ++t4) {
        const int t = w * 4 + t4, mi = t >> 3, nv = t & 7;
        const f32x4 u = mma16<64>(TB + 16 * mi * P64, P64, VbT + 16 * nv * P64, P64, (f32x4){0.f, 0.f, 0.f, 0.f}, lane);
        const f32x4 ww = mma16<64>(TB + 16 * mi * P64, P64, KbT + 16 * nv * P64, P64, (f32x4){0.f, 0.f, 0.f, 0.f}, lane);
        const int c = 16 * nv + r, i0 = 16 * mi + 4 * q;
        v2u up; up.x = pk2(u[0], u[1]); up.y = pk2(u[2], u[3]);
        v2u wp; wp.x = pk2(ww[0], ww[1]); wp.y = pk2(ww[2], ww[3]);
        *(LAS v2u*)(UT + c * P64 + i0) = up; *(LAS v2u*)(WT + c * P64 + i0) = wp;
        *(v2u*)(Ug + c * 64 + i0) = up;
#pragma unroll
        for (int jj = 0; jj < 4; ++jj) Wg[(i0 + jj) * 128 + c] = (bf16)f2bf(ww[jj]);
    }
    LBAR();
#pragma unroll
    for (int t8 = 0; t8 < 8; ++t8) {
        const int mb = w, na = t8;
        const f32x4 pt = mma16<64>(WT + 16 * mb * P64, P64, KdT + 16 * na * P64, P64, (f32x4){0.f, 0.f, 0.f, 0.f}, lane);
        v2u pp; pp.x = pk2(-pt[0], -pt[1]); pp.y = pk2(-pt[2], -pt[3]);
        *(v2u*)(Pp + ((size_t)((na * 4 + (mb >> 1)) * 64 + lane)) * 8 + 4 * (mb & 1)) = pp;
        const int ma = w, nv = t8;
        const f32x4 nn = mma16<64>(KdT + 16 * ma * P64, P64, UT + 16 * nv * P64, P64, (f32x4){0.f, 0.f, 0.f, 0.f}, lane);
        v2u np; np.x = pk2(nn[0], nn[1]); np.y = pk2(nn[2], nn[3]);
        *(v2u*)(NT + (size_t)(16 * nv + r) * 128 + 16 * ma + 4 * q) = np;
    }
    if (tid == 0) ((float*)(F.ws + WS_GL))[item] = __expf(gclast);
    LBAR();
}

constexpr int CH_SLOT = 32768 + 128 * P128 * 2;
#define CH_BAR() do { asm volatile("s_waitcnt lgkmcnt(0)" ::: "memory"); __builtin_amdgcn_s_barrier(); asm volatile("" ::: "memory"); } while (0)
__device__ __forceinline__ void delta_chain(Frame& F, int chain) {
    const int tid = F.tid, lane = F.lane, w = F.wave, r = lane & 15, q = lane >> 4;
    const bf16* Pp = (const bf16*)(F.ws + WS_PP) + (size_t)chain * 132 * 16384; bf16* NT = (bf16*)(F.ws + WS_NT) + (size_t)chain * 132 * 16384;
    LAS unsigned char* ring = F.lds; LAS float* gls = (LAS float*)(F.lds + 2 * CH_SLOT);
    if (tid < 132) gls[tid] = ((const float*)(F.ws + WS_GL))[chain * 132 + tid];
    if (w >= 4) {
        const int lt = tid - 256;
        unsigned ndst[8];
#pragma unroll
        for (int k = 0; k < 8; ++k) { const int p = lt + 256 * k; ndst[k] = 32768u + (unsigned)((p >> 4) * P128 + (p & 15) * 8) * 2u; }
        v4u rp[3][8], rn[3][8];
#define CH_LOAD(set, step) do { const v4u* ps_ = (const v4u*)(Pp + (size_t)(step) * 16384) + lt; const v4u* ns_ = (const v4u*)(NT + (size_t)(step) * 16384) + lt; \
        _Pragma("unroll") for (int k = 0; k < 8; ++k) { rp[set][k] = ps_[256 * k]; rn[set][k] = ns_[256 * k]; } } while (0)
#define CH_WRITE(set, slot) do { LAS unsigned char* sb_ = ring + (slot) * CH_SLOT; \
        _Pragma("unroll") for (int k = 0; k < 8; ++k) { *(LAS v4u*)(sb_ + (lt + 256 * k) * 16) = rp[set][k]; *(LAS v4u*)(sb_ + ndst[k]) = rn[set][k]; } } while (0)
        CH_LOAD(0, 0); CH_LOAD(1, 1); CH_LOAD(2, 2);
        CH_WRITE(0, 0);
        CH_BAR();
        for (int n = 0; n < 132; n += 3) {
            if (n + 3 < 132) CH_LOAD(0, n + 3);
            CH_WRITE(1, (n + 1) & 1);
            CH_BAR();
            if (n + 4 < 132) CH_LOAD(1, n + 4);
            CH_WRITE(2, (n + 2) & 1);
            CH_BAR();
            if (n + 5 < 132) CH_LOAD(2, n + 5);
            if (n + 3 < 132) CH_WRITE(0, (n + 3) & 1);
            CH_BAR();
        }
#undef CH_LOAD
#undef CH_WRITE
    } else {
        f32x4 acc[2][8];
#pragma unroll
        for (int nb = 0; nb < 2; ++nb)
#pragma unroll
            for (int m = 0; m < 8; ++m) acc[nb][m] = (f32x4){0.f, 0.f, 0.f, 0.f};
        bf16* srow = NT + (size_t)(32 * w + r) * 128 + 4 * q;
        const unsigned noff = 32768u + (unsigned)((32 * w + r) * P128 + 4 * q) * 2u;
        CH_BAR();
        for (int n = 0; n < 132; ++n) {
            const LAS unsigned char* slot = ring + (n & 1) * CH_SLOT;
            const float gl = gls[n];
            v2u sp[2][8];
#pragma unroll
            for (int nb = 0; nb < 2; ++nb)
#pragma unroll
                for (int m = 0; m < 8; ++m) {
                    sp[nb][m].x = pk2(acc[nb][m][0], acc[nb][m][1]); sp[nb][m].y = pk2(acc[nb][m][2], acc[nb][m][3]);
                    *(v2u*)(srow + (size_t)n * 16384 + nb * 2048 + 16 * m) = sp[nb][m];
                    const v2u nv = *(const LAS v2u*)(slot + noff + nb * (16 * P128 * 2) + m * 32);
                    acc[nb][m][0] = gl * acc[nb][m][0] + bflo(nv.x); acc[nb][m][1] = gl * acc[nb][m][1] + bfhi(nv.x);
                    acc[nb][m][2] = gl * acc[nb][m][2] + bflo(nv.y); acc[nb][m][3] = gl * acc[nb][m][3] + bfhi(nv.y);
                }
#pragma unroll
            for (int kb = 0; kb < 4; ++kb) {
                const v4u bu0 = {sp[0][2 * kb].x, sp[0][2 * kb].y, sp[0][2 * kb + 1].x, sp[0][2 * kb + 1].y};
                const v4u bu1 = {sp[1][2 * kb].x, sp[1][2 * kb].y, sp[1][2 * kb + 1].x, sp[1][2 * kb + 1].y};
                const bf16x8_t b0 = __builtin_bit_cast(bf16x8_t, bu0), b1 = __builtin_bit_cast(bf16x8_t, bu1);
#pragma unroll
                for (int m = 0; m < 8; ++m) {
                    const bf16x8_t a = *(const LAS bf16x8_t*)(slot + (m * 4 + kb) * 1024 + lane * 16);
                    acc[0][m] = __builtin_amdgcn_mfma_f32_16x16x32_bf16(a, b0, acc[0][m], 0, 0, 0);
                    acc[1][m] = __builtin_amdgcn_mfma_f32_16x16x32_bf16(a, b1, acc[1][m], 0, 0, 0);
                }
            }
            CH_BAR();
        }
    }
    asm volatile("s_waitcnt vmcnt(0)" ::: "memory");
    __syncthreads();
}

__device__ __forceinline__ void delta_out_item(Frame& F, const Args& A, int l, int c, int h) {
    const int tid = F.tid, lane = F.lane, w = F.wave, r = lane & 15, q = lane >> 4;
    const bf16* DQ = (const bf16*)(F.ws + WS_DQ); const bf16* DK = (const bf16*)(F.ws + WS_DK);
    const int row0 = 64 * c;
    LAS bf16* Qs = (LAS bf16*)(F.lds);
    LAS bf16* Ks = (LAS bf16*)(F.lds + 17408);
    LAS bf16* ST = (LAS bf16*)(F.lds + 35840);
    LAS bf16* Ws = (LAS bf16*)(F.lds + 70656);
    LAS bf16* ATT = (LAS bf16*)(F.lds + 88064);
    LAS float* gcs = (LAS float*)(F.lds + 97280);
    LAS bf16* VNT = (LAS bf16*)(F.lds + 97792);
    LAS float* OS = (LAS float*)(F.lds);
    const int mi = w >> 1, nvb = 4 * (w & 1);
    f32x4 oacc[4];
#pragma unroll
    for (int k = 0; k < 4; ++k) oacc[k] = (f32x4){0.f, 0.f, 0.f, 0.f};
    for (int dir = 0; dir < 2; ++dir) {
        const int chain = dir * 8 + h, n = chunk_scan_index(dir, c);
        const size_t item = (size_t)chain * 132 + n;
        const bf16* Sg = (const bf16*)(F.ws + WS_NT) + item * 16384; const bf16* Ug = (const bf16*)(F.ws + WS_UG) + item * 8192; const bf16* Wg = (const bf16*)(F.ws + WS_WG) + item * 8192;
        const float g_in = (w == 0) ? ((const float*)(F.ws + WS_DGB))[(size_t)chain * MROWS + row0 + (dir ? 63 - lane : lane)] : 0.f;
        v2u uu[4];
#pragma unroll
        for (int k = 0; k < 4; ++k) uu[k] = *(const v2u*)(Ug + (16 * (nvb + k) + r) * 64 + (dir ? 60 - (16 * mi + 4 * q) : (16 * mi + 4 * q)));
        {   v4u rq[2], rk[2], rw[2], rs[4];
#pragma unroll
            for (int i2 = 0; i2 < 2; ++i2) { const int p = tid + 512 * i2, t = p >> 4, c8 = (p & 15) * 8; const size_t off = (size_t)(row0 + t) * 1024 + h * 128 + c8;
                if (dir == 0) { rq[i2] = *(const v4u*)(DQ + off); rk[i2] = *(const v4u*)(DK + off); }
                rw[i2] = *(const v4u*)(Wg + (size_t)(dir ? 63 - t : t) * 128 + c8); }
#pragma unroll
            for (int i4 = 0; i4 < 4; ++i4) { const int p = tid + 512 * i4; rs[i4] = *(const v4u*)(Sg + (p >> 4) * 128 + (p & 15) * 8); }
#pragma unroll
            for (int i2 = 0; i2 < 2; ++i2) { const int p = tid + 512 * i2, t = p >> 4, c8 = (p & 15) * 8;
                if (dir == 0) { *(LAS v4u*)(Qs + t * P128 + c8) = rq[i2]; *(LAS v4u*)(Ks + t * P128 + c8) = rk[i2]; }
                *(LAS v4u*)(Ws + t * P128 + c8) = rw[i2]; }
#pragma unroll
            for (int i4 = 0; i4 < 4; ++i4) { const int p = tid + 512 * i4; *(LAS v4u*)(ST + (p >> 4) * P128 + (p & 15) * 8) = rs[i4]; }
        }
        if (w == 0) { const float s_ = wave_incl_scan(g_in, lane); gcs[dir ? 63 - lane : lane] = s_; }
        LBAR();
#pragma unroll
        for (int t2 = 0; t2 < 2; ++t2) {
            const int t = w * 2 + t2, ai = t >> 2, nj = t & 3;
            const f32x4 acc = mma16<128>(Qs + 16 * ai * P128, P128, Ks + 16 * nj * P128, P128, (f32x4){0.f, 0.f, 0.f, 0.f}, lane);
            const int tj = 16 * nj + r; const float gj = gcs[tj];
#pragma unroll
            for (int jj = 0; jj < 4; ++jj) { const int ti = 16 * ai + 4 * q + jj; const bool ok = dir ? (tj >= ti) : (tj <= ti);
                ATT[ti * P64 + tj] = (bf16)f2bf(ok ? acc[jj] * __expf(gcs[ti] - gj) : 0.f); }
        }
#pragma unroll
        for (int k = 0; k < 4; ++k) {
            const int nv = nvb + k;
            const f32x4 ws = mma16<128>(Ws + 16 * mi * P128, P128, ST + 16 * nv * P128, P128, (f32x4){0.f, 0.f, 0.f, 0.f}, lane);
            const int v = 16 * nv + r, t0 = 16 * mi + 4 * q;
            float u[4];
            if (dir == 0) { u[0] = bflo(uu[k].x); u[1] = bfhi(uu[k].x); u[2] = bflo(uu[k].y); u[3] = bfhi(uu[k].y); }
            else { u[3] = bflo(uu[k].x); u[2] = bfhi(uu[k].x); u[1] = bflo(uu[k].y); u[0] = bfhi(uu[k].y); }
            v2u o; o.x = pk2(u[0] - ws[0], u[1] - ws[1]); o.y = pk2(u[2] - ws[2], u[3] - ws[3]);
            *(LAS v2u*)(VNT + v * P64 + t0) = o;
        }
        LBAR();
#pragma unroll
        for (int k = 0; k < 4; ++k) {
            const int nv = nvb + k;
            f32x4 a = mma16<128>(Qs + 16 * mi * P128, P128, ST + 16 * nv * P128, P128, (f32x4){0.f, 0.f, 0.f, 0.f}, lane);
#pragma unroll
            for (int jj = 0; jj < 4; ++jj) a[jj] *= __expf(gcs[16 * mi + 4 * q + jj]);
            a = mma16<64>(ATT + 16 * mi * P64, P64, VNT + 16 * nv * P64, P64, a, lane);
            oacc[k] += a;
        }
        LBAR();
    }
#pragma unroll
    for (int k = 0; k < 4; ++k)
#pragma unroll
        for (int jj = 0; jj < 4; ++jj) OS[(16 * mi + 4 * q + jj) * 132 + 16 * (nvb + k) + r] = oacc[k][jj];
    LBAR();
    {   const float* enw = A.in[19] + l * 128 + lane * 2; const float ew0 = enw[0], ew1 = enw[1];
        const bf16* Z = (const bf16*)(F.ws + WS_Z); bf16* E_ = (bf16*)(F.ws + WS_E);
        unsigned gz[8];
#pragma unroll
        for (int t8 = 0; t8 < 8; ++t8) gz[t8] = *(const unsigned*)(Z + (size_t)(row0 + w * 8 + t8) * ZP + C_EG + h * 128 + lane * 2);
#pragma unroll
        for (int t8 = 0; t8 < 8; ++t8) { const int t = w * 8 + t8;
            const float x0 = OS[t * 132 + lane * 2], x1 = OS[t * 132 + lane * 2 + 1];
            const float rs = __builtin_amdgcn_rsqf(wave_sum(x0 * x0 + x1 * x1) * (1.0f / 128.f) + 1e-6f);
            const size_t row = row0 + t; const unsigned g = gz[t8];
            *(unsigned*)(E_ + row * 1024 + h * 128 + lane * 2) = pk2(x0 * rs * ew0 * siluf_(bflo(g)), x1 * rs * ew1 * siluf_(bfhi(g)));
        }
    }
    LBAR();
}
constexpr int NIN_MAIN = 13824;
__device__ __forceinline__ void g1_tail_item(Frame& F, int it) {
    const int tid = F.tid, lane = F.lane, w = F.wave, r = lane & 15, q = lane >> 4;
    const bf16* Hm = (const bf16*)(F.ws + WS_H) + (size_t)(64 * it) * DM_;
    const bf16* Wt = (const bf16*)(F.ws + WS_W0 + WO_IN) + (size_t)NIN_MAIN * DM_;
    LAS bf16* As = (LAS bf16*)F.lds; LAS bf16* Bs = As + 64 * 264;
    f32x4 acc[2] = {(f32x4){0.f, 0.f, 0.f, 0.f}, (f32x4){0.f, 0.f, 0.f, 0.f}};
    v4u pa[4], pb[4];
#pragma unroll
    for (int k = 0; k < 4; ++k) { const int p = tid + 512 * k, row = p >> 5, c8 = (p & 31) * 8; pa[k] = *(const v4u*)(Hm + (size_t)row * DM_ + c8); pb[k] = *(const v4u*)(Wt + (size_t)row * DM_ + c8); }
    for (int kc = 0; kc < 8; ++kc) {
#pragma unroll
        for (int k = 0; k < 4; ++k) { const int p = tid + 512 * k, row = p >> 5, c8 = (p & 31) * 8; *(LAS v4u*)(As + row * 264 + c8) = pa[k]; *(LAS v4u*)(Bs + row * 264 + c8) = pb[k]; }
        __syncthreads();
        if (kc + 1 < 8) {
#pragma unroll
            for (int k = 0; k < 4; ++k) { const int p = tid + 512 * k, row = p >> 5, c8 = (p & 31) * 8 + (kc + 1) * 256; pa[k] = *(const v4u*)(Hm + (size_t)row * DM_ + c8); pb[k] = *(const v4u*)(Wt + (size_t)row * DM_ + c8); }
        }
#pragma unroll
        for (int t2 = 0; t2 < 2; ++t2) { const int t = w * 2 + t2, mi = t >> 2, nj = t & 3;
            acc[t2] = mma16<256>(As + 16 * mi * 264, 264, Bs + 16 * nj * 264, 264, acc[t2], lane); }
        __syncthreads();
    }
    bf16* Z = (bf16*)(F.ws + WS_Z);
#pragma unroll
    for (int t2 = 0; t2 < 2; ++t2) { const int t = w * 2 + t2, mi = t >> 2, nj = t & 3;
#pragma unroll
        for (int jj = 0; jj < 4; ++jj) Z[(size_t)(64 * it + 16 * mi + 4 * q + jj) * ZP + NIN_MAIN + 16 * nj + r] = (bf16)f2bf(acc[t2][jj]); }
}

__device__ __forceinline__ f32x4 small_mm_acc(Frame& F, const bf16* Ap, int lda, const bf16* Bp, int ldb, int K, f32x4 acc) {
    const int tid = F.tid, lane = F.lane, w = F.wave;
    LAS bf16* As = (LAS bf16*)F.lds; LAS bf16* Bs = As + 32 * 264;
    v4u pa[2][2], pb[2][4];
#define SM_LOAD(set, kc_) do { \
    _Pragma("unroll") for (int k = 0; k < 2; ++k) { const int p = tid + 512 * k, row = p >> 5, c8 = (p & 31) * 8 + (kc_) * 256; pa[set][k] = *(const v4u*)(Ap + (size_t)row * lda + c8); } \
    _Pragma("unroll") for (int k = 0; k < 4; ++k) { const int p = tid + 512 * k, row = p >> 5, c8 = (p & 31) * 8 + (kc_) * 256; pb[set][k] = *(const v4u*)(Bp + (size_t)row * ldb + c8); } } while (0)
#define SM_STEP(set, kc_) do { \
    _Pragma("unroll") for (int k = 0; k < 2; ++k) { const int p = tid + 512 * k, row = p >> 5, c8 = (p & 31) * 8; *(LAS v4u*)(As + row * 264 + c8) = pa[set][k]; } \
    _Pragma("unroll") for (int k = 0; k < 4; ++k) { const int p = tid + 512 * k, row = p >> 5, c8 = (p & 31) * 8; *(LAS v4u*)(Bs + row * 264 + c8) = pb[set][k]; } \
    LBAR(); \
    if ((kc_) + 2 < nk) SM_LOAD(set, (kc_) + 2); \
    acc = mma16<256>(As + 16 * (w >> 2) * 264, 264, Bs + 16 * (w & 3) * 264, 264, acc, lane); \
    LBAR(); } while (0)
    const int nk = K >> 8;
    SM_LOAD(0, 0); SM_LOAD(1, 1);
    for (int kc = 0; kc < nk; kc += 2) { SM_STEP(0, kc); SM_STEP(1, kc + 1); }
#undef SM_LOAD
#undef SM_STEP
    return acc;
}
__device__ __forceinline__ void ctx_f32_item(Frame& F, int it, const bf16* A, int K, const bf16* Bt, bf16* Y) {
    const int rt = it >> 5, ct = it & 31, lane = F.lane, w = F.wave, r = lane & 15, q = lane >> 4;
    const f32x4 acc = small_mm_acc(F, A + (size_t)(32 * rt) * K, K, Bt + (size_t)(64 * ct) * K, K, K, (f32x4){0.f, 0.f, 0.f, 0.f});
#pragma unroll
    for (int jj = 0; jj < 4; ++jj) Y[(size_t)(32 * rt + 16 * (w >> 2) + 4 * q + jj) * DM_ + 64 * ct + 16 * (w & 3) + r] = (bf16)f2bf(acc[jj]);
}
__device__ __forceinline__ void ctx_g2_item(Frame& F, int it) {
    const int rt = it >> 5, ct = it & 31, lane = F.lane, w = F.wave, r = lane & 15, q = lane >> 4;
    unsigned char* ws = F.ws; unsigned char* wb = ws + WS_W0;
    const bf16* Zm = (const bf16*)(ws + WS_Z) + C_MG;
    const int col = 64 * ct + 16 * (w & 3) + r, rowb = 32 * rt + 16 * (w >> 2) + 4 * q;
    f32x4 tot = {0.f, 0.f, 0.f, 0.f};
    {   const f32x4 a = small_mm_acc(F, (const bf16*)(ws + WS_A) + (size_t)(32 * rt) * 512, 512, (const bf16*)(wb + WO_UA) + (size_t)(64 * ct) * 512, 512, 512, (f32x4){0.f, 0.f, 0.f, 0.f});
#pragma unroll
        for (int jj = 0; jj < 4; ++jj) tot[jj] += a[jj] * sigmoidf_(bf2f(Zm[(size_t)(rowb + jj) * ZP + col])); }
    {   const f32x4 a = small_mm_acc(F, (const bf16*)(ws + WS_D) + (size_t)(32 * rt) * 512, 512, (const bf16*)(wb + WO_UD) + (size_t)(64 * ct) * 512, 512, 512, (f32x4){0.f, 0.f, 0.f, 0.f});
#pragma unroll
        for (int jj = 0; jj < 4; ++jj) tot[jj] += a[jj] * sigmoidf_(bf2f(Zm[(size_t)(rowb + jj) * ZP + DM_ + col])); }
    {   const f32x4 a = small_mm_acc(F, (const bf16*)(ws + WS_E) + (size_t)(32 * rt) * 1024, 1024, (const bf16*)(wb + WO_UE) + (size_t)(64 * ct) * 1024, 1024, 1024, (f32x4){0.f, 0.f, 0.f, 0.f});
#pragma unroll
        for (int jj = 0; jj < 4; ++jj) tot[jj] += a[jj] * sigmoidf_(bf2f(Zm[(size_t)(rowb + jj) * ZP + 2 * DM_ + col])); }
    bf16* YB = (bf16*)(ws + WS_YB);
#pragma unroll
    for (int jj = 0; jj < 4; ++jj) YB[(size_t)(rowb + jj) * DM_ + col] = (bf16)f2bf(tot[jj]);
}

__device__ __forceinline__ void gla_cum_decay(Frame& F, const Args& A, int l, int dir, int h, int row0, LAS float* bs, LAS float* part, float* bsg) {
    const int tg = F.wave >> 1, d = (F.wave & 1) * 64 + F.lane;
    const float* ZG = (const float*)(F.ws + WS_ZG);
    const float* w2 = A.in[11] + ((size_t)(l * 2 + dir) * 16) * 512 + h * 128 + d; const float bd = A.in[12][(size_t)(l * 2 + dir) * 512 + h * 128 + d];
    float wc[16], g[16];
#pragma unroll
    for (int j = 0; j < 16; ++j) wc[j] = w2[j * 512];
    LAS float* lrs = part + 512;
    {   const int t = F.tid >> 3, j2 = (F.tid & 7) * 2; const float* src = ZG + (size_t)(row0 + t) * 64 + dir * 16 + j2; lrs[t * 16 + j2] = src[0]; lrs[t * 16 + j2 + 1] = src[1]; }
    LBAR();
#pragma unroll
    for (int k = 0; k < 16; ++k) {
        const LAS float* lr = lrs + (tg * 16 + k) * 16;
        float x = bd;
#pragma unroll
        for (int j = 0; j < 16; ++j) x += lr[j] * wc[j];
        g[k] = (fminf(x, 0.f) - __logf(1.0f + __expf(-fabsf(x)))) * 0.0625f;
    }
    float run = 0.f;
    if (dir == 0) {
#pragma unroll
        for (int k = 0; k < 16; ++k) { run += g[k]; g[k] = run; }
    } else {
#pragma unroll
        for (int k = 15; k >= 0; --k) { run += g[k]; g[k] = run; }
    }
    part[tg * 128 + d] = run;
    LBAR();
    float off = 0.f;
#pragma unroll
    for (int t2 = 0; t2 < 4; ++t2) { const float pv = part[t2 * 128 + d]; if (dir == 0 ? (t2 < tg) : (t2 > tg)) off += pv; }
#pragma unroll
    for (int k = 0; k < 16; ++k) { bs[(tg * 16 + k) * 128 + d] = g[k] + off; bsg[(tg * 16 + k) * 128 + d] = g[k] + off; }
    LBAR();
}
__device__ __forceinline__ void gla_prep2_item(Frame& F, const Args& A, int l, int chain, int c) {
    const int dir = chain >> 2, h = chain & 3, tid = F.tid, lane = F.lane, w = F.wave, r = lane & 15, q = lane >> 4;
    const bf16* Z = (const bf16*)(F.ws + WS_Z);
    const int row0 = 64 * c, n = chunk_scan_index(dir, c);
    LAS float* bs = (LAS float*)F.lds;
    LAS bf16* KdT = (LAS bf16*)(F.lds + 32768);
    LAS bf16* VT = (LAS bf16*)(F.lds + 51200);
    gla_cum_decay(F, A, l, dir, h, row0, bs, (LAS float*)(F.lds + 69632), (float*)(F.ws + WS_BS) + ((size_t)chain * 132 + chunk_scan_index(dir, c)) * 8192);
    const int tl = dir ? 0 : 63;
    {   const int ip = tid & 31, c8 = (tid >> 5) * 8, t0 = 2 * ip, t1 = t0 + 1;
        const bf16* z0 = Z + (size_t)(row0 + t0) * ZP + h * 128 + c8; const bf16* z1 = z0 + ZP;
        const v4u kv0 = *(const v4u*)(z0 + C_GK), kv1 = *(const v4u*)(z1 + C_GK), vv0 = *(const v4u*)(z0 + C_GV), vv1 = *(const v4u*)(z1 + C_GV);
        const unsigned k0w[4] = {kv0.x, kv0.y, kv0.z, kv0.w}, k1w[4] = {kv1.x, kv1.y, kv1.z, kv1.w}, v0w[4] = {vv0.x, vv0.y, vv0.z, vv0.w}, v1w[4] = {vv1.x, vv1.y, vv1.z, vv1.w};
#pragma unroll
        for (int e = 0; e < 4; ++e) {
            const int d0 = c8 + 2 * e, d1 = d0 + 1;
            const float bl0 = bs[tl * 128 + d0], bl1 = bs[tl * 128 + d1];
            *(LAS unsigned*)(KdT + d0 * P64 + t0) = pk2(bflo(k0w[e]) * __expf(bl0 - bs[t0 * 128 + d0]), bflo(k1w[e]) * __expf(bl0 - bs[t1 * 128 + d0]));
            *(LAS unsigned*)(KdT + d1 * P64 + t0) = pk2(bfhi(k0w[e]) * __expf(bl1 - bs[t0 * 128 + d1]), bfhi(k1w[e]) * __expf(bl1 - bs[t1 * 128 + d1]));
            *(LAS unsigned*)(VT + d0 * P64 + t0) = (v0w[e] & 0xffffu) | (v1w[e] << 16);
            *(LAS unsigned*)(VT + d1 * P64 + t0) = (v0w[e] >> 16) | (v1w[e] & 0xffff0000u);
        }
    }
    LBAR();
    const size_t item = (size_t)chain * 132 + n;
    float* GS = (float*)(F.ws + WS_GS) + item * 16384;
#pragma unroll
    for (int t8 = 0; t8 < 8; ++t8) {
        const int mv = w, na = t8;
        const f32x4 d = mma16<64>(VT + 16 * mv * P64, P64, KdT + 16 * na * P64, P64, (f32x4){0.f, 0.f, 0.f, 0.f}, lane);
#pragma unroll
        for (int jj = 0; jj < 4; ++jj) GS[(16 * mv + 4 * q + jj) * 128 + 16 * na + r] = d[jj];
    }
    if (tid < 128) ((float*)(F.ws + WS_GD))[item * 128 + tid] = __expf(bs[tl * 128 + tid]);
    LBAR();
}
__device__ __forceinline__ void gla_scan_item(Frame& F, int it) {
    const int chain = it >> 3, e4 = (it & 7) * 512 + F.tid, v = e4 >> 5, a4 = (e4 & 31) * 4;
    float* p = (float*)(F.ws + WS_GS) + (size_t)chain * 132 * 16384 + v * 128 + a4;
    const float* gd = (const float*)(F.ws + WS_GD) + (size_t)chain * 132 * 128 + a4;
    f32x4 S = {0.f, 0.f, 0.f, 0.f};
    for (int n = 0; n < 132; n += 12) {
        f32x4 x[12]; f32x4 d[12];
#pragma unroll
        for (int k = 0; k < 12; ++k) { x[k] = *(const f32x4*)(p + (size_t)(n + k) * 16384); d[k] = *(const f32x4*)(gd + (n + k) * 128); }
#pragma unroll
        for (int k = 0; k < 12; ++k) { *(f32x4*)(p + (size_t)(n + k) * 16384) = S; S = S * d[k] + x[k]; }
    }
}
__device__ __forceinline__ void gla_out_item(Frame& F, const Args& A, int l, int c, int h) {
    const int tid = F.tid, lane = F.lane, w = F.wave, r = lane & 15, q = lane >> 4;
    const bf16* Z = (const bf16*)(F.ws + WS_Z);
    const int row0 = 64 * c;
    LAS float* bs = (LAS float*)F.lds;
    LAS bf16* Qt = (LAS bf16*)(F.lds + 32768);
    LAS bf16* Kt = (LAS bf16*)(F.lds + 50176);
    LAS bf16* VT = (LAS bf16*)(F.lds + 67584);
    LAS bf16* ST = (LAS bf16*)(F.lds + 86016);
    LAS bf16* ATT = (LAS bf16*)(F.lds + 120832);
    LAS float* OS = (LAS float*)F.lds;
    const int mi = w >> 1, nvb = 4 * (w & 1);
    f32x4 oacc[4];
#pragma unroll
    for (int k = 0; k < 4; ++k) oacc[k] = (f32x4){0.f, 0.f, 0.f, 0.f};
    for (int dir = 0; dir < 2; ++dir) {
        const int chain = dir * 4 + h, n = chunk_scan_index(dir, c);
        const float* Sg = (const float*)(F.ws + WS_GS) + ((size_t)chain * 132 + n) * 16384;
        const float* bsg = (const float*)(F.ws + WS_BS) + ((size_t)chain * 132 + n) * 8192;
        {
            v4u qv[2], kv[2]; f32x4 bA[2], bB[2], sv[8]; v4u vv0 = {0u, 0u, 0u, 0u}, vv1 = {0u, 0u, 0u, 0u};
#pragma unroll
            for (int i2 = 0; i2 < 2; ++i2) { const int p = tid + 512 * i2, t = p >> 4, c8 = (p & 15) * 8; const bf16* zr = Z + (size_t)(row0 + t) * ZP + h * 128 + c8;
                qv[i2] = *(const v4u*)(zr + C_GQ); kv[i2] = *(const v4u*)(zr + C_GK); bA[i2] = *(const f32x4*)(bsg + t * 128 + c8); bB[i2] = *(const f32x4*)(bsg + t * 128 + c8 + 4); }
#pragma unroll
            for (int i8 = 0; i8 < 8; ++i8) { const int p = tid + 512 * i8; sv[i8] = *(const f32x4*)(Sg + (p >> 5) * 128 + (p & 31) * 4); }
            const int ipv = tid & 31, c8v = (tid >> 5) * 8, t0v = 2 * ipv;
            if (dir == 0) { const bf16* z0 = Z + (size_t)(row0 + t0v) * ZP + h * 128 + c8v + C_GV; vv0 = *(const v4u*)z0; vv1 = *(const v4u*)(z0 + ZP); }
#pragma unroll
            for (int i2 = 0; i2 < 2; ++i2) { const int p = tid + 512 * i2, t = p >> 4, c8 = (p & 15) * 8;
                const unsigned qw[4] = {qv[i2].x, qv[i2].y, qv[i2].z, qv[i2].w}, kw[4] = {kv[i2].x, kv[i2].y, kv[i2].z, kv[i2].w};
                const float bb[8] = {bA[i2].x, bA[i2].y, bA[i2].z, bA[i2].w, bB[i2].x, bB[i2].y, bB[i2].z, bB[i2].w};
                unsigned qo[4], ko[4];
#pragma unroll
                for (int e = 0; e < 4; ++e) { const float b0 = bb[2 * e], b1 = bb[2 * e + 1];
                    qo[e] = pk2(bflo(qw[e]) * __expf(b0), bfhi(qw[e]) * __expf(b1)); ko[e] = pk2(bflo(kw[e]) * __expf(-b0), bfhi(kw[e]) * __expf(-b1)); }
                *(LAS v4u*)(Qt + t * P128 + c8) = (v4u){qo[0], qo[1], qo[2], qo[3]}; *(LAS v4u*)(Kt + t * P128 + c8) = (v4u){ko[0], ko[1], ko[2], ko[3]}; }
            if (dir == 0) {
                const unsigned v0w[4] = {vv0.x, vv0.y, vv0.z, vv0.w}, v1w[4] = {vv1.x, vv1.y, vv1.z, vv1.w};
#pragma unroll
                for (int e = 0; e < 4; ++e) {
                    *(LAS unsigned*)(VT + (c8v + 2 * e) * P64 + t0v) = (v0w[e] & 0xffffu) | (v1w[e] << 16);
                    *(LAS unsigned*)(VT + (c8v + 2 * e + 1) * P64 + t0v) = (v0w[e] >> 16) | (v1w[e] & 0xffff0000u); }
            }
#pragma unroll
            for (int i8 = 0; i8 < 8; ++i8) { const int p = tid + 512 * i8; v2u o; o.x = pk2(sv[i8].x, sv[i8].y); o.y = pk2(sv[i8].z, sv[i8].w);
                *(LAS v2u*)(ST + (p >> 5) * P128 + (p & 31) * 4) = o; }
        }
        LBAR();
#pragma unroll
        for (int t2 = 0; t2 < 2; ++t2) {
            const int t = w * 2 + t2, ai = t >> 2, nj = t & 3;
            const f32x4 acc = mma16<128>(Qt + 16 * ai * P128, P128, Kt + 16 * nj * P128, P128, (f32x4){0.f, 0.f, 0.f, 0.f}, lane);
            const int tj = 16 * nj + r;
#pragma unroll
            for (int jj = 0; jj < 4; ++jj) { const int ti = 16 * ai + 4 * q + jj; const bool ok = dir ? (tj >= ti) : (tj <= ti);
                ATT[ti * P64 + tj] = (bf16)f2bf(ok ? acc[jj] : 0.f); }
        }
        LBAR();
#pragma unroll
        for (int k = 0; k < 4; ++k) {
            const int nv = nvb + k;
            oacc[k] = mma16<64>(ATT + 16 * mi * P64, P64, VT + 16 * nv * P64, P64, oacc[k], lane);
            oacc[k] = mma16<128>(Qt + 16 * mi * P128, P128, ST + 16 * nv * P128, P128, oacc[k], lane);
        }
        LBAR();
    }
#pragma unroll
    for (int k = 0; k < 4; ++k)
#pragma unroll
        for (int jj = 0; jj < 4; ++jj) OS[(16 * mi + 4 * q + jj) * 132 + 16 * (nvb + k) + r] = oacc[k][jj] * 0.08838834764831845f;
    LBAR();
    {   const float* gnw = A.in[13] + l * 128 + lane * 2; const float gw0 = gnw[0], gw1 = gnw[1];
        bf16* A_ = (bf16*)(F.ws + WS_A);
        unsigned gz[8];
#pragma unroll
        for (int t8 = 0; t8 < 8; ++t8) gz[t8] = *(const unsigned*)(Z + (size_t)(row0 + w * 8 + t8) * ZP + C_GG + h * 128 + lane * 2);
#pragma unroll
        for (int t8 = 0; t8 < 8; ++t8) { const int t = w * 8 + t8;
            const float x0 = OS[t * 132 + lane * 2], x1 = OS[t * 132 + lane * 2 + 1];
            const float rs = __builtin_amdgcn_rsqf(wave_sum(x0 * x0 + x1 * x1) * (1.0f / 128.f) + 1e-6f);
            const size_t row = row0 + t; const unsigned g = gz[t8];
            *(unsigned*)(A_ + row * 512 + h * 128 + lane * 2) = pk2(x0 * rs * gw0 * siluf_(bflo(g)), x1 * rs * gw1 * siluf_(bfhi(g)));
        }
    }
    LBAR();
}
__device__ __forceinline__ void diff_out_rows(Frame& F, const Args& A, int l) {
    const int gw = F.bid * 8 + F.wave, NGW = F.G * 8, lane = F.lane;
    const bf16* AO = (const bf16*)(F.ws + WS_AO); bf16* D_ = (bf16*)(F.ws + WS_D);
    const float lam_init = l == 0 ? 0.2f : 0.35550906759096924f;
    const float* lp = A.in[14] + l * 256;
    const float lam = expf(wave_sum(lp[lane] * lp[64 + lane])) - expf(wave_sum(lp[128 + lane] * lp[192 + lane])) + lam_init;
    const float* dnw = A.in[15] + l * 128 + lane * 2; const float dw0 = dnw[0], dw1 = dnw[1];
    for (int r = gw + (l == 1 ? CTXL : 0); r < MROWS; r += NGW) {
        unsigned wa[4], wb_[4];
#pragma unroll
        for (int h = 0; h < 4; ++h) { wa[h] = *(const unsigned*)(AO + (size_t)r * 1024 + (h * 2) * 128 + lane * 2); wb_[h] = *(const unsigned*)(AO + (size_t)r * 1024 + (h * 2 + 1) * 128 + lane * 2); }
#pragma unroll
        for (int h = 0; h < 4; ++h) {
            const int c = h * 128 + lane * 2;
            const unsigned w1 = wa[h], w2 = wb_[h];
            const float x0 = bflo(w1) - lam * bflo(w2), x1 = bfhi(w1) - lam * bfhi(w2);
            const float rs = __builtin_amdgcn_rsqf(wave_sum(x0 * x0 + x1 * x1) * (1.0f / 128.f) + 1e-6f) * (1.0f - lam_init);
            *(unsigned*)(D_ + (size_t)r * 512 + c) = pk2(x0 * rs * dw0, x1 * rs * dw1);
        }
    }
}
#ifndef MK_SINGLE
#define MK_SINGLE 1
#endif
template <int l> __device__ __forceinline__ void layer_phases(Frame& F, const Args& args, unsigned char* lds, const int lo, const int hi, const XcdBarrier& bar) {
    unsigned char* ws = args.ws;
#define IN(k) (lo <= (k) && (k) < hi)
#define SEAM(k) do { if (IN(k) && IN((k) + 1)) { xcd_barrier(bar); if (REP_SYNC > 1) xcd_barrier(bar); } } while (0)
    const int pb = 2 + 11 * l;
    unsigned char* wb = ws + WS_W0;
    if (IN(pb + 0) && !SKIP_G1) {
        pg8::Gemm g{(const bf16*)(ws + WS_H), (const bf16*)(wb + WO_IN), MROWS, NIN_MAIN, DM_}; pg8::StaticOrder S; S.init(MROWS, NIN_MAIN, F.G, F.bid); S.rep = REP_G1;
        pg8::EpiZ E{(bf16*)(ws + WS_Z), ZP, (float*)(ws + WS_ZG)};
        pg8::gemm_phase<pg8::EpiZ, pg8::StaticOrder, true, true>(F.lds, g, S, E);
    } SEAM(pb + 0);
    if (IN(pb + 1)) { if (F.bid < 132) g1_tail_item(F, F.bid); prep_phase(F, args, l); } SEAM(pb + 1);
    if (IN(pb + 2)) {
        for (int it = F.bid; it < 2112 * REP_C1; it += F.G) delta_prep2_item(F, (it % 2112) / 132, it % 132);
        for (int it = F.G - 1 - F.bid; it < 1056 * REP_C2; it += F.G) gla_prep2_item(F, args, l, (it % 1056) / 132, it % 132);
    } SEAM(pb + 2);
    if (IN(pb + 3)) {
        if (F.bid < 16) delta_chain(F, F.bid);
        else if (F.bid - 16 < 64) gla_scan_item(F, F.bid - 16);
        {
            const attn_body::bf16* AQ = (const attn_body::bf16*)(ws + WS_AQ); const attn_body::bf16* AK = (const attn_body::bf16*)(ws + WS_AK);
            const attn_body::bf16* AV = (const attn_body::bf16*)(ws + WS_AV); attn_body::bf16* AO = (attn_body::bf16*)(ws + WS_AO);
            unsigned* cnt = (unsigned*)(ws + WS_CNT) + 64 * l;
            volatile LAS unsigned* slot = (volatile LAS unsigned*)(F.lds + MISC_OFF) + 16;
            for (;;) {
                if (F.tid == 0) slot[0] = __hip_atomic_fetch_add(cnt, 1u, __ATOMIC_RELAXED, __HIP_MEMORY_SCOPE_AGENT);
                __syncthreads();
                const int ui = (int)slot[0];
                __syncthreads();
                constexpr int NU = (l == 1) ? 512 : 528;
                if (ui >= NU * REP_ATTN) break;
                const int uj = ui % NU; const int qb = 32 - uj / 16, rem = uj % 16, hm = rem >> 1, half = rem & 1;
                attn_body::attn_unit<8>(AQ + (size_t)qb * 256 * 512 + hm * 64, AK + hm * 64, AV + (hm >> 1) * 128 + half * 64,
                                        AO + (size_t)qb * 256 * 1024 + hm * 128 + half * 64, qb == 0 ? 4 : 132, (char*)lds);
            }
        }
        if (l == 0) p0_dynamic(F, args, 0, (unsigned*)(ws + WS_CNT) + 128, I_IN, PER_L);
        else p0_dynamic(F, args, 1, (unsigned*)(ws + WS_CNT) + 256, I_IN, PER_L - I_2);
    } SEAM(pb + 3);
    if (IN(pb + 4)) {
        for (int it = F.bid; it < 1056 * REP_C3; it += F.G) { if (l == 1 && ((it % 1056) >> 3) < 4) continue; delta_out_item(F, args, l, (it % 1056) >> 3, it & 7); }
        for (int it = F.G - 1 - F.bid; it < 528 * REP_C4; it += F.G) { if (l == 1 && ((it % 528) >> 2) < 4) continue; gla_out_item(F, args, l, (it % 528) >> 2, it & 3); }
        diff_out_rows(F, args, l);
    } SEAM(pb + 4);
    if (IN(pb + 5) && !SKIP_G2) {
        const bf16* Zm = (const bf16*)(ws + WS_Z) + C_MG; float* YF = (float*)(ws + WS_R2); bf16* YB = (bf16*)(ws + WS_YB);
        pg8::StaticOrder S; S.init(MROWS - CTXL, DM_, F.G, F.bid); S.pmoff = 1;
        { pg8::Gemm g{(const bf16*)(ws + WS_A), (const bf16*)(wb + WO_UA), MROWS, DM_, 512}; pg8::EpiGate<0> E{Zm, ZP, YF, YB, DM_};
          pg8::gemm_phase<pg8::EpiGate<0>, pg8::StaticOrder, true, true>(F.lds, g, S, E); }
        { pg8::Gemm g{(const bf16*)(ws + WS_D), (const bf16*)(wb + WO_UD), MROWS, DM_, 512}; pg8::EpiGate<1> E{Zm + DM_, ZP, YF, YB, DM_};
          pg8::gemm_phase<pg8::EpiGate<1>, pg8::StaticOrder, true, true>(F.lds, g, S, E); }
        { pg8::Gemm g{(const bf16*)(ws + WS_E), (const bf16*)(wb + WO_UE), MROWS, DM_, 1024}; pg8::EpiGate<2> E{Zm + 2 * DM_, ZP, YF, YB, DM_};
          pg8::gemm_phase<pg8::EpiGate<2>, pg8::StaticOrder, true, true>(F.lds, g, S, E); }
        if (l == 0) for (int it = F.bid; it < 256; it += F.G) ctx_g2_item(F, it);
    } SEAM(pb + 5);
    if (IN(pb + 6) && !SKIP_G3) {
        pg8::Gemm g{(const bf16*)(ws + WS_YB), (const bf16*)(wb + WO_O), MROWS, DM_, DM_}; pg8::StaticOrder S; S.init(MROWS - CTXL, DM_, F.G, F.bid); S.pmoff = 1; S.rep = REP_G3;
        pg8::EpiF32 E{(bf16*)(ws + WS_R2), DM_};
        pg8::gemm_phase<pg8::EpiF32, pg8::StaticOrder, true, true>(F.lds, g, S, E);
        if (l == 0) for (int it = F.bid; it < 256; it += F.G) ctx_f32_item(F, it, (const bf16*)(ws + WS_YB), DM_, (const bf16*)(wb + WO_O), (bf16*)(ws + WS_R2));
    } SEAM(pb + 6);
    if (IN(pb + 7)) { row_phase<1>(F, args, l); } SEAM(pb + 7);
    if (IN(pb + 8) && !SKIP_G4) {
        pg8::Gemm g{(const bf16*)(ws + WS_H), (const bf16*)(wb + WO_13), MROWS, 2 * DFF, DM_}; pg8::StaticOrder S; S.init(MROWS - CTXL * l, 2 * DFF, F.G, F.bid); S.pmoff = l; S.rep = REP_G4;
        pg8::EpiSwiglu E{(bf16*)(ws + WS_HFF), DFF};
        pg8::gemm_phase<pg8::EpiSwiglu, pg8::StaticOrder, true, true>(F.lds, g, S, E);
        if (l == 0) p0_dynamic(F, args, 1, (unsigned*)(ws + WS_CNT) + 192, 0, I_IN);
        else p0_dynamic(F, args, 1, (unsigned*)(ws + WS_CNT) + 320, PER_L - I_2, PER_L);
    } SEAM(pb + 8);
    if (IN(pb + 9) && !SKIP_G5) {
        pg8::Gemm g{(const bf16*)(ws + WS_HFF), (const bf16*)(wb + WO_2), MROWS, DM_, DFF}; pg8::StaticOrder S; S.init(MROWS - CTXL, DM_, F.G, F.bid); S.pmoff = 1; S.rep = REP_G5;
        pg8::EpiF32 E{(bf16*)(ws + WS_R2), DM_};
        pg8::gemm_phase<pg8::EpiF32, pg8::StaticOrder, true, true>(F.lds, g, S, E);
        if (l == 0) { for (int it = F.bid; it < 256; it += F.G) ctx_f32_item(F, it, (const bf16*)(ws + WS_HFF), DFF, (const bf16*)(wb + WO_2), (bf16*)(ws + WS_R2));
                    }
    } SEAM(pb + 9);
    if (IN(pb + 10)) { row_phase<2>(F, args, l); } SEAM(pb + 10);
#undef IN
#undef SEAM
}
__global__ void __launch_bounds__(512, 2) mega_fwd(Args args) {
    extern __shared__ __attribute__((aligned(16))) unsigned char lds[];
    Frame F;
    F.lds = (LAS unsigned char*)lds; F.tid = threadIdx.x; F.lane = F.tid & 63; F.wave = __builtin_amdgcn_readfirstlane(F.tid >> 6);
    F.G = gridDim.x; F.bid = blockIdx.x; F.ws = args.ws; F.out = args.out;
    const int lo = args.ph_lo, hi = args.ph_hi;
    if (lo < 0) cg::this_grid().sync();
    for (int u = F.tid; u < 64; u += 512) ((LAS unsigned*)(F.lds + MISC_OFF))[u] = 0u;
    __syncthreads();
    XcdBarrier bar; bar.bar = (unsigned*)(args.ws + WS_BAR); bar.x = 0; bar.st = nullptr;
    if (hi - lo > 1) bar = xcd_barrier_post((unsigned*)(args.ws + WS_BAR), (volatile LAS unsigned*)(F.lds + MISC_OFF) + 8);
#define IN(k) (lo <= (k) && (k) < hi)
#define SEAM(k) do { if (IN(k) && IN((k) + 1)) { xcd_barrier(bar); if (REP_SYNC > 1) xcd_barrier(bar); } } while (0)
    unsigned char* ws = args.ws;
    if (IN(0)) { p0_phase(F, args, 0, true, 0, I_IN); } SEAM(0);
    if (IN(1)) { row_phase<0>(F, args, 0); } SEAM(1);
    layer_phases<0>(F, args, lds, lo, hi, bar);
    layer_phases<1>(F, args, lds, lo, hi, bar);
#undef IN
#undef SEAM
}

extern "C" void kernel_launch(void* const* d_in, const int* in_sizes, int n_in, void* d_out, int out_size, void* d_ws, size_t ws_size, hipStream_t stream) {
    static int grid = 0;
    if (grid == 0) {
        if (n_in != 27 || out_size != SEQ_ * DM_ || ws_size < WS_END2) { fprintf(stderr, "kernel_launch: unexpected shapes (n_in %d, out %d, ws %zu < %zu)\n", n_in, out_size, ws_size, (size_t)WS_END2); grid = -1; return; }
        if (hipFuncSetAttribute((const void*)mega_fwd, hipFuncAttributeMaxDynamicSharedMemorySize, LDS_BYTES) != hipSuccess) { fprintf(stderr, "kernel_launch: hipFuncSetAttribute failed\n"); grid = -1; return; }
        int dev = 0, cus = 0, per_cu = 0;
        hipGetDevice(&dev); hipDeviceGetAttribute(&cus, hipDeviceAttributeMultiprocessorCount, dev);
        hipOccupancyMaxActiveBlocksPerMultiprocessor(&per_cu, (const void*)mega_fwd, 512, LDS_BYTES);
        if (per_cu < 1) { fprintf(stderr, "kernel_launch: occupancy query says %d blocks per CU\n", per_cu); per_cu = 1; }
        (void)hipGetLastError();
        grid = cus;
    }
    if (grid < 0) return;
    Args a{};
    for (int i = 0; i < 27; ++i) a.in[i] = (const float*)d_in[i];
    a.out = (float*)d_out; a.ws = (unsigned char*)d_ws;
#if MK_SINGLE
    if (hipMemsetAsync((char*)d_ws + WS_BAR, 0, BAR_BYTES, stream) != hipSuccess) { fprintf(stderr, "kernel_launch: memset failed\n"); return; }
    a.ph_lo = 0; a.ph_hi = NPH;
    void* kargs[] = {&a};
    hipError_t e = hipLaunchCooperativeKernel((const void*)mega_fwd, dim3(grid), dim3(512), kargs, LDS_BYTES, stream);
    if (e != hipSuccess) fprintf(stderr, "cooperative launch failed: %s (grid %d)\n", hipGetErrorString(e), grid);
#else
    for (int p = 0; p < NPH; ++p) { a.ph_lo = p; a.ph_hi = p + 1; hipLaunchKernelGGL(mega_fwd, dim3(grid), dim3(512), LDS_BYTES, stream, a); }
#endif
}
```

```cpp
#include <hip/hip_runtime.h>
#include <hip/hip_cooperative_groups.h>
#include <hip/hip_bf16.h>
#include <cstdio>
#include <cstdint>
#include <cmath>
namespace cg = cooperative_groups;
#ifndef SKIP_G1
#define SKIP_G1 0
#endif
#ifndef SKIP_G2
#define SKIP_G2 0
#endif
#ifndef SKIP_G3
#define SKIP_G3 0
#endif
#ifndef SKIP_G4
#define SKIP_G4 0
#endif
#ifndef SKIP_G5
#define SKIP_G5 0
#endif
#ifndef REP_G1
#define REP_G1 1
#endif
#ifndef REP_G3
#define REP_G3 1
#endif
#ifndef REP_G4
#define REP_G4 1
#endif
#ifndef REP_G5
#define REP_G5 1
#endif
#ifndef REP_C1
#define REP_C1 1
#endif
#ifndef REP_C2
#define REP_C2 1
#endif
#ifndef REP_C3
#define REP_C3 1
#endif
#ifndef REP_C4
#define REP_C4 1
#endif
#ifndef REP_GEMM
#define REP_GEMM 1
#endif
#ifndef REP_CHUNK
#define REP_CHUNK 1
#endif
#ifndef REP_ATTN
#define REP_ATTN 1
#endif
#ifndef REP_ROWS
#define REP_ROWS 1
#endif
#ifndef REP_P0
#define REP_P0 1
#endif
#ifndef REP_SYNC
#define REP_SYNC 1
#endif
namespace pg8 {
#define PG8_LAS __attribute__((address_space(3)))
typedef unsigned short bf16_t;
typedef short bf16x8 __attribute__((ext_vector_type(8)));
typedef float f32x4 __attribute__((ext_vector_type(4)));
typedef unsigned u32x4 __attribute__((ext_vector_type(4)));
constexpr int BM = 256, BK = 64, HALF = 128, HTB = HALF * BK * 2  , STAGE_BYTES = 8 * HTB, NXCD = 8, WGM = 8;

__host__ __device__ __forceinline__ int lds_byte(int r, int c) { const int st = (r >> 4) * 2 + (c >> 5), rr = r & 15, cc = c & 31, ob = rr * 64 + cc * 2; return st * 1024 + (ob ^ (((ob >> 9) & 1) << 5)); }
__host__ __device__ __forceinline__ void stage_rc(int b, int& R, int& C) { const int st = b / 1024, sb = b % 1024, swz = sb ^ (((sb >> 9) & 1) << 5); R = (st >> 1) * 16 + swz / 64; C = (st & 1) * 32 + (swz % 64) / 2; }
__host__ __device__ __forceinline__ int perm32(int rho) { const int n = rho >> 4, i = rho & 15; return 8 * (i >> 2) + 4 * n + (i & 3); }

struct Unit { int pm, pn; };
struct Gemm { const bf16_t* A; const bf16_t* Bt; int M, N, K; };

struct StaticOrder {
    int nM, nN, nwg, G, c, rep = 1, pmoff = 0;
    __host__ __device__ void init(int M, int N, int G_, int c_) { nM = M / BM; nN = N / BM; nwg = nM * nN; G = G_; c = c_; }
    __host__ __device__ bool next(int i, Unit& u) const {
        const long L = (long)(i / rep) * G + c; if (L >= nwg) return false;
        int wgid = (int)L; { const int q = nwg / NXCD, r = nwg % NXCD, xcd = wgid % NXCD, off = wgid / NXCD; wgid = (xcd < r ? xcd * (q + 1) : r * (q + 1) + (xcd - r) * q) + off; }
        const int nig = WGM * nN, gid = wgid / nig, fm = gid * WGM, gsz = (nM - fm) < WGM ? (nM - fm) : WGM;
        u.pm = pmoff + fm + ((wgid % nig) % gsz); u.pn = (wgid % nig) / gsz; return true;
    }
    __device__ __forceinline__ void a_ready(const Unit&) const {}
    __device__ __forceinline__ void done(const Unit&) const {}
};

__device__ __forceinline__ unsigned cvt_pk_bf16(float lo, float hi) { unsigned r; asm volatile("v_cvt_pk_bf16_f32 %0, %1, %2" : "=v"(r) : "v"(lo), "v"(hi)); return r; }
typedef float f32x2 __attribute__((ext_vector_type(2)));
typedef unsigned u32x2 __attribute__((ext_vector_type(2)));
__device__ __forceinline__ float ep_sigmoid(float x) { return __builtin_amdgcn_rcpf(1.0f + __expf(-x)); }
struct EpiZ {
    static constexpr bool PERM = true, AFTER_DRAIN = false;
    bf16_t* Z; int ldz; float* ZG;
    __device__ __forceinline__ void operator()(const f32x4 (&acc)[2][2][4][2], const Unit& u, int wr, int wc, int fr, int fq) const {
        const int row0 = u.pm * BM + wr * 64 + fr, col0 = u.pn * BM + wc * 32 + 8 * fq;
#pragma unroll
        for (int ai = 0; ai < 2; ++ai)
#pragma unroll
            for (int m = 0; m < 4; ++m) { const int row = row0 + ai * HALF + m * 16;
#pragma unroll
                for (int bj = 0; bj < 2; ++bj) { const int c = col0 + bj * HALF; const f32x4 v0 = acc[ai][bj][m][0], v1 = acc[ai][bj][m][1];
                    u32x4 w; w.x = cvt_pk_bf16(v0[0], v0[1]); w.y = cvt_pk_bf16(v0[2], v0[3]); w.z = cvt_pk_bf16(v1[0], v1[1]); w.w = cvt_pk_bf16(v1[2], v1[3]);
                    *(u32x4*)(Z + (size_t)row * ldz + c) = w;
                    int gc = -1; if (c >= 1536 && c < 1568) gc = c - 1536; else if (c >= 6688 && c < 6720) gc = 32 + c - 6688;
                    if (gc >= 0) { float* g = ZG + (size_t)row * 64 + gc; *(f32x4*)g = v0; *(f32x4*)(g + 4) = v1; } } }
    }
};
template <int MODE> struct EpiGate {
    static constexpr bool PERM = true, AFTER_DRAIN = false;
    const bf16_t* Zg; int ldz; float* YF; bf16_t* YB; int ldc;
    __device__ __forceinline__ void operator()(const f32x4 (&acc)[2][2][4][2], const Unit& u, int wr, int wc, int fr, int fq) const {
        const int row0 = u.pm * BM + wr * 64 + fr, col0 = u.pn * BM + wc * 32 + 8 * fq;
#pragma unroll
        for (int ai = 0; ai < 2; ++ai)
#pragma unroll
            for (int m = 0; m < 4; ++m) { const int row = row0 + ai * HALF + m * 16;
#pragma unroll
                for (int bj = 0; bj < 2; ++bj) { const int c = col0 + bj * HALF;
                    const u32x4 gz = *(const u32x4*)(Zg + (size_t)row * ldz + c);
                    f32x4 g0, g1;
                    g0[0] = ep_sigmoid(__builtin_bit_cast(float, gz.x << 16)); g0[1] = ep_sigmoid(__builtin_bit_cast(float, gz.x & 0xffff0000u));
                    g0[2] = ep_sigmoid(__builtin_bit_cast(float, gz.y << 16)); g0[3] = ep_sigmoid(__builtin_bit_cast(float, gz.y & 0xffff0000u));
                    g1[0] = ep_sigmoid(__builtin_bit_cast(float, gz.z << 16)); g1[1] = ep_sigmoid(__builtin_bit_cast(float, gz.z & 0xffff0000u));
                    g1[2] = ep_sigmoid(__builtin_bit_cast(float, gz.w << 16)); g1[3] = ep_sigmoid(__builtin_bit_cast(float, gz.w & 0xffff0000u));
                    f32x4 v0 = acc[ai][bj][m][0] * g0, v1 = acc[ai][bj][m][1] * g1;
                    bf16_t* y = (bf16_t*)YF + (size_t)row * ldc + c;
                    if (MODE >= 1) { const u32x4 t = *(const u32x4*)y;
                        v0[0] += __builtin_bit_cast(float, t.x << 16); v0[1] += __builtin_bit_cast(float, t.x & 0xffff0000u); v0[2] += __builtin_bit_cast(float, t.y << 16); v0[3] += __builtin_bit_cast(float, t.y & 0xffff0000u);
                        v1[0] += __builtin_bit_cast(float, t.z << 16); v1[1] += __builtin_bit_cast(float, t.z & 0xffff0000u); v1[2] += __builtin_bit_cast(float, t.w << 16); v1[3] += __builtin_bit_cast(float, t.w & 0xffff0000u); }
                    u32x4 w; w.x = cvt_pk_bf16(v0[0], v0[1]); w.y = cvt_pk_bf16(v0[2], v0[3]); w.z = cvt_pk_bf16(v1[0], v1[1]); w.w = cvt_pk_bf16(v1[2], v1[3]);
                    if (MODE <= 1) *(u32x4*)y = w; else *(u32x4*)(YB + (size_t)row * ldc + c) = w; } }
    }
};
struct EpiF32 {
    static constexpr bool PERM = true, AFTER_DRAIN = false;
    bf16_t* Y; int ldc;
    __device__ __forceinline__ void operator()(const f32x4 (&acc)[2][2][4][2], const Unit& u, int wr, int wc, int fr, int fq) const {
        const int row0 = u.pm * BM + wr * 64 + fr, col0 = u.pn * BM + wc * 32 + 8 * fq;
#pragma unroll
        for (int ai = 0; ai < 2; ++ai)
#pragma unroll
            for (int m = 0; m < 4; ++m) { const int row = row0 + ai * HALF + m * 16;
#pragma unroll
                for (int bj = 0; bj < 2; ++bj) { const f32x4 v0 = acc[ai][bj][m][0], v1 = acc[ai][bj][m][1];
                    u32x4 w; w.x = cvt_pk_bf16(v0[0], v0[1]); w.y = cvt_pk_bf16(v0[2], v0[3]); w.z = cvt_pk_bf16(v1[0], v1[1]); w.w = cvt_pk_bf16(v1[2], v1[3]);
                    *(u32x4*)(Y + (size_t)row * ldc + col0 + bj * HALF) = w; } }
    }
};
struct EpiSwiglu {
    static constexpr bool PERM = true, AFTER_DRAIN = false;
    bf16_t* Hf; int ldc;
    __device__ __forceinline__ void operator()(const f32x4 (&acc)[2][2][4][2], const Unit& u, int wr, int wc, int fr, int fq) const {
        const int row0 = u.pm * BM + wr * 64 + fr, col0 = u.pn * HALF + wc * 32 + 8 * fq;
#pragma unroll
        for (int ai = 0; ai < 2; ++ai)
#pragma unroll
            for (int m = 0; m < 4; ++m) { const int row = row0 + ai * HALF + m * 16; float o[8];
#pragma unroll
                for (int n = 0; n < 2; ++n)
#pragma unroll
                    for (int j = 0; j < 4; ++j) { const float a = acc[ai][0][m][n][j], b = acc[ai][1][m][n][j]; o[n * 4 + j] = a * __builtin_amdgcn_rcpf(1.0f + __expf(-a)) * b; }
                u32x4 w; w.x = cvt_pk_bf16(o[0], o[1]); w.y = cvt_pk_bf16(o[2], o[3]); w.z = cvt_pk_bf16(o[4], o[5]); w.w = cvt_pk_bf16(o[6], o[7]);
                *(u32x4*)(Hf + (size_t)row * ldc + col0) = w; }
    }
};
template <class Epi, class Sched, bool ALIGN_EPI = false, bool SP2 = false>
__device__ __forceinline__ void gemm_phase(PG8_LAS unsigned char* lds, const Gemm g, const Sched& S, const Epi& E) {
    const int tid = threadIdx.x, wid = __builtin_amdgcn_readfirstlane(tid >> 6), lane = tid & 63, wr = wid >> 2, wc = wid & 3, fr = lane & 15, fq = lane >> 4;
    const int K = g.K, nt = K / BK;
    unsigned voffA[2], voffB[2];
#pragma unroll
    for (int i = 0; i < 2; ++i) { int R, C; stage_rc(tid * 16 + i * 8192, R, C); const int Rb = Epi::PERM ? ((R & ~31) + perm32(R & 31)) : R;
        voffA[i] = (unsigned)(R * K + C) * 2u; voffB[i] = (unsigned)(Rb * K + C) * 2u; }
    const size_t kstep = (size_t)(BK * 2);
    const size_t hstep = (size_t)HALF * K * 2;
    const size_t tstep = 2 * hstep;
    const unsigned ldsw = (unsigned)wid * 1024u;
    const int aoff = lds_byte(wr * 64 + fr, fq * 8), boff = lds_byte(wc * 32 + fr, fq * 8);
#define PG8_SA(b, h) (((b) * 2 + (h)) * HTB)
#define PG8_SB(b, h) ((4 + (b) * 2 + (h)) * HTB)
#define PG8_STAGE(bufoff, gbase, voff) do { _Pragma("unroll") for (int _i = 0; _i < 2; ++_i) \
        __builtin_amdgcn_global_load_lds((const unsigned*)((const char*)(gbase) + (voff)[_i]), (PG8_LAS unsigned*)(lds + (bufoff) + ldsw + _i * 8192), 16, 0, 0); } while (0)
#define PG8_LDA(dst, b, h) do { _Pragma("unroll") for (int m = 0; m < 4; ++m) _Pragma("unroll") for (int k = 0; k < 2; ++k) dst[m][k] = *(const PG8_LAS bf16x8*)(lds + PG8_SA(b, h) + aoff + m * 2048 + k * 1024); } while (0)
#define PG8_LDB(dst, b, h) do { _Pragma("unroll") for (int n = 0; n < 2; ++n) _Pragma("unroll") for (int k = 0; k < 2; ++k) dst[n][k] = *(const PG8_LAS bf16x8*)(lds + PG8_SB(b, h) + boff + n * 2048 + k * 1024); } while (0)
#define PG8_MMA(ai, bj, At, Bt) do { __builtin_amdgcn_s_setprio(1); _Pragma("unroll") for (int m = 0; m < 4; ++m) _Pragma("unroll") for (int n = 0; n < 2; ++n) _Pragma("unroll") for (int k = 0; k < 2; ++k) \
        acc[ai][bj][m][n] = __builtin_amdgcn_mfma_f32_16x16x32_bf16(Bt[n][k], At[m][k], acc[ai][bj][m][n], 0, 0, 0); __builtin_amdgcn_s_setprio(0); } while (0)
#define PG8_WAIT_V(n) asm volatile("s_waitcnt vmcnt(" #n ")" ::: "memory")
#define PG8_WAIT_L(n) asm volatile("s_waitcnt lgkmcnt(" #n ")" ::: "memory")
#define PG8_BAR __builtin_amdgcn_s_barrier()
#define PG8_SCHED __builtin_amdgcn_sched_barrier(0)
    Unit cur, nxt; int ui = 0;
    if (!S.next(0, cur)) return;
    f32x4 acc[2][2][4][2];
#pragma unroll
    for (int a = 0; a < 2; ++a)
#pragma unroll
        for (int b = 0; b < 2; ++b)
#pragma unroll
            for (int m = 0; m < 4; ++m)
#pragma unroll
                for (int n = 0; n < 2; ++n) acc[a][b][m][n] = (f32x4){0.f, 0.f, 0.f, 0.f};
    bf16x8 At[4][2], B0[2][2], B1[2][2];
    const char* cA = (const char*)g.A + (size_t)cur.pm * tstep; const char* cB = (const char*)g.Bt + (size_t)cur.pn * tstep;
    S.a_ready(cur);
    if constexpr (SP2) {
        PG8_STAGE(PG8_SB(0, 0), cB, voffB); PG8_STAGE(PG8_SB(0, 1), cB + hstep, voffB); PG8_STAGE(PG8_SA(0, 0), cA, voffA); PG8_STAGE(PG8_SA(0, 1), cA + hstep, voffA);
        if (wr == 1) PG8_BAR;
        PG8_WAIT_V(2); PG8_BAR;
        PG8_STAGE(PG8_SB(1, 0), cB + kstep, voffB); PG8_STAGE(PG8_SA(1, 0), cA + kstep, voffA); PG8_STAGE(PG8_SB(1, 1), cB + hstep + kstep, voffB);
        PG8_WAIT_V(6); PG8_BAR;
    } else {
        PG8_STAGE(PG8_SB(0, 0), cB, voffB); PG8_STAGE(PG8_SA(0, 0), cA, voffA); PG8_STAGE(PG8_SB(0, 1), cB + hstep, voffB); PG8_STAGE(PG8_SA(0, 1), cA + hstep, voffA);
        if (wr == 1) PG8_BAR;
        PG8_WAIT_V(4); PG8_BAR;
        PG8_STAGE(PG8_SB(1, 0), cB + kstep, voffB); PG8_STAGE(PG8_SA(1, 0), cA + kstep, voffA); PG8_STAGE(PG8_SB(1, 1), cB + hstep + kstep, voffB);
        PG8_WAIT_V(6); PG8_BAR;
    }
    for (;;) {
        const bool has_next = S.next(ui + 1, nxt);
        const char* nA = has_next ? (const char*)g.A + (size_t)nxt.pm * tstep : cA; const char* nB = has_next ? (const char*)g.Bt + (size_t)nxt.pn * tstep : cB;
        for (int t = 0; t < nt; t += 2) {
            const bool last = (t == nt - 2);
            const char* a1 = cA + (size_t)(t + 1) * kstep;
            const char* a2 = last ? nA : cA + (size_t)(t + 2) * kstep; const char* b2 = last ? nB : cB + (size_t)(t + 2) * kstep;
            const char* a3 = a2 + kstep; const char* b3 = b2 + kstep;
            if (last && has_next) S.a_ready(nxt);
            if constexpr (SP2) {
            PG8_LDB(B0, 0, 0); PG8_LDB(B1, 0, 1); PG8_SCHED; PG8_LDA(At, 0, 0); PG8_STAGE(PG8_SA(1, 1), a1 + hstep, voffA);
            PG8_WAIT_V(8); PG8_WAIT_L(0); PG8_BAR; PG8_MMA(0, 0, At, B0); PG8_MMA(0, 1, At, B1); PG8_BAR; PG8_SCHED;
            PG8_LDA(At, 0, 1); PG8_STAGE(PG8_SB(0, 0), b2, voffB); PG8_STAGE(PG8_SB(0, 1), b2 + hstep, voffB); PG8_STAGE(PG8_SA(0, 0), a2, voffA);
            PG8_WAIT_V(8); PG8_WAIT_L(0); PG8_BAR; PG8_MMA(1, 0, At, B0); PG8_MMA(1, 1, At, B1); PG8_BAR; PG8_SCHED;
            PG8_LDB(B0, 1, 0); PG8_LDB(B1, 1, 1); PG8_SCHED; PG8_LDA(At, 1, 0); PG8_STAGE(PG8_SA(0, 1), a2 + hstep, voffA);
            PG8_WAIT_V(8); PG8_WAIT_L(0); PG8_BAR; PG8_MMA(0, 0, At, B0); PG8_MMA(0, 1, At, B1); PG8_BAR; PG8_SCHED;
            PG8_LDA(At, 1, 1); PG8_STAGE(PG8_SB(1, 0), b3, voffB); PG8_STAGE(PG8_SB(1, 1), b3 + hstep, voffB); PG8_STAGE(PG8_SA(1, 0), a3, voffA);
            PG8_WAIT_V(8); PG8_WAIT_L(0); PG8_BAR; PG8_MMA(1, 0, At, B0); PG8_MMA(1, 1, At, B1); PG8_BAR; PG8_SCHED;
            } else {
            PG8_LDB(B0, 0, 0); PG8_SCHED; PG8_LDA(At, 0, 0); PG8_STAGE(PG8_SA(1, 1), a1 + hstep, voffA);
            PG8_WAIT_L(8); PG8_BAR; PG8_WAIT_L(0); PG8_MMA(0, 0, At, B0); PG8_BAR; PG8_SCHED;
            PG8_LDB(B1, 0, 1); PG8_STAGE(PG8_SB(0, 0), b2, voffB);
            PG8_BAR; PG8_WAIT_L(0); PG8_MMA(0, 1, At, B1); PG8_BAR;
            PG8_LDA(At, 0, 1); PG8_STAGE(PG8_SA(0, 0), a2, voffA);
            PG8_BAR; PG8_WAIT_L(0); PG8_MMA(1, 0, At, B0); PG8_BAR; PG8_SCHED;
            PG8_STAGE(PG8_SB(0, 1), b2 + hstep, voffB);
            PG8_WAIT_V(6); PG8_BAR; PG8_MMA(1, 1, At, B1); PG8_BAR;
            PG8_LDB(B0, 1, 0); PG8_SCHED; PG8_LDA(At, 1, 0); PG8_STAGE(PG8_SA(0, 1), a2 + hstep, voffA);
            PG8_WAIT_L(8); PG8_BAR; PG8_WAIT_L(0); PG8_MMA(0, 0, At, B0); PG8_BAR; PG8_SCHED;
            PG8_LDB(B1, 1, 1); PG8_STAGE(PG8_SB(1, 0), b3, voffB);
            PG8_BAR; PG8_WAIT_L(0); PG8_MMA(0, 1, At, B1); PG8_BAR;
            PG8_LDA(At, 1, 1); PG8_STAGE(PG8_SA(1, 0), a3, voffA);
            PG8_BAR; PG8_WAIT_L(0); PG8_MMA(1, 0, At, B0); PG8_BAR; PG8_SCHED;
            PG8_STAGE(PG8_SB(1, 1), b3 + hstep, voffB);
            PG8_WAIT_V(6); PG8_BAR; PG8_MMA(1, 1, At, B1); PG8_BAR;
            }
        }
        if constexpr (ALIGN_EPI) { if (wr == 0) PG8_BAR; }
        if constexpr (!Epi::AFTER_DRAIN) { E(acc, cur, wr, wc, fr, fq); S.done(cur); }
        if (!has_next) break;
#pragma unroll
        for (int a = 0; a < 2; ++a)
#pragma unroll
            for (int b = 0; b < 2; ++b)
#pragma unroll
                for (int m = 0; m < 4; ++m)
#pragma unroll
                    for (int n = 0; n < 2; ++n) acc[a][b][m][n] = (f32x4){0.f, 0.f, 0.f, 0.f};
        cur = nxt; cA = nA; cB = nB; ++ui;
        if constexpr (ALIGN_EPI) { if (wr == 1) PG8_BAR; }
    }
    PG8_WAIT_V(0);
    if constexpr (!ALIGN_EPI) { if (wr == 0) PG8_BAR; }
    PG8_BAR;
    if constexpr (Epi::AFTER_DRAIN) { E.fused(acc, cur, wr, wc, fr, fq, lds, wid, lane); S.done(cur); }
#undef PG8_SA
#undef PG8_SB
#undef PG8_STAGE
#undef PG8_LDA
#undef PG8_LDB
#undef PG8_MMA
#undef PG8_WAIT_V
#undef PG8_WAIT_L
#undef PG8_BAR
#undef PG8_SCHED
}
}
#include <hip/hip_bf16.h>
#include <cmath>
namespace attn_body {
using bf16=__hip_bfloat16;
using bf16x8=__attribute__((ext_vector_type(8)))short;
using s16x4=__attribute__((ext_vector_type(4)))short;
using f32x16=__attribute__((ext_vector_type(16)))float;
using u32x4=__attribute__((ext_vector_type(4)))unsigned;
constexpr int D=64,DM=512,OPITCH=1024;
constexpr int NW=8,QBLK=32,QB=QBLK*NW,KVBLK=64;
constexpr int ATTN_PITCH=DM, ATTN_UNIT_ROWS=QB;
__device__ __forceinline__ int crow(int r,int hi){return (r&3)+8*(r>>2)+4*hi;}
#define SBAR() __builtin_amdgcn_sched_barrier(0)
__device__ __forceinline__ void cmask(f32x16&p0,f32x16&p1,int jb,int qrel,int hi){
  const float NEG=-INFINITY; int kb=64*jb+4*hi;
  #pragma unroll
  for(int r=0;r<16;++r){int kv=kb+(r&3)+8*(r>>2); if(kv>qrel)p0[r]=NEG; if(kv+32>qrel)p1[r]=NEG;}
}

constexpr int NSLOT=3, SLOTB=8192;
constexpr int LDS_K=0, LDS_V=NSLOT*SLOTB, LDS_WS=2*NSLOT*SLOTB, LDS_OST=LDS_WS+NW*64*4, LDS_BYTES=LDS_OST+NW*4096;
constexpr float C2=0.125f*1.4426950408889634f;
__device__ __forceinline__ void glds16(const void*gsrc,unsigned lds_dst){unsigned keep;
  asm volatile("s_mov_b32 %0, m0\n\ts_mov_b32 m0, %2\n\ts_nop 0\n\tglobal_load_lds_dwordx4 %1, off\n\ts_mov_b32 m0, %0":"=&s"(keep):"v"(gsrc),"s"(lds_dst):"memory");}
__device__ __forceinline__ float max3f(float a,float b,float c){float r;asm("v_max3_f32 %0, %1, %2, %3":"=v"(r):"v"(a),"v"(b),"v"(c));return r;}
__device__ __forceinline__ float max2f(float a,float b){float r;asm("v_max_f32_e32 %0, %1, %2":"=v"(r):"v"(a),"v"(b));return r;}
__device__ __forceinline__ float fadd_s(float a,float b){float r;asm("v_add_f32_e32 %0, %1, %2":"=v"(r):"v"(a),"v"(b));return r;}
__device__ __forceinline__ float fsub_s(float a,float b){float r;asm("v_sub_f32_e32 %0, %1, %2":"=v"(r):"v"(a),"v"(b));return r;}
typedef float f32x2_t __attribute__((ext_vector_type(2))); typedef __bf16 bf16x2_t __attribute__((ext_vector_type(2)));
__device__ __forceinline__ unsigned cvtpk_s(float lo,float hi){f32x2_t v={lo,hi};bf16x2_t b=__builtin_convertvector(v,bf16x2_t);return __builtin_bit_cast(unsigned,b);}
#define WAIT_BAR(N) asm volatile("s_waitcnt vmcnt(" #N ") lgkmcnt(0)\n\ts_barrier":::"memory")

__device__ __forceinline__ void qkt(f32x16&p0,f32x16&p1,const char*Kslot,const bf16x8*qr,const f32x16&negm,int r32,int hi){
  const char*kb=Kslot+hi*1024+r32*16;
  #pragma unroll
  for(int d0=0;d0<4;++d0){
    const bf16x8 b0=*reinterpret_cast<const bf16x8*>(kb+d0*2048);
    const bf16x8 b1=*reinterpret_cast<const bf16x8*>(kb+d0*2048+512);
    if(d0==0){p0=__builtin_amdgcn_mfma_f32_32x32x16_bf16(b0,qr[0],negm,0,0,0);p1=__builtin_amdgcn_mfma_f32_32x32x16_bf16(b1,qr[0],negm,0,0,0);}
    else{p0=__builtin_amdgcn_mfma_f32_32x32x16_bf16(b0,qr[d0],p0,0,0,0);p1=__builtin_amdgcn_mfma_f32_32x32x16_bf16(b1,qr[d0],p1,0,0,0);}}
}
typedef __attribute__((address_space(3))) const char* lds_cptr;
typedef short v4i16_t __attribute__((ext_vector_type(4)));
__device__ __forceinline__ void kload8(bf16x8*kf,lds_cptr kp){
  kf[0]=*(const __attribute__((address_space(3))) bf16x8*)(kp);      kf[1]=*(const __attribute__((address_space(3))) bf16x8*)(kp+512);
  kf[2]=*(const __attribute__((address_space(3))) bf16x8*)(kp+2048); kf[3]=*(const __attribute__((address_space(3))) bf16x8*)(kp+2560);
  kf[4]=*(const __attribute__((address_space(3))) bf16x8*)(kp+4096); kf[5]=*(const __attribute__((address_space(3))) bf16x8*)(kp+4608);
  kf[6]=*(const __attribute__((address_space(3))) bf16x8*)(kp+6144); kf[7]=*(const __attribute__((address_space(3))) bf16x8*)(kp+6656);
}
__device__ __forceinline__ void kload2(bf16x8*kf,lds_cptr kp,int j){ kf[2*j]=*(const __attribute__((address_space(3))) bf16x8*)(kp+j*2048); kf[2*j+1]=*(const __attribute__((address_space(3))) bf16x8*)(kp+j*2048+512); }
__device__ __forceinline__ s16x4 vtr(lds_cptr p){ return __builtin_bit_cast(s16x4,__builtin_amdgcn_ds_read_tr16_b64_v4i16((__attribute__((address_space(3))) v4i16_t*)p)); }
__device__ __forceinline__ float rowmax(const f32x16&p0,const f32x16&p1){
  float a=max3f(p0[0],p0[1],p1[0]),b=max3f(p0[2],p0[3],p1[1]);a=max3f(a,p1[2],p1[3]);
  #pragma unroll
  for(int r=4;r<16;r+=4){a=max3f(a,p0[r],p0[r+1]);b=max3f(b,p0[r+2],p0[r+3]);a=max3f(a,p1[r],p1[r+1]);b=max3f(b,p1[r+2],p1[r+3]);}
  const float m=max2f(a,b);
  auto rr=__builtin_amdgcn_permlane32_swap(__float_as_uint(m),__float_as_uint(m),false,false);
  return max2f(__uint_as_float(rr[0]),__uint_as_float(rr[1]));
}
__device__ __forceinline__ void pv(f32x16*o,int vb,bf16x8 pa0,bf16x8 pa1,bf16x8 pa2,bf16x8 pa3){
  #pragma unroll
  for(int d0=0;d0<2;++d0){s16x4 lo[4],hi[4];
    #pragma unroll
    for(int ks=0;ks<4;++ks){
      asm volatile("ds_read_b64_tr_b16 %0,%1 offset:%c2":"=&v"(lo[ks]):"v"(vb),"i"(d0*4096+ks*1024):"memory");
      asm volatile("ds_read_b64_tr_b16 %0,%1 offset:%c2":"=&v"(hi[ks]):"v"(vb),"i"(d0*4096+ks*1024+512):"memory");}
    asm volatile("s_waitcnt lgkmcnt(0)":::"memory");SBAR();
    #define PK(k) (bf16x8){lo[k][0],lo[k][1],lo[k][2],lo[k][3],hi[k][0],hi[k][1],hi[k][2],hi[k][3]}
    o[d0]=__builtin_amdgcn_mfma_f32_32x32x16_bf16(pa0,PK(0),o[d0],0,0,0);
    o[d0]=__builtin_amdgcn_mfma_f32_32x32x16_bf16(pa1,PK(1),o[d0],0,0,0);
    o[d0]=__builtin_amdgcn_mfma_f32_32x32x16_bf16(pa2,PK(2),o[d0],0,0,0);
    o[d0]=__builtin_amdgcn_mfma_f32_32x32x16_bf16(pa3,PK(3),o[d0],0,0,0);
    #undef PK
  }
}

#ifndef ATTN_STORE16
#define ATTN_STORE16(p,v) (*(u32x4*)(p)=(v))
#endif
template<int THRL> __device__ __forceinline__ void attn_unit(const bf16*Qu,const bf16*__restrict__ Kh,const bf16*__restrict__ Vh,bf16*Ou,const int NT,char*shm){
  const int tid=threadIdx.x,lane=tid&63,r32=lane&31,hi=lane>>5; const int wid=__builtin_amdgcn_readfirstlane(tid>>6);
  const bf16*Qw=Qu+(long)(wid*QBLK)*DM;
  const unsigned lds0=(unsigned)(uintptr_t)shm;
  float*wsf=(float*)(shm+LDS_WS)+wid*64;
  const bf16*ksrc=Kh+(long)lane*DM+wid*8;
  const bf16*vsrc=Vh+(long)(16*(wid&3)+(lane>>2))*DM+(wid>>2)*32+(lane&3)*8;
  const unsigned kdst=lds0+LDS_K+wid*1024, vdst=lds0+LDS_V+wid*1024;
  #define DMA_K(t,slot) glds16(ksrc+(long)(t)*KVBLK*DM,(unsigned)__builtin_amdgcn_readfirstlane(kdst+(slot)))
  #define DMA_V(t,slot) glds16(vsrc+(long)(t)*KVBLK*DM,(unsigned)__builtin_amdgcn_readfirstlane(vdst+(slot)))
  const int vb0=(int)(lds0+LDS_V)+((lane>>4)&1)*32+(lane&3)*8+(4*hi+((lane&15)>>2))*64;
  const char*Kbase=shm+LDS_K; bf16x8 kf[8];
  const lds_cptr shm3=(lds_cptr)shm; const lds_cptr kp0=shm3+LDS_K+hi*1024+r32*16; const lds_cptr vp0=shm3+LDS_V+((lane>>4)&1)*32+(lane&3)*8+(4*hi+((lane&15)>>2))*64;
  DMA_K(0,0);DMA_V(0,0);DMA_K(1,SLOTB);
  bf16x8 qr[4];
  #pragma unroll
  for(int d0=0;d0<4;++d0)qr[d0]=*reinterpret_cast<const bf16x8*>(&Qw[(long)r32*DM+d0*16+hi*8]);
  float mhat=0.f,l_reg=0.f;f32x16 o[2];o[0]=f32x16{};o[1]=f32x16{};f32x16 negm=f32x16{};asm volatile("":"+v"(negm));
  #define CMASK(P0,P1,t) do{}while(0)
  bool resc=false;
  #define START(P0,P1) do{ const float rm=rowmax(P0,P1); resc=false; \
    { const float dl=rm; mhat=fadd_s(mhat,dl); \
      _Pragma("unroll") for(int r=0;r<16;++r){P0[r]=fsub_s(P0[r],dl);P1[r]=fsub_s(P1[r],dl);} \
      _Pragma("unroll") for(int r=0;r<16;++r)negm[r]=-mhat; asm volatile("":"+v"(negm)); } \
    _Pragma("unroll") for(int r=0;r<16;++r)P0[r]=__builtin_amdgcn_exp2f(P0[r]); }while(0)
  #define RESC() do{ if(resc){ asm volatile("s_waitcnt lgkmcnt(0)":::"memory"); \
      _Pragma("unroll") for(int d_=0;d_<2;++d_) _Pragma("unroll") for(int r=0;r<16;++r)o[d_][r]*=wsf[crow(r,hi)]; } }while(0)
  f32x16 pA0,pA1,pB0,pB1;
  int sl_prev=0,sl_cur=0,sl_next=SLOTB;
  #define ROT() do{sl_prev=sl_cur;sl_cur=sl_next;sl_next=(sl_next==(NSLOT-1)*SLOTB)?0:sl_next+SLOTB;}while(0)
  DMA_K(2,2*SLOTB);
  WAIT_BAR(3);
  qkt(pA0,pA1,Kbase,qr,negm,r32,hi);asm volatile("s_nop 15\n\ts_nop 7":"+v"(pA0),"+v"(pA1));CMASK(pA0,pA1,0);
  START(pA0,pA1);
  _Pragma("unroll") for(int r=0;r<16;++r)pA1[r]=__builtin_amdgcn_exp2f(pA1[r]);
  WAIT_BAR(0);
  DMA_K(3,0);DMA_V(1,SLOTB);
  ROT();
  kload8(kf,kp0+sl_cur);
  WAIT_BAR(2);
  s16x4 vlo[8],vhi[8]; u32x4 pw0,pw1,pw2,pw3;
  #define PKW(P,B) cvtpk_s(P[B],P[B+1])
  #define PAF(k) __builtin_bit_cast(bf16x8,pw##k)
  #define VFR(i) (bf16x8){vlo[i][0],vlo[i][1],vlo[i][2],vlo[i][3],vhi[i][0],vhi[i][1],vhi[i][2],vhi[i][3]}
  #define PIN(x) asm volatile("":"+v"(x))
  #define MX3(a,b,c) __builtin_fmaxf(__builtin_fmaxf((a),(b)),(c))
  #define GAPA(MF,A0,A1,A2,A3,W0,W1,PW) do{ MF; sacc+=A0; sacc+=A1; sacc+=A2; sacc+=A3; PIN(sacc); W0; W1; PIN(PW); SBAR(); }while(0)
  #define EX(v) __builtin_amdgcn_exp2f(v)
  #define GAPB(MF,X,B) do{ MF; X[B]=EX(X[B]); X[B+1]=EX(X[B+1]); X[B+2]=EX(X[B+2]); X[B+3]=EX(X[B+3]); PIN(X); SBAR(); }while(0)
  #define VRD(i) do{ vlo[i]=vtr(vp_+(((i)>>2)*4096+((i)&3)*1024)); vhi[i]=vtr(vp_+(((i)>>2)*4096+((i)&3)*1024+512)); }while(0)
  #define KRD(G,j) do{ if(G){ kload2(kf,kp0+sl_next,j); SBAR(); } }while(0)
  #define STEP(C0,C1,P0,P1,t,GK,GV,GL) do{ SBAR(); \
    const lds_cptr vp_=vp0+sl_prev; \
    VRD(0); SBAR(); float sacc=(P0[0]+P0[1]); \
    GAPA(C0=__builtin_amdgcn_mfma_f32_32x32x16_bf16(kf[0],qr[0],negm,0,0,0), P0[2],P0[3],P0[4],P0[5],     pw0[0]=PKW(P0,0), pw0[1]=PKW(P0,2), pw0); \
    VRD(4); SBAR(); GAPA(C1=__builtin_amdgcn_mfma_f32_32x32x16_bf16(kf[1],qr[0],negm,0,0,0), P0[6],P0[7],P0[8],P0[9],     pw0[2]=PKW(P0,4), pw0[3]=PKW(P0,6), pw0); \
    VRD(1); SBAR(); GAPA(C0=__builtin_amdgcn_mfma_f32_32x32x16_bf16(kf[2],qr[1],C0,0,0,0),   P0[10],P0[11],P0[12],P0[13], pw1[0]=PKW(P0,8), pw1[1]=PKW(P0,10), pw1); \
    VRD(5); SBAR(); GAPA(C1=__builtin_amdgcn_mfma_f32_32x32x16_bf16(kf[3],qr[1],C1,0,0,0),   P0[14],P0[15],P1[0],P1[1],   pw1[2]=PKW(P0,12),pw1[3]=PKW(P0,14), pw1); \
    VRD(2); SBAR(); GAPA(C0=__builtin_amdgcn_mfma_f32_32x32x16_bf16(kf[4],qr[2],C0,0,0,0),   P1[2],P1[3],P1[4],P1[5],     pw2[0]=PKW(P1,0), pw2[1]=PKW(P1,2), pw2); \
    VRD(6); SBAR(); GAPA(C1=__builtin_amdgcn_mfma_f32_32x32x16_bf16(kf[5],qr[2],C1,0,0,0),   P1[6],P1[7],P1[8],P1[9],     pw2[2]=PKW(P1,4), pw2[3]=PKW(P1,6), pw2); \
    VRD(3); SBAR(); GAPA(C0=__builtin_amdgcn_mfma_f32_32x32x16_bf16(kf[6],qr[3],C0,0,0,0),   P1[10],P1[11],P1[12],P1[13], pw3[0]=PKW(P1,8), pw3[1]=PKW(P1,10), pw3); \
    VRD(7); SBAR(); GAPA(C1=__builtin_amdgcn_mfma_f32_32x32x16_bf16(kf[7],qr[3],C1,0,0,0),   P1[14],P1[15],0.f,0.f,       pw3[2]=PKW(P1,12),pw3[3]=PKW(P1,14), pw3); \
    l_reg+=sacc; \
    if(GK){DMA_K((t)+3,sl_cur);} if(GV){DMA_V((t)+1,sl_next);} \
    CMASK(C0,C1,t); \
    { float a=MX3(C0[0],C0[1],C1[0]),b=MX3(C0[2],C0[3],C1[1]); a=MX3(a,C1[2],C1[3]); \
      _Pragma("unroll") for(int r=4;r<16;r+=4){a=MX3(a,C0[r],C0[r+1]);b=MX3(b,C0[r+2],C0[r+3]);a=MX3(a,C1[r],C1[r+1]);b=MX3(b,C1[r+2],C1[r+3]);} \
      float rm=__builtin_fmaxf(a,b); { auto rr=__builtin_amdgcn_permlane32_swap(__float_as_uint(rm),__float_as_uint(rm),false,false); rm=__builtin_fmaxf(__uint_as_float(rr[0]),__uint_as_float(rr[1])); } \
      resc=false; \
      if(__builtin_expect(__any(rm>(float)THRL),0)){ const float dl=__builtin_fmaxf(rm,0.f); mhat+=dl; \
        _Pragma("unroll") for(int r=0;r<16;++r){C0[r]-=dl;C1[r]-=dl;} \
        _Pragma("unroll") for(int r=0;r<16;++r)negm[r]=-mhat; asm volatile("":"+v"(negm)); \
        const float f=__builtin_amdgcn_exp2f(-dl); l_reg*=f; if(hi==0)wsf[r32]=f; resc=true; } } \
    SBAR(); \
    GAPB(o[0]=__builtin_amdgcn_mfma_f32_32x32x16_bf16(PAF(0),VFR(0),o[0],0,0,0), C0,0); \
    GAPB(o[1]=__builtin_amdgcn_mfma_f32_32x32x16_bf16(PAF(0),VFR(4),o[1],0,0,0), C0,4); \
    KRD(GL,0); GAPB(o[0]=__builtin_amdgcn_mfma_f32_32x32x16_bf16(PAF(1),VFR(1),o[0],0,0,0), C0,8); \
    KRD(GL,1); GAPB(o[1]=__builtin_amdgcn_mfma_f32_32x32x16_bf16(PAF(1),VFR(5),o[1],0,0,0), C0,12); \
    KRD(GL,2); GAPB(o[0]=__builtin_amdgcn_mfma_f32_32x32x16_bf16(PAF(2),VFR(2),o[0],0,0,0), C1,0); \
    KRD(GL,3); GAPB(o[1]=__builtin_amdgcn_mfma_f32_32x32x16_bf16(PAF(2),VFR(6),o[1],0,0,0), C1,4); \
    GAPB(o[0]=__builtin_amdgcn_mfma_f32_32x32x16_bf16(PAF(3),VFR(3),o[0],0,0,0), C1,8); \
    GAPB(o[1]=__builtin_amdgcn_mfma_f32_32x32x16_bf16(PAF(3),VFR(7),o[1],0,0,0), C1,12); \
    }while(0)
  int t=1;
  #undef CMASK
  #define CMASK(P0,P1,t) do{}while(0)
  for(;t+5<NT;t+=2){
    STEP(pB0,pB1,pA0,pA1,t,true,true,true);     WAIT_BAR(2); RESC(); ROT();
    STEP(pA0,pA1,pB0,pB1,t+1,true,true,true);   WAIT_BAR(2); RESC(); ROT();
  }
  #undef CMASK
  #define CMASK(P0,P1,t) do{}while(0)
  #define ENDW(tt) do{ if((tt)+3<NT){WAIT_BAR(2);} else if((tt)+2<NT){WAIT_BAR(1);} else {WAIT_BAR(0);} }while(0)
  for(;t+1<NT;t+=2){
    STEP(pB0,pB1,pA0,pA1,t,(t+3<NT),(t+1<NT),(t+1<NT));       ENDW(t);   RESC(); ROT();
    STEP(pA0,pA1,pB0,pB1,t+1,(t+4<NT),(t+2<NT),(t+2<NT));     ENDW(t+1); RESC(); ROT();
  }
  STEP(pB0,pB1,pA0,pA1,NT-1,false,false,false); RESC();
  { float sacc=pB0[0]+pB0[1]; _Pragma("unroll") for(int r=2;r<16;++r)sacc+=pB0[r]; _Pragma("unroll") for(int r=0;r<16;++r)sacc+=pB1[r]; l_reg+=sacc;
    pw0=(u32x4){PKW(pB0,0),PKW(pB0,2),PKW(pB0,4),PKW(pB0,6)};pw1=(u32x4){PKW(pB0,8),PKW(pB0,10),PKW(pB0,12),PKW(pB0,14)};pw2=(u32x4){PKW(pB1,0),PKW(pB1,2),PKW(pB1,4),PKW(pB1,6)};pw3=(u32x4){PKW(pB1,8),PKW(pB1,10),PKW(pB1,12),PKW(pB1,14)};
    SBAR(); pv(o,vb0+sl_cur,PAF(0),PAF(1),PAF(2),PAF(3)); }
  #undef PKW
  #undef PAF
  #undef VFR
  #undef PIN
  #undef MX3
  #undef GAPA
  #undef GAPB
  #undef EX
  #undef VRD
  #undef KRD
  #undef STEP
  #undef ENDW
  {auto rr=__builtin_amdgcn_permlane32_swap(__float_as_uint(l_reg),__float_as_uint(l_reg),false,false);l_reg=__uint_as_float(rr[0])+__uint_as_float(rr[1]);}
  if(hi==0)wsf[32+r32]=l_reg;asm volatile("s_waitcnt lgkmcnt(0)":::"memory");
  float rli[16];
  #pragma unroll
  for(int r=0;r<16;++r)rli[r]=__builtin_amdgcn_rcpf(wsf[32+crow(r,hi)]);
  bf16*Ow=Ou+(long)(wid*QBLK)*OPITCH;
  { bf16*stg=(bf16*)(shm+LDS_OST)+wid*2048;
    #pragma unroll
    for(int r=0;r<16;++r){const int orow=crow(r,hi);
      #pragma unroll
      for(int d0=0;d0<2;++d0)stg[orow*64+d0*32+r32]=__float2bfloat16(o[d0][r]*rli[r]);}
    asm volatile("s_waitcnt lgkmcnt(0)":::"memory");
    #pragma unroll
    for(int i=0;i<4;++i){const int row=i*8+(lane>>3),ch=lane&7; const u32x4 v=*(const u32x4*)(stg+row*64+ch*8); ATTN_STORE16(Ow+(long)row*OPITCH+ch*8,v);} }
  asm volatile("s_waitcnt lgkmcnt(0)\n\ts_barrier":::"memory");
  #undef DMA_K
  #undef DMA_V
  #undef CMASK
  #undef START
  #undef RESC
  #undef ROT
}
constexpr int ATTN_LDS_BYTES=LDS_BYTES;
#undef SBAR
#undef WAIT_BAR
}
#define GAS __attribute__((address_space(1)))
#define LAS __attribute__((address_space(3)))
typedef unsigned short bf16;
typedef unsigned v4u __attribute__((ext_vector_type(4)));
typedef unsigned v2u __attribute__((ext_vector_type(2)));
typedef float f32x4 __attribute__((ext_vector_type(4)));
#define LDS_WAIT() asm volatile("s_waitcnt lgkmcnt(0)" ::: "memory")

constexpr int DM_ = 2048, SEQ_ = 8192, CTXL = 256, MROWS = SEQ_ + CTXL;
constexpr int NIN = 13888, NINP = 14080, DFF = 5632;
constexpr int ZP = NINP;
constexpr int C_GQ = 0, C_GK = 512, C_GV = 1024, C_GLR = 1536, C_GG = 1568, C_DQ = 2080, C_DK = 2592, C_DV = 3104,
              C_EQ = 3616, C_EA = 6688, C_EB = 6704, C_EG = 6720, C_MG = 7744;
constexpr size_t MiB = 1u << 20;
constexpr size_t WS_MOD = 0;
constexpr size_t WS_BAR = 512 * 1024, BAR_BYTES = 16384;
constexpr int MISC_OFF = 147456 - 256;
constexpr size_t WS_CNT = WS_BAR + 14336;
constexpr size_t WS_W0 = 1 * MiB, W_LAYER = 137 * MiB;
constexpr size_t WO_IN = 0, WO_UA = 55 * MiB, WO_UD = 57 * MiB, WO_UE = 59 * MiB, WO_O = 63 * MiB, WO_13 = 71 * MiB, WO_2 = 115 * MiB;
constexpr size_t WS_X = WS_W0 + 2 * W_LAYER;
constexpr size_t WS_H = WS_X + 66 * MiB;
constexpr size_t WS_Z = WS_H + 33 * MiB;
constexpr size_t WS_ZG = WS_Z + 227 * MiB;
constexpr size_t WS_AQ = WS_ZG + 3 * MiB, WS_AK = WS_AQ + 9 * MiB, WS_AV = WS_AK + 9 * MiB, WS_AO = WS_AV + 9 * MiB;
constexpr size_t WS_DQ = WS_AO + 17 * MiB, WS_DK = WS_DQ + 17 * MiB, WS_DV = WS_DK + 17 * MiB, WS_DGB = WS_DV + 17 * MiB;
constexpr size_t WS_A = WS_DGB + 2 * MiB, WS_D = WS_A + 9 * MiB, WS_E = WS_D + 9 * MiB;
constexpr size_t WS_R2 = WS_E + 17 * MiB;
constexpr size_t WS_YB = WS_R2 + 66 * MiB;
constexpr size_t WS_END = WS_YB + 33 * MiB;
constexpr size_t WS_HFF = WS_Z;

constexpr int LDS_BYTES = 147456;
constexpr int NPH = 24;

typedef float pk_f32x2 __attribute__((ext_vector_type(2))); typedef __bf16 pk_bf16x2 __attribute__((ext_vector_type(2)));
__device__ __forceinline__ unsigned pk2(float lo, float hi) { const pk_f32x2 v = {lo, hi}; const pk_bf16x2 b = __builtin_convertvector(v, pk_bf16x2); return __builtin_bit_cast(unsigned, b); }
__device__ __forceinline__ unsigned f2bf(float f) { return pk2(f, 0.f) & 0xffffu; }
__device__ __forceinline__ float bf2f(unsigned short b) { return __builtin_bit_cast(float, (unsigned)b << 16); }
__device__ __forceinline__ float bflo(unsigned w) { return __builtin_bit_cast(float, w << 16); }
__device__ __forceinline__ float bfhi(unsigned w) { return __builtin_bit_cast(float, w & 0xffff0000u); }
__device__ __forceinline__ float wave_sum(float v) {
#pragma unroll
    for (int o = 1; o < 64; o <<= 1) v += __shfl_xor(v, o);
    return v;
}
__device__ __forceinline__ float sigmoidf_(float x) { return __builtin_amdgcn_rcpf(1.0f + __expf(-x)); }
__device__ __forceinline__ float siluf_(float x) { return x * __builtin_amdgcn_rcpf(1.0f + __expf(-x)); }

struct Args { const float* in[27]; float* out; unsigned char* ws; int ph_lo, ph_hi; };

struct Frame {
    LAS unsigned char* lds;
    int tid, lane, wave, G, bid;
    unsigned char* ws; float* out;
};

#define XB_TMO      128
#define XB_XCNT(j)  (256  + 64 * (j))
#define XB_XSUB(j)  (1280 + 64 * (j))
#define XB_XGEN(j)  (2304 + 64 * (j))
#define XB_TOP      3328
#define XB_TOPGEN   3392
#define XCD_BAR_WORDS 3456
#define XB_SPIN_CAP (1u << 18)

__device__ __forceinline__ unsigned xb_ld(unsigned* p)              { return __hip_atomic_load(p, __ATOMIC_RELAXED, __HIP_MEMORY_SCOPE_AGENT); }
__device__ __forceinline__ unsigned xb_add(unsigned* p, unsigned v) { return __hip_atomic_fetch_add(p, v, __ATOMIC_RELAXED, __HIP_MEMORY_SCOPE_AGENT); }
__device__ __forceinline__ unsigned xb_xcc_id() { return (unsigned)__builtin_amdgcn_s_getreg((3 << 11) | 20) & 0xFu; }
#define XB_SPIN(cond, bar) do { unsigned _sp = 0; while (cond) { __builtin_amdgcn_s_sleep(1); \
    if ((++_sp & 255u) == 0u) { if (xb_ld(&(bar)[XB_TMO])) break; if (_sp > XB_SPIN_CAP) { atomicAdd(&(bar)[XB_TMO], 1u); break; } } } } while (0)

struct XcdBarrier {
    unsigned* bar; unsigned x;
    volatile LAS unsigned* st;
};

__device__ __forceinline__ XcdBarrier xcd_barrier_post(unsigned* bar, volatile LAS unsigned* st) {
    XcdBarrier b; b.bar = bar; b.x = xb_xcc_id(); b.st = st;
    if (threadIdx.x == 0) (void)xb_add(&bar[XB_XCNT(b.x)], 1u);
    return b;
}
__device__ __forceinline__ void xcd_barrier_complete(unsigned* bar, unsigned x, unsigned& nloc, unsigned& nx) {
    const unsigned G = gridDim.x * gridDim.y * gridDim.z;
    unsigned sum, cnt, mine, sp = 0u;
    for (;;) {
        sum = 0u; cnt = 0u; mine = 0u;
#pragma unroll
        for (unsigned j = 0; j < 16; ++j) { const unsigned c = xb_ld(&bar[XB_XCNT(j)]); sum += c; cnt += (c > 0u) ? 1u : 0u; mine = (j == x) ? c : mine; }
        if (sum == G) break;
        __builtin_amdgcn_s_sleep(1);
        if ((++sp & 255u) == 0u) { if (xb_ld(&bar[XB_TMO])) break; if (sp > XB_SPIN_CAP) { atomicAdd(&bar[XB_TMO], 1u); break; } }
    }
    nloc = mine > 0u ? mine : 1u; nx = cnt > 0u ? cnt : 1u;
}

__device__ __forceinline__ void xcd_barrier(const XcdBarrier& b) {
    asm volatile("s_waitcnt vmcnt(0)" ::: "memory");
    __syncthreads();
    if (threadIdx.x == 0) {
        unsigned* bar = b.bar;
        __builtin_amdgcn_s_waitcnt(0);
        unsigned nloc = b.st[0], nx = b.st[1];
        if (nloc == 0u) { xcd_barrier_complete(bar, b.x, nloc, nx); b.st[0] = nloc; b.st[1] = nx; }
        const unsigned old = xb_add(&bar[XB_XSUB(b.x)], 1u);
        const unsigned gen = old / nloc;
        if (old + 1u == (gen + 1u) * nloc) {
            __builtin_amdgcn_fence(__ATOMIC_RELEASE, "agent");
            asm volatile("s_waitcnt vmcnt(0)" ::: "memory");
            const unsigned og = xb_add(&bar[XB_TOP], 1u);
            const unsigned tg = og / nx;
            if (og + 1u == (tg + 1u) * nx) xb_add(&bar[XB_TOPGEN], 1u);
            else XB_SPIN(xb_ld(&bar[XB_TOPGEN]) == tg, bar);
            __builtin_amdgcn_fence(__ATOMIC_ACQUIRE, "agent");
            xb_add(&bar[XB_XGEN(b.x)], 1u);
            asm volatile("s_waitcnt vmcnt(0)" ::: "memory");
        } else {
            XB_SPIN(xb_ld(&bar[XB_XGEN(b.x)]) == gen, bar);
            __builtin_amdgcn_fence(__ATOMIC_ACQUIRE, "agent");
            asm volatile("s_waitcnt vmcnt(0)" ::: "memory");
        }
    }
    __syncthreads();
}

__device__ __forceinline__ void p0_transpose_item(const float* W, int K, int N, bf16* WT, int k0, int n0, int drow, LAS float* scr, int lane) {
#pragma unroll 8
    for (int i = 0; i < 32; ++i) { const int kk = 2 * i + (lane >> 5); scr[kk * 33 + (lane & 31)] = __builtin_nontemporal_load(W + (size_t)(k0 + kk) * N + n0 + (lane & 31)); }
    LDS_WAIT(); asm volatile("" ::: "memory");
    const int c = lane & 7;
#pragma unroll
    for (int j = 0; j < 4; ++j) { const int n = (lane >> 3) + 8 * j; const LAS float* s = scr + (8 * c) * 33 + n;
        v4u o; o.x = pk2(s[0 * 33], s[1 * 33]); o.y = pk2(s[2 * 33], s[3 * 33]); o.z = pk2(s[4 * 33], s[5 * 33]); o.w = pk2(s[6 * 33], s[7 * 33]);
        *(v4u*)(WT + (size_t)(drow + n) * K + k0 + 8 * c) = o; }
    LDS_WAIT(); asm volatile("" ::: "memory");
}
__device__ __forceinline__ void tr_plain(const float* W, int K, int N, bf16* WT, int item, LAS float* scr, int lane) {
    const int nblk = N / 32, kb = item / nblk, nb = item % nblk;
    p0_transpose_item(W, K, N, WT, 64 * kb, 32 * nb, 32 * nb, scr, lane);
}
__device__ __forceinline__ void tr_ffn13(const float* W, bf16* WT, int item, int which, LAS float* scr, int lane) {
    const int nblk = DFF / 32, kb = item / nblk, nb = item % nblk, n0 = 32 * nb;
    p0_transpose_item(W, DM_, DFF, WT, 64 * kb, n0, 256 * (n0 >> 7) + (n0 & 127) + 128 * which, scr, lane);
}
constexpr int I_IN = 32 * (NIN / 32), I_UA = 8 * 64, I_UE = 16 * 64, I_O = 32 * 64, I_F = 32 * (DFF / 32), I_2 = (DFF / 64) * 64;
constexpr int PER_L = I_IN + 2 * I_UA + I_UE + I_O + 2 * I_F + I_2;
__device__ __forceinline__ void p0_item(Frame& F, const Args& A, const int l, int r, LAS float* scr) {
    unsigned char* wb = F.ws + WS_W0;
    if (r < I_IN) { tr_plain(A.in[10] + (size_t)l * DM_ * NIN, DM_, NIN, (bf16*)(wb + WO_IN), r, scr, F.lane); return; } r -= I_IN;
    if (r < I_UA) { tr_plain(A.in[20] + (size_t)l * 512 * DM_, 512, DM_, (bf16*)(wb + WO_UA), r, scr, F.lane); return; } r -= I_UA;
    if (r < I_UA) { tr_plain(A.in[21] + (size_t)l * 512 * DM_, 512, DM_, (bf16*)(wb + WO_UD), r, scr, F.lane); return; } r -= I_UA;
    if (r < I_UE) { tr_plain(A.in[22] + (size_t)l * 1024 * DM_, 1024, DM_, (bf16*)(wb + WO_UE), r, scr, F.lane); return; } r -= I_UE;
    if (r < I_O) { tr_plain(A.in[23] + (size_t)l * DM_ * DM_, DM_, DM_, (bf16*)(wb + WO_O), r, scr, F.lane); return; } r -= I_O;
    if (r < I_F) { tr_ffn13(A.in[24] + (size_t)l * DM_ * DFF, (bf16*)(wb + WO_13), r, 0, scr, F.lane); return; } r -= I_F;
    if (r < I_F) { tr_ffn13(A.in[25] + (size_t)l * DM_ * DFF, (bf16*)(wb + WO_13), r, 1, scr, F.lane); return; } r -= I_F;
    tr_plain(A.in[26] + (size_t)l * DFF * DM_, DFF, DM_, (bf16*)(wb + WO_2), r, scr, F.lane);
}
__device__ __forceinline__ void p0_dynamic(Frame& F, const Args& A, const int l, unsigned* cnt, const int lo_, const int hi) {
    LAS float* scr = (LAS float*)(F.lds + F.wave * 16384);
    volatile LAS unsigned* slot = (volatile LAS unsigned*)(F.lds + MISC_OFF) + 16;
    for (;;) {
        if (F.tid == 0) slot[0] = __hip_atomic_fetch_add(cnt, 64u, __ATOMIC_RELAXED, __HIP_MEMORY_SCOPE_AGENT);
        __syncthreads();
        const int base = lo_ + (int)slot[0];
        __syncthreads();
        if (base >= hi) break;
        for (int k = 0; k < 8; ++k) { const int it = base + F.wave * 8 + k; if (it < hi) p0_item(F, A, l, it, scr); }
    }
}
__device__ __forceinline__ void p0_phase(Frame& F, const Args& A, const int l, const bool gemv, const int ilo, const int ihi) {
    LAS float* scr = (LAS float*)(F.lds + F.wave * 16384);
    const int gw = F.bid * 8 + F.wave, NGW = F.G * 8;
    for (int it = ilo + gw; it < ilo + (ihi - ilo) * REP_P0; it += NGW) p0_item(F, A, l, ilo + (it - ilo) % (ihi - ilo), scr);
    __syncthreads();
    if (!gemv) return;
    LAS float* red = (LAS float*)F.lds;
    const float* cl = A.in[1]; const float* cc = A.in[3];
    for (int it = F.bid; it < 2 * 192; it += F.G) {
        const int lg = it / 192, jb = it % 192, kg = F.tid >> 4, jl = F.tid & 15;
        const float* wp = A.in[4] + ((size_t)lg * DM_ + kg * 64) * 12288 + jb * 64 + jl * 4;
        f32x4 al = {0.f, 0.f, 0.f, 0.f}, ac = {0.f, 0.f, 0.f, 0.f};
#pragma unroll 8
        for (int kk = 0; kk < 64; ++kk) {
            const f32x4 w = __builtin_nontemporal_load((const f32x4*)(wp + (size_t)kk * 12288));
            const float sl = siluf_(cl[kg * 64 + kk]), sc = siluf_(cc[kg * 64 + kk]);
            al += w * sl; ac += w * sc;
        }
        LAS float* rp = red + (kg * 16 + jl) * 8;
        rp[0] = al.x; rp[1] = al.y; rp[2] = al.z; rp[3] = al.w; rp[4] = ac.x; rp[5] = ac.y; rp[6] = ac.z; rp[7] = ac.w;
        __syncthreads();
        if (F.tid < 128) {
            const int j2 = F.tid & 15, comp = F.tid >> 4; float s = 0.f;
            for (int g = 0; g < 32; ++g) s += red[(g * 16 + j2) * 8 + comp];
            const int sidx = comp >> 2, col = jb * 64 + j2 * 4 + (comp & 3);
            ((float*)(F.ws + WS_MOD))[(size_t)(lg * 2 + sidx) * 12288 + col] = s + A.in[5][(size_t)lg * 12288 + col];
        }
        __syncthreads();
    }
}

template <int MODE> __device__ __forceinline__ void row_phase(Frame& F, const Args& A, int l) {
    const int gw = F.bid * 8 + F.wave, NGW = F.G * 8;
    float* X = (float*)(F.ws + WS_X); const bf16* Y2 = (const bf16*)(F.ws + WS_R2); bf16* H = (bf16*)(F.ws + WS_H);
    const float* MOD = (const float*)(F.ws + WS_MOD);
    for (int r = gw + ((MODE >= 1 && l == 1) ? CTXL : 0); r < MROWS; r += NGW) {
        const int s = r < CTXL ? 1 : 0;
        const float* mod = MOD + (size_t)(l * 2 + s) * 12288;
        f32x4 v[8];
        if (MODE == 0) {
            const float* src = s ? A.in[2] + (size_t)r * DM_ : A.in[0] + (size_t)(r - CTXL) * DM_;
#pragma unroll
            for (int j = 0; j < 8; ++j) v[j] = *(const f32x4*)(src + (F.lane + 64 * j) * 4);
        } else {
            const bf16* y = Y2 + (size_t)r * DM_; float ss = 0.f;
            const float* w = (MODE == 1 ? A.in[7] : A.in[9]) + (size_t)l * DM_;
            const float* gate = mod + (MODE == 1 ? 2 : 5) * DM_;
            f32x4 xv[8], wv[8], gv[8];
#pragma unroll
            for (int j = 0; j < 8; ++j) { const int c = (F.lane + 64 * j) * 4; { const v2u yy = *(const v2u*)(y + c); v[j] = (f32x4){bflo(yy.x), bfhi(yy.x), bflo(yy.y), bfhi(yy.y)}; } xv[j] = *(const f32x4*)(((MODE == 1 && l == 0 && !s) ? A.in[0] + (size_t)(r - CTXL) * DM_ : (const float*)X + (size_t)r * DM_) + c); wv[j] = *(const f32x4*)(w + c); gv[j] = *(const f32x4*)(gate + c); }
#pragma unroll
            for (int j = 0; j < 8; ++j) ss += v[j].x * v[j].x + v[j].y * v[j].y + v[j].z * v[j].z + v[j].w * v[j].w;
            const float rs = __builtin_amdgcn_rsqf(wave_sum(ss) * (1.0f / DM_) + 1e-6f);
#pragma unroll
            for (int j = 0; j < 8; ++j) v[j] = xv[j] + gv[j] * (v[j] * rs * wv[j]);
        }
        if (MODE == 2 && l == 1) {
            if (!s) {
#pragma unroll
                for (int j = 0; j < 8; ++j) *(f32x4*)(F.out + (size_t)(r - CTXL) * DM_ + (F.lane + 64 * j) * 4) = v[j];
            }
            continue;
        }
        float ss = 0.f;
        const float* wn = (MODE == 0 ? A.in[6] : MODE == 1 ? A.in[8] + (size_t)l * DM_ : A.in[6] + (size_t)(l + 1) * DM_);
        const float* modn = (MODE == 2) ? MOD + (size_t)((l + 1) * 2 + s) * 12288 : mod;
        const float* sh = modn + (MODE == 1 ? 3 : 0) * DM_; const float* sc = sh + DM_;
#pragma unroll
        for (int j = 0; j < 8; ++j) { if (MODE != 0 || s) *(f32x4*)(X + (size_t)r * DM_ + (F.lane + 64 * j) * 4) = v[j]; ss += v[j].x * v[j].x + v[j].y * v[j].y + v[j].z * v[j].z + v[j].w * v[j].w; }
        const float rs2 = __builtin_amdgcn_rsqf(wave_sum(ss) * (1.0f / DM_) + 1e-6f);
#pragma unroll
        for (int j = 0; j < 8; ++j) { const int c = (F.lane + 64 * j) * 4;
            const f32x4 wv = *(const f32x4*)(wn + c), shv = *(const f32x4*)(sh + c), scv = *(const f32x4*)(sc + c);
            const f32x4 h = (v[j] * rs2 * wv) * (1.0f + scv) + shv;
            v2u o; o.x = pk2(h.x, h.y); o.y = pk2(h.z, h.w);
            *(v2u*)(H + (size_t)r * DM_ + c) = o; }
    }
}
__device__ __forceinline__ void prep_phase(Frame& F, const Args& A, int l) {
    const int gw = F.bid * 8 + F.wave, NGW = F.G * 8, lane = F.lane;
    const bf16* Z = (const bf16*)(F.ws + WS_Z); const float* ZG = (const float*)(F.ws + WS_ZG);
    bf16* AQ = (bf16*)(F.ws + WS_AQ); bf16* AK = (bf16*)(F.ws + WS_AK); bf16* AV = (bf16*)(F.ws + WS_AV);
    bf16* DQ = (bf16*)(F.ws + WS_DQ); bf16* DK = (bf16*)(F.ws + WS_DK); bf16* DV = (bf16*)(F.ws + WS_DV);
    float* DG = (float*)(F.ws + WS_DGB); float* DB = DG + 16 * MROWS;
    const float* conv_w = A.in[16] + (size_t)l * 5 * 3072;
    const float* a_log = A.in[17] + l * 16; const float* dt_bias = A.in[18] + l * 16;
    constexpr float C2 = 0.125f * 1.4426950408889634f;
    for (int g_ = gw; g_ < (MROWS / 4) * REP_ROWS; g_ += NGW) {
        const int r0 = (g_ % (MROWS / 4)) * 4;
        const bool lat = r0 >= CTXL; const int lo = lat ? CTXL : 0, hi = lat ? MROWS : CTXL;
        for (int it = 0; it < 6; ++it) {
            const int ch0 = it * 512 + lane * 8, p = it >> 1;
            v4u xr[8];
#pragma unroll
            for (int j = 0; j < 8; ++j) { const int rr = r0 + j - 2; xr[j] = (rr >= lo && rr < hi) ? *(const v4u*)(Z + (size_t)rr * ZP + C_EQ + ch0) : (v4u){0u, 0u, 0u, 0u}; }
            float acc[4][8];
#pragma unroll
            for (int j = 0; j < 4; ++j)
#pragma unroll
                for (int e = 0; e < 8; ++e) acc[j][e] = 0.f;
#pragma unroll
            for (int i = 0; i < 5; ++i) {
                const f32x4 c0 = *(const f32x4*)(conv_w + i * 3072 + ch0), c1 = *(const f32x4*)(conv_w + i * 3072 + ch0 + 4);
#pragma unroll
                for (int j = 0; j < 4; ++j) { const v4u x = xr[j + i];
                    acc[j][0] += bflo(x.x) * c0.x; acc[j][1] += bfhi(x.x) * c0.y; acc[j][2] += bflo(x.y) * c0.z; acc[j][3] += bfhi(x.y) * c0.w;
                    acc[j][4] += bflo(x.z) * c1.x; acc[j][5] += bfhi(x.z) * c1.y; acc[j][6] += bflo(x.w) * c1.z; acc[j][7] += bfhi(x.w) * c1.w; }
            }
            bf16* dstb = (p == 0 ? DQ : p == 1 ? DK : DV) + (ch0 & 1023);
#pragma unroll
            for (int j = 0; j < 4; ++j) {
                float sv[8]; float ss = 0.f;
#pragma unroll
                for (int e = 0; e < 8; ++e) { sv[e] = siluf_(acc[j][e]); ss += sv[e] * sv[e]; }
                if (p < 2) {
                    ss += __shfl_xor(ss, 1); ss += __shfl_xor(ss, 2); ss += __shfl_xor(ss, 4); ss += __shfl_xor(ss, 8);
                    const float sc = __builtin_amdgcn_rsqf(ss + 1e-6f) * (p == 0 ? 0.08838834764831845f : 1.0f);
#pragma unroll
                    for (int e = 0; e < 8; ++e) sv[e] *= sc;
                }
                v4u o; o.x = pk2(sv[0], sv[1]); o.y = pk2(sv[2], sv[3]); o.z = pk2(sv[4], sv[5]); o.w = pk2(sv[6], sv[7]);
                *(v4u*)(dstb + (size_t)(r0 + j) * 1024) = o;
            }
        }
        {
            const int r = r0 + (lane >> 4), gi = lane & 15;
            const float a = ZG[(size_t)r * 64 + 32 + gi], bt = ZG[(size_t)r * 64 + 48 + gi];
            const float xs = a + dt_bias[gi];
            const float sp = xs > 20.f ? xs : log1pf(expf(xs));
            DG[(size_t)gi * MROWS + r] = -expf(a_log[gi]) * sp;
            DB[(size_t)gi * MROWS + r] = 1.0f / (1.0f + expf(-bt));
        }
        for (int j = 0; j < 4; ++j) {
            const int r = r0 + j, t = r - CTXL; const bf16* zr = Z + (size_t)r * ZP;
            const v4u qv = *(const v4u*)(zr + C_DQ + lane * 8), kv = *(const v4u*)(zr + C_DK + lane * 8), vv = *(const v4u*)(zr + C_DV + lane * 8);
            *(v4u*)(AV + (size_t)r * 512 + lane * 8) = vv;
            float q[8], k[8];
            q[0] = bflo(qv.x); q[1] = bfhi(qv.x); q[2] = bflo(qv.y); q[3] = bfhi(qv.y); q[4] = bflo(qv.z); q[5] = bfhi(qv.z); q[6] = bflo(qv.w); q[7] = bfhi(qv.w);
            k[0] = bflo(kv.x); k[1] = bfhi(kv.x); k[2] = bflo(kv.y); k[3] = bfhi(kv.y); k[4] = bflo(kv.z); k[5] = bfhi(kv.z); k[6] = bflo(kv.w); k[7] = bfhi(kv.w);
            if (lat) {
                const int sub = lane & 3, part = (lane >> 2) & 1; const float pos = (float)(part ? (t & 63) : (t >> 6));
                const float sgn = (sub & 2) ? 1.0f : -1.0f;
#pragma unroll
                for (int e = 0; e < 8; ++e) {
                    const float qp = __shfl_xor(q[e], 2), kp = __shfl_xor(k[e], 2);
                    const int i = (sub & 1) * 8 + e;
                    const float inv = __builtin_amdgcn_exp2f(-(float)i * 0.8304820237218406f);
                    const float rev = (pos * inv) * 0.15915494309189535f;
                    const float cs = __builtin_amdgcn_cosf(rev), sn = __builtin_amdgcn_sinf(rev);
                    q[e] = q[e] * cs + sgn * qp * sn; k[e] = k[e] * cs + sgn * kp * sn;
                }
            }
            v4u qo, ko;
            qo.x = pk2(q[0] * C2, q[1] * C2); qo.y = pk2(q[2] * C2, q[3] * C2); qo.z = pk2(q[4] * C2, q[5] * C2); qo.w = pk2(q[6] * C2, q[7] * C2);
            ko.x = pk2(k[0], k[1]); ko.y = pk2(k[2], k[3]); ko.z = pk2(k[4], k[5]); ko.w = pk2(k[6], k[7]);
            *(v4u*)(AQ + (size_t)r * 512 + lane * 8) = qo; *(v4u*)(AK + (size_t)r * 512 + lane * 8) = ko;
        }
    }
}

__device__ __forceinline__ int scan_row(int dir, int n, int i) {
    if (dir == 0) return 64 * n + i;
    return (n < 4 ? 64 * (3 - n) : CTXL + 64 * (127 - (n - 4))) + 63 - i;
}

__device__ __forceinline__ void gla_chain_naive(Frame& F, const Args& A, int l, int chain) {
    const int dir = chain >> 2, h = chain & 3, tid = F.tid, lane = F.lane;
    const bf16* Z = (const bf16*)(F.ws + WS_Z); const float* ZG = (const float*)(F.ws + WS_ZG);
    float* OA = (float*)(F.ws + WS_YB) + (size_t)dir * MROWS * 512;
    const float* w2 = A.in[11] + ((size_t)(l * 2 + dir) * 16) * 512 + h * 128; const float* gb = A.in[12] + (size_t)(l * 2 + dir) * 512 + h * 128;
    LAS bf16* qs = (LAS bf16*)F.lds; LAS bf16* ks = qs + 64 * 128; LAS bf16* vs = ks + 64 * 128; LAS float* eg = (LAS float*)(F.lds + 49152);
    float S[64];
#pragma unroll
    for (int d = 0; d < 64; ++d) S[d] = 0.f;
    const int col = (tid >> 6) * 32 + (lane & 31), half = lane >> 5;
    for (int n = 0; n < 132; ++n) {
        for (int p = tid; p < 1024; p += 512) { const int i = p >> 4, c8 = (p & 15) * 8; const bf16* zr = Z + (size_t)scan_row(dir, n, i) * ZP + h * 128 + c8;
            *(LAS v4u*)(qs + i * 128 + c8) = *(const v4u*)(zr + C_GQ); *(LAS v4u*)(ks + i * 128 + c8) = *(const v4u*)(zr + C_GK); *(LAS v4u*)(vs + i * 128 + c8) = *(const v4u*)(zr + C_GV); }
        {   const int i = tid >> 3, dg = (tid & 7) * 16; const float* lr = ZG + (size_t)scan_row(dir, n, i) * 64 + dir * 16;
            float x[16];
#pragma unroll
            for (int jj = 0; jj < 16; ++jj) x[jj] = gb[dg + jj];
            for (int j = 0; j < 16; ++j) { const float lv = lr[j];
#pragma unroll
                for (int jj = 0; jj < 16; ++jj) x[jj] += lv * w2[j * 512 + dg + jj]; }
#pragma unroll
            for (int jj = 0; jj < 16; ++jj) { const float ls = fminf(x[jj], 0.f) - log1pf(expf(-fabsf(x[jj]))); eg[i * 128 + dg + jj] = expf(ls * 0.0625f); }
        }
        __syncthreads();
        if (tid < 256) {
            for (int i = 0; i < 64; ++i) {
                const float vv = bf2f(vs[i * 128 + col]); float o = 0.f;
#pragma unroll
                for (int d4 = 0; d4 < 16; ++d4) {
                    const f32x4 e4 = *(const LAS f32x4*)(eg + i * 128 + half * 64 + d4 * 4);
                    const v2u k2 = *(const LAS v2u*)(ks + i * 128 + half * 64 + d4 * 4), q2 = *(const LAS v2u*)(qs + i * 128 + half * 64 + d4 * 4);
                    S[d4 * 4 + 0] = S[d4 * 4 + 0] * e4.x + bflo(k2.x) * vv; o += S[d4 * 4 + 0] * bflo(q2.x);
                    S[d4 * 4 + 1] = S[d4 * 4 + 1] * e4.y + bfhi(k2.x) * vv; o += S[d4 * 4 + 1] * bfhi(q2.x);
                    S[d4 * 4 + 2] = S[d4 * 4 + 2] * e4.z + bflo(k2.y) * vv; o += S[d4 * 4 + 2] * bflo(q2.y);
                    S[d4 * 4 + 3] = S[d4 * 4 + 3] * e4.w + bfhi(k2.y) * vv; o += S[d4 * 4 + 3] * bfhi(q2.y);
                }
                o += __shfl_xor(o, 32);
                if (half == 0) OA[(size_t)scan_row(dir, n, i) * 512 + h * 128 + col] = o * 0.08838834764831845f;
            }
        }
        __syncthreads();
    }
}
__device__ __forceinline__ void delta_chain_naive(Frame& F, const Args& A, int chain) {
    const int dir = chain >> 3, h = chain & 7, tid = F.tid, lane = F.lane;
    const bf16* DQ = (const bf16*)(F.ws + WS_DQ); const bf16* DK = (const bf16*)(F.ws + WS_DK); const bf16* DV = (const bf16*)(F.ws + WS_DV);
    const float* DG = (const float*)(F.ws + WS_DGB) + (size_t)chain * MROWS; const float* DB = (const float*)(F.ws + WS_DGB) + (size_t)(16 + chain) * MROWS;
    float* OE = (float*)(F.ws + WS_R2) + (size_t)dir * MROWS * 1024;
    LAS bf16* qs = (LAS bf16*)F.lds; LAS bf16* ks = qs + 64 * 128; LAS bf16* vs = ks + 64 * 128; LAS float* gs = (LAS float*)(F.lds + 49152);
    float S[64];
#pragma unroll
    for (int d = 0; d < 64; ++d) S[d] = 0.f;
    const int col = (tid >> 6) * 32 + (lane & 31), half = lane >> 5;
    for (int n = 0; n < 132; ++n) {
        for (int p = tid; p < 1024; p += 512) { const int i = p >> 4, c8 = (p & 15) * 8; const size_t off = (size_t)scan_row(dir, n, i) * 1024 + h * 128 + c8;
            *(LAS v4u*)(qs + i * 128 + c8) = *(const v4u*)(DQ + off); *(LAS v4u*)(ks + i * 128 + c8) = *(const v4u*)(DK + off); *(LAS v4u*)(vs + i * 128 + c8) = *(const v4u*)(DV + off); }
        if (tid < 64) { const int r = scan_row(dir, n, tid); gs[tid] = expf(DG[r]); gs[64 + tid] = DB[r]; }
        __syncthreads();
        if (tid < 256) {
            for (int i = 0; i < 64; ++i) {
                const float vv = bf2f(vs[i * 128 + col]), egv = gs[i], beta = gs[64 + i];
                float kf[64]; float kS = 0.f;
#pragma unroll
                for (int d4 = 0; d4 < 16; ++d4) { const v2u k2 = *(const LAS v2u*)(ks + i * 128 + half * 64 + d4 * 4);
                    kf[d4 * 4 + 0] = bflo(k2.x); kf[d4 * 4 + 1] = bfhi(k2.x); kf[d4 * 4 + 2] = bflo(k2.y); kf[d4 * 4 + 3] = bfhi(k2.y);
                    kS += kf[d4 * 4 + 0] * S[d4 * 4 + 0] + kf[d4 * 4 + 1] * S[d4 * 4 + 1] + kf[d4 * 4 + 2] * S[d4 * 4 + 2] + kf[d4 * 4 + 3] * S[d4 * 4 + 3]; }
                kS += __shfl_xor(kS, 32);
                const float u = beta * (vv - egv * kS); float o = 0.f;
#pragma unroll
                for (int d4 = 0; d4 < 16; ++d4) { const v2u q2 = *(const LAS v2u*)(qs + i * 128 + half * 64 + d4 * 4);
                    S[d4 * 4 + 0] = S[d4 * 4 + 0] * egv + kf[d4 * 4 + 0] * u; o += S[d4 * 4 + 0] * bflo(q2.x);
                    S[d4 * 4 + 1] = S[d4 * 4 + 1] * egv + kf[d4 * 4 + 1] * u; o += S[d4 * 4 + 1] * bfhi(q2.x);
                    S[d4 * 4 + 2] = S[d4 * 4 + 2] * egv + kf[d4 * 4 + 2] * u; o += S[d4 * 4 + 2] * bflo(q2.y);
                    S[d4 * 4 + 3] = S[d4 * 4 + 3] * egv + kf[d4 * 4 + 3] * u; o += S[d4 * 4 + 3] * bfhi(q2.y); }
                o += __shfl_xor(o, 32);
                if (half == 0) OE[(size_t)scan_row(dir, n, i) * 1024 + h * 128 + col] = o;
            }
        }
        __syncthreads();
    }
}

__device__ __forceinline__ void out_phase(Frame& F, const Args& A, int l) {
    const int gw = F.bid * 8 + F.wave, NGW = F.G * 8, lane = F.lane;
    const bf16* Z = (const bf16*)(F.ws + WS_Z); const bf16* AO = (const bf16*)(F.ws + WS_AO);
    const float* OA = (const float*)(F.ws + WS_YB); const float* OE = (const float*)(F.ws + WS_R2);
    bf16* A_ = (bf16*)(F.ws + WS_A); bf16* D_ = (bf16*)(F.ws + WS_D); bf16* E_ = (bf16*)(F.ws + WS_E);
    const float lam_init = l == 0 ? 0.2f : 0.35550906759096924f;
    const float* lp = A.in[14] + l * 256;
    const float lam = expf(wave_sum(lp[lane] * lp[64 + lane])) - expf(wave_sum(lp[128 + lane] * lp[192 + lane])) + lam_init;
    const float* gnw = A.in[13] + l * 128 + lane * 2; const float* dnw = A.in[15] + l * 128 + lane * 2; const float* enw = A.in[19] + l * 128 + lane * 2;
    const float gw0 = gnw[0], gw1 = gnw[1], dw0 = dnw[0], dw1 = dnw[1], ew0 = enw[0], ew1 = enw[1];
    for (int r = gw; r < MROWS; r += NGW) {
        const bf16* zr = Z + (size_t)r * ZP;
        for (int h = 0; h < 4; ++h) {
            const int c = h * 128 + lane * 2;
            {   const float* o0 = OA + (size_t)r * 512 + c; const float* o1 = o0 + (size_t)MROWS * 512;
                const float x0 = o0[0] + o1[0], x1 = o0[1] + o1[1];
                const float rs = __builtin_amdgcn_rsqf(wave_sum(x0 * x0 + x1 * x1) * (1.0f / 128.f) + 1e-6f);
                const unsigned g = *(const unsigned*)(zr + C_GG + c);
                *(unsigned*)(A_ + (size_t)r * 512 + c) = pk2(x0 * rs * gw0 * siluf_(bflo(g)), x1 * rs * gw1 * siluf_(bfhi(g))); }
            {   const unsigned w1 = *(const unsigned*)(AO + (size_t)r * 1024 + (h * 2) * 128 + lane * 2), w2 = *(const unsigned*)(AO + (size_t)r * 1024 + (h * 2 + 1) * 128 + lane * 2);
                const float x0 = bflo(w1) - lam * bflo(w2), x1 = bfhi(w1) - lam * bfhi(w2);
                const float rs = __builtin_amdgcn_rsqf(wave_sum(x0 * x0 + x1 * x1) * (1.0f / 128.f) + 1e-6f) * (1.0f - lam_init);
                *(unsigned*)(D_ + (size_t)r * 512 + c) = pk2(x0 * rs * dw0, x1 * rs * dw1); }
        }
        for (int h = 0; h < 8; ++h) {
            const int c = h * 128 + lane * 2;
            const float* o0 = OE + (size_t)r * 1024 + c; const float* o1 = o0 + (size_t)MROWS * 1024;
            const float x0 = o0[0] + o1[0], x1 = o0[1] + o1[1];
            const float rs = __builtin_amdgcn_rsqf(wave_sum(x0 * x0 + x1 * x1) * (1.0f / 128.f) + 1e-6f);
            const unsigned g = *(const unsigned*)(zr + C_EG + c);
            *(unsigned*)(E_ + (size_t)r * 1024 + c) = pk2(x0 * rs * ew0 * siluf_(bflo(g)), x1 * rs * ew1 * siluf_(bfhi(g)));
        }
    }
}
typedef short bf16x8_t __attribute__((ext_vector_type(8)));
#define LBAR() do { asm volatile("s_waitcnt lgkmcnt(0)" ::: "memory"); __builtin_amdgcn_s_barrier(); asm volatile("" ::: "memory"); } while (0)
constexpr int P128 = 136, P64 = 72;
template <int K> __device__ __forceinline__ f32x4 mma16(const LAS bf16* A, int lda, const LAS bf16* Bt, int ldb, f32x4 acc, int lane) {
    const int r = lane & 15, q = lane >> 4;
    const LAS bf16* ap = A + r * lda + q * 8; const LAS bf16* bp = Bt + r * ldb + q * 8;
#pragma unroll
    for (int k0 = 0; k0 < K; k0 += 32) {
        const bf16x8_t a = *(const LAS bf16x8_t*)(ap + k0), b = *(const LAS bf16x8_t*)(bp + k0);
        acc = __builtin_amdgcn_mfma_f32_16x16x32_bf16(a, b, acc, 0, 0, 0);
    }
    return acc;
}
__device__ __forceinline__ int chunk_scan_index(int dir, int c) { return dir == 0 ? c : (c < 4 ? 3 - c : 135 - c); }
__device__ __forceinline__ float wave_incl_scan(float x, int lane) {
#pragma unroll
    for (int o = 1; o < 64; o <<= 1) { const float t = __shfl_up(x, o); if (lane >= o) x += t; }
    return x;
}
constexpr size_t WS_DS = WS_W0 + W_LAYER;
constexpr size_t WS_PP = WS_DS, WS_NT = WS_DS + 66 * MiB, WS_GL = WS_DS + 132 * MiB, WS_GD = WS_GL + 1 * MiB;
constexpr size_t WS_UG = WS_H, WS_WG = WS_END, WS_GS = WS_R2, WS_BS = WS_YB;
constexpr size_t WS_END2 = WS_END + 33 * MiB;

__device__ __forceinline__ void delta_prep2_item(Frame& F, int chain, int n) {
    const int dir = chain >> 3, h = chain & 7, tid = F.tid, lane = F.lane, w = F.wave;
    const bf16* DK = (const bf16*)(F.ws + WS_DK); const bf16* DV = (const bf16*)(F.ws + WS_DV);
    const float* DG = (const float*)(F.ws + WS_DGB) + (size_t)chain * MROWS; const float* DB = (const float*)(F.ws + WS_DGB) + (size_t)(16 + chain) * MROWS;
    const size_t item = (size_t)chain * 132 + n;
    bf16* Pp = (bf16*)(F.ws + WS_PP) + item * 16384; bf16* NT = (bf16*)(F.ws + WS_NT) + item * 16384;
    bf16* Ug = (bf16*)(F.ws + WS_UG) + item * 8192; bf16* Wg = (bf16*)(F.ws + WS_WG) + item * 8192;
    LAS bf16* Ks = (LAS bf16*)(F.lds);
    LAS float* AM = (LAS float*)(F.lds + 18432);
    LAS bf16* UT = (LAS bf16*)(F.lds);
    LAS bf16* KbT = (LAS bf16*)(F.lds + 35840);
    LAS bf16* KdT = (LAS bf16*)(F.lds + 54272);
    LAS bf16* VbT = (LAS bf16*)(F.lds + 72704);
    LAS bf16* TB = (LAS bf16*)(F.lds + 91136);
    LAS bf16* WT = (LAS bf16*)(F.lds + 100352);
    LAS float* gcs = (LAS float*)(F.lds + 118784); LAS float* bts = gcs + 64;
    const int ip = tid & 31, c8 = (tid >> 5) * 8, i0 = 2 * ip, i1 = i0 + 1;
    const size_t off0 = (size_t)scan_row(dir, n, i0) * 1024 + h * 128 + c8, off1 = (size_t)scan_row(dir, n, i1) * 1024 + h * 128 + c8;
    const v4u kv0 = *(const v4u*)(DK + off0), kv1 = *(const v4u*)(DK + off1), vv0 = *(const v4u*)(DV + off0), vv1 = *(const v4u*)(DV + off1);
    if (w == 0) { const int r = scan_row(dir, n, lane); gcs[lane] = wave_incl_scan(DG[r], lane); bts[lane] = DB[r]; }
    LBAR();
    const float gclast = gcs[63];
    {
        *(LAS v4u*)(Ks + i0 * P128 + c8) = kv0; *(LAS v4u*)(Ks + i1 * P128 + c8) = kv1;
        const float bt0 = bts[i0], bt1 = bts[i1], fb0 = bt0 * __expf(gcs[i0]), fb1 = bt1 * __expf(gcs[i1]), fd0 = __expf(gclast - gcs[i0]), fd1 = __expf(gclast - gcs[i1]);
        const unsigned k0w[4] = {kv0.x, kv0.y, kv0.z, kv0.w}, k1w[4] = {kv1.x, kv1.y, kv1.z, kv1.w}, v0w[4] = {vv0.x, vv0.y, vv0.z, vv0.w}, v1w[4] = {vv1.x, vv1.y, vv1.z, vv1.w};
#pragma unroll
        for (int e = 0; e < 4; ++e) {
            const float ka0 = bflo(k0w[e]), kb0 = bfhi(k0w[e]), ka1 = bflo(k1w[e]), kb1 = bfhi(k1w[e]);
            const float va0 = bflo(v0w[e]), vb0 = bfhi(v0w[e]), va1 = bflo(v1w[e]), vb1 = bfhi(v1w[e]);
            const int ca = (c8 + 2 * e) * P64 + i0, cb = (c8 + 2 * e + 1) * P64 + i0;
            *(LAS unsigned*)(KbT + ca) = pk2(ka0 * fb0, ka1 * fb1); *(LAS unsigned*)(KbT + cb) = pk2(kb0 * fb0, kb1 * fb1);
            *(LAS unsigned*)(KdT + ca) = pk2(ka0 * fd0, ka1 * fd1); *(LAS unsigned*)(KdT + cb) = pk2(kb0 * fd0, kb1 * fd1);
            *(LAS unsigned*)(VbT + ca) = pk2(va0 * bt0, va1 * bt1); *(LAS unsigned*)(VbT + cb) = pk2(vb0 * bt0, vb1 * bt1);
        }
    }
    LBAR();
    const int r = lane & 15, q = lane >> 4;
#pragma unroll
    for (int t2 = 0; t2 < 2; ++t2) {
        const int t = w * 2 + t2, mi = t >> 2, nj = t & 3;
        const f32x4 acc = mma16<128>(Ks + 16 * mi * P128, P128, Ks + 16 * nj * P128, P128, (f32x4){0.f, 0.f, 0.f, 0.f}, lane);
        const int j = 16 * nj + r; const float gj = gcs[j];
#pragma unroll
        for (int jj = 0; jj < 4; ++jj) { const int i = 16 * mi + 4 * q + jj;
            AM[i * 68 + j] = (j < i) ? bts[i] * acc[jj] * __expf(gcs[i] - gj) : 0.f; }
    }
    LBAR();
    {
        LAS float* TM = (LAS float*)(F.lds + 119296);
        LAS float* XM = (LAS float*)(F.lds + 136704);
        if (w == 0) {
            const int b16 = 16 * (lane >> 4), c = lane & 15;
            float t[16];
#pragma unroll
            for (int i = 0; i < 16; ++i) {
                float s_ = (i == c) ? 1.f : 0.f;
#pragma unroll
                for (int j4 = 0; j4 < (i + 3) / 4; ++j4) {
                    const f32x4 a = *(const LAS f32x4*)(AM + (b16 + i) * 68 + b16 + j4 * 4);
                    if (j4 * 4 + 0 < i) s_ -= a.x * t[j4 * 4 + 0];
                    if (j4 * 4 + 1 < i) s_ -= a.y * t[j4 * 4 + 1];
                    if (j4 * 4 + 2 < i) s_ -= a.z * t[j4 * 4 + 2];
                    if (j4 * 4 + 3 < i) s_ -= a.w * t[j4 * 4 + 3];
                }
                t[i] = s_;
                TM[(b16 + i) * 68 + b16 + c] = s_;
            }
        }
        LBAR();
        const int rr = (tid >> 4) & 15, cc = tid & 15;
#pragma unroll
        for (int d = 1; d < 4; ++d) {
            for (int blk = tid >> 8; blk < 4 - d; blk += 2) {
                const int bj = blk, bi = blk + d; float x = 0.f;
                for (int k = bj; k < bi; ++k)
#pragma unroll
                    for (int m = 0; m < 16; ++m) x += AM[(16 * bi + rr) * 68 + 16 * k + m] * TM[(16 * k + m) * 68 + 16 * bj + cc];
                XM[(blk * 16 + rr) * 17 + cc] = x;
            }
            LBAR();
            for (int blk = tid >> 8; blk < 4 - d; blk += 2) {
                const int bj = blk, bi = blk + d; float x = 0.f;
#pragma unroll
                for (int m = 0; m < 16; ++m) x -= TM[(16 * bi + rr) * 68 + 16 * bi + m] * XM[(blk * 16 + m) * 17 + cc];
                TM[(16 * bi + rr) * 68 + 16 * bj + cc] = x;
            }
            LBAR();
        }
        {   const int i = tid >> 3, j0 = (tid & 7) * 8; float v[8];
#pragma unroll
            for (int e = 0; e < 8; ++e) v[e] = ((j0 + e) >> 4) > (i >> 4) ? 0.f : TM[i * 68 + j0 + e];
            v4u o; o.x = pk2(v[0], v[1]); o.y = pk2(v[2], v[3]); o.z = pk2(v[4], v[5]); o.w = pk2(v[6], v[7]);
            *(LAS v4u*)(TB + i * P64 + j0) = o; }
    }
    LBAR();
#pragma unroll
    for (int t4 = 0; t4 < 4; ++t4) {
        const int t = w * 4 + t4, mi = t >> 3, nv = t & 7;
        const f32x4 u = mma16<64>(TB + 16 * mi * P64, P64, VbT + 16 * nv * P64, P64, (f32x4){0.f, 0.f, 0.f, 0.f}, lane);
        const f32x4 ww = mma16<64>(TB + 16 * mi * P64, P64, KbT + 16 * nv * P64, P64, (f32x4){0.f, 0.f, 0.f, 0.f}, lane);
        const int c = 16 * nv + r, i0 = 16 * mi + 4 * q;
        v2u up; up.x = pk2(u[0], u[1]); up.y = pk2(u[2], u[3]);
        v2u wp; wp.x = pk2(ww[0], ww[1]); wp.y = pk2(ww[2], ww[3]);
        *(LAS v2u*)(UT + c * P64 + i0) = up; *(LAS v2u*)(WT + c * P64 + i0) = wp;
        *(v2u*)(Ug + c * 64 + i0) = up;
#pragma unroll
        for (int jj = 0; jj < 4; ++jj) Wg[(i0 + jj) * 128 + c] = (bf16)f2bf(ww[jj]);
    }
    LBAR();
#pragma unroll
    for (int t8 = 0; t8 < 8; ++t8) {
        const int mb = w, na = t8;
        const f32x4 pt = mma16<64>(WT + 16 * mb * P64, P64, KdT + 16 * na * P64, P64, (f32x4){0.f, 0.f, 0.f, 0.f}, lane);
        v2u pp; pp.x = pk2(-pt[0], -pt[1]); pp.y = pk2(-pt[2], -pt[3]);
        *(v2u*)(Pp + ((size_t)((na * 4 + (mb >> 1)) * 64 + lane)) * 8 + 4 * (mb & 1)) = pp;
        const int ma = w, nv = t8;
        const f32x4 nn = mma16<64>(KdT + 16 * ma * P64, P64, UT + 16 * nv * P64, P64, (f32x4){0.f, 0.f, 0.f, 0.f}, lane);
        v2u np; np.x = pk2(nn[0], nn[1]); np.y = pk2(nn[2], nn[3]);
        *(v2u*)(NT + (size_t)(16 * nv + r) * 128 + 16 * ma + 4 * q) = np;
    }
    if (tid == 0) ((float*)(F.ws + WS_GL))[item] = __expf(gclast);
    LBAR();
}

constexpr int CH_SLOT = 32768 + 128 * P128 * 2;
#define CH_BAR() do { asm volatile("s_waitcnt lgkmcnt(0)" ::: "memory"); __builtin_amdgcn_s_barrier(); asm volatile("" ::: "memory"); } while (0)
__device__ __forceinline__ void delta_chain(Frame& F, int chain) {
    const int tid = F.tid, lane = F.lane, w = F.wave, r = lane & 15, q = lane >> 4;
    const bf16* Pp = (const bf16*)(F.ws + WS_PP) + (size_t)chain * 132 * 16384; bf16* NT = (bf16*)(F.ws + WS_NT) + (size_t)chain * 132 * 16384;
    LAS unsigned char* ring = F.lds; LAS float* gls = (LAS float*)(F.lds + 2 * CH_SLOT);
    if (tid < 132) gls[tid] = ((const float*)(F.ws + WS_GL))[chain * 132 + tid];
    if (w >= 4) {
        const int lt = tid - 256;
        unsigned ndst[8];
#pragma unroll
        for (int k = 0; k < 8; ++k) { const int p = lt + 256 * k; ndst[k] = 32768u + (unsigned)((p >> 4) * P128 + (p & 15) * 8) * 2u; }
        v4u rp[3][8], rn[3][8];
#define CH_LOAD(set, step) do { const v4u* ps_ = (const v4u*)(Pp + (size_t)(step) * 16384) + lt; const v4u* ns_ = (const v4u*)(NT + (size_t)(step) * 16384) + lt; \
        _Pragma("unroll") for (int k = 0; k < 8; ++k) { rp[set][k] = ps_[256 * k]; rn[set][k] = ns_[256 * k]; } } while (0)
#define CH_WRITE(set, slot) do { LAS unsigned char* sb_ = ring + (slot) * CH_SLOT; \
        _Pragma("unroll") for (int k = 0; k < 8; ++k) { *(LAS v4u*)(sb_ + (lt + 256 * k) * 16) = rp[set][k]; *(LAS v4u*)(sb_ + ndst[k]) = rn[set][k]; } } while (0)
        CH_LOAD(0, 0); CH_LOAD(1, 1); CH_LOAD(2, 2);
        CH_WRITE(0, 0);
        CH_BAR();
        for (int n = 0; n < 132; n += 3) {
            if (n + 3 < 132) CH_LOAD(0, n + 3);
            CH_WRITE(1, (n + 1) & 1);
            CH_BAR();
            if (n + 4 < 132) CH_LOAD(1, n + 4);
            CH_WRITE(2, (n + 2) & 1);
            CH_BAR();
            if (n + 5 < 132) CH_LOAD(2, n + 5);
            if (n + 3 < 132) CH_WRITE(0, (n + 3) & 1);
            CH_BAR();
        }
#undef CH_LOAD
#undef CH_WRITE
    } else {
        f32x4 acc[2][8];
#pragma unroll
        for (int nb = 0; nb < 2; ++nb)
#pragma unroll
            for (int m = 0; m < 8; ++m) acc[nb][m] = (f32x4){0.f, 0.f, 0.f, 0.f};
        bf16* srow = NT + (size_t)(32 * w + r) * 128 + 4 * q;
        const unsigned noff = 32768u + (unsigned)((32 * w + r) * P128 + 4 * q) * 2u;
        CH_BAR();
        for (int n = 0; n < 132; ++n) {
            const LAS unsigned char* slot = ring + (n & 1) * CH_SLOT;
            const float gl = gls[n];
            v2u sp[2][8];
#pragma unroll
            for (int nb = 0; nb < 2; ++nb)
#pragma unroll
                for (int m = 0; m < 8; ++m) {
                    sp[nb][m].x = pk2(acc[nb][m][0], acc[nb][m][1]); sp[nb][m].y = pk2(acc[nb][m][2], acc[nb][m][3]);
                    *(v2u*)(srow + (size_t)n * 16384 + nb * 2048 + 16 * m) = sp[nb][m];
                    const v2u nv = *(const LAS v2u*)(slot + noff + nb * (16 * P128 * 2) + m * 32);
                    acc[nb][m][0] = gl * acc[nb][m][0] + bflo(nv.x); acc[nb][m][1] = gl * acc[nb][m][1] + bfhi(nv.x);
                    acc[nb][m][2] = gl * acc[nb][m][2] + bflo(nv.y); acc[nb][m][3] = gl * acc[nb][m][3] + bfhi(nv.y);
                }
#pragma unroll
            for (int kb = 0; kb < 4; ++kb) {
                const v4u bu0 = {sp[0][2 * kb].x, sp[0][2 * kb].y, sp[0][2 * kb + 1].x, sp[0][2 * kb + 1].y};
                const v4u bu1 = {sp[1][2 * kb].x, sp[1][2 * kb].y, sp[1][2 * kb + 1].x, sp[1][2 * kb + 1].y};
                const bf16x8_t b0 = __builtin_bit_cast(bf16x8_t, bu0), b1 = __builtin_bit_cast(bf16x8_t, bu1);
#pragma unroll
                for (int m = 0; m < 8; ++m) {
                    const bf16x8_t a = *(const LAS bf16x8_t*)(slot + (m * 4 + kb) * 1024 + lane * 16);
                    acc[0][m] = __builtin_amdgcn_mfma_f32_16x16x32_bf16(a, b0, acc[0][m], 0, 0, 0);
                    acc[1][m] = __builtin_amdgcn_mfma_f32_16x16x32_bf16(a, b1, acc[1][m], 0, 0, 0);
                }
            }
            CH_BAR();
        }
    }
    asm volatile("s_waitcnt vmcnt(0)" ::: "memory");
    __syncthreads();
}

__device__ __forceinline__ void delta_out_item(Frame& F, const Args& A, int l, int c, int h) {
    const int tid = F.tid, lane = F.lane, w = F.wave, r = lane & 15, q = lane >> 4;
    const bf16* DQ = (const bf16*)(F.ws + WS_DQ); const bf16* DK = (const bf16*)(F.ws + WS_DK);
    const int row0 = 64 * c;
    LAS bf16* Qs = (LAS bf16*)(F.lds);
    LAS bf16* Ks = (LAS bf16*)(F.lds + 17408);
    LAS bf16* ST = (LAS bf16*)(F.lds + 35840);
    LAS bf16* Ws = (LAS bf16*)(F.lds + 70656);
    LAS bf16* ATT = (LAS bf16*)(F.lds + 88064);
    LAS float* gcs = (LAS float*)(F.lds + 97280);
    LAS bf16* VNT = (LAS bf16*)(F.lds + 97792);
    LAS float* OS = (LAS float*)(F.lds);
    const int mi = w >> 1, nvb = 4 * (w & 1);
    f32x4 oacc[4];
#pragma unroll
    for (int k = 0; k < 4; ++k) oacc[k] = (f32x4){0.f, 0.f, 0.f, 0.f};
    for (int dir = 0; dir < 2; ++dir) {
        const int chain = dir * 8 + h, n = chunk_scan_index(dir, c);
        const size_t item = (size_t)chain * 132 + n;
        const bf16* Sg = (const bf16*)(F.ws + WS_NT) + item * 16384; const bf16* Ug = (const bf16*)(F.ws + WS_UG) + item * 8192; const bf16* Wg = (const bf16*)(F.ws + WS_WG) + item * 8192;
        const float g_in = (w == 0) ? ((const float*)(F.ws + WS_DGB))[(size_t)chain * MROWS + row0 + (dir ? 63 - lane : lane)] : 0.f;
        v2u uu[4];
#pragma unroll
        for (int k = 0; k < 4; ++k) uu[k] = *(const v2u*)(Ug + (16 * (nvb + k) + r) * 64 + (dir ? 60 - (16 * mi + 4 * q) : (16 * mi + 4 * q)));
        {   v4u rq[2], rk[2], rw[2], rs[4];
#pragma unroll
            for (int i2 = 0; i2 < 2; ++i2) { const int p = tid + 512 * i2, t = p >> 4, c8 = (p & 15) * 8; const size_t off = (size_t)(row0 + t) * 1024 + h * 128 + c8;
                if (dir == 0) { rq[i2] = *(const v4u*)(DQ + off); rk[i2] = *(const v4u*)(DK + off); }
                rw[i2] = *(const v4u*)(Wg + (size_t)(dir ? 63 - t : t) * 128 + c8); }
#pragma unroll
            for (int i4 = 0; i4 < 4; ++i4) { const int p = tid + 512 * i4; rs[i4] = *(const v4u*)(Sg + (p >> 4) * 128 + (p & 15) * 8); }
#pragma unroll
            for (int i2 = 0; i2 < 2; ++i2) { const int p = tid + 512 * i2, t = p >> 4, c8 = (p & 15) * 8;
                if (dir == 0) { *(LAS v4u*)(Qs + t * P128 + c8) = rq[i2]; *(LAS v4u*)(Ks + t * P128 + c8) = rk[i2]; }
                *(LAS v4u*)(Ws + t * P128 + c8) = rw[i2]; }
#pragma unroll
            for (int i4 = 0; i4 < 4; ++i4) { const int p = tid + 512 * i4; *(LAS v4u*)(ST + (p >> 4) * P128 + (p & 15) * 8) = rs[i4]; }
        }
        if (w == 0) { const float s_ = wave_incl_scan(g_in, lane); gcs[dir ? 63 - lane : lane] = s_; }
        LBAR();
#pragma unroll
        for (int t2 = 0; t2 < 2; ++t2) {
            const int t = w * 2 + t2, ai = t >> 2, nj = t & 3;
            const f32x4 acc = mma16<128>(Qs + 16 * ai * P128, P128, Ks + 16 * nj * P128, P128, (f32x4){0.f, 0.f, 0.f, 0.f}, lane);
            const int tj = 16 * nj + r; const float gj = gcs[tj];
#pragma unroll
            for (int jj = 0; jj < 4; ++jj) { const int ti = 16 * ai + 4 * q + jj; const bool ok = dir ? (tj >= ti) : (tj <= ti);
                ATT[ti * P64 + tj] = (bf16)f2bf(ok ? acc[jj] * __expf(gcs[ti] - gj) : 0.f); }
        }
#pragma unroll
        for (int k = 0; k < 4; ++k) {
            const int nv = nvb + k;
            const f32x4 ws = mma16<128>(Ws + 16 * mi * P128, P128, ST + 16 * nv * P128, P128, (f32x4){0.f, 0.f, 0.f, 0.f}, lane);
            const int v = 16 * nv + r, t0 = 16 * mi + 4 * q;
            float u[4];
            if (dir == 0) { u[0] = bflo(uu[k].x); u[1] = bfhi(uu[k].x); u[2] = bflo(uu[k].y); u[3] = bfhi(uu[k].y); }
            else { u[3] = bflo(uu[k].x); u[2] = bfhi(uu[k].x); u[1] = bflo(uu[k].y); u[0] = bfhi(uu[k].y); }
            v2u o; o.x = pk2(u[0] - ws[0], u[1] - ws[1]); o.y = pk2(u[2] - ws[2], u[3] - ws[3]);
            *(LAS v2u*)(VNT + v * P64 + t0) = o;
        }
        LBAR();
#pragma unroll
        for (int k = 0; k < 4; ++k) {
            const int nv = nvb + k;
            f32x4 a = mma16<128>(Qs + 16 * mi * P128, P128, ST + 16 * nv * P128, P128, (f32x4){0.f, 0.f, 0.f, 0.f}, lane);
#pragma unroll
            for (int jj = 0; jj < 4; ++jj) a[jj] *= __expf(gcs[16 * mi + 4 * q + jj]);
            a = mma16<64>(ATT + 16 * mi * P64, P64, VNT + 16 * nv * P64, P64, a, lane);
            oacc[k] += a;
        }
        LBAR();
    }
#pragma unroll
    for (int k = 0; k < 4; ++k)
#pragma unroll
        for (int jj = 0; jj < 4; ++jj) OS[(16 * mi + 4 * q + jj) * 132 + 16 * (nvb + k) + r] = oacc[k][jj];
    LBAR();
    {   const float* enw = A.in[19] + l * 128 + lane * 2; const float ew0 = enw[0], ew1 = enw[1];
        const bf16* Z = (const bf16*)(F.ws + WS_Z); bf16* E_ = (bf16*)(F.ws + WS_E);
        unsigned gz[8];
#pragma unroll
        for (int t8 = 0; t8 < 8; ++t8) gz[t8] = *(const unsigned*)(Z + (size_t)(row0 + w * 8 + t8) * ZP + C_EG + h * 128 + lane * 2);
#pragma unroll
        for (int t8 = 0; t8 < 8; ++t8) { const int t = w * 8 + t8;
            const float x0 = OS[t * 132 + lane * 2], x1 = OS[t * 132 + lane * 2 + 1];
            const float rs = __builtin_amdgcn_rsqf(wave_sum(x0 * x0 + x1 * x1) * (1.0f / 128.f) + 1e-6f);
            const size_t row = row0 + t; const unsigned g = gz[t8];
            *(unsigned*)(E_ + row * 1024 + h * 128 + lane * 2) = pk2(x0 * rs * ew0 * siluf_(bflo(g)), x1 * rs * ew1 * siluf_(bfhi(g)));
        }
    }
    LBAR();
}
constexpr int NIN_MAIN = 13824;
__device__ __forceinline__ void g1_tail_item(Frame& F, int it) {
    const int tid = F.tid, lane = F.lane, w = F.wave, r = lane & 15, q = lane >> 4;
    const bf16* Hm = (const bf16*)(F.ws + WS_H) + (size_t)(64 * it) * DM_;
    const bf16* Wt = (const bf16*)(F.ws + WS_W0 + WO_IN) + (size_t)NIN_MAIN * DM_;
    LAS bf16* As = (LAS bf16*)F.lds; LAS bf16* Bs = As + 64 * 264;
    f32x4 acc[2] = {(f32x4){0.f, 0.f, 0.f, 0.f}, (f32x4){0.f, 0.f, 0.f, 0.f}};
    v4u pa[4], pb[4];
#pragma unroll
    for (int k = 0; k < 4; ++k) { const int p = tid + 512 * k, row = p >> 5, c8 = (p & 31) * 8; pa[k] = *(const v4u*)(Hm + (size_t)row * DM_ + c8); pb[k] = *(const v4u*)(Wt + (size_t)row * DM_ + c8); }
    for (int kc = 0; kc < 8; ++kc) {
#pragma unroll
        for (int k = 0; k < 4; ++k) { const int p = tid + 512 * k, row = p >> 5, c8 = (p & 31) * 8; *(LAS v4u*)(As + row * 264 + c8) = pa[k]; *(LAS v4u*)(Bs + row * 264 + c8) = pb[k]; }
        __syncthreads();
        if (kc + 1 < 8) {
#pragma unroll
            for (int k = 0; k < 4; ++k) { const int p = tid + 512 * k, row = p >> 5, c8 = (p & 31) * 8 + (kc + 1) * 256; pa[k] = *(const v4u*)(Hm + (size_t)row * DM_ + c8); pb[k] = *(const v4u*)(Wt + (size_t)row * DM_ + c8); }
        }
#pragma unroll
        for (int t2 = 0; t2 < 2; ++t2) { const int t = w * 2 + t2, mi = t >> 2, nj = t & 3;
            acc[t2] = mma16<256>(As + 16 * mi * 264, 264, Bs + 16 * nj * 264, 264, acc[t2], lane); }
        __syncthreads();
    }
    bf16* Z = (bf16*)(F.ws + WS_Z);
#pragma unroll
    for (int t2 = 0; t2 < 2; ++t2) { const int t = w * 2 + t2, mi = t >> 2, nj = t & 3;
#pragma unroll
        for (int jj = 0; jj < 4; ++jj) Z[(size_t)(64 * it + 16 * mi + 4 * q + jj) * ZP + NIN_MAIN + 16 * nj + r] = (bf16)f2bf(acc[t2][jj]); }
}

__device__ __forceinline__ f32x4 small_mm_acc(Frame& F, const bf16* Ap, int lda, const bf16* Bp, int ldb, int K, f32x4 acc) {
    const int tid = F.tid, lane = F.lane, w = F.wave;
    LAS bf16* As = (LAS bf16*)F.lds; LAS bf16* Bs = As + 32 * 264;
    v4u pa[2][2], pb[2][4];
#define SM_LOAD(set, kc_) do { \
    _Pragma("unroll") for (int k = 0; k < 2; ++k) { const int p = tid + 512 * k, row = p >> 5, c8 = (p & 31) * 8 + (kc_) * 256; pa[set][k] = *(const v4u*)(Ap + (size_t)row * lda + c8); } \
    _Pragma("unroll") for (int k = 0; k < 4; ++k) { const int p = tid + 512 * k, row = p >> 5, c8 = (p & 31) * 8 + (kc_) * 256; pb[set][k] = *(const v4u*)(Bp + (size_t)row * ldb + c8); } } while (0)
#define SM_STEP(set, kc_) do { \
    _Pragma("unroll") for (int k = 0; k < 2; ++k) { const int p = tid + 512 * k, row = p >> 5, c8 = (p & 31) * 8; *(LAS v4u*)(As + row * 264 + c8) = pa[set][k]; } \
    _Pragma("unroll") for (int k = 0; k < 4; ++k) { const int p = tid + 512 * k, row = p >> 5, c8 = (p & 31) * 8; *(LAS v4u*)(Bs + row * 264 + c8) = pb[set][k]; } \
    LBAR(); \
    if ((kc_) + 2 < nk) SM_LOAD(set, (kc_) + 2); \
    acc = mma16<256>(As + 16 * (w >> 2) * 264, 264, Bs + 16 * (w & 3) * 264, 264, acc, lane); \
    LBAR(); } while (0)
    const int nk = K >> 8;
    SM_LOAD(0, 0); SM_LOAD(1, 1);
    for (int kc = 0; kc < nk; kc += 2) { SM_STEP(0, kc); SM_STEP(1, kc + 1); }
#undef SM_LOAD
#undef SM_STEP
    return acc;
}
__device__ __forceinline__ void ctx_f32_item(Frame& F, int it, const bf16* A, int K, const bf16* Bt, bf16* Y) {
    const int rt = it >> 5, ct = it & 31, lane = F.lane, w = F.wave, r = lane & 15, q = lane >> 4;
    const f32x4 acc = small_mm_acc(F, A + (size_t)(32 * rt) * K, K, Bt + (size_t)(64 * ct) * K, K, K, (f32x4){0.f, 0.f, 0.f, 0.f});
#pragma unroll
    for (int jj = 0; jj < 4; ++jj) Y[(size_t)(32 * rt + 16 * (w >> 2) + 4 * q + jj) * DM_ + 64 * ct + 16 * (w & 3) + r] = (bf16)f2bf(acc[jj]);
}
__device__ __forceinline__ void ctx_g2_item(Frame& F, int it) {
    const int rt = it >> 5, ct = it & 31, lane = F.lane, w = F.wave, r = lane & 15, q = lane >> 4;
    unsigned char* ws = F.ws; unsigned char* wb = ws + WS_W0;
    const bf16* Zm = (const bf16*)(ws + WS_Z) + C_MG;
    const int col = 64 * ct + 16 * (w & 3) + r, rowb = 32 * rt + 16 * (w >> 2) + 4 * q;
    f32x4 tot = {0.f, 0.f, 0.f, 0.f};
    {   const f32x4 a = small_mm_acc(F, (const bf16*)(ws + WS_A) + (size_t)(32 * rt) * 512, 512, (const bf16*)(wb + WO_UA) + (size_t)(64 * ct) * 512, 512, 512, (f32x4){0.f, 0.f, 0.f, 0.f});
#pragma unroll
        for (int jj = 0; jj < 4; ++jj) tot[jj] += a[jj] * sigmoidf_(bf2f(Zm[(size_t)(rowb + jj) * ZP + col])); }
    {   const f32x4 a = small_mm_acc(F, (const bf16*)(ws + WS_D) + (size_t)(32 * rt) * 512, 512, (const bf16*)(wb + WO_UD) + (size_t)(64 * ct) * 512, 512, 512, (f32x4){0.f, 0.f, 0.f, 0.f});
#pragma unroll
        for (int jj = 0; jj < 4; ++jj) tot[jj] += a[jj] * sigmoidf_(bf2f(Zm[(size_t)(rowb + jj) * ZP + DM_ + col])); }
    {   const f32x4 a = small_mm_acc(F, (const bf16*)(ws + WS_E) + (size_t)(32 * rt) * 1024, 1024, (const bf16*)(wb + WO_UE) + (size_t)(64 * ct) * 1024, 1024, 1024, (f32x4){0.f, 0.f, 0.f, 0.f});
#pragma unroll
        for (int jj = 0; jj < 4; ++jj) tot[jj] += a[jj] * sigmoidf_(bf2f(Zm[(size_t)(rowb + jj) * ZP + 2 * DM_ + col])); }
    bf16* YB = (bf16*)(ws + WS_YB);
#pragma unroll
    for (int jj = 0; jj < 4; ++jj) YB[(size_t)(rowb + jj) * DM_ + col] = (bf16)f2bf(tot[jj]);
}

__device__ __forceinline__ void gla_cum_decay(Frame& F, const Args& A, int l, int dir, int h, int row0, LAS float* bs, LAS float* part, float* bsg) {
    const int tg = F.wave >> 1, d = (F.wave & 1) * 64 + F.lane;
    const float* ZG = (const float*)(F.ws + WS_ZG);
    const float* w2 = A.in[11] + ((size_t)(l * 2 + dir) * 16) * 512 + h * 128 + d; const float bd = A.in[12][(size_t)(l * 2 + dir) * 512 + h * 128 + d];
    float wc[16], g[16];
#pragma unroll
    for (int j = 0; j < 16; ++j) wc[j] = w2[j * 512];
    LAS float* lrs = part + 512;
    {   const int t = F.tid >> 3, j2 = (F.tid & 7) * 2; const float* src = ZG + (size_t)(row0 + t) * 64 + dir * 16 + j2; lrs[t * 16 + j2] = src[0]; lrs[t * 16 + j2 + 1] = src[1]; }
    LBAR();
#pragma unroll
    for (int k = 0; k < 16; ++k) {
        const LAS float* lr = lrs + (tg * 16 + k) * 16;
        float x = bd;
#pragma unroll
        for (int j = 0; j < 16; ++j) x += lr[j] * wc[j];
        g[k] = (fminf(x, 0.f) - __logf(1.0f + __expf(-fabsf(x)))) * 0.0625f;
    }
    float run = 0.f;
    if (dir == 0) {
#pragma unroll
        for (int k = 0; k < 16; ++k) { run += g[k]; g[k] = run; }
    } else {
#pragma unroll
        for (int k = 15; k >= 0; --k) { run += g[k]; g[k] = run; }
    }
    part[tg * 128 + d] = run;
    LBAR();
    float off = 0.f;
#pragma unroll
    for (int t2 = 0; t2 < 4; ++t2) { const float pv = part[t2 * 128 + d]; if (dir == 0 ? (t2 < tg) : (t2 > tg)) off += pv; }
#pragma unroll
    for (int k = 0; k < 16; ++k) { bs[(tg * 16 + k) * 128 + d] = g[k] + off; bsg[(tg * 16 + k) * 128 + d] = g[k] + off; }
    LBAR();
}
__device__ __forceinline__ void gla_prep2_item(Frame& F, const Args& A, int l, int chain, int c) {
    const int dir = chain >> 2, h = chain & 3, tid = F.tid, lane = F.lane, w = F.wave, r = lane & 15, q = lane >> 4;
    const bf16* Z = (const bf16*)(F.ws + WS_Z);
    const int row0 = 64 * c, n = chunk_scan_index(dir, c);
    LAS float* bs = (LAS float*)F.lds;
    LAS bf16* KdT = (LAS bf16*)(F.lds + 32768);
    LAS bf16* VT = (LAS bf16*)(F.lds + 51200);
    gla_cum_decay(F, A, l, dir, h, row0, bs, (LAS float*)(F.lds + 69632), (float*)(F.ws + WS_BS) + ((size_t)chain * 132 + chunk_scan_index(dir, c)) * 8192);
    const int tl = dir ? 0 : 63;
    {   const int ip = tid & 31, c8 = (tid >> 5) * 8, t0 = 2 * ip, t1 = t0 + 1;
        const bf16* z0 = Z + (size_t)(row0 + t0) * ZP + h * 128 + c8; const bf16* z1 = z0 + ZP;
        const v4u kv0 = *(const v4u*)(z0 + C_GK), kv1 = *(const v4u*)(z1 + C_GK), vv0 = *(const v4u*)(z0 + C_GV), vv1 = *(const v4u*)(z1 + C_GV);
        const unsigned k0w[4] = {kv0.x, kv0.y, kv0.z, kv0.w}, k1w[4] = {kv1.x, kv1.y, kv1.z, kv1.w}, v0w[4] = {vv0.x, vv0.y, vv0.z, vv0.w}, v1w[4] = {vv1.x, vv1.y, vv1.z, vv1.w};
#pragma unroll
        for (int e = 0; e < 4; ++e) {
            const int d0 = c8 + 2 * e, d1 = d0 + 1;
            const float bl0 = bs[tl * 128 + d0], bl1 = bs[tl * 128 + d1];
            *(LAS unsigned*)(KdT + d0 * P64 + t0) = pk2(bflo(k0w[e]) * __expf(bl0 - bs[t0 * 128 + d0]), bflo(k1w[e]) * __expf(bl0 - bs[t1 * 128 + d0]));
            *(LAS unsigned*)(KdT + d1 * P64 + t0) = pk2(bfhi(k0w[e]) * __expf(bl1 - bs[t0 * 128 + d1]), bfhi(k1w[e]) * __expf(bl1 - bs[t1 * 128 + d1]));
            *(LAS unsigned*)(VT + d0 * P64 + t0) = (v0w[e] & 0xffffu) | (v1w[e] << 16);
            *(LAS unsigned*)(VT + d1 * P64 + t0) = (v0w[e] >> 16) | (v1w[e] & 0xffff0000u);
        }
    }
    LBAR();
    const size_t item = (size_t)chain * 132 + n;
    float* GS = (float*)(F.ws + WS_GS) + item * 16384;
#pragma unroll
    for (int t8 = 0; t8 < 8; ++t8) {
        const int mv = w, na = t8;
        const f32x4 d = mma16<64>(VT + 16 * mv * P64, P64, KdT + 16 * na * P64, P64, (f32x4){0.f, 0.f, 0.f, 0.f}, lane);
#pragma unroll
        for (int jj = 0; jj < 4; ++jj) GS[(16 * mv + 4 * q + jj) * 128 + 16 * na + r] = d[jj];
    }
    if (tid < 128) ((float*)(F.ws + WS_GD))[item * 128 + tid] = __expf(bs[tl * 128 + tid]);
    LBAR();
}
__device__ __forceinline__ void gla_scan_item(Frame& F, int it) {
    const int chain = it >> 3, e4 = (it & 7) * 512 + F.tid, v = e4 >> 5, a4 = (e4 & 31) * 4;
    float* p = (float*)(F.ws + WS_GS) + (size_t)chain * 132 * 16384 + v * 128 + a4;
    const float* gd = (const float*)(F.ws + WS_GD) + (size_t)chain * 132 * 128 + a4;
    f32x4 S = {0.f, 0.f, 0.f, 0.f};
    for (int n = 0; n < 132; n += 12) {
        f32x4 x[12]; f32x4 d[12];
#pragma unroll
        for (int k = 0; k < 12; ++k) { x[k] = *(const f32x4*)(p + (size_t)(n + k) * 16384); d[k] = *(const f32x4*)(gd + (n + k) * 128); }
#pragma unroll
        for (int k = 0; k < 12; ++k) { *(f32x4*)(p + (size_t)(n + k) * 16384) = S; S = S * d[k] + x[k]; }
    }
}
__device__ __forceinline__ void gla_out_item(Frame& F, const Args& A, int l, int c, int h) {
    const int tid = F.tid, lane = F.lane, w = F.wave, r = lane & 15, q = lane >> 4;
    const bf16* Z = (const bf16*)(F.ws + WS_Z);
    const int row0 = 64 * c;
    LAS float* bs = (LAS float*)F.lds;
    LAS bf16* Qt = (LAS bf16*)(F.lds + 32768);
    LAS bf16* Kt = (LAS bf16*)(F.lds + 50176);
    LAS bf16* VT = (LAS bf16*)(F.lds + 67584);
    LAS bf16* ST = (LAS bf16*)(F.lds + 86016);
    LAS bf16* ATT = (LAS bf16*)(F.lds + 120832);
    LAS float* OS = (LAS float*)F.lds;
    const int mi = w >> 1, nvb = 4 * (w & 1);
    f32x4 oacc[4];
#pragma unroll
    for (int k = 0; k < 4; ++k) oacc[k] = (f32x4){0.f, 0.f, 0.f, 0.f};
    for (int dir = 0; dir < 2; ++dir) {
        const int chain = dir * 4 + h, n = chunk_scan_index(dir, c);
        const float* Sg = (const float*)(F.ws + WS_GS) + ((size_t)chain * 132 + n) * 16384;
        const float* bsg = (const float*)(F.ws + WS_BS) + ((size_t)chain * 132 + n) * 8192;
        {
            v4u qv[2], kv[2]; f32x4 bA[2], bB[2], sv[8]; v4u vv0 = {0u, 0u, 0u, 0u}, vv1 = {0u, 0u, 0u, 0u};
#pragma unroll
            for (int i2 = 0; i2 < 2; ++i2) { const int p = tid + 512 * i2, t = p >> 4, c8 = (p & 15) * 8; const bf16* zr = Z + (size_t)(row0 + t) * ZP + h * 128 + c8;
                qv[i2] = *(const v4u*)(zr + C_GQ); kv[i2] = *(const v4u*)(zr + C_GK); bA[i2] = *(const f32x4*)(bsg + t * 128 + c8); bB[i2] = *(const f32x4*)(bsg + t * 128 + c8 + 4); }
#pragma unroll
            for (int i8 = 0; i8 < 8; ++i8) { const int p = tid + 512 * i8; sv[i8] = *(const f32x4*)(Sg + (p >> 5) * 128 + (p & 31) * 4); }
            const int ipv = tid & 31, c8v = (tid >> 5) * 8, t0v = 2 * ipv;
            if (dir == 0) { const bf16* z0 = Z + (size_t)(row0 + t0v) * ZP + h * 128 + c8v + C_GV; vv0 = *(const v4u*)z0; vv1 = *(const v4u*)(z0 + ZP); }
#pragma unroll
            for (int i2 = 0; i2 < 2; ++i2) { const int p = tid + 512 * i2, t = p >> 4, c8 = (p & 15) * 8;
                const unsigned qw[4] = {qv[i2].x, qv[i2].y, qv[i2].z, qv[i2].w}, kw[4] = {kv[i2].x, kv[i2].y, kv[i2].z, kv[i2].w};
                const float bb[8] = {bA[i2].x, bA[i2].y, bA[i2].z, bA[i2].w, bB[i2].x, bB[i2].y, bB[i2].z, bB[i2].w};
                unsigned qo[4], ko[4];
#pragma unroll
                for (int e = 0; e < 4; ++e) { const float b0 = bb[2 * e], b1 = bb[2 * e + 1];
                    qo[e] = pk2(bflo(qw[e]) * __expf(b0), bfhi(qw[e]) * __expf(b1)); ko[e] = pk2(bflo(kw[e]) * __expf(-b0), bfhi(kw[e]) * __expf(-b1)); }
                *(LAS v4u*)(Qt + t * P128 + c8) = (v4u){qo[0], qo[1], qo[2], qo[3]}; *(LAS v4u*)(Kt + t * P128 + c8) = (v4u){ko[0], ko[1], ko[2], ko[3]}; }
            if (dir == 0) {
                const unsigned v0w[4] = {vv0.x, vv0.y, vv0.z, vv0.w}, v1w[4] = {vv1.x, vv1.y, vv1.z, vv1.w};
#pragma unroll
                for (int e = 0; e < 4; ++e) {
                    *(LAS unsigned*)(VT + (c8v + 2 * e) * P64 + t0v) = (v0w[e] & 0xffffu) | (v1w[e] << 16);
                    *(LAS unsigned*)(VT + (c8v + 2 * e + 1) * P64 + t0v) = (v0w[e] >> 16) | (v1w[e] & 0xffff0000u); }
            }
#pragma unroll
            for (int i8 = 0; i8 < 8; ++i8) { const int p = tid + 512 * i8; v2u o; o.x = pk2(sv[i8].x, sv[i8].y); o.y = pk2(sv[i8].z, sv[i8].w);
                *(LAS v2u*)(ST + (p >> 5) * P128 + (p & 31) * 4) = o; }
        }
        LBAR();
#pragma unroll
        for (int t2 = 0; t2 < 2; ++t2) {
            const int t = w * 2 + t2, ai = t >> 2, nj = t & 3;
            const f32x4 acc = mma16<128>(Qt + 16 * ai * P128, P128, Kt + 16 * nj * P128, P128, (f32x4){0.f, 0.f, 0.f, 0.f}, lane);
            const int tj = 16 * nj + r;
#pragma unroll
            for (int jj = 0; jj < 4; ++jj) { const int ti = 16 * ai + 4 * q + jj; const bool ok = dir ? (tj >= ti) : (tj <= ti);
                ATT[ti * P64 + tj] = (bf16)f2bf(ok ? acc[jj] : 0.f); }
        }
        LBAR();
#pragma unroll
        for (int k = 0; k < 4; ++k) {
            const int nv = nvb + k;
            oacc[k] = mma16<64>(ATT + 16 * mi * P64, P64, VT + 16 * nv * P64, P64, oacc[k], lane);
            oacc[k] = mma16<128>(Qt + 16 * mi * P128, P128, ST + 16 * nv * P128, P128, oacc[k], lane);
        }
        LBAR();
    }
#pragma unroll
    for (int k = 0; k < 4; ++k)
#pragma unroll
        for (int jj = 0; jj < 4; ++jj) OS[(16 * mi + 4 * q + jj) * 132 + 16 * (nvb + k) + r] = oacc[k][jj] * 0.08838834764831845f;
    LBAR();
    {   const float* gnw = A.in[13] + l * 128 + lane * 2; const float gw0 = gnw[0], gw1 = gnw[1];
        bf16* A_ = (bf16*)(F.ws + WS_A);
        unsigned gz[8];
#pragma unroll
        for (int t8 = 0; t8 < 8; ++t8) gz[t8] = *(const unsigned*)(Z + (size_t)(row0 + w * 8 + t8) * ZP + C_GG + h * 128 + lane * 2);
#pragma unroll
        for (int t8 = 0; t8 < 8; ++t8) { const int t = w * 8 + t8;
            const float x0 = OS[t * 132 + lane * 2], x1 = OS[t * 132 + lane * 2 + 1];
            const float rs = __builtin_amdgcn_rsqf(wave_sum(x0 * x0 + x1 * x1) * (1.0f / 128.f) + 1e-6f);
            const size_t row = row0 + t; const unsigned g = gz[t8];
            *(unsigned*)(A_ + row * 512 + h * 128 + lane * 2) = pk2(x0 * rs * gw0 * siluf_(bflo(g)), x1 * rs * gw1 * siluf_(bfhi(g)));
        }
    }
    LBAR();
}
__device__ __forceinline__ void diff_out_rows(Frame& F, const Args& A, int l) {
    const int gw = F.bid * 8 + F.wave, NGW = F.G * 8, lane = F.lane;
    const bf16* AO = (const bf16*)(F.ws + WS_AO); bf16* D_ = (bf16*)(F.ws + WS_D);
    const float lam_init = l == 0 ? 0.2f : 0.35550906759096924f;
    const float* lp = A.in[14] + l * 256;
    const float lam = expf(wave_sum(lp[lane] * lp[64 + lane])) - expf(wave_sum(lp[128 + lane] * lp[192 + lane])) + lam_init;
    const float* dnw = A.in[15] + l * 128 + lane * 2; const float dw0 = dnw[0], dw1 = dnw[1];
    for (int r = gw + (l == 1 ? CTXL : 0); r < MROWS; r += NGW) {
        unsigned wa[4], wb_[4];
#pragma unroll
        for (int h = 0; h < 4; ++h) { wa[h] = *(const unsigned*)(AO + (size_t)r * 1024 + (h * 2) * 128 + lane * 2); wb_[h] = *(const unsigned*)(AO + (size_t)r * 1024 + (h * 2 + 1) * 128 + lane * 2); }
#pragma unroll
        for (int h = 0; h < 4; ++h) {
            const int c = h * 128 + lane * 2;
            const unsigned w1 = wa[h], w2 = wb_[h];
            const float x0 = bflo(w1) - lam * bflo(w2), x1 = bfhi(w1) - lam * bfhi(w2);
            const float rs = __builtin_amdgcn_rsqf(wave_sum(x0 * x0 + x1 * x1) * (1.0f / 128.f) + 1e-6f) * (1.0f - lam_init);
            *(unsigned*)(D_ + (size_t)r * 512 + c) = pk2(x0 * rs * dw0, x1 * rs * dw1);
        }
    }
}
#ifndef MK_SINGLE
#define MK_SINGLE 1
#endif
template <int l> __device__ __forceinline__ void layer_phases(Frame& F, const Args& args, unsigned char* lds, const int lo, const int hi, const XcdBarrier& bar) {
    unsigned char* ws = args.ws;
#define IN(k) (lo <= (k) && (k) < hi)
#define SEAM(k) do { if (IN(k) && IN((k) + 1)) { xcd_barrier(bar); if (REP_SYNC > 1) xcd_barrier(bar); } } while (0)
    const int pb = 2 + 11 * l;
    unsigned char* wb = ws + WS_W0;
    if (IN(pb + 0) && !SKIP_G1) {
        pg8::Gemm g{(const bf16*)(ws + WS_H), (const bf16*)(wb + WO_IN), MROWS, NIN_MAIN, DM_}; pg8::StaticOrder S; S.init(MROWS, NIN_MAIN, F.G, F.bid); S.rep = REP_G1;
        pg8::EpiZ E{(bf16*)(ws + WS_Z), ZP, (float*)(ws + WS_ZG)};
        pg8::gemm_phase<pg8::EpiZ, pg8::StaticOrder, true, true>(F.lds, g, S, E);
    } SEAM(pb + 0);
    if (IN(pb + 1)) { if (F.bid < 132) g1_tail_item(F, F.bid); prep_phase(F, args, l); } SEAM(pb + 1);
    if (IN(pb + 2)) {
        for (int it = F.bid; it < 2112 * REP_C1; it += F.G) delta_prep2_item(F, (it % 2112) / 132, it % 132);
        for (int it = F.G - 1 - F.bid; it < 1056 * REP_C2; it += F.G) gla_prep2_item(F, args, l, (it % 1056) / 132, it % 132);
    } SEAM(pb + 2);
    if (IN(pb + 3)) {
        if (F.bid < 16) delta_chain(F, F.bid);
        else if (F.bid - 16 < 64) gla_scan_item(F, F.bid - 16);
        {
            const attn_body::bf16* AQ = (const attn_body::bf16*)(ws + WS_AQ); const attn_body::bf16* AK = (const attn_body::bf16*)(ws + WS_AK);
            const attn_body::bf16* AV = (const attn_body::bf16*)(ws + WS_AV); attn_body::bf16* AO = (attn_body::bf16*)(ws + WS_AO);
            unsigned* cnt = (unsigned*)(ws + WS_CNT) + 64 * l;
            volatile LAS unsigned* slot = (volatile LAS unsigned*)(F.lds + MISC_OFF) + 16;
            for (;;) {
                if (F.tid == 0) slot[0] = __hip_atomic_fetch_add(cnt, 1u, __ATOMIC_RELAXED, __HIP_MEMORY_SCOPE_AGENT);
                __syncthreads();
                const int ui = (int)slot[0];
                __syncthreads();
                constexpr int NU = (l == 1) ? 512 : 528;
                if (ui >= NU * REP_ATTN) break;
                const int uj = ui % NU; const int qb = 32 - uj / 16, rem = uj % 16, hm = rem >> 1, half = rem & 1;
                attn_body::attn_unit<8>(AQ + (size_t)qb * 256 * 512 + hm * 64, AK + hm * 64, AV + (hm >> 1) * 128 + half * 64,
                                        AO + (size_t)qb * 256 * 1024 + hm * 128 + half * 64, qb == 0 ? 4 : 132, (char*)lds);
            }
        }
        if (l == 0) p0_dynamic(F, args, 0, (unsigned*)(ws + WS_CNT) + 128, I_IN, PER_L);
        else p0_dynamic(F, args, 1, (unsigned*)(ws + WS_CNT) + 256, I_IN, PER_L - I_2);
    } SEAM(pb + 3);
    if (IN(pb + 4)) {
        for (int it = F.bid; it < 1056 * REP_C3; it += F.G) { if (l == 1 && ((it % 1056) >> 3) < 4) continue; delta_out_item(F, args, l, (it % 1056) >> 3, it & 7); }
        for (int it = F.G - 1 - F.bid; it < 528 * REP_C4; it += F.G) { if (l == 1 && ((it % 528) >> 2) < 4) continue; gla_out_item(F, args, l, (it % 528) >> 2, it & 3); }
        diff_out_rows(F, args, l);
    } SEAM(pb + 4);
    if (IN(pb + 5) && !SKIP_G2) {
        const bf16* Zm = (const bf16*)(ws + WS_Z) + C_MG; float* YF = (float*)(ws + WS_R2); bf16* YB = (bf16*)(ws + WS_YB);
        pg8::StaticOrder S; S.init(MROWS - CTXL, DM_, F.G, F.bid); S.pmoff = 1;
        { pg8::Gemm g{(const bf16*)(ws + WS_A), (const bf16*)(wb + WO_UA), MROWS, DM_, 512}; pg8::EpiGate<0> E{Zm, ZP, YF, YB, DM_};
          pg8::gemm_phase<pg8::EpiGate<0>, pg8::StaticOrder, true, true>(F.lds, g, S, E); }
        { pg8::Gemm g{(const bf16*)(ws + WS_D), (const bf16*)(wb + WO_UD), MROWS, DM_, 512}; pg8::EpiGate<1> E{Zm + DM_, ZP, YF, YB, DM_};
          pg8::gemm_phase<pg8::EpiGate<1>, pg8::StaticOrder, true, true>(F.lds, g, S, E); }
        { pg8::Gemm g{(const bf16*)(ws + WS_E), (const bf16*)(wb + WO_UE), MROWS, DM_, 1024}; pg8::EpiGate<2> E{Zm + 2 * DM_, ZP, YF, YB, DM_};
          pg8::gemm_phase<pg8::EpiGate<2>, pg8::StaticOrder, true, true>(F.lds, g, S, E); }
        if (l == 0) for (int it = F.bid; it < 256; it += F.G) ctx_g2_item(F, it);
    } SEAM(pb + 5);
    if (IN(pb + 6) && !SKIP_G3) {
        pg8::Gemm g{(const bf16*)(ws + WS_YB), (const bf16*)(wb + WO_O), MROWS, DM_, DM_}; pg8::StaticOrder S; S.init(MROWS - CTXL, DM_, F.G, F.bid); S.pmoff = 1; S.rep = REP_G3;
        pg8::EpiF32 E{(bf16*)(ws + WS_R2), DM_};
        pg8::gemm_phase<pg8::EpiF32, pg8::StaticOrder, true, true>(F.lds, g, S, E);
        if (l == 0) for (int it = F.bid; it < 256; it += F.G) ctx_f32_item(F, it, (const bf16*)(ws + WS_YB), DM_, (const bf16*)(wb + WO_O), (bf16*)(ws + WS_R2));
    } SEAM(pb + 6);
    if (IN(pb + 7)) { row_phase<1>(F, args, l); } SEAM(pb + 7);
    if (IN(pb + 8) && !SKIP_G4) {
        pg8::Gemm g{(const bf16*)(ws + WS_H), (const bf16*)(wb + WO_13), MROWS, 2 * DFF, DM_}; pg8::StaticOrder S; S.init(MROWS - CTXL * l, 2 * DFF, F.G, F.bid); S.pmoff = l; S.rep = REP_G4;
        pg8::EpiSwiglu E{(bf16*)(ws + WS_HFF), DFF};
        pg8::gemm_phase<pg8::EpiSwiglu, pg8::StaticOrder, true, true>(F.lds, g, S, E);
        if (l == 0) p0_dynamic(F, args, 1, (unsigned*)(ws + WS_CNT) + 192, 0, I_IN);
        else p0_dynamic(F, args, 1, (unsigned*)(ws + WS_CNT) + 320, PER_L - I_2, PER_L);
    } SEAM(pb + 8);
    if (IN(pb + 9) && !SKIP_G5) {
        pg8::Gemm g{(const bf16*)(ws + WS_HFF), (const bf16*)(wb + WO_2), MROWS, DM_, DFF}; pg8::StaticOrder S; S.init(MROWS - CTXL, DM_, F.G, F.bid); S.pmoff = 1; S.rep = REP_G5;
        pg8::EpiF32 E{(bf16*)(ws + WS_R2), DM_};
        pg8::gemm_phase<pg8::EpiF32, pg8::StaticOrder, true, true>(F.lds, g, S, E);
        if (l == 0) { for (int it = F.bid; it < 256; it += F.G) ctx_f32_item(F, it, (const bf16*)(ws + WS_HFF), DFF, (const bf16*)(wb + WO_2), (bf16*)(ws + WS_R2));
                    }
    } SEAM(pb + 9);
    if (IN(pb + 10)) { row_phase<2>(F, args, l); } SEAM(pb + 10);
#undef IN
#undef SEAM
}
__global__ void __launch_bounds__(512, 2) mega_fwd(Args args) {
    extern __shared__ __attribute__((aligned(16))) unsigned char lds[];
    Frame F;
    F.lds = (LAS unsigned char*)lds; F.tid = threadIdx.x; F.lane = F.tid & 63; F.wave = __builtin_amdgcn_readfirstlane(F.tid >> 6);
    F.G = gridDim.x; F.bid = blockIdx.x; F.ws = args.ws; F.out = args.out;
    const int lo = args.ph_lo, hi = args.ph_hi;
    if (lo < 0) cg::this_grid().sync();
    for (int u = F.tid; u < 64; u += 512) ((LAS unsigned*)(F.lds + MISC_OFF))[u] = 0u;
    __syncthreads();
    XcdBarrier bar; bar.bar = (unsigned*)(args.ws + WS_BAR); bar.x = 0; bar.st = nullptr;
    if (hi - lo > 1) bar = xcd_barrier_post((unsigned*)(args.ws + WS_BAR), (volatile LAS unsigned*)(F.lds + MISC_OFF) + 8);
#define IN(k) (lo <= (k) && (k) < hi)
#define SEAM(k) do { if (IN(k) && IN((k) + 1)) { xcd_barrier(bar); if (REP_SYNC > 1) xcd_barrier(bar); } } while (0)
    unsigned char* ws = args.ws;
    if (IN(0)) { p0_phase(F, args, 0, true, 0, I_IN); } SEAM(0);
    if (IN(1)) { row_phase<0>(F, args, 0); } SEAM(1);
    layer_phases<0>(F, args, lds, lo, hi, bar);
    layer_phases<1>(F, args, lds, lo, hi, bar);
#undef IN
#undef SEAM
}

extern "C" void kernel_launch(void* const* d_in, const int* in_sizes, int n_in, void* d_out, int out_size, void* d_ws, size_t ws_size, hipStream_t stream) {
    static int grid = 0;
    if (grid == 0) {
        if (n_in != 27 || out_size != SEQ_ * DM_ || ws_size < WS_END2) { fprintf(stderr, "kernel_launch: unexpected shapes (n_in %d, out %d, ws %zu < %zu)\n", n_in, out_size, ws_size, (size_t)WS_END2); grid = -1; return; }
        if (hipFuncSetAttribute((const void*)mega_fwd, hipFuncAttributeMaxDynamicSharedMemorySize, LDS_BYTES) != hipSuccess) { fprintf(stderr, "kernel_launch: hipFuncSetAttribute failed\n"); grid = -1; return; }
        int dev = 0, cus = 0, per_cu = 0;
        hipGetDevice(&dev); hipDeviceGetAttribute(&cus, hipDeviceAttributeMultiprocessorCount, dev);
        hipOccupancyMaxActiveBlocksPerMultiprocessor(&per_cu, (const void*)mega_fwd, 512, LDS_BYTES);
        if (per_cu < 1) { fprintf(stderr, "kernel_launch: occupancy query says %d blocks per CU\n", per_cu); per_cu = 1; }
        (void)hipGetLastError();
        grid = cus;
    }
    if (grid < 0) return;
    Args a{};
    for (int i = 0; i < 27; ++i) a.in[i] = (const float*)d_in[i];
    a.out = (float*)d_out; a.ws = (unsigned char*)d_ws;
#if MK_SINGLE
    if (hipMemsetAsync((char*)d_ws + WS_BAR, 0, BAR_BYTES, stream) != hipSuccess) { fprintf(stderr, "kernel_launch: memset failed\n"); return; }
    a.ph_lo = 0; a.ph_hi = NPH;
    void* kargs[] = {&a};
    hipError_t e = hipLaunchCooperativeKernel((const void*)mega_fwd, dim3(grid), dim3(512), kargs, LDS_BYTES, stream);
    if (e != hipSuccess) fprintf(stderr, "cooperative launch failed: %s (grid %d)\n", hipGetErrorString(e), grid);
#else
    for (int p = 0; p < NPH; ++p) { a.ph_lo = p; a.ph_hi = p + 1; hipLaunchKernelGGL(mega_fwd, dim3(grid), dim3(512), LDS_BYTES, stream, a); }
#endif
}
```
